# Optimizing an MI355X kernel written in HIP

```python
import math
import jax, jax.numpy as jnp
from jax import lax
import numpy as np

D_MODEL = 1024
BATCH = 4
SEQ = 8192
DEPTH = 1

ATTN_HEADS = 8
ATTN_HEAD_DIM = 64
ATTN_WIDTH = ATTN_HEADS * ATTN_HEAD_DIM
MOBA_BLOCK = 256
MOBA_TOPK = 3
MOBA_Q_BLOCK = 64
REL_BUCKETS = 32
REL_MAX_DISTANCE = 128
DN_HEADS = 4
DN_HEAD_K = 128
DN_HEAD_V = 128
DN_QK_WIDTH = DN_HEADS * DN_HEAD_K
DN_V_WIDTH = DN_HEADS * DN_HEAD_V
DN_CONV_WIDTH = 4
DN_CONV_CH = 2 * DN_QK_WIDTH + DN_V_WIDTH
DN_CHUNK = 64
D_MIX = ATTN_WIDTH + DN_V_WIDTH
IN_COLS = 4 * ATTN_WIDTH + DN_CONV_CH + DN_V_WIDTH + 2 * DN_HEADS
EPS = 1e-6

kernel_name = "hymba_moba_gated_deltanet_layer"


def rms_norm(x, w):
    xf = x.astype(jnp.float32)
    y = xf * lax.rsqrt(jnp.mean(xf * xf, axis=-1, keepdims=True) + EPS)
    return (y * w.astype(jnp.float32)).astype(x.dtype)


def l2_norm(x):
    xf = x.astype(jnp.float32)
    return xf * lax.rsqrt(jnp.sum(xf * xf, axis=-1, keepdims=True) + EPS)


def t5_bucket(dist):
    n = jnp.maximum(dist, 0)
    max_exact = REL_BUCKETS // 2
    nf = jnp.maximum(n, 1).astype(jnp.float32)
    large = max_exact + (jnp.log(nf / max_exact) / math.log(REL_MAX_DISTANCE / max_exact)
                         * (REL_BUCKETS - max_exact)).astype(jnp.int32)
    large = jnp.minimum(large, REL_BUCKETS - 1)
    return jnp.where(n < max_exact, n, large)


def causal_depthwise_conv(u, w):
    k_w, ch = w.shape
    return lax.conv_general_dilated(u, w[:, None, :], window_strides=(1,), padding=[(k_w - 1, 0)],
                                    dimension_numbers=('NWC', 'WIO', 'NWC'), feature_group_count=ch)


def moba_attention(q, k, v, rel_bias):
    B, H, S, D = q.shape
    nb = -(-S // MOBA_BLOCK)
    s_pad = nb * MOBA_BLOCK
    padw = ((0, 0), (0, 0), (0, s_pad - S), (0, 0))
    q, k, v = jnp.pad(q, padw), jnp.pad(k, padw), jnp.pad(v, padw)
    k_blocks = k.reshape(B, H, nb, MOBA_BLOCK, D)
    v_blocks = v.reshape(B, H, nb, MOBA_BLOCK, D)
    n_gate = max(nb, MOBA_TOPK)
    k_mean = jnp.mean(k_blocks.astype(jnp.float32), axis=3)
    k_mean = jnp.pad(k_mean, ((0, 0), (0, 0), (0, n_gate - nb), (0, 0)))
    scale = D ** -0.5
    b_ix = jnp.arange(B)[:, None, None, None]
    h_ix = jnp.arange(H)[None, :, None, None]
    blk_ar = jnp.arange(MOBA_BLOCK)
    nqb = s_pad // MOBA_Q_BLOCK
    q_sweep = jnp.moveaxis(q.reshape(B, H, nqb, MOBA_Q_BLOCK, D), 2, 0)

    def one_query_block(args):
        qb, q_blk = args
        q_pos = qb * MOBA_Q_BLOCK + jnp.arange(MOBA_Q_BLOCK)
        own = (qb * MOBA_Q_BLOCK) // MOBA_BLOCK
        gate = jnp.einsum('bhqd,bhnd->bhqn', q_blk.astype(jnp.float32), k_mean)
        gate = jnp.where(jnp.arange(n_gate) < own, gate, -jnp.inf)
        _, idx = lax.top_k(gate, MOBA_TOPK)
        valid = idx < own
        idx = jnp.minimum(idx, nb - 1)
        k_sel = k_blocks[b_ix, h_ix, idx]
        v_sel = v_blocks[b_ix, h_ix, idx]
        s_sel = jnp.einsum('bhqd,bhqsjd->bhqsj', q_blk, k_sel).astype(jnp.float32) * scale
        dist_sel = q_pos[None, None, :, None, None] - (idx[..., None] * MOBA_BLOCK + blk_ar)
        s_sel = s_sel + rel_bias[t5_bucket(dist_sel), h_ix[..., None]]
        s_sel = jnp.where(valid[..., None], s_sel, -jnp.inf)
        k_own = lax.dynamic_index_in_dim(k_blocks, own, axis=2, keepdims=False)
        v_own = lax.dynamic_index_in_dim(v_blocks, own, axis=2, keepdims=False)
        dist_own = q_pos[:, None] - (own * MOBA_BLOCK + blk_ar)[None, :]
        s_own = (jnp.einsum('bhqd,bhjd->bhqj', q_blk, k_own).astype(jnp.float32) * scale
                 + jnp.moveaxis(rel_bias[t5_bucket(dist_own)], -1, 0))
        s_own = jnp.where(dist_own >= 0, s_own, -jnp.inf)
        logits = jnp.concatenate([s_own, s_sel.reshape(B, H, MOBA_Q_BLOCK, MOBA_TOPK * MOBA_BLOCK)], axis=-1)
        p = jax.nn.softmax(logits, axis=-1).astype(v.dtype)
        p_own = p[..., :MOBA_BLOCK]
        p_sel = p[..., MOBA_BLOCK:].reshape(B, H, MOBA_Q_BLOCK, MOBA_TOPK, MOBA_BLOCK)
        return (jnp.einsum('bhqj,bhjd->bhqd', p_own, v_own)
                + jnp.einsum('bhqsj,bhqsjd->bhqd', p_sel, v_sel))

    out = lax.map(one_query_block, (jnp.arange(nqb), q_sweep))
    out = jnp.moveaxis(out, 0, 2).reshape(B, H, s_pad, D)
    return out[:, :, :S]


def gated_delta_rule_chunked(q, k, v, g, beta):
    B, H, S, DK = q.shape
    DV = v.shape[-1]
    C = DN_CHUNK
    n = S // C
    q = (q * DK ** -0.5).reshape(B, H, n, C, DK)
    k = k.reshape(B, H, n, C, DK)
    v = v.reshape(B, H, n, C, DV)
    beta = beta.reshape(B, H, n, C)
    g = jnp.cumsum(g.reshape(B, H, n, C), axis=-1)
    incl = jnp.tril(jnp.ones((C, C), dtype=bool))
    strict = jnp.tril(jnp.ones((C, C), dtype=bool), k=-1)
    diff = g[..., :, None] - g[..., None, :]
    decay = jnp.where(incl, jnp.exp(jnp.where(incl, diff, 0.0)), 0.0)
    kb = k * beta[..., None]
    lmat = jnp.where(strict, jnp.einsum('bhnid,bhnjd->bhnij', kb, k) * decay, 0.0)
    amat = lmat + jnp.eye(C, dtype=jnp.float32)
    u = lax.linalg.triangular_solve(amat, v * beta[..., None], left_side=True, lower=True, unit_diagonal=True)
    w = lax.linalg.triangular_solve(amat, kb * jnp.exp(g)[..., None], left_side=True, lower=True, unit_diagonal=True)
    a_intra = jnp.einsum('bhnid,bhnjd->bhnij', q, k) * decay
    q_dec = q * jnp.exp(g)[..., None]
    k_dec = k * jnp.exp(g[..., -1:] - g)[..., None]
    g_last = jnp.exp(g[..., -1])

    def step(state, xs):
        q_i, a_i, w_i, u_i, k_i, gl_i = xs
        v_new = u_i - jnp.einsum('bhcd,bhde->bhce', w_i, state)
        o_i = jnp.einsum('bhcd,bhde->bhce', q_i, state) + jnp.einsum('bhcj,bhje->bhce', a_i, v_new)
        state = state * gl_i[..., None, None] + jnp.einsum('bhcd,bhce->bhde', k_i, v_new)
        return state, o_i

    xs = (jnp.moveaxis(q_dec, 2, 0), jnp.moveaxis(a_intra, 2, 0), jnp.moveaxis(w, 2, 0),
          jnp.moveaxis(u, 2, 0), jnp.moveaxis(k_dec, 2, 0), jnp.moveaxis(g_last, 2, 0))
    _, o = lax.scan(step, jnp.zeros((B, H, DK, DV), jnp.float32), xs)
    return jnp.moveaxis(o, 0, 2).reshape(B, H, S, DV)


def setup_inputs(seed: int = 0) -> dict:
    key = jax.random.key(seed)
    ks = jax.random.split(key, 12)
    f32 = jnp.float32
    x = jax.random.normal(ks[0], (BATCH, SEQ, D_MODEL), f32)
    rel_bias = 0.5 * jax.random.normal(ks[1], (REL_BUCKETS, ATTN_HEADS), f32)
    norm_w = 1.0 + 0.02 * jax.random.normal(ks[2], (DEPTH, D_MODEL), f32)
    w_in = jax.random.normal(ks[3], (DEPTH, D_MODEL, IN_COLS), f32) * D_MODEL ** -0.5
    q_norm_w = 1.0 + 0.02 * jax.random.normal(ks[4], (DEPTH, ATTN_HEAD_DIM), f32)
    k_norm_w = 1.0 + 0.02 * jax.random.normal(ks[5], (DEPTH, ATTN_HEAD_DIM), f32)
    conv_w = jax.random.normal(ks[6], (DEPTH, DN_CONV_WIDTH, DN_CONV_CH), f32) * DN_CONV_WIDTH ** -0.5
    a_log = jnp.log(jax.random.uniform(ks[7], (DEPTH, DN_HEADS), f32, minval=1.0, maxval=16.0))
    dt = jnp.exp(jax.random.uniform(ks[8], (DEPTH, DN_HEADS), f32,
                                    minval=math.log(1e-3), maxval=math.log(1e-1)))
    dt_bias = dt + jnp.log(-jnp.expm1(-dt))
    dn_norm_w = 1.0 + 0.02 * jax.random.normal(ks[9], (DEPTH, DN_HEAD_V), f32)
    w_out = jax.random.normal(ks[10], (DEPTH, D_MIX, D_MODEL), f32) * D_MIX ** -0.5
    return {"x": x, "rel_bias": rel_bias, "norm_w": norm_w, "w_in": w_in,
            "q_norm_w": q_norm_w, "k_norm_w": k_norm_w, "conv_w": conv_w,
            "a_log": a_log, "dt_bias": dt_bias, "dn_norm_w": dn_norm_w, "w_out": w_out}


def reference(x, rel_bias, norm_w, w_in, q_norm_w, k_norm_w, conv_w, a_log, dt_bias, dn_norm_w, w_out):
    B, S, _ = x.shape
    splits = [ATTN_WIDTH, 2 * ATTN_WIDTH, 3 * ATTN_WIDTH, 4 * ATTN_WIDTH,
              4 * ATTN_WIDTH + DN_CONV_CH, 4 * ATTN_WIDTH + DN_CONV_CH + DN_V_WIDTH,
              4 * ATTN_WIDTH + DN_CONV_CH + DN_V_WIDTH + DN_HEADS]
    for layer in range(DEPTH):
        h = rms_norm(x, norm_w[layer])
        proj = jnp.einsum('bsd,dc->bsc', h, w_in[layer])
        q_a, k_a, v_a, z_a, qkv_dn, z_dn, b_dn, a_dn = jnp.split(proj, splits, axis=-1)

        heads_a = lambda t: t.reshape(B, S, ATTN_HEADS, ATTN_HEAD_DIM).transpose(0, 2, 1, 3)
        qa = rms_norm(heads_a(q_a), q_norm_w[layer])
        ka = rms_norm(heads_a(k_a), k_norm_w[layer])
        va = heads_a(v_a)
        o_a = moba_attention(qa, ka, va, rel_bias)
        o_a = o_a.transpose(0, 2, 1, 3).reshape(B, S, ATTN_WIDTH)
        y_a = o_a * jax.nn.silu(z_a)

        qkv_dn = jax.nn.silu(causal_depthwise_conv(qkv_dn, conv_w[layer]))
        q_d, k_d, v_d = jnp.split(qkv_dn, [DN_QK_WIDTH, 2 * DN_QK_WIDTH], axis=-1)
        q_d = l2_norm(q_d.reshape(B, S, DN_HEADS, DN_HEAD_K)).transpose(0, 2, 1, 3)
        k_d = l2_norm(k_d.reshape(B, S, DN_HEADS, DN_HEAD_K)).transpose(0, 2, 1, 3)
        v_d = v_d.reshape(B, S, DN_HEADS, DN_HEAD_V).transpose(0, 2, 1, 3).astype(jnp.float32)
        beta = jax.nn.sigmoid(b_dn.astype(jnp.float32)).transpose(0, 2, 1)
        g = (-jnp.exp(a_log[layer].astype(jnp.float32))
             * jax.nn.softplus(a_dn.astype(jnp.float32) + dt_bias[layer].astype(jnp.float32))).transpose(0, 2, 1)
        o_d = gated_delta_rule_chunked(q_d, k_d, v_d, g, beta)
        o_d = o_d.transpose(0, 2, 1, 3).astype(x.dtype)
        o_d = rms_norm(o_d, dn_norm_w[layer]).reshape(B, S, DN_V_WIDTH)
        y_d = o_d * jax.nn.silu(z_dn)

        y = jnp.concatenate([y_a, y_d], axis=-1)
        x = x + jnp.einsum('bsc,cd->bsd', y, w_out[layer])
    return x
```

```cpp
#include <hip/hip_runtime.h>
#include <stdint.h>
#include <math.h>
#include <cstdio>

typedef unsigned short bf16_t;
typedef short bf16x8 __attribute__((ext_vector_type(8)));
typedef float f32x4 __attribute__((ext_vector_type(4)));
typedef unsigned u32x4 __attribute__((ext_vector_type(4)));

constexpr int NB = 4, SEQ = 8192, DM = 1024, MTOK = NB * SEQ;
constexpr int AH = 8, AD = 64, AW = 512, NBLK = 32;
constexpr int DH = 4, DKH = 128, NCOL = 4104, DCONV = 1536;
constexpr float EPS = 1e-6f;
constexpr float LOG2E = 1.4426950408889634f;
constexpr float QSCALE = 0.125f * LOG2E;

constexpr size_t MiB = 1u << 20;
constexpr size_t WS_CTL = 0, CTL_BYTES = 1 * MiB;
constexpr size_t WS_KMEAN = 512 * 1024;
constexpr size_t WS_WT1 = 1 * MiB;
constexpr size_t WS_WT2 = 9 * MiB;
constexpr size_t WS_BETA = 11 * MiB;
constexpr size_t WS_GDEC = 11 * MiB + 512 * 1024;
constexpr size_t WS_QA = 12 * MiB, WS_KA = 44 * MiB, WS_VA = 76 * MiB;
constexpr size_t WS_ZA = 108 * MiB, WS_ZD = 140 * MiB;
constexpr size_t WS_QKVD = 172 * MiB;
constexpr size_t WS_QD = 268 * MiB, WS_KD = 300 * MiB, WS_VD = 332 * MiB;
constexpr size_t WS_REC = 268 * MiB;
constexpr size_t WS_GLB = 256 * 1024;
constexpr size_t WS_Y = 412 * MiB;
constexpr size_t WS_END = 476 * MiB;
constexpr size_t OUT_OD = 64 * MiB;

__device__ __forceinline__ unsigned short f2bf(float f) { unsigned u = __float_as_uint(f); return (unsigned short)((u + 0x7fffu + ((u >> 16) & 1u)) >> 16); }
__device__ __forceinline__ float bf2f(unsigned short u) { return __uint_as_float(((unsigned)u) << 16); }
__device__ __forceinline__ float wave_sum(float v) {
#pragma unroll
    for (int o = 1; o < 64; o <<= 1) v += __shfl_xor(v, o);
    return v;
}
__device__ __forceinline__ float silu_f(float x) { return x / (1.0f + __expf(-x)); }
__host__ __device__ __forceinline__ int wt1_ltile(int pt) { return pt < 8 ? pt : (pt < 10 ? pt + 6 : pt - 2); }
__host__ __device__ __forceinline__ int wt1_logical(int p) { const int pn = wt1_ltile(p >> 8), t = p & 255, bj = t >> 7, wc = (t >> 5) & 3, i = t & 31; return 256 * pn + 64 * wc + 32 * bj + i; }
__host__ __device__ __forceinline__ int wt1_physical(int c) { const int ln = c >> 8, pn = ln < 8 ? ln : (ln < 14 ? ln + 2 : ln - 6), wc = (c >> 6) & 3, bj = (c >> 5) & 1, i = c & 31; return 256 * pn + 128 * bj + 32 * wc + i; }

__device__ __forceinline__ void wt_tile(const float* W, int ldw, bf16_t* WT, int kb, int pb, bool perm, float* lds, int tid) {
#pragma unroll 4
    for (int i = 0; i < 16; ++i) { const int kk = i * 4 + (tid >> 6), pp = tid & 63, p = pb * 64 + pp; const int c = perm ? wt1_logical(p) : p;
        lds[kk * 65 + pp] = W[(size_t)(kb * 64 + kk) * ldw + c]; }
    __syncthreads();
#pragma unroll 4
    for (int i = 0; i < 16; ++i) { const int pp = i * 4 + (tid >> 6), kk = tid & 63;
        WT[(size_t)(pb * 64 + pp) * 1024 + kb * 64 + kk] = f2bf(lds[kk * 65 + pp]); }
    __syncthreads();
}
__global__ void __launch_bounds__(256) k_wt(const float* w_in, const float* w_out, bf16_t* WT1, bf16_t* WT2) {
    __shared__ float lds[64 * 65];
    const int tid = threadIdx.x;
    for (int it = blockIdx.x; it < 1024 + 256; it += gridDim.x) {
        if (it < 1024) wt_tile(w_in, NCOL, WT1, it & 15, it >> 4, true, lds, tid);
        else { const int r = it - 1024; wt_tile(w_out, DM, WT2, r & 15, r >> 4, false, lds, tid); }
    }
}

__global__ void __launch_bounds__(256) k_rows(const float* x, const float* norm_w, const float* w_in, const float* a_log, const float* dt_bias,
                                              bf16_t* HN, float* BETA, float* GDEC) {
    __shared__ float w8[1024 * 8];
    const int tid = threadIdx.x, lane = tid & 63, wave = tid >> 6;
    for (int i = tid; i < 1024 * 8; i += 256) w8[i] = w_in[(size_t)(i >> 3) * NCOL + 4096 + (i & 7)];
    __syncthreads();
    f32x4 nw[4];
#pragma unroll
    for (int j = 0; j < 4; ++j) nw[j] = ((const f32x4*)norm_w)[lane + 64 * j];
    const int gw = blockIdx.x * 4 + wave, ngw = gridDim.x * 4;
    for (int row = gw; row < MTOK; row += ngw) {
        const f32x4* xr = (const f32x4*)(x + (size_t)row * DM) + lane;
        f32x4 v[4]; float ss = 0.f;
#pragma unroll
        for (int j = 0; j < 4; ++j) { v[j] = xr[64 * j]; ss += v[j][0] * v[j][0] + v[j][1] * v[j][1] + v[j][2] * v[j][2] + v[j][3] * v[j][3]; }
        ss = wave_sum(ss);
        const float rstd = 1.0f / sqrtf(ss * (1.0f / DM) + EPS);
        float d[8];
#pragma unroll
        for (int c = 0; c < 8; ++c) d[c] = 0.f;
#pragma unroll
        for (int j = 0; j < 4; ++j) {
            f32x4 h = v[j] * rstd * nw[j];
            unsigned lo = (unsigned)f2bf(h[0]) | ((unsigned)f2bf(h[1]) << 16), hi = (unsigned)f2bf(h[2]) | ((unsigned)f2bf(h[3]) << 16);
            *(uint2*)(HN + (size_t)row * DM + 4 * (lane + 64 * j)) = make_uint2(lo, hi);
#pragma unroll
            for (int e = 0; e < 4; ++e) { const float* wr = w8 + (4 * (lane + 64 * j) + e) * 8;
#pragma unroll
                for (int c = 0; c < 8; ++c) d[c] += h[e] * wr[c]; }
        }
#pragma unroll
        for (int c = 0; c < 8; ++c) d[c] = wave_sum(d[c]);
        if (lane < 4) {
            const int hh = lane; float bd = d[0], ad = d[4];
            if (hh == 1) { bd = d[1]; ad = d[5]; } else if (hh == 2) { bd = d[2]; ad = d[6]; } else if (hh == 3) { bd = d[3]; ad = d[7]; }
            const float beta = 1.0f / (1.0f + expf(-bd));
            const float z = ad + dt_bias[hh];
            const float sp = fmaxf(z, 0.f) + log1pf(expf(-fabsf(z)));
            const float g = -expf(a_log[hh]) * sp;
            const int b = row / SEQ, s = row % SEQ;
            BETA[(size_t)(b * DH + hh) * SEQ + s] = beta; GDEC[(size_t)(b * DH + hh) * SEQ + s] = g;
        }
    }
}

struct G1Out { bf16_t *QA, *KA, *VA, *ZA, *ZD, *QKVD; float* KMEAN; const float *qnw, *knw; };
__global__ void __launch_bounds__(256) k_gemm1(const bf16_t* HN, const bf16_t* WT1, G1Out o) {
    const int tid = threadIdx.x, lane = tid & 63, wave = tid >> 6, fr = lane & 15, fq = lane >> 4;
    const int rt = blockIdx.x >> 4, gq = blockIdx.x & 15, cg = gq * 4 + wave;
    f32x4 acc[2][4];
#pragma unroll
    for (int m = 0; m < 2; ++m)
#pragma unroll
        for (int n = 0; n < 4; ++n) acc[m][n] = (f32x4){0.f, 0.f, 0.f, 0.f};
    const bf16_t* ap[2]; const bf16_t* bp[4];
#pragma unroll
    for (int m = 0; m < 2; ++m) ap[m] = HN + (size_t)(rt * 32 + m * 16 + fr) * DM + 8 * fq;
#pragma unroll
    for (int n = 0; n < 4; ++n) bp[n] = WT1 + (size_t)wt1_physical(cg * 64 + n * 16 + fr) * DM + 8 * fq;
    for (int k0 = 0; k0 < DM; k0 += 32) {
        bf16x8 a[2], b[4];
#pragma unroll
        for (int m = 0; m < 2; ++m) a[m] = *(const bf16x8*)(ap[m] + k0);
#pragma unroll
        for (int n = 0; n < 4; ++n) b[n] = *(const bf16x8*)(bp[n] + k0);
#pragma unroll
        for (int m = 0; m < 2; ++m)
#pragma unroll
            for (int n = 0; n < 4; ++n) acc[m][n] = __builtin_amdgcn_mfma_f32_16x16x32_bf16(a[m], b[n], acc[m][n], 0, 0, 0);
    }
    const int row_base = rt * 32, b_ = row_base / SEQ;
    if (cg < 16) {
        const bool isq = cg < 8; const int head = cg & 7; const float* nwp = isq ? o.qnw : o.knw;
        float nwv[4];
#pragma unroll
        for (int n = 0; n < 4; ++n) nwv[n] = nwp[n * 16 + fr];
        float ksum[4] = {0.f, 0.f, 0.f, 0.f};
#pragma unroll
        for (int m = 0; m < 2; ++m)
#pragma unroll
            for (int r = 0; r < 4; ++r) {
                float ss = 0.f;
#pragma unroll
                for (int n = 0; n < 4; ++n) ss += acc[m][n][r] * acc[m][n][r];
                ss += __shfl_xor(ss, 1); ss += __shfl_xor(ss, 2); ss += __shfl_xor(ss, 4); ss += __shfl_xor(ss, 8);
                const float rs = 1.0f / sqrtf(ss * (1.0f / 64.0f) + EPS);
                const int row = row_base + m * 16 + fq * 4 + r, s = row % SEQ;
                bf16_t* dst = (isq ? o.QA : o.KA) + ((size_t)(b_ * AH + head) * SEQ + s) * AD;
#pragma unroll
                for (int n = 0; n < 4; ++n) { const float val = acc[m][n][r] * rs * nwv[n]; ksum[n] += val; dst[n * 16 + fr] = f2bf(isq ? val * QSCALE : val); }
            }
        if (!isq) {
            const int blk = (row_base % SEQ) >> 8;
#pragma unroll
            for (int n = 0; n < 4; ++n) { float t = ksum[n]; t += __shfl_xor(t, 16); t += __shfl_xor(t, 32);
                if (fq == 0) atomicAdd(o.KMEAN + ((size_t)(b_ * AH + head) * NBLK + blk) * AD + n * 16 + fr, t * (1.0f / 256.0f)); }
        }
    } else {
#pragma unroll
        for (int m = 0; m < 2; ++m)
#pragma unroll
            for (int r = 0; r < 4; ++r) {
                const int row = row_base + m * 16 + fq * 4 + r, s = row % SEQ;
#pragma unroll
                for (int n = 0; n < 4; ++n) {
                    const int c = cg * 64 + n * 16 + fr; const float val = acc[m][n][r];
                    if (c < 1536) { const int head = (c - 1024) >> 6; o.VA[((size_t)(b_ * AH + head) * SEQ + s) * AD + (c & 63)] = f2bf(val); }
                    else if (c < 2048) o.ZA[(size_t)row * AW + (c - 1536)] = f2bf(silu_f(val));
                    else if (c < 3584) o.QKVD[(size_t)row * DCONV + (c - 2048)] = f2bf(val);
                    else o.ZD[(size_t)row * AW + (c - 3584)] = f2bf(silu_f(val));
                }
            }
    }
}

__global__ void __launch_bounds__(256) k_gemm2(const bf16_t* Y, const bf16_t* WT2, const float* x, float* out) {
    const int tid = threadIdx.x, lane = tid & 63, wave = tid >> 6, fr = lane & 15, fq = lane >> 4;
    const int rt = blockIdx.x >> 2, gq = blockIdx.x & 3, cg = gq * 4 + wave;
    f32x4 acc[2][4];
#pragma unroll
    for (int m = 0; m < 2; ++m)
#pragma unroll
        for (int n = 0; n < 4; ++n) acc[m][n] = (f32x4){0.f, 0.f, 0.f, 0.f};
    const bf16_t* ap[2]; const bf16_t* bp[4];
#pragma unroll
    for (int m = 0; m < 2; ++m) ap[m] = Y + (size_t)(rt * 32 + m * 16 + fr) * DM + 8 * fq;
#pragma unroll
    for (int n = 0; n < 4; ++n) bp[n] = WT2 + (size_t)(cg * 64 + n * 16 + fr) * DM + 8 * fq;
    for (int k0 = 0; k0 < DM; k0 += 32) {
        bf16x8 a[2], b[4];
#pragma unroll
        for (int m = 0; m < 2; ++m) a[m] = *(const bf16x8*)(ap[m] + k0);
#pragma unroll
        for (int n = 0; n < 4; ++n) b[n] = *(const bf16x8*)(bp[n] + k0);
#pragma unroll
        for (int m = 0; m < 2; ++m)
#pragma unroll
            for (int n = 0; n < 4; ++n) acc[m][n] = __builtin_amdgcn_mfma_f32_16x16x32_bf16(a[m], b[n], acc[m][n], 0, 0, 0);
    }
#pragma unroll
    for (int m = 0; m < 2; ++m)
#pragma unroll
        for (int r = 0; r < 4; ++r) {
            const size_t row = rt * 32 + m * 16 + fq * 4 + r;
#pragma unroll
            for (int n = 0; n < 4; ++n) { const size_t idx = row * DM + cg * 64 + n * 16 + fr; out[idx] = x[idx] + acc[m][n][r]; }
        }
}

__global__ void __launch_bounds__(256) k_dn_prep(const bf16_t* QKVD, const float* conv_w, bf16_t* QD, bf16_t* KD, bf16_t* VD) {
    const int tid = threadIdx.x, lane = tid & 63, wave = tid >> 6;
    const int gw = blockIdx.x * 4 + wave, ngw = gridDim.x * 4;
    for (int it = gw; it < MTOK * DH; it += ngw) {
        const int row = it >> 2, hh = it & 3, b = row / SEQ, s = row % SEQ;
        float val[3][2];
#pragma unroll
        for (int part = 0; part < 3; ++part)
#pragma unroll
            for (int e = 0; e < 2; ++e) {
                const int cc = part * 512 + hh * 128 + lane + 64 * e; float a = 0.f;
#pragma unroll
                for (int j = 0; j < 4; ++j) { const int sj = s - 3 + j; if (sj >= 0) a += conv_w[j * DCONV + cc] * bf2f(QKVD[(size_t)(row - 3 + j) * DCONV + cc]); }
                val[part][e] = silu_f(a);
            }
        float sq = wave_sum(val[0][0] * val[0][0] + val[0][1] * val[0][1]);
        float sk = wave_sum(val[1][0] * val[1][0] + val[1][1] * val[1][1]);
        const float rq = (1.0f / sqrtf(sq + EPS)) * 0.08838834764831845f, rk = 1.0f / sqrtf(sk + EPS);
        const size_t base = ((size_t)(b * DH + hh) * SEQ + s) * DKH;
#pragma unroll
        for (int e = 0; e < 2; ++e) { QD[base + lane + 64 * e] = f2bf(val[0][e] * rq); KD[base + lane + 64 * e] = f2bf(val[1][e] * rk); VD[base + lane + 64 * e] = f2bf(val[2][e]); }
    }
}
__global__ void __launch_bounds__(128) k_dn_seq(const bf16_t* QD, const bf16_t* KD, const bf16_t* VD, const float* BETA, const float* GDEC, float* OD) {
    __shared__ __attribute__((aligned(16))) float kq[2][256];
    const int e = threadIdx.x, bh = blockIdx.x, b = bh >> 2, hh = bh & 3;
    float S[128];
#pragma unroll
    for (int d = 0; d < 128; ++d) S[d] = 0.f;
    const size_t base = (size_t)bh * SEQ * DKH;
    float kn = bf2f(KD[base + e]), qn = bf2f(QD[base + e]), vn_ = bf2f(VD[base + e]), gn = GDEC[(size_t)bh * SEQ], bn = BETA[(size_t)bh * SEQ];
    for (int t = 0; t < SEQ; ++t) {
        float* buf = kq[t & 1];
        buf[e] = kn; buf[128 + e] = qn;
        const float vt = vn_, alpha = __expf(gn), beta = bn;
        if (t + 1 < SEQ) { const size_t nx = base + (size_t)(t + 1) * DKH + e; kn = bf2f(KD[nx]); qn = bf2f(QD[nx]); vn_ = bf2f(VD[nx]); gn = GDEC[(size_t)bh * SEQ + t + 1]; bn = BETA[(size_t)bh * SEQ + t + 1]; }
        __syncthreads();
        float ks = 0.f;
#pragma unroll
        for (int d = 0; d < 128; d += 4) { const f32x4 k4 = *(const f32x4*)(buf + d); ks += k4[0] * S[d] + k4[1] * S[d + 1] + k4[2] * S[d + 2] + k4[3] * S[d + 3]; }
        const float vnew = beta * (vt - alpha * ks);
        float o = 0.f;
#pragma unroll
        for (int d = 0; d < 128; d += 4) { const f32x4 k4 = *(const f32x4*)(buf + d), q4 = *(const f32x4*)(buf + 128 + d);
#pragma unroll
            for (int i = 0; i < 4; ++i) { S[d + i] = alpha * S[d + i] + k4[i] * vnew; o += q4[i] * S[d + i]; } }
        OD[((size_t)b * SEQ + t) * AW + hh * 128 + e] = o;
    }
}

__device__ __forceinline__ int t5_bucket_dev(int n) {
    if (n < 16) return n;
    int bkt = 16;
    bkt += (n >= 19) + (n >= 21) + (n >= 24) + (n >= 27) + (n >= 31) + (n >= 35) + (n >= 40) + (n >= 46) + (n >= 52) + (n >= 59) + (n >= 67) + (n >= 77) + (n >= 87) + (n >= 99) + (n >= 113);
    return bkt;
}
__global__ void __launch_bounds__(256) k_attn(const bf16_t* QA, const bf16_t* KA, const bf16_t* VA, const float* KMEAN, const float* rel_bias,
                                              const float* qnw, const float* knw, const bf16_t* ZA, bf16_t* Y) {
    __shared__ float qs_all[4][64];
    __shared__ float bias_all[4][32];
    const int tid = threadIdx.x, lane = tid & 63, wave = tid >> 6;
    float* qs = qs_all[wave]; float* bt = bias_all[wave];
    const int gq = blockIdx.x * 4 + wave;
    const int bh = gq / SEQ, s = gq % SEQ, h = bh & 7, b = bh >> 3, own = s >> 8;
    float mq = fabsf(qnw[lane]), mk = fabsf(knw[lane]), mb = (lane < 32) ? rel_bias[lane * AH + h] : -1e30f;
#pragma unroll
    for (int o = 1; o < 64; o <<= 1) { mq = fmaxf(mq, __shfl_xor(mq, o)); mk = fmaxf(mk, __shfl_xor(mk, o)); mb = fmaxf(mb, __shfl_xor(mb, o)); }
    const float mref = (8.0f * mq * mk + mb) * LOG2E;
    qs[lane] = bf2f(QA[(size_t)gq * AD + lane]);
    if (lane < 32) bt[lane] = rel_bias[lane * AH + h] * LOG2E;
    __syncthreads();
    float gate = -INFINITY;
    if (lane < own) { const float* km = KMEAN + ((size_t)bh * NBLK + lane) * AD; float a = 0.f;
        for (int d = 0; d < 64; ++d) a += qs[d] * km[d];
        gate = a; }
    unsigned selmask = 0u;
    for (int r = 0; r < 3; ++r) {
        float bv = gate; int bi = lane;
#pragma unroll
        for (int o = 1; o < 64; o <<= 1) { const float ov = __shfl_xor(bv, o); const int oi = __shfl_xor(bi, o); if (ov > bv || (ov == bv && oi < bi)) { bv = ov; bi = oi; } }
        if (bv > -INFINITY) { selmask |= 1u << bi; if (lane == bi) gate = -INFINITY; }
    }
    selmask |= 1u << own;
    float l = 0.f, oacc = 0.f;
    const bf16_t* Kb = KA + (size_t)bh * SEQ * AD; const bf16_t* Vb = VA + (size_t)bh * SEQ * AD;
    for (int j = 0; j <= own; ++j) {
        if (!((selmask >> j) & 1u)) continue;
        for (int t4 = 0; t4 < 4; ++t4) {
            const int kpos = j * 256 + t4 * 64 + lane;
            const bf16_t* kr = Kb + (size_t)kpos * AD; float sc = 0.f;
#pragma unroll
            for (int c = 0; c < 8; ++c) { const bf16x8 kv = *(const bf16x8*)(kr + c * 8);
#pragma unroll
                for (int i = 0; i < 8; ++i) sc += qs[c * 8 + i] * bf2f((unsigned short)kv[i]); }
            const int dist = s - kpos; float p = 0.f;
            if (dist >= 0) p = exp2f(sc + bt[t5_bucket_dev(dist)] - mref);
            l += p;
            const bf16_t* vr = Vb + (size_t)(j * 256 + t4 * 64) * AD + lane;
#pragma unroll 8
            for (int k = 0; k < 64; ++k) oacc += __shfl(p, k) * bf2f(vr[(size_t)k * AD]);
        }
    }
    l = wave_sum(l);
    const size_t tok = (size_t)b * SEQ + s;
    const float yv = (oacc / l) * bf2f(ZA[tok * AW + h * 64 + lane]);
    Y[tok * DM + h * 64 + lane] = f2bf(yv);
}

__global__ void __launch_bounds__(256) k_ycomb(const float* OD, const float* dnw, const bf16_t* ZD, bf16_t* Y) {
    const int tid = threadIdx.x, lane = tid & 63, wave = tid >> 6;
    const int gw = blockIdx.x * 4 + wave, ngw = gridDim.x * 4;
    for (int it = gw; it < MTOK * DH; it += ngw) {
        const int row = it >> 2, hh = it & 3;
        const float a0 = OD[(size_t)row * AW + hh * 128 + lane], a1 = OD[(size_t)row * AW + hh * 128 + 64 + lane];
        const float ss = wave_sum(a0 * a0 + a1 * a1);
        const float rs = 1.0f / sqrtf(ss * (1.0f / 128.0f) + EPS);
        Y[(size_t)row * DM + 512 + hh * 128 + lane] = f2bf(a0 * rs * dnw[lane] * bf2f(ZD[(size_t)row * AW + hh * 128 + lane]));
        Y[(size_t)row * DM + 512 + hh * 128 + 64 + lane] = f2bf(a1 * rs * dnw[64 + lane] * bf2f(ZD[(size_t)row * AW + hh * 128 + 64 + lane]));
    }
}


#define CBAR_ALL() do{ asm volatile("s_waitcnt vmcnt(0) lgkmcnt(0)":::"memory"); __builtin_amdgcn_s_barrier(); asm volatile("":::"memory"); }while(0)
#define CBAR_LDS() do{ asm volatile("s_waitcnt lgkmcnt(0)":::"memory"); __builtin_amdgcn_s_barrier(); asm volatile("":::"memory"); }while(0)
namespace pg8 {
#define PG8_LAS __attribute__((address_space(3)))
constexpr int BM = 256, BK = 64, HALF = 128, HTB = HALF * BK * 2  , STAGE_BYTES = 8 * HTB, NXCD = 8, WGM = 8;

__host__ __device__ __forceinline__ int lds_byte(int r, int c) { const int st = (r >> 4) * 2 + (c >> 5), rr = r & 15, cc = c & 31, ob = rr * 64 + cc * 2; return st * 1024 + (ob ^ (((ob >> 9) & 1) << 5)); }
__host__ __device__ __forceinline__ void stage_rc(int b, int& R, int& C) { const int st = b / 1024, sb = b % 1024, swz = sb ^ (((sb >> 9) & 1) << 5); R = (st >> 1) * 16 + swz / 64; C = (st & 1) * 32 + (swz % 64) / 2; }
__host__ __device__ __forceinline__ int perm32(int rho) { const int n = rho >> 4, i = rho & 15; return 8 * (i >> 2) + 4 * n + (i & 3); }

struct Unit { int pm, pn; };
struct Gemm { const bf16_t* A; const bf16_t* Bt; int M, N, K; };

struct StaticOrder {
    int nM, nN, nwg, G, c;
    __host__ __device__ void init(int M, int N, int G_, int c_) { nM = M / BM; nN = N / BM; nwg = nM * nN; G = G_; c = c_; }
    __host__ __device__ bool next(int i, Unit& u) const {
        const long L = (long)i * G + c; if (L >= nwg) return false;
        int wgid = (int)L; { const int q = nwg / NXCD, r = nwg % NXCD, xcd = wgid % NXCD, off = wgid / NXCD; wgid = (xcd < r ? xcd * (q + 1) : r * (q + 1) + (xcd - r) * q) + off; }
        const int nig = WGM * nN, gid = wgid / nig, fm = gid * WGM, gsz = (nM - fm) < WGM ? (nM - fm) : WGM;
        u.pm = fm + ((wgid % nig) % gsz); u.pn = (wgid % nig) / gsz; return true;
    }
    __device__ __forceinline__ void a_ready(const Unit&) const {}
    __device__ __forceinline__ void done(const Unit&) const {}
};

__device__ __forceinline__ unsigned cvt_pk_bf16(float lo, float hi) { unsigned r; asm volatile("v_cvt_pk_bf16_f32 %0, %1, %2" : "=v"(r) : "v"(lo), "v"(hi)); return r; }
typedef float f32x2 __attribute__((ext_vector_type(2)));
template <class Epi, class Sched, bool ALIGN_EPI = false, bool SP2 = false>
__device__ __forceinline__ void gemm_phase(PG8_LAS unsigned char* lds, const Gemm g, const Sched& S, const Epi& E) {
    const int tid = threadIdx.x, wid = __builtin_amdgcn_readfirstlane(tid >> 6), lane = tid & 63, wr = wid >> 2, wc = wid & 3, fr = lane & 15, fq = lane >> 4;
    const int K = g.K, nt = K / BK;
    unsigned voffA[2], voffB[2];
#pragma unroll
    for (int i = 0; i < 2; ++i) { int R, C; stage_rc(tid * 16 + i * 8192, R, C); const int Rb = Epi::PERM ? ((R & ~31) + perm32(R & 31)) : R;
        voffA[i] = (unsigned)(R * K + C) * 2u; voffB[i] = (unsigned)(Rb * K + C) * 2u; }
    const size_t kstep = (size_t)(BK * 2);
    const size_t hstep = (size_t)HALF * K * 2;
    const size_t tstep = 2 * hstep;
    const unsigned ldsw = (unsigned)wid * 1024u;
    const int aoff = lds_byte(wr * 64 + fr, fq * 8), boff = lds_byte(wc * 32 + fr, fq * 8);
#define PG8_SA(b, h) (((b) * 2 + (h)) * HTB)
#define PG8_SB(b, h) ((4 + (b) * 2 + (h)) * HTB)
#define PG8_STAGE(bufoff, gbase, voff) do { _Pragma("unroll") for (int _i = 0; _i < 2; ++_i) \
        __builtin_amdgcn_global_load_lds((const unsigned*)((const char*)(gbase) + (voff)[_i]), (PG8_LAS unsigned*)(lds + (bufoff) + ldsw + _i * 8192), 16, 0, 0); } while (0)
#define PG8_LDA(dst, b, h) do { _Pragma("unroll") for (int m = 0; m < 4; ++m) _Pragma("unroll") for (int k = 0; k < 2; ++k) dst[m][k] = *(const PG8_LAS bf16x8*)(lds + PG8_SA(b, h) + aoff + m * 2048 + k * 1024); } while (0)
#define PG8_LDB(dst, b, h) do { _Pragma("unroll") for (int n = 0; n < 2; ++n) _Pragma("unroll") for (int k = 0; k < 2; ++k) dst[n][k] = *(const PG8_LAS bf16x8*)(lds + PG8_SB(b, h) + boff + n * 2048 + k * 1024); } while (0)
#define PG8_MMA(ai, bj, At, Bt) do { __builtin_amdgcn_s_setprio(1); _Pragma("unroll") for (int m = 0; m < 4; ++m) _Pragma("unroll") for (int n = 0; n < 2; ++n) _Pragma("unroll") for (int k = 0; k < 2; ++k) \
        acc[ai][bj][m][n] = __builtin_amdgcn_mfma_f32_16x16x32_bf16(Bt[n][k], At[m][k], acc[ai][bj][m][n], 0, 0, 0); __builtin_amdgcn_s_setprio(0); } while (0)
#define PG8_WAIT_V(n) asm volatile("s_waitcnt vmcnt(" #n ")" ::: "memory")
#define PG8_WAIT_L(n) asm volatile("s_waitcnt lgkmcnt(" #n ")" ::: "memory")
#define PG8_BAR __builtin_amdgcn_s_barrier()
#define PG8_SCHED __builtin_amdgcn_sched_barrier(0)
    Unit cur, nxt; int ui = 0;
    if (!S.next(0, cur)) return;
    f32x4 acc[2][2][4][2];
#pragma unroll
    for (int a = 0; a < 2; ++a)
#pragma unroll
        for (int b = 0; b < 2; ++b)
#pragma unroll
            for (int m = 0; m < 4; ++m)
#pragma unroll
                for (int n = 0; n < 2; ++n) acc[a][b][m][n] = (f32x4){0.f, 0.f, 0.f, 0.f};
    bf16x8 At[4][2], B0[2][2], B1[2][2];
    const char* cA = (const char*)g.A + (size_t)cur.pm * tstep; const char* cB = (const char*)g.Bt + (size_t)cur.pn * tstep;
    S.a_ready(cur);
    if constexpr (SP2) {
        PG8_STAGE(PG8_SB(0, 0), cB, voffB); PG8_STAGE(PG8_SB(0, 1), cB + hstep, voffB); PG8_STAGE(PG8_SA(0, 0), cA, voffA); PG8_STAGE(PG8_SA(0, 1), cA + hstep, voffA);
        if (wr == 1) PG8_BAR;
        PG8_WAIT_V(2); PG8_BAR;
        PG8_STAGE(PG8_SB(1, 0), cB + kstep, voffB); PG8_STAGE(PG8_SA(1, 0), cA + kstep, voffA); PG8_STAGE(PG8_SB(1, 1), cB + hstep + kstep, voffB);
        PG8_WAIT_V(6); PG8_BAR;
    } else {
        PG8_STAGE(PG8_SB(0, 0), cB, voffB); PG8_STAGE(PG8_SA(0, 0), cA, voffA); PG8_STAGE(PG8_SB(0, 1), cB + hstep, voffB); PG8_STAGE(PG8_SA(0, 1), cA + hstep, voffA);
        if (wr == 1) PG8_BAR;
        PG8_WAIT_V(4); PG8_BAR;
        PG8_STAGE(PG8_SB(1, 0), cB + kstep, voffB); PG8_STAGE(PG8_SA(1, 0), cA + kstep, voffA); PG8_STAGE(PG8_SB(1, 1), cB + hstep + kstep, voffB);
        PG8_WAIT_V(6); PG8_BAR;
    }
    for (;;) {
        const bool has_next = S.next(ui + 1, nxt);
        const char* nA = has_next ? (const char*)g.A + (size_t)nxt.pm * tstep : cA; const char* nB = has_next ? (const char*)g.Bt + (size_t)nxt.pn * tstep : cB;
        for (int t = 0; t < nt; t += 2) {
            const bool last = (t == nt - 2);
            const char* a1 = cA + (size_t)(t + 1) * kstep;
            const char* a2 = last ? nA : cA + (size_t)(t + 2) * kstep; const char* b2 = last ? nB : cB + (size_t)(t + 2) * kstep;
            const char* a3 = a2 + kstep; const char* b3 = b2 + kstep;
            if (last && has_next) S.a_ready(nxt);
            if constexpr (SP2) {
            PG8_LDB(B0, 0, 0); PG8_LDB(B1, 0, 1); PG8_SCHED; PG8_LDA(At, 0, 0); PG8_STAGE(PG8_SA(1, 1), a1 + hstep, voffA);
            PG8_WAIT_V(8); PG8_WAIT_L(0); PG8_BAR; PG8_MMA(0, 0, At, B0); PG8_MMA(0, 1, At, B1); PG8_BAR; PG8_SCHED;
            PG8_LDA(At, 0, 1); PG8_STAGE(PG8_SB(0, 0), b2, voffB); PG8_STAGE(PG8_SB(0, 1), b2 + hstep, voffB); PG8_STAGE(PG8_SA(0, 0), a2, voffA);
            PG8_WAIT_V(8); PG8_WAIT_L(0); PG8_BAR; PG8_MMA(1, 0, At, B0); PG8_MMA(1, 1, At, B1); PG8_BAR; PG8_SCHED;
            PG8_LDB(B0, 1, 0); PG8_LDB(B1, 1, 1); PG8_SCHED; PG8_LDA(At, 1, 0); PG8_STAGE(PG8_SA(0, 1), a2 + hstep, voffA);
            PG8_WAIT_V(8); PG8_WAIT_L(0); PG8_BAR; PG8_MMA(0, 0, At, B0); PG8_MMA(0, 1, At, B1); PG8_BAR; PG8_SCHED;
            PG8_LDA(At, 1, 1); PG8_STAGE(PG8_SB(1, 0), b3, voffB); PG8_STAGE(PG8_SB(1, 1), b3 + hstep, voffB); PG8_STAGE(PG8_SA(1, 0), a3, voffA);
            PG8_WAIT_V(8); PG8_WAIT_L(0); PG8_BAR; PG8_MMA(1, 0, At, B0); PG8_MMA(1, 1, At, B1); PG8_BAR; PG8_SCHED;
            } else {
            PG8_LDB(B0, 0, 0); PG8_SCHED; PG8_LDA(At, 0, 0); PG8_STAGE(PG8_SA(1, 1), a1 + hstep, voffA);
            PG8_WAIT_L(8); PG8_BAR; PG8_WAIT_L(0); PG8_MMA(0, 0, At, B0); PG8_BAR; PG8_SCHED;
            PG8_LDB(B1, 0, 1); PG8_STAGE(PG8_SB(0, 0), b2, voffB);
            PG8_BAR; PG8_WAIT_L(0); PG8_MMA(0, 1, At, B1); PG8_BAR;
            PG8_LDA(At, 0, 1); PG8_STAGE(PG8_SA(0, 0), a2, voffA);
            PG8_BAR; PG8_WAIT_L(0); PG8_MMA(1, 0, At, B0); PG8_BAR; PG8_SCHED;
            PG8_STAGE(PG8_SB(0, 1), b2 + hstep, voffB);
            PG8_WAIT_V(6); PG8_BAR; PG8_MMA(1, 1, At, B1); PG8_BAR;
            PG8_LDB(B0, 1, 0); PG8_SCHED; PG8_LDA(At, 1, 0); PG8_STAGE(PG8_SA(0, 1), a2 + hstep, voffA);
            PG8_WAIT_L(8); PG8_BAR; PG8_WAIT_L(0); PG8_MMA(0, 0, At, B0); PG8_BAR; PG8_SCHED;
            PG8_LDB(B1, 1, 1); PG8_STAGE(PG8_SB(1, 0), b3, voffB);
            PG8_BAR; PG8_WAIT_L(0); PG8_MMA(0, 1, At, B1); PG8_BAR;
            PG8_LDA(At, 1, 1); PG8_STAGE(PG8_SA(1, 0), a3, voffA);
            PG8_BAR; PG8_WAIT_L(0); PG8_MMA(1, 0, At, B0); PG8_BAR; PG8_SCHED;
            PG8_STAGE(PG8_SB(1, 1), b3 + hstep, voffB);
            PG8_WAIT_V(6); PG8_BAR; PG8_MMA(1, 1, At, B1); PG8_BAR;
            }
        }
        if constexpr (ALIGN_EPI) { if (wr == 0) PG8_BAR; }
        if constexpr (!Epi::AFTER_DRAIN) { E(acc, cur, wr, wc, fr, fq); S.done(cur); }
        if (!has_next) break;
#pragma unroll
        for (int a = 0; a < 2; ++a)
#pragma unroll
            for (int b = 0; b < 2; ++b)
#pragma unroll
                for (int m = 0; m < 4; ++m)
#pragma unroll
                    for (int n = 0; n < 2; ++n) acc[a][b][m][n] = (f32x4){0.f, 0.f, 0.f, 0.f};
        cur = nxt; cA = nA; cB = nB; ++ui;
        if constexpr (ALIGN_EPI) { if (wr == 1) PG8_BAR; }
    }
    PG8_WAIT_V(0);
    if constexpr (!ALIGN_EPI) { if (wr == 0) PG8_BAR; }
    PG8_BAR;
    if constexpr (Epi::AFTER_DRAIN) { E.fused(acc, cur, wr, wc, fr, fq, lds, wid, lane); S.done(cur); }
#undef PG8_SA
#undef PG8_SB
#undef PG8_STAGE
#undef PG8_LDA
#undef PG8_LDB
#undef PG8_MMA
#undef PG8_WAIT_V
#undef PG8_WAIT_L
#undef PG8_BAR
#undef PG8_SCHED
}
}

namespace pg8 {
__device__ __forceinline__ float fast_silu(float x) { return x * __builtin_amdgcn_rcpf(1.0f + __expf(-x)); }
struct EpiProj {
    static constexpr bool PERM = true, AFTER_DRAIN = false;
    bf16_t *QA, *KA, *VA, *ZA, *ZD, *QKVD; float* KMEAN; const float *qnw, *knw; int pt_off;
    __device__ __forceinline__ void operator()(const f32x4 (&acc)[2][2][4][2], const Unit& u, int wr, int wc, int fr, int fq) const {
        const int pn = wt1_ltile(u.pn + pt_off), b = u.pm >> 5, blk = u.pm & 31;
        const int s0 = blk * 256 + wr * 64 + fr;
        const int row0 = u.pm * BM + wr * 64 + fr;
        if (pn < 4) {
            const bool isq = pn < 2; const int head = (pn & 1) * 4 + wc; const float* nwp = isq ? qnw : knw;
            f32x4 nw[2][2];
#pragma unroll
            for (int bj = 0; bj < 2; ++bj)
#pragma unroll
                for (int n = 0; n < 2; ++n) nw[bj][n] = *(const f32x4*)(nwp + 32 * bj + 8 * fq + 4 * n);
            f32x4 ksum[2][2];
#pragma unroll
            for (int bj = 0; bj < 2; ++bj)
#pragma unroll
                for (int n = 0; n < 2; ++n) ksum[bj][n] = (f32x4){0.f, 0.f, 0.f, 0.f};
            bf16_t* dbase = (isq ? QA : KA) + ((size_t)(b * 8 + head) * 8192) * 64 + 8 * fq;
            const float sc = isq ? 0.125f * 1.4426950408889634f : 1.0f;
#pragma unroll
            for (int ai = 0; ai < 2; ++ai)
#pragma unroll
                for (int m = 0; m < 4; ++m) {
                    float ss = 0.f;
#pragma unroll
                    for (int bj = 0; bj < 2; ++bj)
#pragma unroll
                        for (int n = 0; n < 2; ++n) { const f32x4 v = acc[ai][bj][m][n]; ss += (v[0] * v[0] + v[1] * v[1]) + (v[2] * v[2] + v[3] * v[3]); }
                    ss += __shfl_xor(ss, 16); ss += __shfl_xor(ss, 32);
                    const float rs = (1.0f / sqrtf(ss * (1.0f / 64.0f) + 1e-6f));
                    bf16_t* dst = dbase + (size_t)(s0 + ai * 128 + m * 16) * 64;
#pragma unroll
                    for (int bj = 0; bj < 2; ++bj) {
                        const f32x4 v0 = acc[ai][bj][m][0] * rs * nw[bj][0], v1 = acc[ai][bj][m][1] * rs * nw[bj][1];
                        ksum[bj][0] += v0; ksum[bj][1] += v1;
                        u32x4 w; w.x = cvt_pk_bf16(v0[0] * sc, v0[1] * sc); w.y = cvt_pk_bf16(v0[2] * sc, v0[3] * sc); w.z = cvt_pk_bf16(v1[0] * sc, v1[1] * sc); w.w = cvt_pk_bf16(v1[2] * sc, v1[3] * sc);
                        *(u32x4*)(dst + 32 * bj) = w;
                    }
                }
            if (!isq) {
                float* km = KMEAN + ((size_t)(b * 8 + head) * 32 + blk) * 64 + 8 * fq;
#pragma unroll
                for (int bj = 0; bj < 2; ++bj)
#pragma unroll
                    for (int n = 0; n < 2; ++n)
#pragma unroll
                        for (int e = 0; e < 4; ++e) {
                            float t = ksum[bj][n][e];
                            t += __shfl_xor(t, 1); t += __shfl_xor(t, 2); t += __shfl_xor(t, 4); t += __shfl_xor(t, 8);
                            if (fr == 0) atomicAdd(km + 32 * bj + 4 * n + e, t * (1.0f / 256.0f));
                        }
            }
        } else {
            bf16_t* dbase; size_t ld; int colb; bool act;
            if (pn < 6) { const int head = (pn - 4) * 4 + wc; dbase = VA + ((size_t)(b * 8 + head) * 8192 + blk * 256) * 64; ld = 64; colb = 0; act = false; }
            else if (pn < 8) { dbase = ZA + (size_t)(u.pm * BM) * 512; ld = 512; colb = (pn - 6) * 256 + wc * 64; act = true; }
            else if (pn < 14) { dbase = QKVD + (size_t)(u.pm * BM) * 1536; ld = 1536; colb = (pn - 8) * 256 + wc * 64; act = false; }
            else { dbase = ZD + (size_t)(u.pm * BM) * 512; ld = 512; colb = (pn - 14) * 256 + wc * 64; act = true; }
            const int rloc = wr * 64 + fr;
#pragma unroll
            for (int ai = 0; ai < 2; ++ai)
#pragma unroll
                for (int m = 0; m < 4; ++m) {
                    bf16_t* dst = dbase + (size_t)(rloc + ai * 128 + m * 16) * ld + colb + 8 * fq;
#pragma unroll
                    for (int bj = 0; bj < 2; ++bj) {
                        f32x4 v0 = acc[ai][bj][m][0], v1 = acc[ai][bj][m][1];
                        if (act) {
#pragma unroll
                            for (int e = 0; e < 4; ++e) { v0[e] = fast_silu(v0[e]); v1[e] = fast_silu(v1[e]); }
                        }
                        u32x4 w; w.x = cvt_pk_bf16(v0[0], v0[1]); w.y = cvt_pk_bf16(v0[2], v0[3]); w.z = cvt_pk_bf16(v1[0], v1[1]); w.w = cvt_pk_bf16(v1[2], v1[3]);
                        *(u32x4*)(dst + 32 * bj) = w;
                    }
                }
        }
        (void)row0;
    }
};
struct EpiOut {
    static constexpr bool PERM = false, AFTER_DRAIN = false;
    const float* X; float* O;
    __device__ __forceinline__ void operator()(const f32x4 (&acc)[2][2][4][2], const Unit& u, int wr, int wc, int fr, int fq) const {
        const int row0 = u.pm * BM + wr * 64 + fr, col0 = u.pn * BM + wc * 32 + 4 * fq;
#pragma unroll
        for (int ai = 0; ai < 2; ++ai)
#pragma unroll
            for (int m = 0; m < 4; ++m) { const size_t off = (size_t)(row0 + ai * HALF + m * 16) * 1024 + col0;
#pragma unroll
                for (int bj = 0; bj < 2; ++bj)
#pragma unroll
                    for (int n = 0; n < 2; ++n) { const f32x4 xv = *(const f32x4*)(X + off + bj * HALF + n * 16); *(f32x4*)(O + off + bj * HALF + n * 16) = xv + acc[ai][bj][m][n]; } }
    }
};
}

#define LAS __attribute__((address_space(3)))
constexpr int NWAVES = 8;
constexpr int RING_OFF = 0;
constexpr int LDS_BYTES = 163840;
constexpr int LDSCTL_OFF = LDS_BYTES - 1024, MISC_OFF = LDSCTL_OFF + 320;
constexpr int CW_BAR = 4096;

#define XB_TMO      128
#define XB_XCNT(j)  (256  + 64 * (j))
#define XB_XSUB(j)  (1280 + 64 * (j))
#define XB_XGEN(j)  (2304 + 64 * (j))
#define XB_TOP      3328
#define XB_TOPGEN   3392
#define XCD_BAR_WORDS 3456
#define XB_SPIN_CAP (1u << 18)
__device__ __forceinline__ unsigned xb_ld(unsigned* p)              { return __hip_atomic_load(p, __ATOMIC_RELAXED, __HIP_MEMORY_SCOPE_AGENT); }
__device__ __forceinline__ unsigned xb_add(unsigned* p, unsigned v) { return __hip_atomic_fetch_add(p, v, __ATOMIC_RELAXED, __HIP_MEMORY_SCOPE_AGENT); }
__device__ __forceinline__ unsigned xb_xcc_id() { return (unsigned)__builtin_amdgcn_s_getreg((3 << 11) | 20) & 0xFu; }
#define XB_SPIN(cond, bar) do { unsigned _sp = 0; while (cond) { __builtin_amdgcn_s_sleep(1); \
    if ((++_sp & 255u) == 0u) { if (xb_ld(&(bar)[XB_TMO])) break; if (_sp > XB_SPIN_CAP) { atomicAdd(&(bar)[XB_TMO], 1u); break; } } } } while (0)
struct XcdBarrier { unsigned* bar; unsigned x; volatile LAS unsigned* st; };
__device__ __forceinline__ XcdBarrier xcd_barrier_post(unsigned* bar, volatile LAS unsigned* st) {
    XcdBarrier b; b.bar = bar; b.x = xb_xcc_id(); b.st = st;
    if (threadIdx.x == 0) (void)xb_add(&bar[XB_XCNT(b.x)], 1u);
    return b;
}
__device__ __forceinline__ void xcd_barrier_complete(unsigned* bar, unsigned x, unsigned& nloc, unsigned& nx) {
    const unsigned G = gridDim.x * gridDim.y * gridDim.z;
    unsigned sum, cnt, mine, sp = 0u;
    for (;;) {
        sum = 0u; cnt = 0u; mine = 0u;
#pragma unroll
        for (unsigned j = 0; j < 16; ++j) { const unsigned c = xb_ld(&bar[XB_XCNT(j)]); sum += c; cnt += (c > 0u) ? 1u : 0u; mine = (j == x) ? c : mine; }
        if (sum == G) break;
        __builtin_amdgcn_s_sleep(1);
        if ((++sp & 255u) == 0u) { if (xb_ld(&bar[XB_TMO])) break; if (sp > XB_SPIN_CAP) { atomicAdd(&bar[XB_TMO], 1u); break; } }
    }
    nloc = mine > 0u ? mine : 1u; nx = cnt > 0u ? cnt : 1u;
}
__device__ __forceinline__ void xcd_barrier(const XcdBarrier& b) {
    asm volatile("s_waitcnt vmcnt(0)" ::: "memory");
    __syncthreads();
    if (threadIdx.x == 0) {
        unsigned* bar = b.bar;
        __builtin_amdgcn_s_waitcnt(0);
        unsigned nloc = b.st[0], nx = b.st[1];
        if (nloc == 0u) { xcd_barrier_complete(bar, b.x, nloc, nx); b.st[0] = nloc; b.st[1] = nx; }
        const unsigned old = xb_add(&bar[XB_XSUB(b.x)], 1u);
        const unsigned gen = old / nloc;
        if (old + 1u == (gen + 1u) * nloc) {
            __builtin_amdgcn_fence(__ATOMIC_RELEASE, "agent");
            asm volatile("s_waitcnt vmcnt(0)" ::: "memory");
            const unsigned og = xb_add(&bar[XB_TOP], 1u);
            const unsigned tg = og / nx;
            if (og + 1u == (tg + 1u) * nx) xb_add(&bar[XB_TOPGEN], 1u);
            else XB_SPIN(xb_ld(&bar[XB_TOPGEN]) == tg, bar);
            __builtin_amdgcn_fence(__ATOMIC_ACQUIRE, "agent");
            xb_add(&bar[XB_XGEN(b.x)], 1u);
            asm volatile("s_waitcnt vmcnt(0)" ::: "memory");
        } else {
            XB_SPIN(xb_ld(&bar[XB_XGEN(b.x)]) == gen, bar);
            __builtin_amdgcn_fence(__ATOMIC_ACQUIRE, "agent");
            asm volatile("s_waitcnt vmcnt(0)" ::: "memory");
        }
    }
    __syncthreads();
}

struct Ptrs {
    const float *x, *rel_bias, *norm_w, *w_in, *qnw, *knw, *conv_w, *a_log, *dt_bias, *dnw, *w_out;
    float* out; bf16_t* HN; bf16_t *WT1, *WT2; float *BETA, *GDEC, *KMEAN; bf16_t *QA, *KA, *VA, *ZA, *ZD, *QKVD, *QD, *KD, *VD; float* OD; bf16_t* Y; unsigned* ctl; unsigned char* REC; float* GLB; unsigned* SEL; unsigned short* LIST; float* LP; bf16_t* OPART;
};
__host__ __device__ inline Ptrs make_ptrs(void* const* d_in, void* d_out, unsigned char* ws) {
    Ptrs p;
    p.x = (const float*)d_in[0]; p.rel_bias = (const float*)d_in[1]; p.norm_w = (const float*)d_in[2]; p.w_in = (const float*)d_in[3]; p.qnw = (const float*)d_in[4]; p.knw = (const float*)d_in[5];
    p.conv_w = (const float*)d_in[6]; p.a_log = (const float*)d_in[7]; p.dt_bias = (const float*)d_in[8]; p.dnw = (const float*)d_in[9]; p.w_out = (const float*)d_in[10];
    p.out = (float*)d_out; p.HN = (bf16_t*)d_out;
    p.WT1 = (bf16_t*)(ws + WS_WT1); p.WT2 = (bf16_t*)(ws + WS_WT2); p.BETA = (float*)(ws + WS_BETA); p.GDEC = (float*)(ws + WS_GDEC); p.KMEAN = (float*)(ws + WS_KMEAN);
    p.QA = (bf16_t*)(ws + WS_QA); p.KA = (bf16_t*)(ws + WS_KA); p.VA = (bf16_t*)(ws + WS_VA); p.ZA = (bf16_t*)(ws + WS_ZA); p.ZD = (bf16_t*)(ws + WS_ZD); p.QKVD = (bf16_t*)(ws + WS_QKVD);
    p.QD = (bf16_t*)(ws + WS_QD); p.KD = (bf16_t*)(ws + WS_KD); p.VD = (bf16_t*)(ws + WS_VD); p.OD = (float*)((unsigned char*)d_out + OUT_OD); p.Y = (bf16_t*)(ws + WS_Y); p.ctl = (unsigned*)(ws + WS_CTL); p.REC = ws + WS_REC; p.GLB = (float*)(ws + WS_GLB);
    { unsigned char* o8 = (unsigned char*)d_out; p.SEL = (unsigned*)o8; p.LIST = (unsigned short*)(o8 + 1 * MiB); p.LP = (float*)(o8 + 17 * MiB); p.OPART = (bf16_t*)(o8 + 21 * MiB); }
    return p;
}


namespace dn {
using f32x16=__attribute__((ext_vector_type(16)))float;
typedef unsigned u32x2v __attribute__((ext_vector_type(2)));
constexpr int REC_NW=0, REC_QD=16384, REC_KT=32768, REC_AI=49152, REC_U=57344, REC_BYTES=73728;
constexpr int CH=64;
__device__ __forceinline__ int crow(int r,int hi){return (r&3)+8*(r>>2)+4*hi;}
typedef float f32x2_t __attribute__((ext_vector_type(2))); typedef __bf16 bf16x2_t __attribute__((ext_vector_type(2)));
__device__ __forceinline__ unsigned cvtpk(float lo,float hi){f32x2_t v={lo,hi};bf16x2_t b=__builtin_convertvector(v,bf16x2_t);return __builtin_bit_cast(unsigned,b);}
__device__ __forceinline__ float bflo(unsigned w){return __uint_as_float(w<<16);}
__device__ __forceinline__ float bfhi(unsigned w){return __uint_as_float(w&0xffff0000u);}
#define DN_MFMA32(a,b,c) __builtin_amdgcn_mfma_f32_32x32x16_bf16((a),(b),(c),0,0,0)
#ifndef SCANDBG
#define SCANDBG 0
#endif
#define DN_MFMA4(a,b,c) __builtin_amdgcn_mfma_f32_16x16x4f32((a),(b),(c),0,0,0)
#define DN_BAR() CBAR_ALL()
__device__ __forceinline__ void st16_wt(void*p,u32x4 v){ asm volatile("global_store_dwordx4 %0, %1, off sc1\n\ts_nop 1"::"v"(p),"v"(v):"memory"); }
__device__ __forceinline__ void st8_wt(void*p,unsigned lo,unsigned hi){ __hip_atomic_store((unsigned long long*)p,((unsigned long long)hi<<32)|lo,__ATOMIC_RELAXED,__HIP_MEMORY_SCOPE_AGENT); }

constexpr int P_QI=0, P_KI=16384, P_XT=32768, XT_LD=68, P_LF=P_XT+256*XT_LD*4, LF_LD=68, P_DF=P_LF+64*LF_LD*4, DF_LD=20, P_GC=P_DF+4*16*DF_LD*4, P_EG=P_GC+256, P_EKD=P_EG+256, P_BETA=P_EKD+256, P_END=P_BETA+256;
static_assert(P_END<=131072,"prep LDS");

__device__ __forceinline__ void prep_chunk(int c,const bf16_t*QKVD,const float*conv_w,const float*BETA,const float*GDEC,unsigned char*rec,float*GLB,unsigned*flags,LAS unsigned char*lds,int pdbg=0){
  const int tid=threadIdx.x; int lane=tid&63; asm volatile("":"+v"(lane));
  const int wid=__builtin_amdgcn_readfirstlane(tid>>6);
  const int bh=c>>7,n=c&127,b=bh>>2,h=bh&3,s0=n*CH; const size_t tok0=(size_t)b*SEQ+s0;
  LAS float*GC=(LAS float*)(lds+P_GC); LAS float*EG=(LAS float*)(lds+P_EG); LAS float*EKD=(LAS float*)(lds+P_EKD); LAS float*BT=(LAS float*)(lds+P_BETA);
  LAS float*XT=(LAS float*)(lds+P_XT); LAS float*LF=(LAS float*)(lds+P_LF); LAS float*DF=(LAS float*)(lds+P_DF);
  float g_l=GDEC[(size_t)bh*SEQ+s0+lane]; const float bt_l=BETA[(size_t)bh*SEQ+s0+lane];
  #pragma unroll
  for(int o=1;o<64;o<<=1){ const float t=__shfl_up(g_l,o); if(lane>=o)g_l+=t; }
  const float eg_l=__expf(g_l);
  if(wid==0){
    const float gl=__shfl(g_l,63);
    GC[lane]=g_l; EG[lane]=eg_l; EKD[lane]=__expf(gl-g_l); BT[lane]=bt_l;
    if(lane==63)__hip_atomic_store(GLB+c,eg_l,__ATOMIC_RELAXED,__HIP_MEMORY_SCOPE_AGENT);
  }
  {
    float cw[3][4][2];
    #pragma unroll
    for(int p=0;p<3;++p)
      #pragma unroll
      for(int j=0;j<4;++j){ const float2 w2=*(const float2*)(conv_w+j*DCONV+p*512+h*128+2*lane); cw[p][j][0]=w2.x; cw[p][j][1]=w2.y; }
    unsigned xr[3][11];
    #pragma unroll
    for(int rr=0;rr<11;++rr){ const int sp=s0+8*wid-3+rr;
      #pragma unroll
      for(int p=0;p<3;++p) xr[p][rr]=(sp>=0)?*(const unsigned*)(QKVD+(tok0+8*wid-3+rr)*DCONV+p*512+h*128+2*lane):0u; }
    #pragma unroll
    for(int i=0;i<8;++i){
      const int pos=8*wid+i;
      float v[3][2];
      #pragma unroll
      for(int p=0;p<3;++p){ float a0=0.f,a1=0.f;
        #pragma unroll
        for(int j=0;j<4;++j){ a0+=cw[p][j][0]*bflo(xr[p][i+j]); a1+=cw[p][j][1]*bfhi(xr[p][i+j]); }
        v[p][0]=a0*__builtin_amdgcn_rcpf(1.0f+__expf(-a0)); v[p][1]=a1*__builtin_amdgcn_rcpf(1.0f+__expf(-a1)); }
      const float sq=wave_sum(v[0][0]*v[0][0]+v[0][1]*v[0][1]), sk=wave_sum(v[1][0]*v[1][0]+v[1][1]*v[1][1]);
      const float rq=(1.0f/sqrtf(sq+EPS))*0.08838834764831845f, rk=1.0f/sqrtf(sk+EPS);
      const float q0=v[0][0]*rq,q1=v[0][1]*rq,k0=v[1][0]*rk,k1=v[1][1]*rk;
      const int ch=2*lane; const int off=((ch>>3)*64+pos)*16+(ch&7)*2;
      *(LAS unsigned*)(lds+P_QI+off)=cvtpk(q0,q1);
      *(LAS unsigned*)(lds+P_KI+off)=cvtpk(k0,k1);
      const float bt=__shfl(bt_l,pos), be=bt*__shfl(eg_l,pos);
      XT[(ch)*XT_LD+pos]=v[2][0]*bt; XT[(ch+1)*XT_LD+pos]=v[2][1]*bt;
      XT[(128+ch)*XT_LD+pos]=k0*be; XT[(128+ch+1)*XT_LD+pos]=k1*be;
    }
  }
  CBAR_LDS();
  {
    const int r32=lane&31,hi=lane>>5;
    if(wid<6){
      const int kind=wid/3, w3=wid%3;
      const int ta=(kind==0)?(w3==0?0:1):(w3==2?1:0);
      const int tb=(kind==0)?(w3==2?1:0):(w3==0?0:1);
      const LAS unsigned char*Ab=lds+P_KI+(32*ta+r32)*16+hi*1024;
      const LAS unsigned char*Bb=lds+(kind==0?P_KI:P_QI)+(32*tb+r32)*16+hi*1024;
      f32x16 acc=f32x16{};
      #pragma unroll
      for(int ks=0;ks<8;++ks){ const bf16x8 a=*(const LAS bf16x8*)(Ab+ks*2048), bb=*(const LAS bf16x8*)(Bb+ks*2048); acc=DN_MFMA32(a,bb,acc); }
      if(kind==0){
        const int j=32*tb+r32; const float gj=GC[j];
        #pragma unroll
        for(int r=0;r<16;++r){ const int i=32*ta+crow(r,0)+4*hi; const float val=(j<i)?BT[i]*acc[r]*__expf(GC[i]-gj):0.f; LF[i*LF_LD+j]=val; }
      } else {
        const int i=32*tb+r32; const float gi=GC[i];
        float o_[16];
        #pragma unroll
        for(int r=0;r<16;++r){ const int j=32*ta+crow(r,0)+4*hi; o_[r]=(j<=i)?acc[r]*__expf(gi-GC[j]):0.f; }
        #pragma unroll
        for(int s=0;s<2;++s){ u32x4 w; w.x=cvtpk(o_[8*s],o_[8*s+1]); w.y=cvtpk(o_[8*s+2],o_[8*s+3]); w.z=cvtpk(o_[8*s+4],o_[8*s+5]); w.w=cvtpk(o_[8*s+6],o_[8*s+7]);
          st16_wt(rec+REC_AI+((tb*4+2*ta+s)*64+lane)*16,w); }
      }
    }
  }
  CBAR_LDS();
  if(pdbg&2){} else
  if(wid==0){
    const int bb=lane>>4,j=lane&15; float t[16];
    const LAS float*Lb=LF+(16*bb)*LF_LD+16*bb;
    f32x4 rw[16][4];
    #pragma unroll
    for(int i=1;i<16;++i)
      #pragma unroll
      for(int q=0;q<(i+3)/4;++q) rw[i][q]=*(const LAS f32x4*)(Lb+i*LF_LD+4*q);
    #pragma unroll
    for(int i=0;i<16;++i){ float s=(i==j)?1.0f:0.0f;
      #pragma unroll
      for(int m=0;m<i;++m) s-=rw[i][m>>2][m&3]*t[m];
      t[i]=s; DF[(bb*16+i)*DF_LD+j]=s; }
  } else {
    const int r32=lane&31,hi=lane>>5;
    for(int f=wid-1;f<32;f+=7){
      if(f<16){
        const int i2=f>>3,ks=f&7,pos=32*i2+r32; const float e=EG[pos];
        const u32x2v lo=*(const LAS u32x2v*)(lds+P_QI+((2*ks)*64+pos)*16+8*hi), hi2=*(const LAS u32x2v*)(lds+P_QI+((2*ks+1)*64+pos)*16+8*hi);
        u32x4 w; w.x=cvtpk(bflo(lo.x)*e,bfhi(lo.x)*e); w.y=cvtpk(bflo(lo.y)*e,bfhi(lo.y)*e); w.z=cvtpk(bflo(hi2.x)*e,bfhi(hi2.x)*e); w.w=cvtpk(bflo(hi2.y)*e,bfhi(hi2.y)*e);
        st16_wt(rec+REC_QD+(f*64+lane)*16,w);
      } else {
        const int f2=f-16,t=f2>>2,ks=f2&3,dk=32*t+r32; const LAS unsigned short*kp=(const LAS unsigned short*)(lds+P_KI+(dk>>3)*1024+(dk&7)*2);
        const f32x4 e0=*(const LAS f32x4*)(EKD+16*ks+4*hi), e1=*(const LAS f32x4*)(EKD+16*ks+8+4*hi);
        float x[8];
        #pragma unroll
        for(int j=0;j<8;++j){ const int pos=16*ks+8*(j>>2)+4*hi+(j&3); x[j]=__uint_as_float(((unsigned)kp[pos*8])<<16)*((j<4)?e0[j&3]:e1[j&3]); }
        u32x4 w; w.x=cvtpk(x[0],x[1]); w.y=cvtpk(x[2],x[3]); w.z=cvtpk(x[4],x[5]); w.w=cvtpk(x[6],x[7]);
        st16_wt(rec+REC_KT+(f2*64+lane)*16,w);
      }
    }
  }
  CBAR_LDS();
  if(!(pdbg&1))
  {
    const int cl=lane&15,g=lane>>4;
    #define PK4(v) cvtpk((v)[0],(v)[1]),cvtpk((v)[2],(v)[3])
    #define FRAG(a_,b_) __builtin_bit_cast(bf16x8,(u32x4){PK4(a_),PK4(b_)})
    #define DN_MFMA16(a,b,c) __builtin_amdgcn_mfma_f32_16x16x32_bf16((a),(b),(c),0,0,0)
    const f32x4 z4=(f32x4){0.f,0.f,0.f,0.f};
    #pragma unroll 1
    for(int cc=0;cc<2;++cc){
      const int ct=2*wid+cc, col=16*ct+cl;
      f32x4 Y[4];
      #pragma unroll
      for(int bb=0;bb<4;++bb){
        f32x4 acc=*(const LAS f32x4*)(XT+col*XT_LD+16*bb+4*g);
        const LAS float*Lr=LF+(16*bb+cl)*LF_LD+4*g;
        if(bb==1){ const f32x4 l0=-*(const LAS f32x4*)(Lr); acc=DN_MFMA16(FRAG(l0,z4),FRAG(Y[0],z4),acc); }
        if(bb==2){ const f32x4 l0=-*(const LAS f32x4*)(Lr), l1=-*(const LAS f32x4*)(Lr+16); acc=DN_MFMA16(FRAG(l0,l1),FRAG(Y[0],Y[1]),acc); }
        if(bb==3){ const f32x4 l0=-*(const LAS f32x4*)(Lr), l1=-*(const LAS f32x4*)(Lr+16), l2=-*(const LAS f32x4*)(Lr+32);
          acc=DN_MFMA16(FRAG(l0,l1),FRAG(Y[0],Y[1]),acc); acc=DN_MFMA16(FRAG(l2,z4),FRAG(Y[2],z4),acc); }
        const f32x4 Da=*(const LAS f32x4*)(DF+(bb*16+cl)*DF_LD+4*g);
        Y[bb]=DN_MFMA16(FRAG(Da,z4),FRAG(acc,z4),z4);
      }
      if(ct<8){
        const int dv=col,c4=dv>>5,r32=dv&31;
        #pragma unroll
        for(int bb=0;bb<4;++bb){ const int i2=bb>>1,rh=bb&1,hi2=g&1;
          st8_wt(rec+REC_U+((((c4*2+i2)*2+rh)*64+hi2*32+r32)*8+4*(g>>1))*2,cvtpk(Y[bb][0],Y[bb][1]),cvtpk(Y[bb][2],Y[bb][3])); }
      } else {
        const int kt=ct-8;
        f32x4 sel; sel[0]=(cl==4*g)?-1.f:0.f; sel[1]=(cl==4*g+1)?-1.f:0.f; sel[2]=(cl==4*g+2)?-1.f:0.f; sel[3]=(cl==4*g+3)?-1.f:0.f;
        const bf16x8 selb=FRAG(sel,z4);
        #pragma unroll
        for(int bb=0;bb<4;++bb){
          const f32x4 zt=DN_MFMA16(FRAG(Y[bb],z4),selb,z4);
          const int pos=16*bb+cl,i2=pos>>5,r32=pos&31,hi2=g&1;
          st8_wt(rec+REC_NW+(((i2*8+kt)*64+hi2*32+r32)*8+4*(g>>1))*2,cvtpk(zt[0],zt[1]),cvtpk(zt[2],zt[3])); }
      }
    }
    #undef PK4
    #undef FRAG
    #undef DN_MFMA16
  }
  CBAR_LDS();
}

__device__ __forceinline__ void glds16(const void*gsrc,unsigned lds_dst){unsigned keep;
  asm volatile("s_mov_b32 %0, m0\n\ts_mov_b32 m0, %2\n\ts_nop 0\n\tglobal_load_lds_dwordx4 %1, off\n\ts_mov_b32 m0, %0":"=&s"(keep):"v"(gsrc),"s"(lds_dst):"memory");}
__device__ __forceinline__ void glds4(const void*gsrc,unsigned lds_dst){unsigned keep;
  asm volatile("s_mov_b32 %0, m0\n\ts_mov_b32 m0, %2\n\ts_nop 0\n\tglobal_load_lds_dword %1, off\n\ts_mov_b32 m0, %0":"=&s"(keep):"v"(gsrc),"s"(lds_dst):"memory");}
__device__ __forceinline__ bf16x8 pack8(const f32x16&x,int s){ u32x4 p; p.x=cvtpk(x[8*s],x[8*s+1]); p.y=cvtpk(x[8*s+2],x[8*s+3]); p.z=cvtpk(x[8*s+4],x[8*s+5]); p.w=cvtpk(x[8*s+6],x[8*s+7]); return __builtin_bit_cast(bf16x8,p); }

__device__ __forceinline__ void scan_wait_batch(const unsigned*rdy,int bh,int m0){
  if((threadIdx.x>>6)==4){
    const int l_=threadIdx.x&63; unsigned sp=0u;
    for(;;){ unsigned ok=1u; if(l_<16)ok=__hip_atomic_load(rdy+bh*128+m0+l_,__ATOMIC_RELAXED,__HIP_MEMORY_SCOPE_AGENT);
      if(__all(ok!=0u))break; __builtin_amdgcn_s_sleep(8); if(++sp>(1u<<17))break; }
    __builtin_amdgcn_fence(__ATOMIC_ACQUIRE,"agent"); asm volatile("s_waitcnt vmcnt(0)":::"memory");
  }
  CBAR_LDS();
}
#define DN_M(a,b,c) ((DBG&1)?(c):DN_MFMA32(a,b,c))
constexpr int SC_RING=2*REC_U, SC_STG=SC_RING, STG_LD=80, STG_BYTES=4*64*STG_LD, SC_SSQ=SC_STG+2*STG_BYTES, SC_TCH=SC_SSQ+2*4*64*4, SC_END=SC_TCH+512;
static_assert(SC_END<=160*1024-1024,"scan LDS");
template<int DBG> __device__ __forceinline__ void scan_head(int bh,const unsigned char*REC,const float*GLB,const float*dnw,const bf16_t*ZD,bf16_t*Y,const unsigned*rdy,char*shm,int flags){
  const int tid=threadIdx.x; int lane=tid&63; asm volatile("":"+v"(lane));
  const int wid=__builtin_amdgcn_readfirstlane(tid>>6);
  const int b=bh>>2,h=bh&3;
  const unsigned lds0=(unsigned)(uintptr_t)shm;
  const LAS unsigned char*ldsb=(const LAS unsigned char*)shm;
  const unsigned char*recb=REC+(size_t)bh*128*REC_BYTES;
  const size_t tokb=(size_t)b*SEQ;
  scan_wait_batch(rdy,bh,0);
  if(wid>=4&&wid<6){
    const int lw=wid-4;
    #define DN_FILL(nn,bufoff) do{ const unsigned char*src_=recb+(size_t)(nn)*REC_BYTES+lane*16; \
      _Pragma("unroll") for(int p=0;p<28;++p) glds16(src_+(lw+2*p)*1024,(unsigned)__builtin_amdgcn_readfirstlane(lds0+(bufoff)+(lw+2*p)*1024)); }while(0)
    if(!(flags&4)){ DN_FILL(0,0); }
    DN_BAR();
    for(int n=0;n<=128;++n){
      if(n<128){
        if(((n+1)&15)==0&&n+1<128)scan_wait_batch(rdy,bh,n+1);
        if(n+1<128&&!(flags&4)){ DN_FILL(n+1,((n+1)&1)*REC_U); }
      }
      DN_BAR();
    }
    #undef DN_FILL
  } else if(wid>=6){
    const int ow=wid-6;
    const int rrow=lane>>2,rch=lane&3;
    const bf16_t*zdp=ZD+(tokb+rrow)*AW+h*128+64*ow+8*rch; bf16_t*yp=Y+(tokb+rrow)*DM+512+h*128+64*ow+8*rch;
    f32x4 wv[2][2];
    #pragma unroll
    for(int c=0;c<2;++c){ wv[c][0]=*(const f32x4*)(dnw+64*ow+32*c+8*rch); wv[c][1]=*(const f32x4*)(dnw+64*ow+32*c+8*rch+4); }
    u32x4 zn[2][4],zq[2][4];
    #pragma unroll
    for(int c=0;c<2;++c)
      #pragma unroll
      for(int q=0;q<4;++q) zn[c][q]=*(const u32x4*)(zdp+(size_t)(16*q)*AW+32*c);
    asm volatile("s_waitcnt lgkmcnt(0)\n\ts_barrier":::"memory");
    for(int n=0;n<=128;++n){
      if(n<128&&((n+1)&15)==0&&n+1<128)scan_wait_batch(rdy,bh,n+1);
      if(n>0&&n<128&&!(DBG&2)){
        #pragma unroll
        for(int c=0;c<2;++c)
          #pragma unroll
          for(int q=0;q<4;++q) zq[c][q]=*(const u32x4*)(zdp+(size_t)(n*CH+16*q)*AW+32*c);
      }
      if(n>0&&!(DBG&2)){
        const LAS float*sq=(const LAS float*)(ldsb+SC_SSQ)+((n-1)&1)*256;
        #pragma unroll
        for(int it=0;it<4;++it){
          const int pos=16*it+rrow;
          const float tot=(sq[pos]+sq[64+pos])+(sq[128+pos]+sq[192+pos]);
          const float rs=1.0f/sqrtf(tot*(1.0f/128.0f)+EPS);
          #pragma unroll
          for(int c=0;c<2;++c){
            const LAS unsigned char*stg=ldsb+SC_STG+((n-1)&1)*STG_BYTES+(2*ow+c)*64*STG_LD;
            const u32x4 v=*(const LAS u32x4*)(stg+pos*STG_LD+rch*16); const u32x4 z=zn[c][it]; const f32x4 w0=wv[c][0],w1=wv[c][1]; u32x4 w;
            w[0]=cvtpk(bflo(v[0])*rs*w0[0]*bflo(z[0]),bfhi(v[0])*rs*w0[1]*bfhi(z[0])); w[1]=cvtpk(bflo(v[1])*rs*w0[2]*bflo(z[1]),bfhi(v[1])*rs*w0[3]*bfhi(z[1]));
            w[2]=cvtpk(bflo(v[2])*rs*w1[0]*bflo(z[2]),bfhi(v[2])*rs*w1[1]*bfhi(z[2])); w[3]=cvtpk(bflo(v[3])*rs*w1[2]*bflo(z[3]),bfhi(v[3])*rs*w1[3]*bfhi(z[3]));
            *(u32x4*)(yp+(size_t)((n-1)*CH+16*it)*DM+32*c)=w;
          }
        }
        #pragma unroll
        for(int c=0;c<2;++c)
          #pragma unroll
          for(int q=0;q<4;++q) zn[c][q]=zq[c][q];
      }
      asm volatile("s_waitcnt lgkmcnt(0)\n\ts_barrier":::"memory");
    }
  } else if(flags&8){
    asm volatile("s_waitcnt lgkmcnt(0)\n\ts_barrier":::"memory");
    for(int n=0;n<128;++n){ if(((n+1)&15)==0&&n+1<128)scan_wait_batch(rdy,bh,n+1); asm volatile("s_waitcnt lgkmcnt(0)\n\ts_barrier":::"memory"); }
    asm volatile("s_waitcnt lgkmcnt(0)\n\ts_barrier":::"memory");
  } else {
    const int c4=wid,r32=lane&31,hi=lane>>5;
    f32x16 S[4];
    #pragma unroll
    for(int t=0;t<4;++t)S[t]=f32x16{};
    const unsigned char*up=recb+REC_U+(size_t)(c4*4)*1024+lane*16;
    u32x4 un[4];
    #pragma unroll
    for(int q=0;q<4;++q) un[q]=*(const u32x4*)(up+q*1024);
    float gl_next=__hip_atomic_load(GLB+bh*128,__ATOMIC_RELAXED,__HIP_MEMORY_SCOPE_AGENT);
    asm volatile("s_waitcnt lgkmcnt(0)\n\ts_barrier":::"memory");
    for(int n=0;n<128;++n){
      if(((n+1)&15)==0&&n+1<128)scan_wait_batch(rdy,bh,n+1);
      const LAS unsigned char*rb=ldsb+(n&1)*REC_U+lane*16;
      const float gl=gl_next; gl_next=__hip_atomic_load(GLB+bh*128+((n+1)&127),__ATOMIC_RELAXED,__HIP_MEMORY_SCOPE_AGENT);
      f32x16 av[2],ao[2];
      #pragma unroll
      for(int i2=0;i2<2;++i2)
        #pragma unroll
        for(int rh=0;rh<2;++rh){ const u32x4 u=un[i2*2+rh];
          #pragma unroll
          for(int q=0;q<4;++q){ av[i2][8*rh+2*q]=bflo(u[q]); av[i2][8*rh+2*q+1]=bfhi(u[q]); } }
      { const unsigned char*upn=up+(size_t)((n+1)&127)*REC_BYTES;
        #pragma unroll
        for(int q=0;q<4;++q) un[q]=*(const u32x4*)(upn+q*1024); }
      ao[0]=f32x16{}; ao[1]=f32x16{};
      #define FR(off) (*(const LAS bf16x8*)(rb+(off)))
      #define SB0() __builtin_amdgcn_sched_barrier(0)
      bf16x8 fa[4],fb[4],Sb[8];
      #pragma unroll
      for(int ks=0;ks<8;++ks)Sb[ks]=pack8(S[ks>>1],ks&1);
      #define LDN(B,k0) do{ B[0]=FR(REC_NW+(k0)*1024); B[1]=FR(REC_NW+(8+(k0))*1024); B[2]=FR(REC_NW+((k0)+1)*1024); B[3]=FR(REC_NW+(9+(k0))*1024); }while(0)
      #define MMN(B,k0) do{ av[0]=DN_M(B[0],Sb[k0],av[0]); av[1]=DN_M(B[1],Sb[k0],av[1]); av[0]=DN_M(B[2],Sb[(k0)+1],av[0]); av[1]=DN_M(B[3],Sb[(k0)+1],av[1]); }while(0)
      #define LDQ(B,k0) do{ B[0]=FR(REC_QD+(k0)*1024); B[1]=FR(REC_QD+(8+(k0))*1024); B[2]=FR(REC_QD+((k0)+1)*1024); B[3]=FR(REC_QD+(9+(k0))*1024); }while(0)
      #define MMQ(B,k0) do{ ao[0]=DN_M(Sb[k0],B[0],ao[0]); ao[1]=DN_M(Sb[k0],B[1],ao[1]); ao[0]=DN_M(Sb[(k0)+1],B[2],ao[0]); ao[1]=DN_M(Sb[(k0)+1],B[3],ao[1]); }while(0)
      LDN(fa,0); SB0();
      LDN(fb,2); SB0(); MMN(fa,0); SB0();
      LDN(fa,4); SB0(); MMN(fb,2); SB0();
      LDN(fb,6); SB0(); MMN(fa,4); SB0();
      LDQ(fa,0); SB0(); MMN(fb,6); SB0();
      LDQ(fb,2); SB0(); MMQ(fa,0); SB0();
      #pragma unroll
      for(int t=0;t<4;++t)S[t]=S[t]*gl;
      LDQ(fa,4); SB0(); MMQ(fb,2); SB0();
      bf16x8 vb[2][2];
      #pragma unroll
      for(int i2=0;i2<2;++i2){ vb[i2][0]=pack8(av[i2],0); vb[i2][1]=pack8(av[i2],1); }
      LDQ(fb,6); SB0(); MMQ(fa,4); SB0();
      fa[0]=FR(REC_AI+0*1024); fa[1]=FR(REC_AI+1*1024); fa[2]=FR(REC_AI+4*1024); fa[3]=FR(REC_AI+5*1024); SB0();
      MMQ(fb,6); SB0();
      fb[0]=FR(REC_KT+0*1024); fb[1]=FR(REC_KT+1*1024); fb[2]=FR(REC_KT+2*1024); fb[3]=FR(REC_KT+3*1024); SB0();
      ao[0]=DN_M(vb[0][0],fa[0],ao[0]); ao[0]=DN_M(vb[0][1],fa[1],ao[0]); ao[1]=DN_M(vb[0][0],fa[2],ao[1]); ao[1]=DN_M(vb[0][1],fa[3],ao[1]); SB0();
      fa[0]=FR(REC_KT+4*1024); fa[1]=FR(REC_KT+5*1024); fa[2]=FR(REC_KT+6*1024); fa[3]=FR(REC_KT+7*1024); SB0();
      S[0]=DN_M(fb[0],vb[0][0],S[0]); S[0]=DN_M(fb[1],vb[0][1],S[0]); S[0]=DN_M(fb[2],vb[1][0],S[0]); S[0]=DN_M(fb[3],vb[1][1],S[0]); SB0();
      fb[0]=FR(REC_KT+8*1024); fb[1]=FR(REC_KT+9*1024); fb[2]=FR(REC_KT+10*1024); fb[3]=FR(REC_KT+11*1024); SB0();
      S[1]=DN_M(fa[0],vb[0][0],S[1]); S[1]=DN_M(fa[1],vb[0][1],S[1]); S[1]=DN_M(fa[2],vb[1][0],S[1]); S[1]=DN_M(fa[3],vb[1][1],S[1]); SB0();
      fa[0]=FR(REC_KT+12*1024); fa[1]=FR(REC_KT+13*1024); fa[2]=FR(REC_KT+14*1024); fa[3]=FR(REC_KT+15*1024); SB0();
      S[2]=DN_M(fb[0],vb[0][0],S[2]); S[2]=DN_M(fb[1],vb[0][1],S[2]); S[2]=DN_M(fb[2],vb[1][0],S[2]); S[2]=DN_M(fb[3],vb[1][1],S[2]); SB0();
      fb[0]=FR(REC_AI+6*1024); fb[1]=FR(REC_AI+7*1024); SB0();
      S[3]=DN_M(fa[0],vb[0][0],S[3]); S[3]=DN_M(fa[1],vb[0][1],S[3]); S[3]=DN_M(fa[2],vb[1][0],S[3]); S[3]=DN_M(fa[3],vb[1][1],S[3]); SB0();
      ao[1]=DN_M(vb[1][0],fb[0],ao[1]); ao[1]=DN_M(vb[1][1],fb[1],ao[1]); SB0();
      #undef FR
      #undef LDN
      #undef MMN
      #undef LDQ
      #undef MMQ
      #undef SB0
      { LAS unsigned char*stg=(LAS unsigned char*)(ldsb+SC_STG)+(n&1)*STG_BYTES+c4*64*STG_LD; LAS float*ssq=(LAS float*)(ldsb+SC_SSQ)+(n&1)*256+c4*64;
        #pragma unroll
        for(int i2=0;i2<2;++i2){ float p=0.f; const int pos=32*i2+r32;
          #pragma unroll
          for(int r=0;r<16;++r)p+=ao[i2][r]*ao[i2][r];
          p+=__shfl_xor(p,32);
          if(hi==0)ssq[pos]=p;
          #pragma unroll
          for(int rq=0;rq<4;++rq) *(LAS u32x2v*)(stg+pos*STG_LD+(8*rq+4*hi)*2)=(u32x2v){cvtpk(ao[i2][4*rq],ao[i2][4*rq+1]),cvtpk(ao[i2][4*rq+2],ao[i2][4*rq+3])}; } }
      asm volatile("s_waitcnt lgkmcnt(0)\n\ts_barrier":::"memory");
    }
    asm volatile("s_waitcnt lgkmcnt(0)\n\ts_barrier":::"memory");
  }
}
#undef DN_MFMA32
#undef DN_MFMA4
#undef DN_BAR
}

namespace moba {
using bf16=unsigned short;
using s16x4=__attribute__((ext_vector_type(4)))short;
using f32x16=__attribute__((ext_vector_type(16)))float;
constexpr int D=64,NW=8,QBLK=32,QB=QBLK*NW,KVBLK=64,PITCH=64;
__device__ __forceinline__ int crow(int r,int hi){return (r&3)+8*(r>>2)+4*hi;}
#define SBAR() __builtin_amdgcn_sched_barrier(0)
constexpr int NSLOT=3, SLOTB=8192;
constexpr int NKT=4, LDS_K=0, LDS_V=NKT*SLOTB, LDS_WS=2*NKT*SLOTB, WSW=1024, LDS_OST=LDS_WS+NW*WSW, LDS_TB=LDS_OST+NW*4096, LDS_UNIT=LDS_TB+512, LDS_PFX=LDS_UNIT+64, LDS_BYTES=LDS_PFX+8*132*4;
struct AB { int dbg; const bf16*QA; const bf16*KA; const bf16*VA; const float*KMEAN; const float*rel_bias; const bf16*ZA; bf16*Y; unsigned*SEL; unsigned short*LIST; unsigned*CNT; bf16*OP; float*LP; unsigned*qctl; };
constexpr int LISTCAP=8192, PREVCAP=256;
constexpr float NEGBIG=-1.0e30f;
__device__ __forceinline__ void glds16(const void*gsrc,unsigned lds_dst){unsigned keep;
  asm volatile("s_mov_b32 %0, m0\n\ts_mov_b32 m0, %2\n\ts_nop 0\n\tglobal_load_lds_dwordx4 %1, off\n\ts_mov_b32 m0, %0":"=&s"(keep):"v"(gsrc),"s"(lds_dst):"memory");}
typedef float f32x2_t __attribute__((ext_vector_type(2))); typedef __bf16 bf16x2_t __attribute__((ext_vector_type(2)));
__device__ __forceinline__ unsigned cvtpk_s(float lo,float hi){f32x2_t v={lo,hi};bf16x2_t b=__builtin_convertvector(v,bf16x2_t);return __builtin_bit_cast(unsigned,b);}
#define WAIT_BAR(N) asm volatile("s_waitcnt vmcnt(" #N ") lgkmcnt(0)\n\ts_barrier":::"memory")
__device__ __forceinline__ void qkt(f32x16&p0,f32x16&p1,const char*Kslot,const bf16x8*qr,int r32,int hi){
  const f32x16 negm=f32x16{};
  const char*kb=Kslot+hi*1024+r32*16;
  #pragma unroll
  for(int d0=0;d0<4;++d0){
    const bf16x8 b0=*reinterpret_cast<const bf16x8*>(kb+d0*2048);
    const bf16x8 b1=*reinterpret_cast<const bf16x8*>(kb+d0*2048+512);
    if(d0==0){p0=__builtin_amdgcn_mfma_f32_32x32x16_bf16(b0,qr[0],negm,0,0,0);p1=__builtin_amdgcn_mfma_f32_32x32x16_bf16(b1,qr[0],negm,0,0,0);}
    else{p0=__builtin_amdgcn_mfma_f32_32x32x16_bf16(b0,qr[d0],p0,0,0,0);p1=__builtin_amdgcn_mfma_f32_32x32x16_bf16(b1,qr[d0],p1,0,0,0);}}
}
typedef __attribute__((address_space(3))) const char* lds_cptr;
typedef short v4i16_t __attribute__((ext_vector_type(4)));
__device__ __forceinline__ void kload8(bf16x8*kf,lds_cptr kp){
  kf[0]=*(const __attribute__((address_space(3))) bf16x8*)(kp);      kf[1]=*(const __attribute__((address_space(3))) bf16x8*)(kp+512);
  kf[2]=*(const __attribute__((address_space(3))) bf16x8*)(kp+2048); kf[3]=*(const __attribute__((address_space(3))) bf16x8*)(kp+2560);
  kf[4]=*(const __attribute__((address_space(3))) bf16x8*)(kp+4096); kf[5]=*(const __attribute__((address_space(3))) bf16x8*)(kp+4608);
  kf[6]=*(const __attribute__((address_space(3))) bf16x8*)(kp+6144); kf[7]=*(const __attribute__((address_space(3))) bf16x8*)(kp+6656);
}
__device__ __forceinline__ void kload2(bf16x8*kf,lds_cptr kp,int j){ kf[2*j]=*(const __attribute__((address_space(3))) bf16x8*)(kp+j*2048); kf[2*j+1]=*(const __attribute__((address_space(3))) bf16x8*)(kp+j*2048+512); }
__device__ __forceinline__ s16x4 vtr(lds_cptr p){ return __builtin_bit_cast(s16x4,__builtin_amdgcn_ds_read_tr16_b64_v4i16((__attribute__((address_space(3))) v4i16_t*)p)); }
__device__ __forceinline__ void pv(f32x16*o,int vb,bf16x8 pa0,bf16x8 pa1,bf16x8 pa2,bf16x8 pa3){
  #pragma unroll
  for(int d0=0;d0<2;++d0){s16x4 lo[4],hi[4];
    #pragma unroll
    for(int ks=0;ks<4;++ks){
      asm volatile("ds_read_b64_tr_b16 %0,%1 offset:%c2":"=&v"(lo[ks]):"v"(vb),"i"(d0*4096+ks*1024):"memory");
      asm volatile("ds_read_b64_tr_b16 %0,%1 offset:%c2":"=&v"(hi[ks]):"v"(vb),"i"(d0*4096+ks*1024+512):"memory");}
    asm volatile("s_waitcnt lgkmcnt(0)":::"memory");SBAR();
    #define PK(k) (bf16x8){lo[k][0],lo[k][1],lo[k][2],lo[k][3],hi[k][0],hi[k][1],hi[k][2],hi[k][3]}
    o[d0]=__builtin_amdgcn_mfma_f32_32x32x16_bf16(pa0,PK(0),o[d0],0,0,0);
    o[d0]=__builtin_amdgcn_mfma_f32_32x32x16_bf16(pa1,PK(1),o[d0],0,0,0);
    o[d0]=__builtin_amdgcn_mfma_f32_32x32x16_bf16(pa2,PK(2),o[d0],0,0,0);
    o[d0]=__builtin_amdgcn_mfma_f32_32x32x16_bf16(pa3,PK(3),o[d0],0,0,0);
    #undef PK
  }
}
__device__ __forceinline__ void bandfix(f32x16&p0,f32x16&p1,int t,int qpos,int hi,const float*tb){
  const int kb=64*t+4*hi;
  #pragma unroll
  for(int r=0;r<16;++r){ const int kv=kb+(r&3)+8*(r>>2); const int d0=qpos-kv, d1=d0-32;
    const float b0=tb[d0<0?0:(d0>127?127:d0)], b1=tb[d1<0?0:(d1>127?127:d1)];
    p0[r]=d0<0?NEGBIG:p0[r]+b0; p1[r]=d1<0?NEGBIG:p1[r]+b1; if((r&3)==3)SBAR(); }
}


__device__ __forceinline__ unsigned gate_select(const float*KMEAN,int bh,int qb,const bf16x8*qr,int r32,int hi){
  f32x16 gt=f32x16{};
  const float*km=KMEAN+((size_t)bh*32+r32)*64+hi*8;
  #pragma unroll
  for(int d0=0;d0<4;++d0){ const f32x4 ka=*(const f32x4*)(km+d0*16), kb_=*(const f32x4*)(km+d0*16+4);
    u32x4 w; w.x=cvtpk_s(ka[0],ka[1]); w.y=cvtpk_s(ka[2],ka[3]); w.z=cvtpk_s(kb_[0],kb_[1]); w.w=cvtpk_s(kb_[2],kb_[3]);
    gt=__builtin_amdgcn_mfma_f32_32x32x16_bf16(__builtin_bit_cast(bf16x8,w),qr[d0],gt,0,0,0); }
  float a1=-INFINITY,a2=-INFINITY,a3=-INFINITY;
  const int qbh=qb-4*hi;
  #pragma unroll
  for(int r=0;r<16;++r){ float x=gt[r]; if(crow(r,0)>=qbh)x=-INFINITY; gt[r]=x;
    const float t_=fminf(a1,x); a1=fmaxf(a1,x); const float u_=fminf(a2,t_); a2=fmaxf(a2,t_); a3=fmaxf(a3,u_); }
  const float b1=__shfl_xor(a1,32),b2=__shfl_xor(a2,32),b3=__shfl_xor(a3,32);
  const float th=fmaxf(fmaxf(a3,b3),fmaxf(fminf(a2,b1),fminf(a1,b2)));
  unsigned m_=0u;
  #pragma unroll
  for(int r=0;r<16;++r){ if(gt[r]>=th&&gt[r]>-INFINITY)m_|=1u<<crow(r,0); }
  m_<<=4*hi;
  return m_|(unsigned)__shfl_xor((int)m_,32);
}
__device__ __forceinline__ void route_item(int bh,int qb,const AB&A){
  const int tid=threadIdx.x; int lane=tid&63; asm volatile("":"+v"(lane));
  const int r32=lane&31,hi=lane>>5; const int wid=__builtin_amdgcn_readfirstlane(tid>>6);
  const int s=qb*QB+wid*QBLK+r32;
  const bf16*Qw=A.QA+((size_t)bh*SEQ+s)*PITCH;
  bf16x8 qr[4];
  #pragma unroll
  for(int d0=0;d0<4;++d0)qr[d0]=*reinterpret_cast<const bf16x8*>(&Qw[d0*16+hi*8]);
  const unsigned selmask=gate_select(A.KMEAN,bh,qb,qr,r32,hi);
  if(hi==0)__hip_atomic_store(A.SEL+(size_t)bh*SEQ+s,selmask,__ATOMIC_RELAXED,__HIP_MEMORY_SCOPE_AGENT);
  const unsigned rb=(qb>=1&&hi==0)?(selmask&((1u<<qb)-1u)):0u;
  if(qb>=1){
    unsigned mymask=0u;
    for(int j=0;j<qb;++j){ const unsigned bal=(unsigned)__ballot((rb>>j)&1u); if(lane==j)mymask=bal; }
    unsigned base=0u;
    if(mymask)base=__hip_atomic_fetch_add(A.CNT+((lane==qb-1)?1024:0)+bh*32+lane,(unsigned)__popc(mymask),__ATOMIC_RELAXED,__HIP_MEMORY_SCOPE_AGENT);
    unsigned rbt=rb;
    #pragma unroll
    for(int k=0;k<3;++k){
      const int jj=rbt?(__ffs((int)rbt)-1):0; const bool act=rbt!=0u; rbt&=rbt-1u;
      const unsigned mj=(unsigned)__shfl((int)mymask,jj), bj=(unsigned)__shfl((int)base,jj);
      if(act){ const unsigned pos=bj+(unsigned)__popc(mj&((1u<<r32)-1u)); const bool prev=(jj==qb-1);
        if(pos<(unsigned)(prev?PREVCAP:LISTCAP-PREVCAP)){ unsigned short*dst_=A.LIST+((size_t)bh*32+jj)*LISTCAP+(prev?LISTCAP-PREVCAP:0)+pos; const unsigned val_=(unsigned)(s|(k<<13));
          asm volatile("global_store_short %0, %1, off sc1"::"v"(dst_),"v"(val_):"memory"); } }
    }
  }
}
template<int KIND> __device__ __forceinline__ void attn_group(int bh,int j,unsigned gi,unsigned cnt,unsigned entry,const bf16x8(&qr)[4],const AB&A,char*shm){
  const int tid=threadIdx.x; int lane=tid&63; asm volatile("":"+v"(lane));
  const int r32=lane&31,hi=lane>>5; const int wid=__builtin_amdgcn_readfirstlane(tid>>6);
  const int b=bh>>3,h=bh&7;
  const unsigned lds0=(unsigned)(uintptr_t)shm;
  const float*tb=(const float*)(shm+LDS_TB);
  const int srow=(KIND<2)?(int)(entry&8191u):(256*j+32*(int)gi+r32);
  const int vb0=(int)(lds0+LDS_V)+((lane>>4)&1)*32+(lane&3)*8+(4*hi+((lane&15)>>2))*64;
  const char*Kbase=shm+LDS_K; bf16x8 kf[8];
  const lds_cptr shm3=(lds_cptr)shm; const lds_cptr kp0=shm3+LDS_K+hi*1024+r32*16; const lds_cptr vp0=shm3+LDS_V+((lane>>4)&1)*32+(lane&3)*8+(4*hi+((lane&15)>>2))*64;
  constexpr int NT=4;
  float l_reg=0.f;f32x16 o[2];o[0]=f32x16{};o[1]=f32x16{};
  const int qpos=srow;
  #define BANDFIX(P0,P1,t) do{ if(KIND==2||(KIND==1&&(t)>=2)){ bandfix(P0,P1,4*j+(t),qpos,hi,tb); } }while(0)
  f32x16 pA0,pA1,pB0,pB1;
  qkt(pA0,pA1,Kbase,qr,r32,hi);asm volatile("s_nop 15\n\ts_nop 7":"+v"(pA0),"+v"(pA1));BANDFIX(pA0,pA1,0);
  _Pragma("unroll") for(int r=0;r<16;++r)pA0[r]=__builtin_amdgcn_exp2f(pA0[r]);
  _Pragma("unroll") for(int r=0;r<16;++r)pA1[r]=__builtin_amdgcn_exp2f(pA1[r]);
  kload8(kf,kp0+SLOTB);
  s16x4 vlo[8],vhi[8]; u32x4 pw0,pw1,pw2,pw3;
  #define PKW(P,B) cvtpk_s(P[B],P[B+1])
  #define PAF(k) __builtin_bit_cast(bf16x8,pw##k)
  #define VFR(i) (bf16x8){vlo[i][0],vlo[i][1],vlo[i][2],vlo[i][3],vhi[i][0],vhi[i][1],vhi[i][2],vhi[i][3]}
  #define PIN(x) asm volatile("":"+v"(x))
  #define GAPA(MF,A0,A1,A2,A3,W0,W1,PW) do{ MF; sacc+=A0; sacc+=A1; sacc+=A2; sacc+=A3; PIN(sacc); W0; W1; PIN(PW); SBAR(); }while(0)
  #define EX(v) __builtin_amdgcn_exp2f(v)
  #define GAPB(MF,X,B) do{ MF; X[B]=EX(X[B]); X[B+1]=EX(X[B+1]); X[B+2]=EX(X[B+2]); X[B+3]=EX(X[B+3]); PIN(X); SBAR(); }while(0)
  #define VRD(i) do{ vlo[i]=vtr(vp_+(((i)>>2)*4096+((i)&3)*1024)); vhi[i]=vtr(vp_+(((i)>>2)*4096+((i)&3)*1024+512)); }while(0)
  #define KRD(G,jj) do{ if(G){ kload2(kf,kp0+((t_)+1)*SLOTB,jj); SBAR(); } }while(0)
  #define STEP(C0,C1,P0,P1,t,GL) do{ SBAR(); constexpr int t_=(t); \
    const lds_cptr vp_=vp0+(t_-1)*SLOTB; const f32x16 zc_=f32x16{}; \
    VRD(0); SBAR(); float sacc=(P0[0]+P0[1]); \
    GAPA(C0=__builtin_amdgcn_mfma_f32_32x32x16_bf16(kf[0],qr[0],zc_,0,0,0), P0[2],P0[3],P0[4],P0[5],     pw0[0]=PKW(P0,0), pw0[1]=PKW(P0,2), pw0); \
    VRD(4); SBAR(); GAPA(C1=__builtin_amdgcn_mfma_f32_32x32x16_bf16(kf[1],qr[0],zc_,0,0,0), P0[6],P0[7],P0[8],P0[9],     pw0[2]=PKW(P0,4), pw0[3]=PKW(P0,6), pw0); \
    VRD(1); SBAR(); GAPA(C0=__builtin_amdgcn_mfma_f32_32x32x16_bf16(kf[2],qr[1],C0,0,0,0),   P0[10],P0[11],P0[12],P0[13], pw1[0]=PKW(P0,8), pw1[1]=PKW(P0,10), pw1); \
    VRD(5); SBAR(); GAPA(C1=__builtin_amdgcn_mfma_f32_32x32x16_bf16(kf[3],qr[1],C1,0,0,0),   P0[14],P0[15],P1[0],P1[1],   pw1[2]=PKW(P0,12),pw1[3]=PKW(P0,14), pw1); \
    VRD(2); SBAR(); GAPA(C0=__builtin_amdgcn_mfma_f32_32x32x16_bf16(kf[4],qr[2],C0,0,0,0),   P1[2],P1[3],P1[4],P1[5],     pw2[0]=PKW(P1,0), pw2[1]=PKW(P1,2), pw2); \
    VRD(6); SBAR(); GAPA(C1=__builtin_amdgcn_mfma_f32_32x32x16_bf16(kf[5],qr[2],C1,0,0,0),   P1[6],P1[7],P1[8],P1[9],     pw2[2]=PKW(P1,4), pw2[3]=PKW(P1,6), pw2); \
    VRD(3); SBAR(); GAPA(C0=__builtin_amdgcn_mfma_f32_32x32x16_bf16(kf[6],qr[3],C0,0,0,0),   P1[10],P1[11],P1[12],P1[13], pw3[0]=PKW(P1,8), pw3[1]=PKW(P1,10), pw3); \
    VRD(7); SBAR(); GAPA(C1=__builtin_amdgcn_mfma_f32_32x32x16_bf16(kf[7],qr[3],C1,0,0,0),   P1[14],P1[15],0.f,0.f,       pw3[2]=PKW(P1,12),pw3[3]=PKW(P1,14), pw3); \
    l_reg+=sacc; \
    BANDFIX(C0,C1,t_); \
    SBAR(); \
    GAPB(o[0]=__builtin_amdgcn_mfma_f32_32x32x16_bf16(PAF(0),VFR(0),o[0],0,0,0), C0,0); \
    GAPB(o[1]=__builtin_amdgcn_mfma_f32_32x32x16_bf16(PAF(0),VFR(4),o[1],0,0,0), C0,4); \
    KRD(GL,0); GAPB(o[0]=__builtin_amdgcn_mfma_f32_32x32x16_bf16(PAF(1),VFR(1),o[0],0,0,0), C0,8); \
    KRD(GL,1); GAPB(o[1]=__builtin_amdgcn_mfma_f32_32x32x16_bf16(PAF(1),VFR(5),o[1],0,0,0), C0,12); \
    KRD(GL,2); GAPB(o[0]=__builtin_amdgcn_mfma_f32_32x32x16_bf16(PAF(2),VFR(2),o[0],0,0,0), C1,0); \
    KRD(GL,3); GAPB(o[1]=__builtin_amdgcn_mfma_f32_32x32x16_bf16(PAF(2),VFR(6),o[1],0,0,0), C1,4); \
    GAPB(o[0]=__builtin_amdgcn_mfma_f32_32x32x16_bf16(PAF(3),VFR(3),o[0],0,0,0), C1,8); \
    GAPB(o[1]=__builtin_amdgcn_mfma_f32_32x32x16_bf16(PAF(3),VFR(7),o[1],0,0,0), C1,12); \
    }while(0)
  STEP(pB0,pB1,pA0,pA1,1,true);
  STEP(pA0,pA1,pB0,pB1,2,true);
  STEP(pB0,pB1,pA0,pA1,3,false);
  { float sacc=pB0[0]+pB0[1]; _Pragma("unroll") for(int r=2;r<16;++r)sacc+=pB0[r]; _Pragma("unroll") for(int r=0;r<16;++r)sacc+=pB1[r]; l_reg+=sacc;
    pw0=(u32x4){PKW(pB0,0),PKW(pB0,2),PKW(pB0,4),PKW(pB0,6)};pw1=(u32x4){PKW(pB0,8),PKW(pB0,10),PKW(pB0,12),PKW(pB0,14)};pw2=(u32x4){PKW(pB1,0),PKW(pB1,2),PKW(pB1,4),PKW(pB1,6)};pw3=(u32x4){PKW(pB1,8),PKW(pB1,10),PKW(pB1,12),PKW(pB1,14)};
    SBAR(); pv(o,vb0+(NT-1)*SLOTB,PAF(0),PAF(1),PAF(2),PAF(3)); }
  #undef PKW
  #undef PAF
  #undef VFR
  #undef PIN
  #undef GAPA
  #undef GAPB
  #undef EX
  #undef VRD
  #undef KRD
  #undef STEP
  #undef BANDFIX
  l_reg+=__shfl_xor(l_reg,32);
  int lane2=threadIdx.x&63; asm volatile("":"+v"(lane2));
  const int r32e=lane2&31,hie=lane2>>5;
  float*wsr=(float*)(shm+LDS_WS)+wid*(WSW/4);
  if(KIND<2){
    if(hie==0){ wsr[r32e*8]=__builtin_amdgcn_rcpf(l_reg); wsr[r32e*8+1]=l_reg; ((unsigned*)wsr)[r32e*8+2]=entry; }
  } else {
    if(hie==0){
      const unsigned selmask=A.SEL[(size_t)bh*SEQ+srow];
      const unsigned rbits=(j>=1)?(selmask&((1u<<j)-1u)):0u; const int nr=__popc(rbits);
      const float*lp=A.LP+((size_t)bh*SEQ+srow)*3; float lk[3]; float lt=l_reg;
      #pragma unroll
      for(int k=0;k<3;++k){ const float t_=lp[k]; lk[k]=(k<nr)?t_:0.f; lt+=lk[k]; }
      const float inv=1.0f/lt;
      wsr[r32e*8]=inv; wsr[r32e*8+1]=lk[0]*inv; wsr[r32e*8+2]=lk[1]*inv; wsr[r32e*8+3]=lk[2]*inv; ((int*)wsr)[r32e*8+4]=nr;
    }
  }
  asm volatile("s_waitcnt lgkmcnt(0)":::"memory");
  float rli[16];
  #pragma unroll
  for(int r=0;r<16;++r)rli[r]=wsr[(crow(r,0)+4*hie)*8];
  { bf16*stg=(bf16*)(shm+LDS_OST)+wid*2048;
    bf16*stgw=stg+(4*hie)*64+r32e;
    #pragma unroll
    for(int r=0;r<16;++r){
      #pragma unroll
      for(int d0=0;d0<2;++d0)stgw[crow(r,0)*64+d0*32]=f2bf(o[d0][r]*rli[r]);}
    asm volatile("s_waitcnt lgkmcnt(0)":::"memory");
    #pragma unroll
    for(int i=0;i<4;++i){const int row=i*8+(lane2>>3),ch=lane2&7; const u32x4 v=*(const u32x4*)(stg+row*64+ch*8);
      if(KIND<2){
        const unsigned e_=((const unsigned*)wsr)[row*8+2]; const unsigned idx=32u*gi+row;
        if(idx<cnt){ const size_t slot=((size_t)bh*SEQ+(e_&8191u))*3+(e_>>13);
          bf16*dst=A.OP+slot*64+ch*8;
          asm volatile("global_store_dwordx4 %0, %1, off sc1\n\ts_nop 1"::"v"(dst),"v"(v):"memory");
          if(ch==0)__hip_atomic_store(A.LP+slot,wsr[row*8+1],__ATOMIC_RELAXED,__HIP_MEMORY_SCOPE_AGENT); }
      } else {
        const size_t rowg=(size_t)bh*SEQ+256*j+32*gi+row; const size_t tok=(size_t)b*SEQ+256*j+32*gi+row; const int nr=((const int*)wsr)[row*8+4];
        float a8[8];
        #pragma unroll
        for(int e=0;e<4;++e){ a8[2*e]=__uint_as_float(v[e]<<16); a8[2*e+1]=__uint_as_float(v[e]&0xffff0000u); }
        const bf16*op=A.OP+(rowg*3)*64+ch*8;
        u32x4 pk[3];
        #pragma unroll
        for(int k=0;k<3;++k) pk[k]=*(const u32x4*)(op+k*64);
        #pragma unroll
        for(int k=0;k<3;++k){ const float f=wsr[row*8+1+k]; const u32x4 p=(k<nr)?pk[k]:(u32x4){0u,0u,0u,0u};
          #pragma unroll
          for(int e=0;e<4;++e){ a8[2*e]+=f*__uint_as_float(p[e]<<16); a8[2*e+1]+=f*__uint_as_float(p[e]&0xffff0000u); } }
        const u32x4 z=*(const u32x4*)(A.ZA+tok*512+h*64+ch*8); u32x4 w;
        #pragma unroll
        for(int e=0;e<4;++e) w[e]=cvtpk_s(a8[2*e]*__uint_as_float(z[e]<<16),a8[2*e+1]*__uint_as_float(z[e]&0xffff0000u));
        *(u32x4*)(A.Y+tok*1024+h*64+ch*8)=w;
      } } }
  asm volatile("s_waitcnt lgkmcnt(0)":::"memory");
}
template<bool OWN> __device__ __forceinline__ void kv_unit(int bh,int j,const AB&A,char*shm){
  const int tid=threadIdx.x; int lane=tid&63; asm volatile("":"+v"(lane));
  const int wid=__builtin_amdgcn_readfirstlane(tid>>6); const int h=bh&7;
  const unsigned lds0=(unsigned)(uintptr_t)shm;
  const bf16*Kh=A.KA+((size_t)bh*SEQ+(size_t)j*256)*PITCH,*Vh=A.VA+((size_t)bh*SEQ+(size_t)j*256)*PITCH;
  const bf16*ksrc=Kh+(long)lane*PITCH+wid*8;
  const bf16*vsrc=Vh+(long)(16*(wid&3)+(lane>>2))*PITCH+(wid>>2)*32+(lane&3)*8;
  const unsigned kdst=lds0+LDS_K+wid*1024, vdst=lds0+LDS_V+wid*1024;
  #pragma unroll
  for(int t=0;t<NKT;++t){ glds16(ksrc+(long)t*KVBLK*PITCH,(unsigned)__builtin_amdgcn_readfirstlane(kdst+t*SLOTB)); glds16(vsrc+(long)t*KVBLK*PITCH,(unsigned)__builtin_amdgcn_readfirstlane(vdst+t*SLOTB)); }
  float*tb=(float*)(shm+LDS_TB);
  if(tid<128) tb[tid]=(A.rel_bias[t5_bucket_dev(tid)*8+h]-A.rel_bias[31*8+h])*1.4426950408889634f;
  asm volatile("s_waitcnt vmcnt(0) lgkmcnt(0)\n\ts_barrier":::"memory");
  const int r32_=lane&31,hi_=lane>>5;
  #define LOADQ(dst,row) do{ const bf16*q_=A.QA+((size_t)bh*SEQ+(row))*PITCH+hi_*8; _Pragma("unroll") for(int d0=0;d0<4;++d0)(dst)[d0]=*reinterpret_cast<const bf16x8*>(q_+d0*16); }while(0)
  if((A.dbg&1)||(OWN&&(A.dbg&2))||(!OWN&&(A.dbg&4))){}
  else if(OWN){ bf16x8 qr[4]; LOADQ(qr,256*j+32*wid+r32_); attn_group<2>(bh,j,(unsigned)wid,256u,0u,qr,A,shm); }
  else {
    const unsigned short*lst=A.LIST+((size_t)bh*32+j)*LISTCAP;
    const unsigned cf=A.CNT[bh*32+j], cp=A.CNT[1024+bh*32+j];
    const unsigned nf=cf<(unsigned)(LISTCAP-PREVCAP)?cf:(unsigned)(LISTCAP-PREVCAP), np=cp<(unsigned)PREVCAP?cp:(unsigned)PREVCAP;
    const unsigned gp=(np+31u)>>5, gf=(nf+31u)>>5, gt=gp+gf;
    #define LOADE(gi_) (((gi_)<gp)?lst[(LISTCAP-PREVCAP)+((32u*(gi_)+r32_<np)?32u*(gi_)+r32_:0u)]:lst[((32u*((gi_)-gp)+r32_<nf)?32u*((gi_)-gp)+r32_:0u)])
    unsigned gi=wid;
    if(gi<gt){
      unsigned e_cur=LOADE(gi); unsigned e_nxt=(gi+NW<gt)?LOADE(gi+NW):0u;
      bf16x8 q_cur[4],q_nxt[4]; LOADQ(q_cur,e_cur&8191u);
      for(;gi<gt;gi+=NW){
        if(gi+NW<gt)LOADQ(q_nxt,e_nxt&8191u);
        const unsigned e_nn=(gi+2*NW<gt)?LOADE(gi+2*NW):0u;
        if(gi<gp) attn_group<1>(bh,j,gi,np,e_cur,q_cur,A,shm);
        else attn_group<0>(bh,j,gi-gp,nf,e_cur,q_cur,A,shm);
        e_cur=e_nxt; e_nxt=e_nn;
        #pragma unroll
        for(int d0=0;d0<4;++d0)q_cur[d0]=q_nxt[d0];
      }
    }
    #undef LOADE
  }
  #undef LOADQ
  asm volatile("s_waitcnt vmcnt(0) lgkmcnt(0)\n\ts_barrier":::"memory");
  if(!OWN&&threadIdx.x==0)__hip_atomic_fetch_add(A.qctl+512+64*(bh&7),1u,__ATOMIC_RELAXED,__HIP_MEMORY_SCOPE_AGENT);
}
__device__ __forceinline__ void moba_phase(char*lds,const AB&A){
  const int tid=threadIdx.x; volatile unsigned*uw=(volatile unsigned*)(lds+LDS_UNIT);
  const unsigned x0=xb_xcc_id()&7u; unsigned acquired=0u;
  for(unsigned qi=0;qi<8u;){
    const unsigned x=(x0+qi)&7u;
    if(tid==0){ const unsigned k=__hip_atomic_fetch_add(A.qctl+64*x,1u,__ATOMIC_RELAXED,__HIP_MEMORY_SCOPE_AGENT); uw[0]=k; }
    asm volatile("s_waitcnt vmcnt(0) lgkmcnt(0)\n\ts_barrier":::"memory");
    const unsigned k=uw[0];
    asm volatile("s_waitcnt lgkmcnt(0)\n\ts_barrier":::"memory");
    constexpr unsigned T=124u;
    if(k<T){ kv_unit<false>((int)x+8*(int)(k&3u),(int)(k>>2),A,lds); }
    else {
      const unsigned ko=k-T;
      if(ko>=128u){ ++qi; continue; }
      if(!((acquired>>x)&1u)){
        if(tid<64){ unsigned sp=0u; while(__builtin_amdgcn_readfirstlane(__hip_atomic_load(A.qctl+512+64*x,__ATOMIC_RELAXED,__HIP_MEMORY_SCOPE_AGENT))<T){ __builtin_amdgcn_s_sleep(2); if(++sp>(1u<<19))break; }
          __builtin_amdgcn_fence(__ATOMIC_ACQUIRE,"agent"); asm volatile("s_waitcnt vmcnt(0)":::"memory"); }
        asm volatile("s_waitcnt lgkmcnt(0)\n\ts_barrier":::"memory");
        acquired|=1u<<x; }
      kv_unit<true>((int)x+8*(int)(ko&3u),31-(int)(ko>>2),A,lds);
    }
  }
}
#undef SBAR
#undef WAIT_BAR
}
constexpr int CW_AQ = 16384, CW_CNT = 20480, CW_RT = 22592, CW_GQ = 22656, CW_GQ2 = 22720, CW_G1B = 22784, CW_FLAGS = 24576;
__device__ __forceinline__ void p0_phase(const Ptrs& P, LAS unsigned char* lds, int tid, int G) {
    const int lane = tid & 63, wave = tid >> 6;
    LAS float* scr = (LAS float*)lds;
    for (int it = blockIdx.x; it < 1024 + 256; it += G) {
        const bool first = it < 1024; const int r = first ? it : it - 1024; const int kb = r & 15, pb = r >> 4;
        const float* W = first ? P.w_in : P.w_out; const int ldw = first ? NCOL : DM; bf16_t* WT = first ? P.WT1 : P.WT2;
#pragma unroll 4
        for (int i = 0; i < 8; ++i) { const int kk = i * 8 + (tid >> 6), pp = tid & 63, p = pb * 64 + pp; const int c = first ? wt1_logical(p) : p;
            scr[kk * 65 + pp] = W[(size_t)(kb * 64 + kk) * ldw + c]; }
        __syncthreads();
#pragma unroll 4
        for (int i = 0; i < 8; ++i) { const int pp = i * 8 + (tid >> 6), kk = tid & 63;
            WT[(size_t)(pb * 64 + pp) * 1024 + kb * 64 + kk] = f2bf(scr[kk * 65 + pp]); }
        __syncthreads();
    }
    LAS float* w8 = (LAS float*)(lds + 32768);
    for (int i = tid; i < 1024 * 8; i += 512) w8[i] = P.w_in[(size_t)(i >> 3) * NCOL + 4096 + (i & 7)];
    __syncthreads();
    f32x4 nw[4];
#pragma unroll
    for (int j = 0; j < 4; ++j) nw[j] = ((const f32x4*)P.norm_w)[lane + 64 * j];
    const int gw = blockIdx.x * NWAVES + wave, ngw = G * NWAVES;
    for (int row = gw; row < MTOK; row += ngw) {
        const f32x4* xr = (const f32x4*)(P.x + (size_t)row * DM) + lane;
        f32x4 v[4]; float ss = 0.f;
#pragma unroll
        for (int j = 0; j < 4; ++j) { v[j] = xr[64 * j]; ss += v[j][0] * v[j][0] + v[j][1] * v[j][1] + v[j][2] * v[j][2] + v[j][3] * v[j][3]; }
        ss = wave_sum(ss);
        const float rstd = 1.0f / sqrtf(ss * (1.0f / DM) + EPS);
        float d[8];
#pragma unroll
        for (int c = 0; c < 8; ++c) d[c] = 0.f;
#pragma unroll
        for (int j = 0; j < 4; ++j) {
            f32x4 h = v[j] * rstd * nw[j];
            unsigned lo = (unsigned)f2bf(h[0]) | ((unsigned)f2bf(h[1]) << 16), hi = (unsigned)f2bf(h[2]) | ((unsigned)f2bf(h[3]) << 16);
            *(uint2*)(P.HN + (size_t)row * DM + 4 * (lane + 64 * j)) = make_uint2(lo, hi);
#pragma unroll
            for (int e = 0; e < 4; ++e) { const LAS f32x4* wr = (const LAS f32x4*)(w8 + (4 * (lane + 64 * j) + e) * 8); const f32x4 wa = wr[0], wb = wr[1];
#pragma unroll
                for (int c = 0; c < 4; ++c) { d[c] += h[e] * wa[c]; d[4 + c] += h[e] * wb[c]; } }
        }
#pragma unroll
        for (int c = 0; c < 8; ++c) d[c] = wave_sum(d[c]);
        if (lane < 4) {
            const int hh = lane; float bd = d[0], ad = d[4];
            if (hh == 1) { bd = d[1]; ad = d[5]; } else if (hh == 2) { bd = d[2]; ad = d[6]; } else if (hh == 3) { bd = d[3]; ad = d[7]; }
            const float beta = 1.0f / (1.0f + expf(-bd));
            const float z = ad + P.dt_bias[hh];
            const float sp = fmaxf(z, 0.f) + log1pf(expf(-fabsf(z)));
            const float g = -expf(P.a_log[hh]) * sp;
            const int b = row / SEQ, s = row % SEQ;
            P.BETA[(size_t)(b * DH + hh) * SEQ + s] = beta; P.GDEC[(size_t)(b * DH + hh) * SEQ + s] = g;
        }
    }
    __syncthreads();
}

struct Args { const float* in[11]; float* out; unsigned char* ws; int ph_lo, ph_hi, qoff, li; };
__global__ void __launch_bounds__(NWAVES * 64, 2) mega(Args args) {
    extern __shared__ __attribute__((aligned(16))) unsigned char lds_raw[];
    LAS unsigned char* lds = (LAS unsigned char*)lds_raw;
    const int tid = threadIdx.x, G = gridDim.x;
    void* din[11];
#pragma unroll
    for (int i = 0; i < 11; ++i) din[i] = (void*)args.in[i];
    const Ptrs P = make_ptrs(din, args.out, args.ws);
    volatile LAS unsigned* MISC = (volatile LAS unsigned*)(lds + MISC_OFF);
    for (int u = tid; u < (LDS_BYTES - LDSCTL_OFF) / 4; u += NWAVES * 64) ((LAS unsigned*)(lds + LDSCTL_OFF))[u] = 0u;
    __syncthreads();
    XcdBarrier bar = xcd_barrier_post(P.ctl + CW_BAR + args.li * XCD_BAR_WORDS, MISC + 8);
    const int lo = args.ph_lo, hi = args.ph_hi;
#define IN(k) (lo <= (k) && (k) < hi)
#define BOTH(k) (IN(k) && IN((k) + 1))
    if (IN(0)) { p0_phase(P, lds, tid, G); if (BOTH(0)) xcd_barrier(bar); }
    if (IN(1)) {
        pg8::Gemm g{P.HN, P.WT1 + (size_t)2048 * DM, MTOK, 2048, DM}; pg8::StaticOrder S; S.init(MTOK, 2048, G, (int)blockIdx.x);
        pg8::EpiProj E{P.QA, P.KA, P.VA, P.ZA, P.ZD, P.QKVD, P.KMEAN, P.qnw, P.knw, 8};
        pg8::gemm_phase<pg8::EpiProj, pg8::StaticOrder, true, true>(lds + RING_OFF, g, S, E);
        if (BOTH(1)) xcd_barrier(bar);
    }
#define GEMM1B_AND_PUBLISH() do{ \
                pg8::Gemm g{P.HN, P.WT1, MTOK, 2048, DM}; pg8::StaticOrder S; S.init(MTOK, 2048, G - 16, (int)blockIdx.x - 16); \
                pg8::EpiProj E{P.QA, P.KA, P.VA, P.ZA, P.ZD, P.QKVD, P.KMEAN, P.qnw, P.knw, 0}; \
                pg8::gemm_phase<pg8::EpiProj, pg8::StaticOrder, true, true>(lds + RING_OFF, g, S, E); \
                CBAR_ALL();                                \
                if (tid == 0) { __builtin_amdgcn_fence(__ATOMIC_RELEASE, "agent"); asm volatile("s_waitcnt vmcnt(0)" ::: "memory"); \
                    __hip_atomic_fetch_add(P.ctl + CW_G1B, 1u, __ATOMIC_RELAXED, __HIP_MEMORY_SCOPE_AGENT); } \
                CBAR_LDS(); }while(0)
    if (IN(2)) {
        const int dq = args.qoff;
        const moba::AB A{(dq >> 4) & 7, P.QA, P.KA, P.VA, P.KMEAN, P.rel_bias, P.ZA, P.Y, P.SEL, P.LIST, P.ctl + CW_CNT, P.OPART, P.LP, P.ctl + CW_AQ + (dq & ~255)};
        if (blockIdx.x < 16) {
            if (!(dq & 1)) {
#ifdef SCANDBG
                if (dq & 12) dn::scan_head<SCANDBG>((int)blockIdx.x, P.REC, P.GLB, P.dnw, P.ZD, (bf16_t*)P.out, P.ctl + CW_FLAGS, (char*)lds_raw, dq & 12); else
#endif
                dn::scan_head<0>((int)blockIdx.x, P.REC, P.GLB, P.dnw, P.ZD, (dq & 12) ? (bf16_t*)P.out : P.Y, P.ctl + CW_FLAGS, (char*)lds_raw, dq & 12); }
        } else if (!(dq & 128)) {
            volatile LAS unsigned* qw = MISC + 16;
            int pend0 = -1, pend1 = -1, carry = -1;
#ifdef PREPX
#define PREP_EXTRA dn::prep_chunk(pend0, P.QKVD, P.conv_w, P.BETA, P.GDEC, (unsigned char*)P.OPART, P.GLB + 4096, P.ctl + CW_FLAGS, lds, PREPX); dn::prep_chunk(pend1, P.QKVD, P.conv_w, P.BETA, P.GDEC, (unsigned char*)P.OPART + 131072, P.GLB + 4096, P.ctl + CW_FLAGS, lds, PREPX);
#else
#define PREP_EXTRA
#endif
#define PREP_LOOP(LIMIT) for (;;) { \
                if (tid == 0) { unsigned k; if (carry >= 0) k = (unsigned)carry; else k = __hip_atomic_fetch_add(P.ctl + CW_GQ, 1u, __ATOMIC_RELAXED, __HIP_MEMORY_SCOPE_AGENT); qw[0] = k; } \
                carry = -1; \
                CBAR_ALL(); \
                if (pend0 >= 0) { if (tid == 0) { __hip_atomic_store(P.ctl + CW_FLAGS + pend0, 1u, __ATOMIC_RELAXED, __HIP_MEMORY_SCOPE_AGENT); __hip_atomic_store(P.ctl + CW_FLAGS + pend1, 1u, __ATOMIC_RELAXED, __HIP_MEMORY_SCOPE_AGENT); } pend0 = -1; } \
                const unsigned k = (unsigned)__builtin_amdgcn_readfirstlane((int)qw[0]); \
                CBAR_LDS(); \
                if (k >= 1024u) break; \
                if (k >= (LIMIT)) { carry = (int)k; break; } \
                const unsigned cq = 2u * k; \
                pend0 = (int)(cq & 15u) * 128 + (int)(cq >> 4); pend1 = (int)((cq + 1u) & 15u) * 128 + (int)((cq + 1u) >> 4); \
                dn::prep_chunk(pend0, P.QKVD, P.conv_w, P.BETA, P.GDEC, P.REC + (size_t)pend0 * dn::REC_BYTES, P.GLB, P.ctl + CW_FLAGS, lds); \
                dn::prep_chunk(pend1, P.QKVD, P.conv_w, P.BETA, P.GDEC, P.REC + (size_t)pend1 * dn::REC_BYTES, P.GLB, P.ctl + CW_FLAGS, lds); \
                PREP_EXTRA \
            }
            PREP_LOOP(512u)
            GEMM1B_AND_PUBLISH();
            PREP_LOOP(1024u)
#undef PREP_LOOP
            if (tid < 64) { unsigned sp = 0u;
                while (__builtin_amdgcn_readfirstlane(__hip_atomic_load(P.ctl + CW_G1B, __ATOMIC_RELAXED, __HIP_MEMORY_SCOPE_AGENT)) < (unsigned)(G - 16)) { __builtin_amdgcn_s_sleep(8); if (++sp > (1u << 17)) break; }
                __builtin_amdgcn_fence(__ATOMIC_ACQUIRE, "agent"); asm volatile("s_waitcnt vmcnt(0)" ::: "memory"); }
            CBAR_LDS();
            for (;;) {
                if (tid == 0) { const unsigned k = __hip_atomic_fetch_add(P.ctl + CW_GQ2, 1u, __ATOMIC_RELAXED, __HIP_MEMORY_SCOPE_AGENT); qw[0] = k; }
                CBAR_ALL();
                const unsigned k = (unsigned)__builtin_amdgcn_readfirstlane((int)qw[0]);
                CBAR_LDS();
                if (k >= 1024u) break;
                moba::route_item((int)(k >> 5), (int)(k & 31u), A);
#ifdef ROUTE2
                { moba::AB A2 = A; A2.SEL = (unsigned*)P.LP; A2.LIST = (unsigned short*)P.OPART; A2.CNT = P.ctl + 32768; moba::route_item((int)(k >> 5), (int)(k & 31u), A2); }
#endif
                CBAR_ALL();
                if (tid == 0) __hip_atomic_fetch_add(P.ctl + CW_RT, 1u, __ATOMIC_RELAXED, __HIP_MEMORY_SCOPE_AGENT);
                CBAR_LDS();
            }
        }
        if (!(dq & 2)) {
            if (tid < 64) { unsigned sp = 0u;
                while (__builtin_amdgcn_readfirstlane(__hip_atomic_load(P.ctl + CW_RT, __ATOMIC_RELAXED, __HIP_MEMORY_SCOPE_AGENT)) < 1024u) { __builtin_amdgcn_s_sleep(8); if (++sp > (1u << 17)) break; }
                __builtin_amdgcn_fence(__ATOMIC_ACQUIRE, "agent"); asm volatile("s_waitcnt vmcnt(0)" ::: "memory"); }
            CBAR_LDS();
            moba::moba_phase((char*)lds_raw, A);
        }
        if (IN(5)) xcd_barrier(bar);
    }
    if (IN(5)) {
        pg8::Gemm g{P.Y, P.WT2, MTOK, DM, DM}; pg8::StaticOrder S; S.init(MTOK, DM, G, (int)blockIdx.x);
        pg8::EpiOut E{P.x, P.out};
        pg8::gemm_phase<pg8::EpiOut, pg8::StaticOrder, true, true>(lds + RING_OFF, g, S, E);
    }
#undef IN
#undef BOTH
}

extern "C" void kernel_launch(void* const* d_in, const int* in_sizes, int n_in, void* d_out, int out_size, void* d_ws, size_t ws_size, hipStream_t stream) {
    static int grid = 0;
    if (grid == 0) {
        if (n_in != 11 || ws_size < WS_END) { fprintf(stderr, "kernel_launch: unexpected inputs / workspace (%d, %zu)\n", n_in, ws_size); grid = -1; return; }
        int dev = 0, cus = 0;
        if (hipGetDevice(&dev) != hipSuccess || hipDeviceGetAttribute(&cus, hipDeviceAttributeMultiprocessorCount, dev) != hipSuccess) { grid = -1; return; }
        if (hipFuncSetAttribute((const void*)mega, hipFuncAttributeMaxDynamicSharedMemorySize, LDS_BYTES) != hipSuccess) { fprintf(stderr, "kernel_launch: hipFuncSetAttribute failed\n"); grid = -1; return; }
        grid = cus;
    }
    if (grid < 0) return;
    unsigned char* ws = (unsigned char*)d_ws;
    const Ptrs P = make_ptrs(d_in, d_out, ws);
    (void)hipMemsetAsync(ws + WS_CTL, 0, CTL_BYTES, stream);
    Args a{};
    for (int i = 0; i < 11; ++i) a.in[i] = (const float*)d_in[i];
    a.out = (float*)d_out; a.ws = ws;
#ifndef DUPF
#define DUPF 0
#endif
#ifndef DUPP
    a.ph_lo = 0; a.ph_hi = 6;
    hipLaunchKernelGGL(mega, dim3(grid), dim3(NWAVES * 64), LDS_BYTES, stream, a);
#else
#ifdef FIRSTF
    a.qoff = FIRSTF;
#endif
    a.ph_lo = 0; a.ph_hi = DUPP + 1;
    hipLaunchKernelGGL(mega, dim3(grid), dim3(NWAVES * 64), LDS_BYTES, stream, a);
    a.ph_lo = DUPP; a.ph_hi = DUPP + 1; a.qoff = 1024 + 128 + DUPF; a.li = 1;
    hipLaunchKernelGGL(mega, dim3(grid), dim3(NWAVES * 64), LDS_BYTES, stream, a);
    if (DUPP < 5) { a.ph_lo = DUPP + 1; a.ph_hi = 6; a.qoff = 0; a.li = 2;
    hipLaunchKernelGGL(mega, dim3(grid), dim3(NWAVES * 64), LDS_BYTES, stream, a); }
#endif
}
```

```cpp
#include <hip/hip_runtime.h>
#include <stdint.h>
#include <math.h>
#include <cstdio>

typedef unsigned short bf16_t;
typedef short bf16x8 __attribute__((ext_vector_type(8)));
typedef float f32x4 __attribute__((ext_vector_type(4)));
typedef unsigned u32x4 __attribute__((ext_vector_type(4)));

constexpr int NB = 4, SEQ = 8192, DM = 1024, MTOK = NB * SEQ;
constexpr int AH = 8, AD = 64, AW = 512, NBLK = 32;
constexpr int DH = 4, DKH = 128, NCOL = 4104, DCONV = 1536;
constexpr float EPS = 1e-6f;
constexpr float LOG2E = 1.4426950408889634f;
constexpr float QSCALE = 0.125f * LOG2E;

constexpr size_t MiB = 1u << 20;
constexpr size_t WS_CTL = 0, CTL_BYTES = 1 * MiB;
constexpr size_t WS_KMEAN = 512 * 1024;
constexpr size_t WS_WT1 = 1 * MiB;
constexpr size_t WS_WT2 = 9 * MiB;
constexpr size_t WS_BETA = 11 * MiB;
constexpr size_t WS_GDEC = 11 * MiB + 512 * 1024;
constexpr size_t WS_QA = 12 * MiB, WS_KA = 44 * MiB, WS_VA = 76 * MiB;
constexpr size_t WS_ZA = 108 * MiB, WS_ZD = 140 * MiB;
constexpr size_t WS_QKVD = 172 * MiB;
constexpr size_t WS_QD = 268 * MiB, WS_KD = 300 * MiB, WS_VD = 332 * MiB;
constexpr size_t WS_REC = 268 * MiB;
constexpr size_t WS_GLB = 256 * 1024;
constexpr size_t WS_Y = 412 * MiB;
constexpr size_t WS_END = 476 * MiB;
constexpr size_t OUT_OD = 64 * MiB;

__device__ __forceinline__ unsigned short f2bf(float f) { unsigned u = __float_as_uint(f); return (unsigned short)((u + 0x7fffu + ((u >> 16) & 1u)) >> 16); }
__device__ __forceinline__ float bf2f(unsigned short u) { return __uint_as_float(((unsigned)u) << 16); }
__device__ __forceinline__ float wave_sum(float v) {
#pragma unroll
    for (int o = 1; o < 64; o <<= 1) v += __shfl_xor(v, o);
    return v;
}
__device__ __forceinline__ float silu_f(float x) { return x / (1.0f + __expf(-x)); }
__host__ __device__ __forceinline__ int wt1_ltile(int pt) { return pt < 8 ? pt : (pt < 10 ? pt + 6 : pt - 2); }
__host__ __device__ __forceinline__ int wt1_logical(int p) { const int pn = wt1_ltile(p >> 8), t = p & 255, bj = t >> 7, wc = (t >> 5) & 3, i = t & 31; return 256 * pn + 64 * wc + 32 * bj + i; }
__host__ __device__ __forceinline__ int wt1_physical(int c) { const int ln = c >> 8, pn = ln < 8 ? ln : (ln < 14 ? ln + 2 : ln - 6), wc = (c >> 6) & 3, bj = (c >> 5) & 1, i = c & 31; return 256 * pn + 128 * bj + 32 * wc + i; }

__device__ __forceinline__ void wt_tile(const float* W, int ldw, bf16_t* WT, int kb, int pb, bool perm, float* lds, int tid) {
#pragma unroll 4
    for (int i = 0; i < 16; ++i) { const int kk = i * 4 + (tid >> 6), pp = tid & 63, p = pb * 64 + pp; const int c = perm ? wt1_logical(p) : p;
        lds[kk * 65 + pp] = W[(size_t)(kb * 64 + kk) * ldw + c]; }
    __syncthreads();
#pragma unroll 4
    for (int i = 0; i < 16; ++i) { const int pp = i * 4 + (tid >> 6), kk = tid & 63;
        WT[(size_t)(pb * 64 + pp) * 1024 + kb * 64 + kk] = f2bf(lds[kk * 65 + pp]); }
    __syncthreads();
}
__global__ void __launch_bounds__(256) k_wt(const float* w_in, const float* w_out, bf16_t* WT1, bf16_t* WT2) {
    __shared__ float lds[64 * 65];
    const int tid = threadIdx.x;
    for (int it = blockIdx.x; it < 1024 + 256; it += gridDim.x) {
        if (it < 1024) wt_tile(w_in, NCOL, WT1, it & 15, it >> 4, true, lds, tid);
        else { const int r = it - 1024; wt_tile(w_out, DM, WT2, r & 15, r >> 4, false, lds, tid); }
    }
}

__global__ void __launch_bounds__(256) k_rows(const float* x, const float* norm_w, const float* w_in, const float* a_log, const float* dt_bias,
                                              bf16_t* HN, float* BETA, float* GDEC) {
    __shared__ float w8[1024 * 8];
    const int tid = threadIdx.x, lane = tid & 63, wave = tid >> 6;
    for (int i = tid; i < 1024 * 8; i += 256) w8[i] = w_in[(size_t)(i >> 3) * NCOL + 4096 + (i & 7)];
    __syncthreads();
    f32x4 nw[4];
#pragma unroll
    for (int j = 0; j < 4; ++j) nw[j] = ((const f32x4*)norm_w)[lane + 64 * j];
    const int gw = blockIdx.x * 4 + wave, ngw = gridDim.x * 4;
    for (int row = gw; row < MTOK; row += ngw) {
        const f32x4* xr = (const f32x4*)(x + (size_t)row * DM) + lane;
        f32x4 v[4]; float ss = 0.f;
#pragma unroll
        for (int j = 0; j < 4; ++j) { v[j] = xr[64 * j]; ss += v[j][0] * v[j][0] + v[j][1] * v[j][1] + v[j][2] * v[j][2] + v[j][3] * v[j][3]; }
        ss = wave_sum(ss);
        const float rstd = 1.0f / sqrtf(ss * (1.0f / DM) + EPS);
        float d[8];
#pragma unroll
        for (int c = 0; c < 8; ++c) d[c] = 0.f;
#pragma unroll
        for (int j = 0; j < 4; ++j) {
            f32x4 h = v[j] * rstd * nw[j];
            unsigned lo = (unsigned)f2bf(h[0]) | ((unsigned)f2bf(h[1]) << 16), hi = (unsigned)f2bf(h[2]) | ((unsigned)f2bf(h[3]) << 16);
            *(uint2*)(HN + (size_t)row * DM + 4 * (lane + 64 * j)) = make_uint2(lo, hi);
#pragma unroll
            for (int e = 0; e < 4; ++e) { const float* wr = w8 + (4 * (lane + 64 * j) + e) * 8;
#pragma unroll
                for (int c = 0; c < 8; ++c) d[c] += h[e] * wr[c]; }
        }
#pragma unroll
        for (int c = 0; c < 8; ++c) d[c] = wave_sum(d[c]);
        if (lane < 4) {
            const int hh = lane; float bd = d[0], ad = d[4];
            if (hh == 1) { bd = d[1]; ad = d[5]; } else if (hh == 2) { bd = d[2]; ad = d[6]; } else if (hh == 3) { bd = d[3]; ad = d[7]; }
            const float beta = 1.0f / (1.0f + expf(-bd));
            const float z = ad + dt_bias[hh];
            const float sp = fmaxf(z, 0.f) + log1pf(expf(-fabsf(z)));
            const float g = -expf(a_log[hh]) * sp;
            const int b = row / SEQ, s = row % SEQ;
            BETA[(size_t)(b * DH + hh) * SEQ + s] = beta; GDEC[(size_t)(b * DH + hh) * SEQ + s] = g;
        }
    }
}

struct G1Out { bf16_t *QA, *KA, *VA, *ZA, *ZD, *QKVD; float* KMEAN; const float *qnw, *knw; };
__global__ void __launch_bounds__(256) k_gemm1(const bf16_t* HN, const bf16_t* WT1, G1Out o) {
    const int tid = threadIdx.x, lane = tid & 63, wave = tid >> 6, fr = lane & 15, fq = lane >> 4;
    const int rt = blockIdx.x >> 4, gq = blockIdx.x & 15, cg = gq * 4 + wave;
    f32x4 acc[2][4];
#pragma unroll
    for (int m = 0; m < 2; ++m)
#pragma unroll
        for (int n = 0; n < 4; ++n) acc[m][n] = (f32x4){0.f, 0.f, 0.f, 0.f};
    const bf16_t* ap[2]; const bf16_t* bp[4];
#pragma unroll
    for (int m = 0; m < 2; ++m) ap[m] = HN + (size_t)(rt * 32 + m * 16 + fr) * DM + 8 * fq;
#pragma unroll
    for (int n = 0; n < 4; ++n) bp[n] = WT1 + (size_t)wt1_physical(cg * 64 + n * 16 + fr) * DM + 8 * fq;
    for (int k0 = 0; k0 < DM; k0 += 32) {
        bf16x8 a[2], b[4];
#pragma unroll
        for (int m = 0; m < 2; ++m) a[m] = *(const bf16x8*)(ap[m] + k0);
#pragma unroll
        for (int n = 0; n < 4; ++n) b[n] = *(const bf16x8*)(bp[n] + k0);
#pragma unroll
        for (int m = 0; m < 2; ++m)
#pragma unroll
            for (int n = 0; n < 4; ++n) acc[m][n] = __builtin_amdgcn_mfma_f32_16x16x32_bf16(a[m], b[n], acc[m][n], 0, 0, 0);
    }
    const int row_base = rt * 32, b_ = row_base / SEQ;
    if (cg < 16) {
        const bool isq = cg < 8; const int head = cg & 7; const float* nwp = isq ? o.qnw : o.knw;
        float nwv[4];
#pragma unroll
        for (int n = 0; n < 4; ++n) nwv[n] = nwp[n * 16 + fr];
        float ksum[4] = {0.f, 0.f, 0.f, 0.f};
#pragma unroll
        for (int m = 0; m < 2; ++m)
#pragma unroll
            for (int r = 0; r < 4; ++r) {
                float ss = 0.f;
#pragma unroll
                for (int n = 0; n < 4; ++n) ss += acc[m][n][r] * acc[m][n][r];
                ss += __shfl_xor(ss, 1); ss += __shfl_xor(ss, 2); ss += __shfl_xor(ss, 4); ss += __shfl_xor(ss, 8);
                const float rs = 1.0f / sqrtf(ss * (1.0f / 64.0f) + EPS);
                const int row = row_base + m * 16 + fq * 4 + r, s = row % SEQ;
                bf16_t* dst = (isq ? o.QA : o.KA) + ((size_t)(b_ * AH + head) * SEQ + s) * AD;
#pragma unroll
                for (int n = 0; n < 4; ++n) { const float val = acc[m][n][r] * rs * nwv[n]; ksum[n] += val; dst[n * 16 + fr] = f2bf(isq ? val * QSCALE : val); }
            }
        if (!isq) {
            const int blk = (row_base % SEQ) >> 8;
#pragma unroll
            for (int n = 0; n < 4; ++n) { float t = ksum[n]; t += __shfl_xor(t, 16); t += __shfl_xor(t, 32);
                if (fq == 0) atomicAdd(o.KMEAN + ((size_t)(b_ * AH + head) * NBLK + blk) * AD + n * 16 + fr, t * (1.0f / 256.0f)); }
        }
    } else {
#pragma unroll
        for (int m = 0; m < 2; ++m)
#pragma unroll
            for (int r = 0; r < 4; ++r) {
                const int row = row_base + m * 16 + fq * 4 + r, s = row % SEQ;
#pragma unroll
                for (int n = 0; n < 4; ++n) {
                    const int c = cg * 64 + n * 16 + fr; const float val = acc[m][n][r];
                    if (c < 1536) { const int head = (c - 1024) >> 6; o.VA[((size_t)(b_ * AH + head) * SEQ + s) * AD + (c & 63)] = f2bf(val); }
                    else if (c < 2048) o.ZA[(size_t)row * AW + (c - 1536)] = f2bf(silu_f(val));
                    else if (c < 3584) o.QKVD[(size_t)row * DCONV + (c - 2048)] = f2bf(val);
                    else o.ZD[(size_t)row * AW + (c - 3584)] = f2bf(silu_f(val));
                }
            }
    }
}

__global__ void __launch_bounds__(256) k_gemm2(const bf16_t* Y, const bf16_t* WT2, const float* x, float* out) {
    const int tid = threadIdx.x, lane = tid & 63, wave = tid >> 6, fr = lane & 15, fq = lane >> 4;
    const int rt = blockIdx.x >> 2, gq = blockIdx.x & 3, cg = gq * 4 + wave;
    f32x4 acc[2][4];
#pragma unroll
    for (int m = 0; m < 2; ++m)
#pragma unroll
        for (int n = 0; n < 4; ++n) acc[m][n] = (f32x4){0.f, 0.f, 0.f, 0.f};
    const bf16_t* ap[2]; const bf16_t* bp[4];
#pragma unroll
    for (int m = 0; m < 2; ++m) ap[m] = Y + (size_t)(rt * 32 + m * 16 + fr) * DM + 8 * fq;
#pragma unroll
    for (int n = 0; n < 4; ++n) bp[n] = WT2 + (size_t)(cg * 64 + n * 16 + fr) * DM + 8 * fq;
    for (int k0 = 0; k0 < DM; k0 += 32) {
        bf16x8 a[2], b[4];
#pragma unroll
        for (int m = 0; m < 2; ++m) a[m] = *(const bf16x8*)(ap[m] + k0);
#pragma unroll
        for (int n = 0; n < 4; ++n) b[n] = *(const bf16x8*)(bp[n] + k0);
#pragma unroll
        for (int m = 0; m < 2; ++m)
#pragma unroll
            for (int n = 0; n < 4; ++n) acc[m][n] = __builtin_amdgcn_mfma_f32_16x16x32_bf16(a[m], b[n], acc[m][n], 0, 0, 0);
    }
#pragma unroll
    for (int m = 0; m < 2; ++m)
#pragma unroll
        for (int r = 0; r < 4; ++r) {
            const size_t row = rt * 32 + m * 16 + fq * 4 + r;
#pragma unroll
            for (int n = 0; n < 4; ++n) { const size_t idx = row * DM + cg * 64 + n * 16 + fr; out[idx] = x[idx] + acc[m][n][r]; }
        }
}

__global__ void __launch_bounds__(256) k_dn_prep(const bf16_t* QKVD, const float* conv_w, bf16_t* QD, bf16_t* KD, bf16_t* VD) {
    const int tid = threadIdx.x, lane = tid & 63, wave = tid >> 6;
    const int gw = blockIdx.x * 4 + wave, ngw = gridDim.x * 4;
    for (int it = gw; it < MTOK * DH; it += ngw) {
        const int row = it >> 2, hh = it & 3, b = row / SEQ, s = row % SEQ;
        float val[3][2];
#pragma unroll
        for (int part = 0; part < 3; ++part)
#pragma unroll
            for (int e = 0; e < 2; ++e) {
                const int cc = part * 512 + hh * 128 + lane + 64 * e; float a = 0.f;
#pragma unroll
                for (int j = 0; j < 4; ++j) { const int sj = s - 3 + j; if (sj >= 0) a += conv_w[j * DCONV + cc] * bf2f(QKVD[(size_t)(row - 3 + j) * DCONV + cc]); }
                val[part][e] = silu_f(a);
            }
        float sq = wave_sum(val[0][0] * val[0][0] + val[0][1] * val[0][1]);
        float sk = wave_sum(val[1][0] * val[1][0] + val[1][1] * val[1][1]);
        const float rq = (1.0f / sqrtf(sq + EPS)) * 0.08838834764831845f, rk = 1.0f / sqrtf(sk + EPS);
        const size_t base = ((size_t)(b * DH + hh) * SEQ + s) * DKH;
#pragma unroll
        for (int e = 0; e < 2; ++e) { QD[base + lane + 64 * e] = f2bf(val[0][e] * rq); KD[base + lane + 64 * e] = f2bf(val[1][e] * rk); VD[base + lane + 64 * e] = f2bf(val[2][e]); }
    }
}
__global__ void __launch_bounds__(128) k_dn_seq(const bf16_t* QD, const bf16_t* KD, const bf16_t* VD, const float* BETA, const float* GDEC, float* OD) {
    __shared__ __attribute__((aligned(16))) float kq[2][256];
    const int e = threadIdx.x, bh = blockIdx.x, b = bh >> 2, hh = bh & 3;
    float S[128];
#pragma unroll
    for (int d = 0; d < 128; ++d) S[d] = 0.f;
    const size_t base = (size_t)bh * SEQ * DKH;
    float kn = bf2f(KD[base + e]), qn = bf2f(QD[base + e]), vn_ = bf2f(VD[base + e]), gn = GDEC[(size_t)bh * SEQ], bn = BETA[(size_t)bh * SEQ];
    for (int t = 0; t < SEQ; ++t) {
        float* buf = kq[t & 1];
        buf[e] = kn; buf[128 + e] = qn;
        const float vt = vn_, alpha = __expf(gn), beta = bn;
        if (t + 1 < SEQ) { const size_t nx = base + (size_t)(t + 1) * DKH + e; kn = bf2f(KD[nx]); qn = bf2f(QD[nx]); vn_ = bf2f(VD[nx]); gn = GDEC[(size_t)bh * SEQ + t + 1]; bn = BETA[(size_t)bh * SEQ + t + 1]; }
        __syncthreads();
        float ks = 0.f;
#pragma unroll
        for (int d = 0; d < 128; d += 4) { const f32x4 k4 = *(const f32x4*)(buf + d); ks += k4[0] * S[d] + k4[1] * S[d + 1] + k4[2] * S[d + 2] + k4[3] * S[d + 3]; }
        const float vnew = beta * (vt - alpha * ks);
        float o = 0.f;
#pragma unroll
        for (int d = 0; d < 128; d += 4) { const f32x4 k4 = *(const f32x4*)(buf + d), q4 = *(const f32x4*)(buf + 128 + d);
#pragma unroll
            for (int i = 0; i < 4; ++i) { S[d + i] = alpha * S[d + i] + k4[i] * vnew; o += q4[i] * S[d + i]; } }
        OD[((size_t)b * SEQ + t) * AW + hh * 128 + e] = o;
    }
}

__device__ __forceinline__ int t5_bucket_dev(int n) {
    if (n < 16) return n;
    int bkt = 16;
    bkt += (n >= 19) + (n >= 21) + (n >= 24) + (n >= 27) + (n >= 31) + (n >= 35) + (n >= 40) + (n >= 46) + (n >= 52) + (n >= 59) + (n >= 67) + (n >= 77) + (n >= 87) + (n >= 99) + (n >= 113);
    return bkt;
}
__global__ void __launch_bounds__(256) k_attn(const bf16_t* QA, const bf16_t* KA, const bf16_t* VA, const float* KMEAN, const float* rel_bias,
                                              const float* qnw, const float* knw, const bf16_t* ZA, bf16_t* Y) {
    __shared__ float qs_all[4][64];
    __shared__ float bias_all[4][32];
    const int tid = threadIdx.x, lane = tid & 63, wave = tid >> 6;
    float* qs = qs_all[wave]; float* bt = bias_all[wave];
    const int gq = blockIdx.x * 4 + wave;
    const int bh = gq / SEQ, s = gq % SEQ, h = bh & 7, b = bh >> 3, own = s >> 8;
    float mq = fabsf(qnw[lane]), mk = fabsf(knw[lane]), mb = (lane < 32) ? rel_bias[lane * AH + h] : -1e30f;
#pragma unroll
    for (int o = 1; o < 64; o <<= 1) { mq = fmaxf(mq, __shfl_xor(mq, o)); mk = fmaxf(mk, __shfl_xor(mk, o)); mb = fmaxf(mb, __shfl_xor(mb, o)); }
    const float mref = (8.0f * mq * mk + mb) * LOG2E;
    qs[lane] = bf2f(QA[(size_t)gq * AD + lane]);
    if (lane < 32) bt[lane] = rel_bias[lane * AH + h] * LOG2E;
    __syncthreads();
    float gate = -INFINITY;
    if (lane < own) { const float* km = KMEAN + ((size_t)bh * NBLK + lane) * AD; float a = 0.f;
        for (int d = 0; d < 64; ++d) a += qs[d] * km[d];
        gate = a; }
    unsigned selmask = 0u;
    for (int r = 0; r < 3; ++r) {
        float bv = gate; int bi = lane;
#pragma unroll
        for (int o = 1; o < 64; o <<= 1) { const float ov = __shfl_xor(bv, o); const int oi = __shfl_xor(bi, o); if (ov > bv || (ov == bv && oi < bi)) { bv = ov; bi = oi; } }
        if (bv > -INFINITY) { selmask |= 1u << bi; if (lane == bi) gate = -INFINITY; }
    }
    selmask |= 1u << own;
    float l = 0.f, oacc = 0.f;
    const bf16_t* Kb = KA + (size_t)bh * SEQ * AD; const bf16_t* Vb = VA + (size_t)bh * SEQ * AD;
    for (int j = 0; j <= own; ++j) {
        if (!((selmask >> j) & 1u)) continue;
        for (int t4 = 0; t4 < 4; ++t4) {
            const int kpos = j * 256 + t4 * 64 + lane;
            const bf16_t* kr = Kb + (size_t)kpos * AD; float sc = 0.f;
#pragma unroll
            for (int c = 0; c < 8; ++c) { const bf16x8 kv = *(const bf16x8*)(kr + c * 8);
#pragma unroll
                for (int i = 0; i < 8; ++i) sc += qs[c * 8 + i] * bf2f((unsigned short)kv[i]); }
            const int dist = s - kpos; float p = 0.f;
            if (dist >= 0) p = exp2f(sc + bt[t5_bucket_dev(dist)] - mref);
            l += p;
            const bf16_t* vr = Vb + (size_t)(j * 256 + t4 * 64) * AD + lane;
#pragma unroll 8
            for (int k = 0; k < 64; ++k) oacc += __shfl(p, k) * bf2f(vr[(size_t)k * AD]);
        }
    }
    l = wave_sum(l);
    const size_t tok = (size_t)b * SEQ + s;
    const float yv = (oacc / l) * bf2f(ZA[tok * AW + h * 64 + lane]);
    Y[tok * DM + h * 64 + lane] = f2bf(yv);
}

__global__ void __launch_bounds__(256) k_ycomb(const float* OD, const float* dnw, const bf16_t* ZD, bf16_t* Y) {
    const int tid = threadIdx.x, lane = tid & 63, wave = tid >> 6;
    const int gw = blockIdx.x * 4 + wave, ngw = gridDim.x * 4;
    for (int it = gw; it < MTOK * DH; it += ngw) {
        const int row = it >> 2, hh = it & 3;
        const float a0 = OD[(size_t)row * AW + hh * 128 + lane], a1 = OD[(size_t)row * AW + hh * 128 + 64 + lane];
        const float ss = wave_sum(a0 * a0 + a1 * a1);
        const float rs = 1.0f / sqrtf(ss * (1.0f / 128.0f) + EPS);
        Y[(size_t)row * DM + 512 + hh * 128 + lane] = f2bf(a0 * rs * dnw[lane] * bf2f(ZD[(size_t)row * AW + hh * 128 + lane]));
        Y[(size_t)row * DM + 512 + hh * 128 + 64 + lane] = f2bf(a1 * rs * dnw[64 + lane] * bf2f(ZD[(size_t)row * AW + hh * 128 + 64 + lane]));
    }
}


#define CBAR_ALL() do{ asm volatile("s_waitcnt vmcnt(0) lgkmcnt(0)":::"memory"); __builtin_amdgcn_s_barrier(); asm volatile("":::"memory"); }while(0)
#define CBAR_LDS() do{ asm volatile("s_waitcnt lgkmcnt(0)":::"memory"); __builtin_amdgcn_s_barrier(); asm volatile("":::"memory"); }while(0)
namespace pg8 {
#define PG8_LAS __attribute__((address_space(3)))
constexpr int BM = 256, BK = 64, HALF = 128, HTB = HALF * BK * 2  , STAGE_BYTES = 8 * HTB, NXCD = 8, WGM = 8;

__host__ __device__ __forceinline__ int lds_byte(int r, int c) { const int st = (r >> 4) * 2 + (c >> 5), rr = r & 15, cc = c & 31, ob = rr * 64 + cc * 2; return st * 1024 + (ob ^ (((ob >> 9) & 1) << 5)); }
__host__ __device__ __forceinline__ void stage_rc(int b, int& R, int& C) { const int st = b / 1024, sb = b % 1024, swz = sb ^ (((sb >> 9) & 1) << 5); R = (st >> 1) * 16 + swz / 64; C = (st & 1) * 32 + (swz % 64) / 2; }
__host__ __device__ __forceinline__ int perm32(int rho) { const int n = rho >> 4, i = rho & 15; return 8 * (i >> 2) + 4 * n + (i & 3); }

struct Unit { int pm, pn; };
struct Gemm { const bf16_t* A; const bf16_t* Bt; int M, N, K; };

struct StaticOrder {
    int nM, nN, nwg, G, c;
    __host__ __device__ void init(int M, int N, int G_, int c_) { nM = M / BM; nN = N / BM; nwg = nM * nN; G = G_; c = c_; }
    __host__ __device__ bool next(int i, Unit& u) const {
        const long L = (long)i * G + c; if (L >= nwg) return false;
        int wgid = (int)L; { const int q = nwg / NXCD, r = nwg % NXCD, xcd = wgid % NXCD, off = wgid / NXCD; wgid = (xcd < r ? xcd * (q + 1) : r * (q + 1) + (xcd - r) * q) + off; }
        const int nig = WGM * nN, gid = wgid / nig, fm = gid * WGM, gsz = (nM - fm) < WGM ? (nM - fm) : WGM;
        u.pm = fm + ((wgid % nig) % gsz); u.pn = (wgid % nig) / gsz; return true;
    }
    __device__ __forceinline__ void a_ready(const Unit&) const {}
    __device__ __forceinline__ void done(const Unit&) const {}
};

__device__ __forceinline__ unsigned cvt_pk_bf16(float lo, float hi) { unsigned r; asm volatile("v_cvt_pk_bf16_f32 %0, %1, %2" : "=v"(r) : "v"(lo), "v"(hi)); return r; }
typedef float f32x2 __attribute__((ext_vector_type(2)));
template <class Epi, class Sched, bool ALIGN_EPI = false, bool SP2 = false>
__device__ __forceinline__ void gemm_phase(PG8_LAS unsigned char* lds, const Gemm g, const Sched& S, const Epi& E) {
    const int tid = threadIdx.x, wid = __builtin_amdgcn_readfirstlane(tid >> 6), lane = tid & 63, wr = wid >> 2, wc = wid & 3, fr = lane & 15, fq = lane >> 4;
    const int K = g.K, nt = K / BK;
    unsigned voffA[2], voffB[2];
#pragma unroll
    for (int i = 0; i < 2; ++i) { int R, C; stage_rc(tid * 16 + i * 8192, R, C); const int Rb = Epi::PERM ? ((R & ~31) + perm32(R & 31)) : R;
        voffA[i] = (unsigned)(R * K + C) * 2u; voffB[i] = (unsigned)(Rb * K + C) * 2u; }
    const size_t kstep = (size_t)(BK * 2);
    const size_t hstep = (size_t)HALF * K * 2;
    const size_t tstep = 2 * hstep;
    const unsigned ldsw = (unsigned)wid * 1024u;
    const int aoff = lds_byte(wr * 64 + fr, fq * 8), boff = lds_byte(wc * 32 + fr, fq * 8);
#define PG8_SA(b, h) (((b) * 2 + (h)) * HTB)
#define PG8_SB(b, h) ((4 + (b) * 2 + (h)) * HTB)
#define PG8_STAGE(bufoff, gbase, voff) do { _Pragma("unroll") for (int _i = 0; _i < 2; ++_i) \
        __builtin_amdgcn_global_load_lds((const unsigned*)((const char*)(gbase) + (voff)[_i]), (PG8_LAS unsigned*)(lds + (bufoff) + ldsw + _i * 8192), 16, 0, 0); } while (0)
#define PG8_LDA(dst, b, h) do { _Pragma("unroll") for (int m = 0; m < 4; ++m) _Pragma("unroll") for (int k = 0; k < 2; ++k) dst[m][k] = *(const PG8_LAS bf16x8*)(lds + PG8_SA(b, h) + aoff + m * 2048 + k * 1024); } while (0)
#define PG8_LDB(dst, b, h) do { _Pragma("unroll") for (int n = 0; n < 2; ++n) _Pragma("unroll") for (int k = 0; k < 2; ++k) dst[n][k] = *(const PG8_LAS bf16x8*)(lds + PG8_SB(b, h) + boff + n * 2048 + k * 1024); } while (0)
#define PG8_MMA(ai, bj, At, Bt) do { __builtin_amdgcn_s_setprio(1); _Pragma("unroll") for (int m = 0; m < 4; ++m) _Pragma("unroll") for (int n = 0; n < 2; ++n) _Pragma("unroll") for (int k = 0; k < 2; ++k) \
        acc[ai][bj][m][n] = __builtin_amdgcn_mfma_f32_16x16x32_bf16(Bt[n][k], At[m][k], acc[ai][bj][m][n], 0, 0, 0); __builtin_amdgcn_s_setprio(0); } while (0)
#define PG8_WAIT_V(n) asm volatile("s_waitcnt vmcnt(" #n ")" ::: "memory")
#define PG8_WAIT_L(n) asm volatile("s_waitcnt lgkmcnt(" #n ")" ::: "memory")
#define PG8_BAR __builtin_amdgcn_s_barrier()
#define PG8_SCHED __builtin_amdgcn_sched_barrier(0)
    Unit cur, nxt; int ui = 0;
    if (!S.next(0, cur)) return;
    f32x4 acc[2][2][4][2];
#pragma unroll
    for (int a = 0; a < 2; ++a)
#pragma unroll
        for (int b = 0; b < 2; ++b)
#pragma unroll
            for (int m = 0; m < 4; ++m)
#pragma unroll
                for (int n = 0; n < 2; ++n) acc[a][b][m][n] = (f32x4){0.f, 0.f, 0.f, 0.f};
    bf16x8 At[4][2], B0[2][2], B1[2][2];
    const char* cA = (const char*)g.A + (size_t)cur.pm * tstep; const char* cB = (const char*)g.Bt + (size_t)cur.pn * tstep;
    S.a_ready(cur);
    if constexpr (SP2) {
        PG8_STAGE(PG8_SB(0, 0), cB, voffB); PG8_STAGE(PG8_SB(0, 1), cB + hstep, voffB); PG8_STAGE(PG8_SA(0, 0), cA, voffA); PG8_STAGE(PG8_SA(0, 1), cA + hstep, voffA);
        if (wr == 1) PG8_BAR;
        PG8_WAIT_V(2); PG8_BAR;
        PG8_STAGE(PG8_SB(1, 0), cB + kstep, voffB); PG8_STAGE(PG8_SA(1, 0), cA + kstep, voffA); PG8_STAGE(PG8_SB(1, 1), cB + hstep + kstep, voffB);
        PG8_WAIT_V(6); PG8_BAR;
    } else {
        PG8_STAGE(PG8_SB(0, 0), cB, voffB); PG8_STAGE(PG8_SA(0, 0), cA, voffA); PG8_STAGE(PG8_SB(0, 1), cB + hstep, voffB); PG8_STAGE(PG8_SA(0, 1), cA + hstep, voffA);
        if (wr == 1) PG8_BAR;
        PG8_WAIT_V(4); PG8_BAR;
        PG8_STAGE(PG8_SB(1, 0), cB + kstep, voffB); PG8_STAGE(PG8_SA(1, 0), cA + kstep, voffA); PG8_STAGE(PG8_SB(1, 1), cB + hstep + kstep, voffB);
        PG8_WAIT_V(6); PG8_BAR;
    }
    for (;;) {
        const bool has_next = S.next(ui + 1, nxt);
        const char* nA = has_next ? (const char*)g.A + (size_t)nxt.pm * tstep : cA; const char* nB = has_next ? (const char*)g.Bt + (size_t)nxt.pn * tstep : cB;
        for (int t = 0; t < nt; t += 2) {
            const bool last = (t == nt - 2);
            const char* a1 = cA + (size_t)(t + 1) * kstep;
            const char* a2 = last ? nA : cA + (size_t)(t + 2) * kstep; const char* b2 = last ? nB : cB + (size_t)(t + 2) * kstep;
            const char* a3 = a2 + kstep; const char* b3 = b2 + kstep;
            if (last && has_next) S.a_ready(nxt);
            if constexpr (SP2) {
            PG8_LDB(B0, 0, 0); PG8_LDB(B1, 0, 1); PG8_SCHED; PG8_LDA(At, 0, 0); PG8_STAGE(PG8_SA(1, 1), a1 + hstep, voffA);
            PG8_WAIT_V(8); PG8_WAIT_L(0); PG8_BAR; PG8_MMA(0, 0, At, B0); PG8_MMA(0, 1, At, B1); PG8_BAR; PG8_SCHED;
            PG8_LDA(At, 0, 1); PG8_STAGE(PG8_SB(0, 0), b2, voffB); PG8_STAGE(PG8_SB(0, 1), b2 + hstep, voffB); PG8_STAGE(PG8_SA(0, 0), a2, voffA);
            PG8_WAIT_V(8); PG8_WAIT_L(0); PG8_BAR; PG8_MMA(1, 0, At, B0); PG8_MMA(1, 1, At, B1); PG8_BAR; PG8_SCHED;
            PG8_LDB(B0, 1, 0); PG8_LDB(B1, 1, 1); PG8_SCHED; PG8_LDA(At, 1, 0); PG8_STAGE(PG8_SA(0, 1), a2 + hstep, voffA);
            PG8_WAIT_V(8); PG8_WAIT_L(0); PG8_BAR; PG8_MMA(0, 0, At, B0); PG8_MMA(0, 1, At, B1); PG8_BAR; PG8_SCHED;
            PG8_LDA(At, 1, 1); PG8_STAGE(PG8_SB(1, 0), b3, voffB); PG8_STAGE(PG8_SB(1, 1), b3 + hstep, voffB); PG8_STAGE(PG8_SA(1, 0), a3, voffA);
            PG8_WAIT_V(8); PG8_WAIT_L(0); PG8_BAR; PG8_MMA(1, 0, At, B0); PG8_MMA(1, 1, At, B1); PG8_BAR; PG8_SCHED;
            } else {
            PG8_LDB(B0, 0, 0); PG8_SCHED; PG8_LDA(At, 0, 0); PG8_STAGE(PG8_SA(1, 1), a1 + hstep, voffA);
            PG8_WAIT_L(8); PG8_BAR; PG8_WAIT_L(0); PG8_MMA(0, 0, At, B0); PG8_BAR; PG8_SCHED;
            PG8_LDB(B1, 0, 1); PG8_STAGE(PG8_SB(0, 0), b2, voffB);
            PG8_BAR; PG8_WAIT_L(0); PG8_MMA(0, 1, At, B1); PG8_BAR;
            PG8_LDA(At, 0, 1); PG8_STAGE(PG8_SA(0, 0), a2, voffA);
            PG8_BAR; PG8_WAIT_L(0); PG8_MMA(1, 0, At, B0); PG8_BAR; PG8_SCHED;
            PG8_STAGE(PG8_SB(0, 1), b2 + hstep, voffB);
            PG8_WAIT_V(6); PG8_BAR; PG8_MMA(1, 1, At, B1); PG8_BAR;
            PG8_LDB(B0, 1, 0); PG8_SCHED; PG8_LDA(At, 1, 0); PG8_STAGE(PG8_SA(0, 1), a2 + hstep, voffA);
            PG8_WAIT_L(8); PG8_BAR; PG8_WAIT_L(0); PG8_MMA(0, 0, At, B0); PG8_BAR; PG8_SCHED;
            PG8_LDB(B1, 1, 1); PG8_STAGE(PG8_SB(1, 0), b3, voffB);
            PG8_BAR; PG8_WAIT_L(0); PG8_MMA(0, 1, At, B1); PG8_BAR;
            PG8_LDA(At, 1, 1); PG8_STAGE(PG8_SA(1, 0), a3, voffA);
            PG8_BAR; PG8_WAIT_L(0); PG8_MMA(1, 0, At, B0); PG8_BAR; PG8_SCHED;
            PG8_STAGE(PG8_SB(1, 1), b3 + hstep, voffB);
            PG8_WAIT_V(6); PG8_BAR; PG8_MMA(1, 1, At, B1); PG8_BAR;
            }
        }
        if constexpr (ALIGN_EPI) { if (wr == 0) PG8_BAR; }
        if constexpr (!Epi::AFTER_DRAIN) { E(acc, cur, wr, wc, fr, fq); S.done(cur); }
        if (!has_next) break;
#pragma unroll
        for (int a = 0; a < 2; ++a)
#pragma unroll
            for (int b = 0; b < 2; ++b)
#pragma unroll
                for (int m = 0; m < 4; ++m)
#pragma unroll
                    for (int n = 0; n < 2; ++n) acc[a][b][m][n] = (f32x4){0.f, 0.f, 0.f, 0.f};
        cur = nxt; cA = nA; cB = nB; ++ui;
        if constexpr (ALIGN_EPI) { if (wr == 1) PG8_BAR; }
    }
    PG8_WAIT_V(0);
    if constexpr (!ALIGN_EPI) { if (wr == 0) PG8_BAR; }
    PG8_BAR;
    if constexpr (Epi::AFTER_DRAIN) { E.fused(acc, cur, wr, wc, fr, fq, lds, wid, lane); S.done(cur); }
#undef PG8_SA
#undef PG8_SB
#undef PG8_STAGE
#undef PG8_LDA
#undef PG8_LDB
#undef PG8_MMA
#undef PG8_WAIT_V
#undef PG8_WAIT_L
#undef PG8_BAR
#undef PG8_SCHED
}
}

namespace pg8 {
__device__ __forceinline__ float fast_silu(float x) { return x * __builtin_amdgcn_rcpf(1.0f + __expf(-x)); }
struct EpiProj {
    static constexpr bool PERM = true, AFTER_DRAIN = false;
    bf16_t *QA, *KA, *VA, *ZA, *ZD, *QKVD; float* KMEAN; const float *qnw, *knw; int pt_off;
    __device__ __forceinline__ void operator()(const f32x4 (&acc)[2][2][4][2], const Unit& u, int wr, int wc, int fr, int fq) const {
        const int pn = wt1_ltile(u.pn + pt_off), b = u.pm >> 5, blk = u.pm & 31;
        const int s0 = blk * 256 + wr * 64 + fr;
        const int row0 = u.pm * BM + wr * 64 + fr;
        if (pn < 4) {
            const bool isq = pn < 2; const int head = (pn & 1) * 4 + wc; const float* nwp = isq ? qnw : knw;
            f32x4 nw[2][2];
#pragma unroll
            for (int bj = 0; bj < 2; ++bj)
#pragma unroll
                for (int n = 0; n < 2; ++n) nw[bj][n] = *(const f32x4*)(nwp + 32 * bj + 8 * fq + 4 * n);
            f32x4 ksum[2][2];
#pragma unroll
            for (int bj = 0; bj < 2; ++bj)
#pragma unroll
                for (int n = 0; n < 2; ++n) ksum[bj][n] = (f32x4){0.f, 0.f, 0.f, 0.f};
            bf16_t* dbase = (isq ? QA : KA) + ((size_t)(b * 8 + head) * 8192) * 64 + 8 * fq;
            const float sc = isq ? 0.125f * 1.4426950408889634f : 1.0f;
#pragma unroll
            for (int ai = 0; ai < 2; ++ai)
#pragma unroll
                for (int m = 0; m < 4; ++m) {
                    float ss = 0.f;
#pragma unroll
                    for (int bj = 0; bj < 2; ++bj)
#pragma unroll
                        for (int n = 0; n < 2; ++n) { const f32x4 v = acc[ai][bj][m][n]; ss += (v[0] * v[0] + v[1] * v[1]) + (v[2] * v[2] + v[3] * v[3]); }
                    ss += __shfl_xor(ss, 16); ss += __shfl_xor(ss, 32);
                    const float rs = (1.0f / sqrtf(ss * (1.0f / 64.0f) + 1e-6f));
                    bf16_t* dst = dbase + (size_t)(s0 + ai * 128 + m * 16) * 64;
#pragma unroll
                    for (int bj = 0; bj < 2; ++bj) {
                        const f32x4 v0 = acc[ai][bj][m][0] * rs * nw[bj][0], v1 = acc[ai][bj][m][1] * rs * nw[bj][1];
                        ksum[bj][0] += v0; ksum[bj][1] += v1;
                        u32x4 w; w.x = cvt_pk_bf16(v0[0] * sc, v0[1] * sc); w.y = cvt_pk_bf16(v0[2] * sc, v0[3] * sc); w.z = cvt_pk_bf16(v1[0] * sc, v1[1] * sc); w.w = cvt_pk_bf16(v1[2] * sc, v1[3] * sc);
                        *(u32x4*)(dst + 32 * bj) = w;
                    }
                }
            if (!isq) {
                float* km = KMEAN + ((size_t)(b * 8 + head) * 32 + blk) * 64 + 8 * fq;
#pragma unroll
                for (int bj = 0; bj < 2; ++bj)
#pragma unroll
                    for (int n = 0; n < 2; ++n)
#pragma unroll
                        for (int e = 0; e < 4; ++e) {
                            float t = ksum[bj][n][e];
                            t += __shfl_xor(t, 1); t += __shfl_xor(t, 2); t += __shfl_xor(t, 4); t += __shfl_xor(t, 8);
                            if (fr == 0) atomicAdd(km + 32 * bj + 4 * n + e, t * (1.0f / 256.0f));
                        }
            }
        } else {
            bf16_t* dbase; size_t ld; int colb; bool act;
            if (pn < 6) { const int head = (pn - 4) * 4 + wc; dbase = VA + ((size_t)(b * 8 + head) * 8192 + blk * 256) * 64; ld = 64; colb = 0; act = false; }
            else if (pn < 8) { dbase = ZA + (size_t)(u.pm * BM) * 512; ld = 512; colb = (pn - 6) * 256 + wc * 64; act = true; }
            else if (pn < 14) { dbase = QKVD + (size_t)(u.pm * BM) * 1536; ld = 1536; colb = (pn - 8) * 256 + wc * 64; act = false; }
            else { dbase = ZD + (size_t)(u.pm * BM) * 512; ld = 512; colb = (pn - 14) * 256 + wc * 64; act = true; }
            const int rloc = wr * 64 + fr;
#pragma unroll
            for (int ai = 0; ai < 2; ++ai)
#pragma unroll
                for (int m = 0; m < 4; ++m) {
                    bf16_t* dst = dbase + (size_t)(rloc + ai * 128 + m * 16) * ld + colb + 8 * fq;
#pragma unroll
                    for (int bj = 0; bj < 2; ++bj) {
                        f32x4 v0 = acc[ai][bj][m][0], v1 = acc[ai][bj][m][1];
                        if (act) {
#pragma unroll
                            for (int e = 0; e < 4; ++e) { v0[e] = fast_silu(v0[e]); v1[e] = fast_silu(v1[e]); }
                        }
                        u32x4 w; w.x = cvt_pk_bf16(v0[0], v0[1]); w.y = cvt_pk_bf16(v0[2], v0[3]); w.z = cvt_pk_bf16(v1[0], v1[1]); w.w = cvt_pk_bf16(v1[2], v1[3]);
                        *(u32x4*)(dst + 32 * bj) = w;
                    }
                }
        }
        (void)row0;
    }
};
struct EpiOut {
    static constexpr bool PERM = false, AFTER_DRAIN = false;
    const float* X; float* O;
    __device__ __forceinline__ void operator()(const f32x4 (&acc)[2][2][4][2], const Unit& u, int wr, int wc, int fr, int fq) const {
        const int row0 = u.pm * BM + wr * 64 + fr, col0 = u.pn * BM + wc * 32 + 4 * fq;
#pragma unroll
        for (int ai = 0; ai < 2; ++ai)
#pragma unroll
            for (int m = 0; m < 4; ++m) { const size_t off = (size_t)(row0 + ai * HALF + m * 16) * 1024 + col0;
#pragma unroll
                for (int bj = 0; bj < 2; ++bj)
#pragma unroll
                    for (int n = 0; n < 2; ++n) { const f32x4 xv = *(const f32x4*)(X + off + bj * HALF + n * 16); *(f32x4*)(O + off + bj * HALF + n * 16) = xv + acc[ai][bj][m][n]; } }
    }
};
}

#define LAS __attribute__((address_space(3)))
constexpr int NWAVES = 8;
constexpr int RING_OFF = 0;
constexpr int LDS_BYTES = 163840;
constexpr int LDSCTL_OFF = LDS_BYTES - 1024, MISC_OFF = LDSCTL_OFF + 320;
constexpr int CW_BAR = 4096;

#define XB_TMO      128
#define XB_XCNT(j)  (256  + 64 * (j))
#define XB_XSUB(j)  (1280 + 64 * (j))
#define XB_XGEN(j)  (2304 + 64 * (j))
#define XB_TOP      3328
#define XB_TOPGEN   3392
#define XCD_BAR_WORDS 3456
#define XB_SPIN_CAP (1u << 18)
__device__ __forceinline__ unsigned xb_ld(unsigned* p)              { return __hip_atomic_load(p, __ATOMIC_RELAXED, __HIP_MEMORY_SCOPE_AGENT); }
__device__ __forceinline__ unsigned xb_add(unsigned* p, unsigned v) { return __hip_atomic_fetch_add(p, v, __ATOMIC_RELAXED, __HIP_MEMORY_SCOPE_AGENT); }
__device__ __forceinline__ unsigned xb_xcc_id() { return (unsigned)__builtin_amdgcn_s_getreg((3 << 11) | 20) & 0xFu; }
#define XB_SPIN(cond, bar) do { unsigned _sp = 0; while (cond) { __builtin_amdgcn_s_sleep(1); \
    if ((++_sp & 255u) == 0u) { if (xb_ld(&(bar)[XB_TMO])) break; if (_sp > XB_SPIN_CAP) { atomicAdd(&(bar)[XB_TMO], 1u); break; } } } } while (0)
struct XcdBarrier { unsigned* bar; unsigned x; volatile LAS unsigned* st; };
__device__ __forceinline__ XcdBarrier xcd_barrier_post(unsigned* bar, volatile LAS unsigned* st) {
    XcdBarrier b; b.bar = bar; b.x = xb_xcc_id(); b.st = st;
    if (threadIdx.x == 0) (void)xb_add(&bar[XB_XCNT(b.x)], 1u);
    return b;
}
__device__ __forceinline__ void xcd_barrier_complete(unsigned* bar, unsigned x, unsigned& nloc, unsigned& nx) {
    const unsigned G = gridDim.x * gridDim.y * gridDim.z;
    unsigned sum, cnt, mine, sp = 0u;
    for (;;) {
        sum = 0u; cnt = 0u; mine = 0u;
#pragma unroll
        for (unsigned j = 0; j < 16; ++j) { const unsigned c = xb_ld(&bar[XB_XCNT(j)]); sum += c; cnt += (c > 0u) ? 1u : 0u; mine = (j == x) ? c : mine; }
        if (sum == G) break;
        __builtin_amdgcn_s_sleep(1);
        if ((++sp & 255u) == 0u) { if (xb_ld(&bar[XB_TMO])) break; if (sp > XB_SPIN_CAP) { atomicAdd(&bar[XB_TMO], 1u); break; } }
    }
    nloc = mine > 0u ? mine : 1u; nx = cnt > 0u ? cnt : 1u;
}
__device__ __forceinline__ void xcd_barrier(const XcdBarrier& b) {
    asm volatile("s_waitcnt vmcnt(0)" ::: "memory");
    __syncthreads();
    if (threadIdx.x == 0) {
        unsigned* bar = b.bar;
        __builtin_amdgcn_s_waitcnt(0);
        unsigned nloc = b.st[0], nx = b.st[1];
        if (nloc == 0u) { xcd_barrier_complete(bar, b.x, nloc, nx); b.st[0] = nloc; b.st[1] = nx; }
        const unsigned old = xb_add(&bar[XB_XSUB(b.x)], 1u);
        const unsigned gen = old / nloc;
        if (old + 1u == (gen + 1u) * nloc) {
            __builtin_amdgcn_fence(__ATOMIC_RELEASE, "agent");
            asm volatile("s_waitcnt vmcnt(0)" ::: "memory");
            const unsigned og = xb_add(&bar[XB_TOP], 1u);
            const unsigned tg = og / nx;
            if (og + 1u == (tg + 1u) * nx) xb_add(&bar[XB_TOPGEN], 1u);
            else XB_SPIN(xb_ld(&bar[XB_TOPGEN]) == tg, bar);
            __builtin_amdgcn_fence(__ATOMIC_ACQUIRE, "agent");
            xb_add(&bar[XB_XGEN(b.x)], 1u);
            asm volatile("s_waitcnt vmcnt(0)" ::: "memory");
        } else {
            XB_SPIN(xb_ld(&bar[XB_XGEN(b.x)]) == gen, bar);
            __builtin_amdgcn_fence(__ATOMIC_ACQUIRE, "agent");
            asm volatile("s_waitcnt vmcnt(0)" ::: "memory");
        }
    }
    __syncthreads();
}

struct Ptrs {
    const float *x, *rel_bias, *norm_w, *w_in, *qnw, *knw, *conv_w, *a_log, *dt_bias, *dnw, *w_out;
    float* out; bf16_t* HN; bf16_t *WT1, *WT2; float *BETA, *GDEC, *KMEAN; bf16_t *QA, *KA, *VA, *ZA, *ZD, *QKVD, *QD, *KD, *VD; float* OD; bf16_t* Y; unsigned* ctl; unsigned char* REC; float* GLB; unsigned* SEL; unsigned short* LIST; float* LP; bf16_t* OPART;
};
__host__ __device__ inline Ptrs make_ptrs(void* const* d_in, void* d_out, unsigned char* ws) {
    Ptrs p;
    p.x = (const float*)d_in[0]; p.rel_bias = (const float*)d_in[1]; p.norm_w = (const float*)d_in[2]; p.w_in = (const float*)d_in[3]; p.qnw = (const float*)d_in[4]; p.knw = (const float*)d_in[5];
    p.conv_w = (const float*)d_in[6]; p.a_log = (const float*)d_in[7]; p.dt_bias = (const float*)d_in[8]; p.dnw = (const float*)d_in[9]; p.w_out = (const float*)d_in[10];
    p.out = (float*)d_out; p.HN = (bf16_t*)d_out;
    p.WT1 = (bf16_t*)(ws + WS_WT1); p.WT2 = (bf16_t*)(ws + WS_WT2); p.BETA = (float*)(ws + WS_BETA); p.GDEC = (float*)(ws + WS_GDEC); p.KMEAN = (float*)(ws + WS_KMEAN);
    p.QA = (bf16_t*)(ws + WS_QA); p.KA = (bf16_t*)(ws + WS_KA); p.VA = (bf16_t*)(ws + WS_VA); p.ZA = (bf16_t*)(ws + WS_ZA); p.ZD = (bf16_t*)(ws + WS_ZD); p.QKVD = (bf16_t*)(ws + WS_QKVD);
    p.QD = (bf16_t*)(ws + WS_QD); p.KD = (bf16_t*)(ws + WS_KD); p.VD = (bf16_t*)(ws + WS_VD); p.OD = (float*)((unsigned char*)d_out + OUT_OD); p.Y = (bf16_t*)(ws + WS_Y); p.ctl = (unsigned*)(ws + WS_CTL); p.REC = ws + WS_REC; p.GLB = (float*)(ws + WS_GLB);
    { unsigned char* o8 = (unsigned char*)d_out; p.SEL = (unsigned*)o8; p.LIST = (unsigned short*)(o8 + 1 * MiB); p.LP = (float*)(o8 + 17 * MiB); p.OPART = (bf16_t*)(o8 + 21 * MiB); }
    return p;
}


namespace dn {
using f32x16=__attribute__((ext_vector_type(16)))float;
typedef unsigned u32x2v __attribute__((ext_vector_type(2)));
constexpr int REC_NW=0, REC_QD=16384, REC_KT=32768, REC_AI=49152, REC_U=57344, REC_BYTES=73728;
constexpr int CH=64;
__device__ __forceinline__ int crow(int r,int hi){return (r&3)+8*(r>>2)+4*hi;}
typedef float f32x2_t __attribute__((ext_vector_type(2))); typedef __bf16 bf16x2_t __attribute__((ext_vector_type(2)));
__device__ __forceinline__ unsigned cvtpk(float lo,float hi){f32x2_t v={lo,hi};bf16x2_t b=__builtin_convertvector(v,bf16x2_t);return __builtin_bit_cast(unsigned,b);}
__device__ __forceinline__ float bflo(unsigned w){return __uint_as_float(w<<16);}
__device__ __forceinline__ float bfhi(unsigned w){return __uint_as_float(w&0xffff0000u);}
#define DN_MFMA32(a,b,c) __builtin_amdgcn_mfma_f32_32x32x16_bf16((a),(b),(c),0,0,0)
#ifndef SCANDBG
#define SCANDBG 0
#endif
#define DN_MFMA4(a,b,c) __builtin_amdgcn_mfma_f32_16x16x4f32((a),(b),(c),0,0,0)
#define DN_BAR() CBAR_ALL()
__device__ __forceinline__ void st16_wt(void*p,u32x4 v){ asm volatile("global_store_dwordx4 %0, %1, off sc1\n\ts_nop 1"::"v"(p),"v"(v):"memory"); }
__device__ __forceinline__ void st8_wt(void*p,unsigned lo,unsigned hi){ __hip_atomic_store((unsigned long long*)p,((unsigned long long)hi<<32)|lo,__ATOMIC_RELAXED,__HIP_MEMORY_SCOPE_AGENT); }

constexpr int P_QI=0, P_KI=16384, P_XT=32768, XT_LD=68, P_LF=P_XT+256*XT_LD*4, LF_LD=68, P_DF=P_LF+64*LF_LD*4, DF_LD=20, P_GC=P_DF+4*16*DF_LD*4, P_EG=P_GC+256, P_EKD=P_EG+256, P_BETA=P_EKD+256, P_END=P_BETA+256;
static_assert(P_END<=131072,"prep LDS");

__device__ __forceinline__ void prep_chunk(int c,const bf16_t*QKVD,const float*conv_w,const float*BETA,const float*GDEC,unsigned char*rec,float*GLB,unsigned*flags,LAS unsigned char*lds,int pdbg=0){
  const int tid=threadIdx.x; int lane=tid&63; asm volatile("":"+v"(lane));
  const int wid=__builtin_amdgcn_readfirstlane(tid>>6);
  const int bh=c>>7,n=c&127,b=bh>>2,h=bh&3,s0=n*CH; const size_t tok0=(size_t)b*SEQ+s0;
  LAS float*GC=(LAS float*)(lds+P_GC); LAS float*EG=(LAS float*)(lds+P_EG); LAS float*EKD=(LAS float*)(lds+P_EKD); LAS float*BT=(LAS float*)(lds+P_BETA);
  LAS float*XT=(LAS float*)(lds+P_XT); LAS float*LF=(LAS float*)(lds+P_LF); LAS float*DF=(LAS float*)(lds+P_DF);
  float g_l=GDEC[(size_t)bh*SEQ+s0+lane]; const float bt_l=BETA[(size_t)bh*SEQ+s0+lane];
  #pragma unroll
  for(int o=1;o<64;o<<=1){ const float t=__shfl_up(g_l,o); if(lane>=o)g_l+=t; }
  const float eg_l=__expf(g_l);
  if(wid==0){
    const float gl=__shfl(g_l,63);
    GC[lane]=g_l; EG[lane]=eg_l; EKD[lane]=__expf(gl-g_l); BT[lane]=bt_l;
    if(lane==63)__hip_atomic_store(GLB+c,eg_l,__ATOMIC_RELAXED,__HIP_MEMORY_SCOPE_AGENT);
  }
  {
    float cw[3][4][2];
    #pragma unroll
    for(int p=0;p<3;++p)
      #pragma unroll
      for(int j=0;j<4;++j){ const float2 w2=*(const float2*)(conv_w+j*DCONV+p*512+h*128+2*lane); cw[p][j][0]=w2.x; cw[p][j][1]=w2.y; }
    unsigned xr[3][11];
    #pragma unroll
    for(int rr=0;rr<11;++rr){ const int sp=s0+8*wid-3+rr;
      #pragma unroll
      for(int p=0;p<3;++p) xr[p][rr]=(sp>=0)?*(const unsigned*)(QKVD+(tok0+8*wid-3+rr)*DCONV+p*512+h*128+2*lane):0u; }
    #pragma unroll
    for(int i=0;i<8;++i){
      const int pos=8*wid+i;
      float v[3][2];
      #pragma unroll
      for(int p=0;p<3;++p){ float a0=0.f,a1=0.f;
        #pragma unroll
        for(int j=0;j<4;++j){ a0+=cw[p][j][0]*bflo(xr[p][i+j]); a1+=cw[p][j][1]*bfhi(xr[p][i+j]); }
        v[p][0]=a0*__builtin_amdgcn_rcpf(1.0f+__expf(-a0)); v[p][1]=a1*__builtin_amdgcn_rcpf(1.0f+__expf(-a1)); }
      const float sq=wave_sum(v[0][0]*v[0][0]+v[0][1]*v[0][1]), sk=wave_sum(v[1][0]*v[1][0]+v[1][1]*v[1][1]);
      const float rq=(1.0f/sqrtf(sq+EPS))*0.08838834764831845f, rk=1.0f/sqrtf(sk+EPS);
      const float q0=v[0][0]*rq,q1=v[0][1]*rq,k0=v[1][0]*rk,k1=v[1][1]*rk;
      const int ch=2*lane; const int off=((ch>>3)*64+pos)*16+(ch&7)*2;
      *(LAS unsigned*)(lds+P_QI+off)=cvtpk(q0,q1);
      *(LAS unsigned*)(lds+P_KI+off)=cvtpk(k0,k1);
      const float bt=__shfl(bt_l,pos), be=bt*__shfl(eg_l,pos);
      XT[(ch)*XT_LD+pos]=v[2][0]*bt; XT[(ch+1)*XT_LD+pos]=v[2][1]*bt;
      XT[(128+ch)*XT_LD+pos]=k0*be; XT[(128+ch+1)*XT_LD+pos]=k1*be;
    }
  }
  CBAR_LDS();
  {
    const int r32=lane&31,hi=lane>>5;
    if(wid<6){
      const int kind=wid/3, w3=wid%3;
      const int ta=(kind==0)?(w3==0?0:1):(w3==2?1:0);
      const int tb=(kind==0)?(w3==2?1:0):(w3==0?0:1);
      const LAS unsigned char*Ab=lds+P_KI+(32*ta+r32)*16+hi*1024;
      const LAS unsigned char*Bb=lds+(kind==0?P_KI:P_QI)+(32*tb+r32)*16+hi*1024;
      f32x16 acc=f32x16{};
      #pragma unroll
      for(int ks=0;ks<8;++ks){ const bf16x8 a=*(const LAS bf16x8*)(Ab+ks*2048), bb=*(const LAS bf16x8*)(Bb+ks*2048); acc=DN_MFMA32(a,bb,acc); }
      if(kind==0){
        const int j=32*tb+r32; const float gj=GC[j];
        #pragma unroll
        for(int r=0;r<16;++r){ const int i=32*ta+crow(r,0)+4*hi; const float val=(j<i)?BT[i]*acc[r]*__expf(GC[i]-gj):0.f; LF[i*LF_LD+j]=val; }
      } else {
        const int i=32*tb+r32; const float gi=GC[i];
        float o_[16];
        #pragma unroll
        for(int r=0;r<16;++r){ const int j=32*ta+crow(r,0)+4*hi; o_[r]=(j<=i)?acc[r]*__expf(gi-GC[j]):0.f; }
        #pragma unroll
        for(int s=0;s<2;++s){ u32x4 w; w.x=cvtpk(o_[8*s],o_[8*s+1]); w.y=cvtpk(o_[8*s+2],o_[8*s+3]); w.z=cvtpk(o_[8*s+4],o_[8*s+5]); w.w=cvtpk(o_[8*s+6],o_[8*s+7]);
          st16_wt(rec+REC_AI+((tb*4+2*ta+s)*64+lane)*16,w); }
      }
    }
  }
  CBAR_LDS();
  if(pdbg&2){} else
  if(wid==0){
    const int bb=lane>>4,j=lane&15; float t[16];
    const LAS float*Lb=LF+(16*bb)*LF_LD+16*bb;
    f32x4 rw[16][4];
    #pragma unroll
    for(int i=1;i<16;++i)
      #pragma unroll
      for(int q=0;q<(i+3)/4;++q) rw[i][q]=*(const LAS f32x4*)(Lb+i*LF_LD+4*q);
    #pragma unroll
    for(int i=0;i<16;++i){ float s=(i==j)?1.0f:0.0f;
      #pragma unroll
      for(int m=0;m<i;++m) s-=rw[i][m>>2][m&3]*t[m];
      t[i]=s; DF[(bb*16+i)*DF_LD+j]=s; }
  } else {
    const int r32=lane&31,hi=lane>>5;
    for(int f=wid-1;f<32;f+=7){
      if(f<16){
        const int i2=f>>3,ks=f&7,pos=32*i2+r32; const float e=EG[pos];
        const u32x2v lo=*(const LAS u32x2v*)(lds+P_QI+((2*ks)*64+pos)*16+8*hi), hi2=*(const LAS u32x2v*)(lds+P_QI+((2*ks+1)*64+pos)*16+8*hi);
        u32x4 w; w.x=cvtpk(bflo(lo.x)*e,bfhi(lo.x)*e); w.y=cvtpk(bflo(lo.y)*e,bfhi(lo.y)*e); w.z=cvtpk(bflo(hi2.x)*e,bfhi(hi2.x)*e); w.w=cvtpk(bflo(hi2.y)*e,bfhi(hi2.y)*e);
        st16_wt(rec+REC_QD+(f*64+lane)*16,w);
      } else {
        const int f2=f-16,t=f2>>2,ks=f2&3,dk=32*t+r32; const LAS unsigned short*kp=(const LAS unsigned short*)(lds+P_KI+(dk>>3)*1024+(dk&7)*2);
        const f32x4 e0=*(const LAS f32x4*)(EKD+16*ks+4*hi), e1=*(const LAS f32x4*)(EKD+16*ks+8+4*hi);
        float x[8];
        #pragma unroll
        for(int j=0;j<8;++j){ const int pos=16*ks+8*(j>>2)+4*hi+(j&3); x[j]=__uint_as_float(((unsigned)kp[pos*8])<<16)*((j<4)?e0[j&3]:e1[j&3]); }
        u32x4 w; w.x=cvtpk(x[0],x[1]); w.y=cvtpk(x[2],x[3]); w.z=cvtpk(x[4],x[5]); w.w=cvtpk(x[6],x[7]);
        st16_wt(rec+REC_KT+(f2*64+lane)*16,w);
      }
    }
  }
  CBAR_LDS();
  if(!(pdbg&1))
  {
    const int cl=lane&15,g=lane>>4;
    #define PK4(v) cvtpk((v)[0],(v)[1]),cvtpk((v)[2],(v)[3])
    #define FRAG(a_,b_) __builtin_bit_cast(bf16x8,(u32x4){PK4(a_),PK4(b_)})
    #define DN_MFMA16(a,b,c) __builtin_amdgcn_mfma_f32_16x16x32_bf16((a),(b),(c),0,0,0)
    const f32x4 z4=(f32x4){0.f,0.f,0.f,0.f};
    #pragma unroll 1
    for(int cc=0;cc<2;++cc){
      const int ct=2*wid+cc, col=16*ct+cl;
      f32x4 Y[4];
      #pragma unroll
      for(int bb=0;bb<4;++bb){
        f32x4 acc=*(const LAS f32x4*)(XT+col*XT_LD+16*bb+4*g);
        const LAS float*Lr=LF+(16*bb+cl)*LF_LD+4*g;
        if(bb==1){ const f32x4 l0=-*(const LAS f32x4*)(Lr); acc=DN_MFMA16(FRAG(l0,z4),FRAG(Y[0],z4),acc); }
        if(bb==2){ const f32x4 l0=-*(const LAS f32x4*)(Lr), l1=-*(const LAS f32x4*)(Lr+16); acc=DN_MFMA16(FRAG(l0,l1),FRAG(Y[0],Y[1]),acc); }
        if(bb==3){ const f32x4 l0=-*(const LAS f32x4*)(Lr), l1=-*(const LAS f32x4*)(Lr+16), l2=-*(const LAS f32x4*)(Lr+32);
          acc=DN_MFMA16(FRAG(l0,l1),FRAG(Y[0],Y[1]),acc); acc=DN_MFMA16(FRAG(l2,z4),FRAG(Y[2],z4),acc); }
        const f32x4 Da=*(const LAS f32x4*)(DF+(bb*16+cl)*DF_LD+4*g);
        Y[bb]=DN_MFMA16(FRAG(Da,z4),FRAG(acc,z4),z4);
      }
      if(ct<8){
        const int dv=col,c4=dv>>5,r32=dv&31;
        #pragma unroll
        for(int bb=0;bb<4;++bb){ const int i2=bb>>1,rh=bb&1,hi2=g&1;
          st8_wt(rec+REC_U+((((c4*2+i2)*2+rh)*64+hi2*32+r32)*8+4*(g>>1))*2,cvtpk(Y[bb][0],Y[bb][1]),cvtpk(Y[bb][2],Y[bb][3])); }
      } else {
        const int kt=ct-8;
        f32x4 sel; sel[0]=(cl==4*g)?-1.f:0.f; sel[1]=(cl==4*g+1)?-1.f:0.f; sel[2]=(cl==4*g+2)?-1.f:0.f; sel[3]=(cl==4*g+3)?-1.f:0.f;
        const bf16x8 selb=FRAG(sel,z4);
        #pragma unroll
        for(int bb=0;bb<4;++bb){
          const f32x4 zt=DN_MFMA16(FRAG(Y[bb],z4),selb,z4);
          const int pos=16*bb+cl,i2=pos>>5,r32=pos&31,hi2=g&1;
          st8_wt(rec+REC_NW+(((i2*8+kt)*64+hi2*32+r32)*8+4*(g>>1))*2,cvtpk(zt[0],zt[1]),cvtpk(zt[2],zt[3])); }
      }
    }
    #undef PK4
    #undef FRAG
    #undef DN_MFMA16
  }
  CBAR_LDS();
}

__device__ __forceinline__ void glds16(const void*gsrc,unsigned lds_dst){unsigned keep;
  asm volatile("s_mov_b32 %0, m0\n\ts_mov_b32 m0, %2\n\ts_nop 0\n\tglobal_load_lds_dwordx4 %1, off\n\ts_mov_b32 m0, %0":"=&s"(keep):"v"(gsrc),"s"(lds_dst):"memory");}
__device__ __forceinline__ void glds4(const void*gsrc,unsigned lds_dst){unsigned keep;
  asm volatile("s_mov_b32 %0, m0\n\ts_mov_b32 m0, %2\n\ts_nop 0\n\tglobal_load_lds_dword %1, off\n\ts_mov_b32 m0, %0":"=&s"(keep):"v"(gsrc),"s"(lds_dst):"memory");}
__device__ __forceinline__ bf16x8 pack8(const f32x16&x,int s){ u32x4 p; p.x=cvtpk(x[8*s],x[8*s+1]); p.y=cvtpk(x[8*s+2],x[8*s+3]); p.z=cvtpk(x[8*s+4],x[8*s+5]); p.w=cvtpk(x[8*s+6],x[8*s+7]); return __builtin_bit_cast(bf16x8,p); }

__device__ __forceinline__ void scan_wait_batch(const unsigned*rdy,int bh,int m0){
  if((threadIdx.x>>6)==4){
    const int l_=threadIdx.x&63; unsigned sp=0u;
    for(;;){ unsigned ok=1u; if(l_<16)ok=__hip_atomic_load(rdy+bh*128+m0+l_,__ATOMIC_RELAXED,__HIP_MEMORY_SCOPE_AGENT);
      if(__all(ok!=0u))break; __builtin_amdgcn_s_sleep(8); if(++sp>(1u<<17))break; }
    __builtin_amdgcn_fence(__ATOMIC_ACQUIRE,"agent"); asm volatile("s_waitcnt vmcnt(0)":::"memory");
  }
  CBAR_LDS();
}
#define DN_M(a,b,c) ((DBG&1)?(c):DN_MFMA32(a,b,c))
constexpr int SC_RING=2*REC_U, SC_STG=SC_RING, STG_LD=80, STG_BYTES=4*64*STG_LD, SC_SSQ=SC_STG+2*STG_BYTES, SC_TCH=SC_SSQ+2*4*64*4, SC_END=SC_TCH+512;
static_assert(SC_END<=160*1024-1024,"scan LDS");
template<int DBG> __device__ __forceinline__ void scan_head(int bh,const unsigned char*REC,const float*GLB,const float*dnw,const bf16_t*ZD,bf16_t*Y,const unsigned*rdy,char*shm,int flags){
  const int tid=threadIdx.x; int lane=tid&63; asm volatile("":"+v"(lane));
  const int wid=__builtin_amdgcn_readfirstlane(tid>>6);
  const int b=bh>>2,h=bh&3;
  const unsigned lds0=(unsigned)(uintptr_t)shm;
  const LAS unsigned char*ldsb=(const LAS unsigned char*)shm;
  const unsigned char*recb=REC+(size_t)bh*128*REC_BYTES;
  const size_t tokb=(size_t)b*SEQ;
  scan_wait_batch(rdy,bh,0);
  if(wid>=4&&wid<6){
    const int lw=wid-4;
    #define DN_FILL(nn,bufoff) do{ const unsigned char*src_=recb+(size_t)(nn)*REC_BYTES+lane*16; \
      _Pragma("unroll") for(int p=0;p<28;++p) glds16(src_+(lw+2*p)*1024,(unsigned)__builtin_amdgcn_readfirstlane(lds0+(bufoff)+(lw+2*p)*1024)); }while(0)
    if(!(flags&4)){ DN_FILL(0,0); }
    DN_BAR();
    for(int n=0;n<=128;++n){
      if(n<128){
        if(((n+1)&15)==0&&n+1<128)scan_wait_batch(rdy,bh,n+1);
        if(n+1<128&&!(flags&4)){ DN_FILL(n+1,((n+1)&1)*REC_U); }
      }
      DN_BAR();
    }
    #undef DN_FILL
  } else if(wid>=6){
    const int ow=wid-6;
    const int rrow=lane>>2,rch=lane&3;
    const bf16_t*zdp=ZD+(tokb+rrow)*AW+h*128+64*ow+8*rch; bf16_t*yp=Y+(tokb+rrow)*DM+512+h*128+64*ow+8*rch;
    f32x4 wv[2][2];
    #pragma unroll
    for(int c=0;c<2;++c){ wv[c][0]=*(const f32x4*)(dnw+64*ow+32*c+8*rch); wv[c][1]=*(const f32x4*)(dnw+64*ow+32*c+8*rch+4); }
    u32x4 zn[2][4],zq[2][4];
    #pragma unroll
    for(int c=0;c<2;++c)
      #pragma unroll
      for(int q=0;q<4;++q) zn[c][q]=*(const u32x4*)(zdp+(size_t)(16*q)*AW+32*c);
    asm volatile("s_waitcnt lgkmcnt(0)\n\ts_barrier":::"memory");
    for(int n=0;n<=128;++n){
      if(n<128&&((n+1)&15)==0&&n+1<128)scan_wait_batch(rdy,bh,n+1);
      if(n>0&&n<128&&!(DBG&2)){
        #pragma unroll
        for(int c=0;c<2;++c)
          #pragma unroll
          for(int q=0;q<4;++q) zq[c][q]=*(const u32x4*)(zdp+(size_t)(n*CH+16*q)*AW+32*c);
      }
      if(n>0&&!(DBG&2)){
        const LAS float*sq=(const LAS float*)(ldsb+SC_SSQ)+((n-1)&1)*256;
        #pragma unroll
        for(int it=0;it<4;++it){
          const int pos=16*it+rrow;
          const float tot=(sq[pos]+sq[64+pos])+(sq[128+pos]+sq[192+pos]);
          const float rs=1.0f/sqrtf(tot*(1.0f/128.0f)+EPS);
          #pragma unroll
          for(int c=0;c<2;++c){
            const LAS unsigned char*stg=ldsb+SC_STG+((n-1)&1)*STG_BYTES+(2*ow+c)*64*STG_LD;
            const u32x4 v=*(const LAS u32x4*)(stg+pos*STG_LD+rch*16); const u32x4 z=zn[c][it]; const f32x4 w0=wv[c][0],w1=wv[c][1]; u32x4 w;
            w[0]=cvtpk(bflo(v[0])*rs*w0[0]*bflo(z[0]),bfhi(v[0])*rs*w0[1]*bfhi(z[0])); w[1]=cvtpk(bflo(v[1])*rs*w0[2]*bflo(z[1]),bfhi(v[1])*rs*w0[3]*bfhi(z[1]));
            w[2]=cvtpk(bflo(v[2])*rs*w1[0]*bflo(z[2]),bfhi(v[2])*rs*w1[1]*bfhi(z[2])); w[3]=cvtpk(bflo(v[3])*rs*w1[2]*bflo(z[3]),bfhi(v[3])*rs*w1[3]*bfhi(z[3]));
            *(u32x4*)(yp+(size_t)((n-1)*CH+16*it)*DM+32*c)=w;
          }
        }
        #pragma unroll
        for(int c=0;c<2;++c)
          #pragma unroll
          for(int q=0;q<4;++q) zn[c][q]=zq[c][q];
      }
      asm volatile("s_waitcnt lgkmcnt(0)\n\ts_barrier":::"memory");
    }
  } else if(flags&8){
    asm volatile("s_waitcnt lgkmcnt(0)\n\ts_barrier":::"memory");
    for(int n=0;n<128;++n){ if(((n+1)&15)==0&&n+1<128)scan_wait_batch(rdy,bh,n+1); asm volatile("s_waitcnt lgkmcnt(0)\n\ts_barrier":::"memory"); }
    asm volatile("s_waitcnt lgkmcnt(0)\n\ts_barrier":::"memory");
  } else {
    const int c4=wid,r32=lane&31,hi=lane>>5;
    f32x16 S[4];
    #pragma unroll
    for(int t=0;t<4;++t)S[t]=f32x16{};
    const unsigned char*up=recb+REC_U+(size_t)(c4*4)*1024+lane*16;
    u32x4 un[4];
    #pragma unroll
    for(int q=0;q<4;++q) un[q]=*(const u32x4*)(up+q*1024);
    float gl_next=__hip_atomic_load(GLB+bh*128,__ATOMIC_RELAXED,__HIP_MEMORY_SCOPE_AGENT);
    asm volatile("s_waitcnt lgkmcnt(0)\n\ts_barrier":::"memory");
    for(int n=0;n<128;++n){
      if(((n+1)&15)==0&&n+1<128)scan_wait_batch(rdy,bh,n+1);
      const LAS unsigned char*rb=ldsb+(n&1)*REC_U+lane*16;
      const float gl=gl_next; gl_next=__hip_atomic_load(GLB+bh*128+((n+1)&127),__ATOMIC_RELAXED,__HIP_MEMORY_SCOPE_AGENT);
      f32x16 av[2],ao[2];
      #pragma unroll
      for(int i2=0;i2<2;++i2)
        #pragma unroll
        for(int rh=0;rh<2;++rh){ const u32x4 u=un[i2*2+rh];
          #pragma unroll
          for(int q=0;q<4;++q){ av[i2][8*rh+2*q]=bflo(u[q]); av[i2][8*rh+2*q+1]=bfhi(u[q]); } }
      { const unsigned char*upn=up+(size_t)((n+1)&127)*REC_BYTES;
        #pragma unroll
        for(int q=0;q<4;++q) un[q]=*(const u32x4*)(upn+q*1024); }
      ao[0]=f32x16{}; ao[1]=f32x16{};
      #define FR(off) (*(const LAS bf16x8*)(rb+(off)))
      #define SB0() __builtin_amdgcn_sched_barrier(0)
      bf16x8 fa[4],fb[4],Sb[8];
      #pragma unroll
      for(int ks=0;ks<8;++ks)Sb[ks]=pack8(S[ks>>1],ks&1);
      #define LDN(B,k0) do{ B[0]=FR(REC_NW+(k0)*1024); B[1]=FR(REC_NW+(8+(k0))*1024); B[2]=FR(REC_NW+((k0)+1)*1024); B[3]=FR(REC_NW+(9+(k0))*1024); }while(0)
      #define MMN(B,k0) do{ av[0]=DN_M(B[0],Sb[k0],av[0]); av[1]=DN_M(B[1],Sb[k0],av[1]); av[0]=DN_M(B[2],Sb[(k0)+1],av[0]); av[1]=DN_M(B[3],Sb[(k0)+1],av[1]); }while(0)
      #define LDQ(B,k0) do{ B[0]=FR(REC_QD+(k0)*1024); B[1]=FR(REC_QD+(8+(k0))*1024); B[2]=FR(REC_QD+((k0)+1)*1024); B[3]=FR(REC_QD+(9+(k0))*1024); }while(0)
      #define MMQ(B,k0) do{ ao[0]=DN_M(Sb[k0],B[0],ao[0]); ao[1]=DN_M(Sb[k0],B[1],ao[1]); ao[0]=DN_M(Sb[(k0)+1],B[2],ao[0]); ao[1]=DN_M(Sb[(k0)+1],B[3],ao[1]); }while(0)
      LDN(fa,0); SB0();
      LDN(fb,2); SB0(); MMN(fa,0); SB0();
      LDN(fa,4); SB0(); MMN(fb,2); SB0();
      LDN(fb,6); SB0(); MMN(fa,4); SB0();
      LDQ(fa,0); SB0(); MMN(fb,6); SB0();
      LDQ(fb,2); SB0(); MMQ(fa,0); SB0();
      #pragma unroll
      for(int t=0;t<4;++t)S[t]=S[t]*gl;
      LDQ(fa,4); SB0(); MMQ(fb,2); SB0();
      bf16x8 vb[2][2];
      #pragma unroll
      for(int i2=0;i2<2;++i2){ vb[i2][0]=pack8(av[i2],0); vb[i2][1]=pack8(av[i2],1); }
      LDQ(fb,6); SB0(); MMQ(fa,4); SB0();
      fa[0]=FR(REC_AI+0*1024); fa[1]=FR(REC_AI+1*1024); fa[2]=FR(REC_AI+4*1024); fa[3]=FR(REC_AI+5*1024); SB0();
      MMQ(fb,6); SB0();
      fb[0]=FR(REC_KT+0*1024); fb[1]=FR(REC_KT+1*1024); fb[2]=FR(REC_KT+2*1024); fb[3]=FR(REC_KT+3*1024); SB0();
      ao[0]=DN_M(vb[0][0],fa[0],ao[0]); ao[0]=DN_M(vb[0][1],fa[1],ao[0]); ao[1]=DN_M(vb[0][0],fa[2],ao[1]); ao[1]=DN_M(vb[0][1],fa[3],ao[1]); SB0();
      fa[0]=FR(REC_KT+4*1024); fa[1]=FR(REC_KT+5*1024); fa[2]=FR(REC_KT+6*1024); fa[3]=FR(REC_KT+7*1024); SB0();
      S[0]=DN_M(fb[0],vb[0][0],S[0]); S[0]=DN_M(fb[1],vb[0][1],S[0]); S[0]=DN_M(fb[2],vb[1][0],S[0]); S[0]=DN_M(fb[3],vb[1][1],S[0]); SB0();
      fb[0]=FR(REC_KT+8*1024); fb[1]=FR(REC_KT+9*1024); fb[2]=FR(REC_KT+10*1024); fb[3]=FR(REC_KT+11*1024); SB0();
      S[1]=DN_M(fa[0],vb[0][0],S[1]); S[1]=DN_M(fa[1],vb[0][1],S[1]); S[1]=DN_M(fa[2],vb[1][0],S[1]); S[1]=DN_M(fa[3],vb[1][1],S[1]); SB0();
      fa[0]=FR(REC_KT+12*1024); fa[1]=FR(REC_KT+13*1024); fa[2]=FR(REC_KT+14*1024); fa[3]=FR(REC_KT+15*1024); SB0();
      S[2]=DN_M(fb[0],vb[0][0],S[2]); S[2]=DN_M(fb[1],vb[0][1],S[2]); S[2]=DN_M(fb[2],vb[1][0],S[2]); S[2]=DN_M(fb[3],vb[1][1],S[2]); SB0();
      fb[0]=FR(REC_AI+6*1024); fb[1]=FR(REC_AI+7*1024); SB0();
      S[3]=DN_M(fa[0],vb[0][0],S[3]); S[3]=DN_M(fa[1],vb[0][1],S[3]); S[3]=DN_M(fa[2],vb[1][0],S[3]); S[3]=DN_M(fa[3],vb[1][1],S[3]); SB0();
      ao[1]=DN_M(vb[1][0],fb[0],ao[1]); ao[1]=DN_M(vb[1][1],fb[1],ao[1]); SB0();
      #undef FR
      #undef LDN
      #undef MMN
      #undef LDQ
      #undef MMQ
      #undef SB0
      { LAS unsigned char*stg=(LAS unsigned char*)(ldsb+SC_STG)+(n&1)*STG_BYTES+c4*64*STG_LD; LAS float*ssq=(LAS float*)(ldsb+SC_SSQ)+(n&1)*256+c4*64;
        #pragma unroll
        for(int i2=0;i2<2;++i2){ float p=0.f; const int pos=32*i2+r32;
          #pragma unroll
          for(int r=0;r<16;++r)p+=ao[i2][r]*ao[i2][r];
          p+=__shfl_xor(p,32);
          if(hi==0)ssq[pos]=p;
          #pragma unroll
          for(int rq=0;rq<4;++rq) *(LAS u32x2v*)(stg+pos*STG_LD+(8*rq+4*hi)*2)=(u32x2v){cvtpk(ao[i2][4*rq],ao[i2][4*rq+1]),cvtpk(ao[i2][4*rq+2],ao[i2][4*rq+3])}; } }
      asm volatile("s_waitcnt lgkmcnt(0)\n\ts_barrier":::"memory");
    }
    asm volatile("s_waitcnt lgkmcnt(0)\n\ts_barrier":::"memory");
  }
}
#undef DN_MFMA32
#undef DN_MFMA4
#undef DN_BAR
}

namespace moba {
using bf16=unsigned short;
using s16x4=__attribute__((ext_vector_type(4)))short;
using f32x16=__attribute__((ext_vector_type(16)))float;
constexpr int D=64,NW=8,QBLK=32,QB=QBLK*NW,KVBLK=64,PITCH=64;
__device__ __forceinline__ int crow(int r,int hi){return (r&3)+8*(r>>2)+4*hi;}
#define SBAR() __builtin_amdgcn_sched_barrier(0)
constexpr int NSLOT=3, SLOTB=8192;
constexpr int NKT=4, LDS_K=0, LDS_V=NKT*SLOTB, LDS_WS=2*NKT*SLOTB, WSW=1024, LDS_OST=LDS_WS+NW*WSW, LDS_TB=LDS_OST+NW*4096, LDS_UNIT=LDS_TB+512, LDS_PFX=LDS_UNIT+64, LDS_BYTES=LDS_PFX+8*132*4;
struct AB { int dbg; const bf16*QA; const bf16*KA; const bf16*VA; const float*KMEAN; const float*rel_bias; const bf16*ZA; bf16*Y; unsigned*SEL; unsigned short*LIST; unsigned*CNT; bf16*OP; float*LP; unsigned*qctl; };
constexpr int LISTCAP=8192, PREVCAP=256;
constexpr float NEGBIG=-1.0e30f;
__device__ __forceinline__ void glds16(const void*gsrc,unsigned lds_dst){unsigned keep;
  asm volatile("s_mov_b32 %0, m0\n\ts_mov_b32 m0, %2\n\ts_nop 0\n\tglobal_load_lds_dwordx4 %1, off\n\ts_mov_b32 m0, %0":"=&s"(keep):"v"(gsrc),"s"(lds_dst):"memory");}
typedef float f32x2_t __attribute__((ext_vector_type(2))); typedef __bf16 bf16x2_t __attribute__((ext_vector_type(2)));
__device__ __forceinline__ unsigned cvtpk_s(float lo,float hi){f32x2_t v={lo,hi};bf16x2_t b=__builtin_convertvector(v,bf16x2_t);return __builtin_bit_cast(unsigned,b);}
#define WAIT_BAR(N) asm volatile("s_waitcnt vmcnt(" #N ") lgkmcnt(0)\n\ts_barrier":::"memory")
__device__ __forceinline__ void qkt(f32x16&p0,f32x16&p1,const char*Kslot,const bf16x8*qr,int r32,int hi){
  const f32x16 negm=f32x16{};
  const char*kb=Kslot+hi*1024+r32*16;
  #pragma unroll
  for(int d0=0;d0<4;++d0){
    const bf16x8 b0=*reinterpret_cast<const bf16x8*>(kb+d0*2048);
    const bf16x8 b1=*reinterpret_cast<const bf16x8*>(kb+d0*2048+512);
    if(d0==0){p0=__builtin_amdgcn_mfma_f32_32x32x16_bf16(b0,qr[0],negm,0,0,0);p1=__builtin_amdgcn_mfma_f32_32x32x16_bf16(b1,qr[0],negm,0,0,0);}
    else{p0=__builtin_amdgcn_mfma_f32_32x32x16_bf16(b0,qr[d0],p0,0,0,0);p1=__builtin_amdgcn_mfma_f32_32x32x16_bf16(b1,qr[d0],p1,0,0,0);}}
}
typedef __attribute__((address_space(3))) const char* lds_cptr;
typedef short v4i16_t __attribute__((ext_vector_type(4)));
__device__ __forceinline__ void kload8(bf16x8*kf,lds_cptr kp){
  kf[0]=*(const __attribute__((address_space(3))) bf16x8*)(kp);      kf[1]=*(const __attribute__((address_space(3))) bf16x8*)(kp+512);
  kf[2]=*(const __attribute__((address_space(3))) bf16x8*)(kp+2048); kf[3]=*(const __attribute__((address_space(3))) bf16x8*)(kp+2560);
  kf[4]=*(const __attribute__((address_space(3))) bf16x8*)(kp+4096); kf[5]=*(const __attribute__((address_space(3))) bf16x8*)(kp+4608);
  kf[6]=*(const __attribute__((address_space(3))) bf16x8*)(kp+6144); kf[7]=*(const __attribute__((address_space(3))) bf16x8*)(kp+6656);
}
__device__ __forceinline__ void kload2(bf16x8*kf,lds_cptr kp,int j){ kf[2*j]=*(const __attribute__((address_space(3))) bf16x8*)(kp+j*2048); kf[2*j+1]=*(const __attribute__((address_space(3))) bf16x8*)(kp+j*2048+512); }
__device__ __forceinline__ s16x4 vtr(lds_cptr p){ return __builtin_bit_cast(s16x4,__builtin_amdgcn_ds_read_tr16_b64_v4i16((__attribute__((address_space(3))) v4i16_t*)p)); }
__device__ __forceinline__ void pv(f32x16*o,int vb,bf16x8 pa0,bf16x8 pa1,bf16x8 pa2,bf16x8 pa3){
  #pragma unroll
  for(int d0=0;d0<2;++d0){s16x4 lo[4],hi[4];
    #pragma unroll
    for(int ks=0;ks<4;++ks){
      asm volatile("ds_read_b64_tr_b16 %0,%1 offset:%c2":"=&v"(lo[ks]):"v"(vb),"i"(d0*4096+ks*1024):"memory");
      asm volatile("ds_read_b64_tr_b16 %0,%1 offset:%c2":"=&v"(hi[ks]):"v"(vb),"i"(d0*4096+ks*1024+512):"memory");}
    asm volatile("s_waitcnt lgkmcnt(0)":::"memory");SBAR();
    #define PK(k) (bf16x8){lo[k][0],lo[k][1],lo[k][2],lo[k][3],hi[k][0],hi[k][1],hi[k][2],hi[k][3]}
    o[d0]=__builtin_amdgcn_mfma_f32_32x32x16_bf16(pa0,PK(0),o[d0],0,0,0);
    o[d0]=__builtin_amdgcn_mfma_f32_32x32x16_bf16(pa1,PK(1),o[d0],0,0,0);
    o[d0]=__builtin_amdgcn_mfma_f32_32x32x16_bf16(pa2,PK(2),o[d0],0,0,0);
    o[d0]=__builtin_amdgcn_mfma_f32_32x32x16_bf16(pa3,PK(3),o[d0],0,0,0);
    #undef PK
  }
}
__device__ __forceinline__ void bandfix(f32x16&p0,f32x16&p1,int t,int qpos,int hi,const float*tb){
  const int kb=64*t+4*hi;
  #pragma unroll
  for(int r=0;r<16;++r){ const int kv=kb+(r&3)+8*(r>>2); const int d0=qpos-kv, d1=d0-32;
    const float b0=tb[d0<0?0:(d0>127?127:d0)], b1=tb[d1<0?0:(d1>127?127:d1)];
    p0[r]=d0<0?NEGBIG:p0[r]+b0; p1[r]=d1<0?NEGBIG:p1[r]+b1; if((r&3)==3)SBAR(); }
}


__device__ __forceinline__ unsigned gate_select(const float*KMEAN,int bh,int qb,const bf16x8*qr,int r32,int hi){
  f32x16 gt=f32x16{};
  const float*km=KMEAN+((size_t)bh*32+r32)*64+hi*8;
  #pragma unroll
  for(int d0=0;d0<4;++d0){ const f32x4 ka=*(const f32x4*)(km+d0*16), kb_=*(const f32x4*)(km+d0*16+4);
    u32x4 w; w.x=cvtpk_s(ka[0],ka[1]); w.y=cvtpk_s(ka[2],ka[3]); w.z=cvtpk_s(kb_[0],kb_[1]); w.w=cvtpk_s(kb_[2],kb_[3]);
    gt=__builtin_amdgcn_mfma_f32_32x32x16_bf16(__builtin_bit_cast(bf16x8,w),qr[d0],gt,0,0,0); }
  float a1=-INFINITY,a2=-INFINITY,a3=-INFINITY;
  const int qbh=qb-4*hi;
  #pragma unroll
  for(int r=0;r<16;++r){ float x=gt[r]; if(crow(r,0)>=qbh)x=-INFINITY; gt[r]=x;
    const float t_=fminf(a1,x); a1=fmaxf(a1,x); const float u_=fminf(a2,t_); a2=fmaxf(a2,t_); a3=fmaxf(a3,u_); }
  const float b1=__shfl_xor(a1,32),b2=__shfl_xor(a2,32),b3=__shfl_xor(a3,32);
  const float th=fmaxf(fmaxf(a3,b3),fmaxf(fminf(a2,b1),fminf(a1,b2)));
  unsigned m_=0u;
  #pragma unroll
  for(int r=0;r<16;++r){ if(gt[r]>=th&&gt[r]>-INFINITY)m_|=1u<<crow(r,0); }
  m_<<=4*hi;
  return m_|(unsigned)__shfl_xor((int)m_,32);
}
__device__ __forceinline__ void route_item(int bh,int qb,const AB&A){
  const int tid=threadIdx.x; int lane=tid&63; asm volatile("":"+v"(lane));
  const int r32=lane&31,hi=lane>>5; const int wid=__builtin_amdgcn_readfirstlane(tid>>6);
  const int s=qb*QB+wid*QBLK+r32;
  const bf16*Qw=A.QA+((size_t)bh*SEQ+s)*PITCH;
  bf16x8 qr[4];
  #pragma unroll
  for(int d0=0;d0<4;++d0)qr[d0]=*reinterpret_cast<const bf16x8*>(&Qw[d0*16+hi*8]);
  const unsigned selmask=gate_select(A.KMEAN,bh,qb,qr,r32,hi);
  if(hi==0)__hip_atomic_store(A.SEL+(size_t)bh*SEQ+s,selmask,__ATOMIC_RELAXED,__HIP_MEMORY_SCOPE_AGENT);
  const unsigned rb=(qb>=1&&hi==0)?(selmask&((1u<<qb)-1u)):0u;
  if(qb>=1){
    unsigned mymask=0u;
    for(int j=0;j<qb;++j){ const unsigned bal=(unsigned)__ballot((rb>>j)&1u); if(lane==j)mymask=bal; }
    unsigned base=0u;
    if(mymask)base=__hip_atomic_fetch_add(A.CNT+((lane==qb-1)?1024:0)+bh*32+lane,(unsigned)__popc(mymask),__ATOMIC_RELAXED,__HIP_MEMORY_SCOPE_AGENT);
    unsigned rbt=rb;
    #pragma unroll
    for(int k=0;k<3;++k){
      const int jj=rbt?(__ffs((int)rbt)-1):0; const bool act=rbt!=0u; rbt&=rbt-1u;
      const unsigned mj=(unsigned)__shfl((int)mymask,jj), bj=(unsigned)__shfl((int)base,jj);
      if(act){ const unsigned pos=bj+(unsigned)__popc(mj&((1u<<r32)-1u)); const bool prev=(jj==qb-1);
        if(pos<(unsigned)(prev?PREVCAP:LISTCAP-PREVCAP)){ unsigned short*dst_=A.LIST+((size_t)bh*32+jj)*LISTCAP+(prev?LISTCAP-PREVCAP:0)+pos; const unsigned val_=(unsigned)(s|(k<<13));
          asm volatile("global_store_short %0, %1, off sc1"::"v"(dst_),"v"(val_):"memory"); } }
    }
  }
}
template<int KIND> __device__ __forceinline__ void attn_group(int bh,int j,unsigned gi,unsigned cnt,unsigned entry,const bf16x8(&qr)[4],const AB&A,char*shm){
  const int tid=threadIdx.x; int lane=tid&63; asm volatile("":"+v"(lane));
  const int r32=lane&31,hi=lane>>5; const int wid=__builtin_amdgcn_readfirstlane(tid>>6);
  const int b=bh>>3,h=bh&7;
  const unsigned lds0=(unsigned)(uintptr_t)shm;
  const float*tb=(const float*)(shm+LDS_TB);
  const int srow=(KIND<2)?(int)(entry&8191u):(256*j+32*(int)gi+r32);
  const int vb0=(int)(lds0+LDS_V)+((lane>>4)&1)*32+(lane&3)*8+(4*hi+((lane&15)>>2))*64;
  const char*Kbase=shm+LDS_K; bf16x8 kf[8];
  const lds_cptr shm3=(lds_cptr)shm; const lds_cptr kp0=shm3+LDS_K+hi*1024+r32*16; const lds_cptr vp0=shm3+LDS_V+((lane>>4)&1)*32+(lane&3)*8+(4*hi+((lane&15)>>2))*64;
  constexpr int NT=4;
  float l_reg=0.f;f32x16 o[2];o[0]=f32x16{};o[1]=f32x16{};
  const int qpos=srow;
  #define BANDFIX(P0,P1,t) do{ if(KIND==2||(KIND==1&&(t)>=2)){ bandfix(P0,P1,4*j+(t),qpos,hi,tb); } }while(0)
  f32x16 pA0,pA1,pB0,pB1;
  qkt(pA0,pA1,Kbase,qr,r32,hi);asm volatile("s_nop 15\n\ts_nop 7":"+v"(pA0),"+v"(pA1));BANDFIX(pA0,pA1,0);
  _Pragma("unroll") for(int r=0;r<16;++r)pA0[r]=__builtin_amdgcn_exp2f(pA0[r]);
  _Pragma("unroll") for(int r=0;r<16;++r)pA1[r]=__builtin_amdgcn_exp2f(pA1[r]);
  kload8(kf,kp0+SLOTB);
  s16x4 vlo[8],vhi[8]; u32x4 pw0,pw1,pw2,pw3;
  #define PKW(P,B) cvtpk_s(P[B],P[B+1])
  #define PAF(k) __builtin_bit_cast(bf16x8,pw##k)
  #define VFR(i) (bf16x8){vlo[i][0],vlo[i][1],vlo[i][2],vlo[i][3],vhi[i][0],vhi[i][1],vhi[i][2],vhi[i][3]}
  #define PIN(x) asm volatile("":"+v"(x))
  #define GAPA(MF,A0,A1,A2,A3,W0,W1,PW) do{ MF; sacc+=A0; sacc+=A1; sacc+=A2; sacc+=A3; PIN(sacc); W0; W1; PIN(PW); SBAR(); }while(0)
  #define EX(v) __builtin_amdgcn_exp2f(v)
  #define GAPB(MF,X,B) do{ MF; X[B]=EX(X[B]); X[B+1]=EX(X[B+1]); X[B+2]=EX(X[B+2]); X[B+3]=EX(X[B+3]); PIN(X); SBAR(); }while(0)
  #define VRD(i) do{ vlo[i]=vtr(vp_+(((i)>>2)*4096+((i)&3)*1024)); vhi[i]=vtr(vp_+(((i)>>2)*4096+((i)&3)*1024+512)); }while(0)
  #define KRD(G,jj) do{ if(G){ kload2(kf,kp0+((t_)+1)*SLOTB,jj); SBAR(); } }while(0)
  #define STEP(C0,C1,P0,P1,t,GL) do{ SBAR(); constexpr int t_=(t); \
    const lds_cptr vp_=vp0+(t_-1)*SLOTB; const f32x16 zc_=f32x16{}; \
    VRD(0); SBAR(); float sacc=(P0[0]+P0[1]); \
    GAPA(C0=__builtin_amdgcn_mfma_f32_32x32x16_bf16(kf[0],qr[0],zc_,0,0,0), P0[2],P0[3],P0[4],P0[5],     pw0[0]=PKW(P0,0), pw0[1]=PKW(P0,2), pw0); \
    VRD(4); SBAR(); GAPA(C1=__builtin_amdgcn_mfma_f32_32x32x16_bf16(kf[1],qr[0],zc_,0,0,0), P0[6],P0[7],P0[8],P0[9],     pw0[2]=PKW(P0,4), pw0[3]=PKW(P0,6), pw0); \
    VRD(1); SBAR(); GAPA(C0=__builtin_amdgcn_mfma_f32_32x32x16_bf16(kf[2],qr[1],C0,0,0,0),   P0[10],P0[11],P0[12],P0[13], pw1[0]=PKW(P0,8), pw1[1]=PKW(P0,10), pw1); \
    VRD(5); SBAR(); GAPA(C1=__builtin_amdgcn_mfma_f32_32x32x16_bf16(kf[3],qr[1],C1,0,0,0),   P0[14],P0[15],P1[0],P1[1],   pw1[2]=PKW(P0,12),pw1[3]=PKW(P0,14), pw1); \
    VRD(2); SBAR(); GAPA(C0=__builtin_amdgcn_mfma_f32_32x32x16_bf16(kf[4],qr[2],C0,0,0,0),   P1[2],P1[3],P1[4],P1[5],     pw2[0]=PKW(P1,0), pw2[1]=PKW(P1,2), pw2); \
    VRD(6); SBAR(); GAPA(C1=__builtin_amdgcn_mfma_f32_32x32x16_bf16(kf[5],qr[2],C1,0,0,0),   P1[6],P1[7],P1[8],P1[9],     pw2[2]=PKW(P1,4), pw2[3]=PKW(P1,6), pw2); \
    VRD(3); SBAR(); GAPA(C0=__builtin_amdgcn_mfma_f32_32x32x16_bf16(kf[6],qr[3],C0,0,0,0),   P1[10],P1[11],P1[12],P1[13], pw3[0]=PKW(P1,8), pw3[1]=PKW(P1,10), pw3); \
    VRD(7); SBAR(); GAPA(C1=__builtin_amdgcn_mfma_f32_32x32x16_bf16(kf[7],qr[3],C1,0,0,0),   P1[14],P1[15],0.f,0.f,       pw3[2]=PKW(P1,12),pw3[3]=PKW(P1,14), pw3); \
    l_reg+=sacc; \
    BANDFIX(C0,C1,t_); \
    SBAR(); \
    GAPB(o[0]=__builtin_amdgcn_mfma_f32_32x32x16_bf16(PAF(0),VFR(0),o[0],0,0,0), C0,0); \
    GAPB(o[1]=__builtin_amdgcn_mfma_f32_32x32x16_bf16(PAF(0),VFR(4),o[1],0,0,0), C0,4); \
    KRD(GL,0); GAPB(o[0]=__builtin_amdgcn_mfma_f32_32x32x16_bf16(PAF(1),VFR(1),o[0],0,0,0), C0,8); \
    KRD(GL,1); GAPB(o[1]=__builtin_amdgcn_mfma_f32_32x32x16_bf16(PAF(1),VFR(5),o[1],0,0,0), C0,12); \
    KRD(GL,2); GAPB(o[0]=__builtin_amdgcn_mfma_f32_32x32x16_bf16(PAF(2),VFR(2),o[0],0,0,0), C1,0); \
    KRD(GL,3); GAPB(o[1]=__builtin_amdgcn_mfma_f32_32x32x16_bf16(PAF(2),VFR(6),o[1],0,0,0), C1,4); \
    GAPB(o[0]=__builtin_amdgcn_mfma_f32_32x32x16_bf16(PAF(3),VFR(3),o[0],0,0,0), C1,8); \
    GAPB(o[1]=__builtin_amdgcn_mfma_f32_32x32x16_bf16(PAF(3),VFR(7),o[1],0,0,0), C1,12); \
    }while(0)
  STEP(pB0,pB1,pA0,pA1,1,true);
  STEP(pA0,pA1,pB0,pB1,2,true);
  STEP(pB0,pB1,pA0,pA1,3,false);
  { float sacc=pB0[0]+pB0[1]; _Pragma("unroll") for(int r=2;r<16;++r)sacc+=pB0[r]; _Pragma("unroll") for(int r=0;r<16;++r)sacc+=pB1[r]; l_reg+=sacc;
    pw0=(u32x4){PKW(pB0,0),PKW(pB0,2),PKW(pB0,4),PKW(pB0,6)};pw1=(u32x4){PKW(pB0,8),PKW(pB0,10),PKW(pB0,12),PKW(pB0,14)};pw2=(u32x4){PKW(pB1,0),PKW(pB1,2),PKW(pB1,4),PKW(pB1,6)};pw3=(u32x4){PKW(pB1,8),PKW(pB1,10),PKW(pB1,12),PKW(pB1,14)};
    SBAR(); pv(o,vb0+(NT-1)*SLOTB,PAF(0),PAF(1),PAF(2),PAF(3)); }
  #undef PKW
  #undef PAF
  #undef VFR
  #undef PIN
  #undef GAPA
  #undef GAPB
  #undef EX
  #undef VRD
  #undef KRD
  #undef STEP
  #undef BANDFIX
  l_reg+=__shfl_xor(l_reg,32);
  int lane2=threadIdx.x&63; asm volatile("":"+v"(lane2));
  const int r32e=lane2&31,hie=lane2>>5;
  float*wsr=(float*)(shm+LDS_WS)+wid*(WSW/4);
  if(KIND<2){
    if(hie==0){ wsr[r32e*8]=__builtin_amdgcn_rcpf(l_reg); wsr[r32e*8+1]=l_reg; ((unsigned*)wsr)[r32e*8+2]=entry; }
  } else {
    if(hie==0){
      const unsigned selmask=A.SEL[(size_t)bh*SEQ+srow];
      const unsigned rbits=(j>=1)?(selmask&((1u<<j)-1u)):0u; const int nr=__popc(rbits);
      const float*lp=A.LP+((size_t)bh*SEQ+srow)*3; float lk[3]; float lt=l_reg;
      #pragma unroll
      for(int k=0;k<3;++k){ const float t_=lp[k]; lk[k]=(k<nr)?t_:0.f; lt+=lk[k]; }
      const float inv=1.0f/lt;
      wsr[r32e*8]=inv; wsr[r32e*8+1]=lk[0]*inv; wsr[r32e*8+2]=lk[1]*inv; wsr[r32e*8+3]=lk[2]*inv; ((int*)wsr)[r32e*8+4]=nr;
    }
  }
  asm volatile("s_waitcnt lgkmcnt(0)":::"memory");
  float rli[16];
  #pragma unroll
  for(int r=0;r<16;++r)rli[r]=wsr[(crow(r,0)+4*hie)*8];
  { bf16*stg=(bf16*)(shm+LDS_OST)+wid*2048;
    bf16*stgw=stg+(4*hie)*64+r32e;
    #pragma unroll
    for(int r=0;r<16;++r){
      #pragma unroll
      for(int d0=0;d0<2;++d0)stgw[crow(r,0)*64+d0*32]=f2bf(o[d0][r]*rli[r]);}
    asm volatile("s_waitcnt lgkmcnt(0)":::"memory");
    #pragma unroll
    for(int i=0;i<4;++i){const int row=i*8+(lane2>>3),ch=lane2&7; const u32x4 v=*(const u32x4*)(stg+row*64+ch*8);
      if(KIND<2){
        const unsigned e_=((const unsigned*)wsr)[row*8+2]; const unsigned idx=32u*gi+row;
        if(idx<cnt){ const size_t slot=((size_t)bh*SEQ+(e_&8191u))*3+(e_>>13);
          bf16*dst=A.OP+slot*64+ch*8;
          asm volatile("global_store_dwordx4 %0, %1, off sc1\n\ts_nop 1"::"v"(dst),"v"(v):"memory");
          if(ch==0)__hip_atomic_store(A.LP+slot,wsr[row*8+1],__ATOMIC_RELAXED,__HIP_MEMORY_SCOPE_AGENT); }
      } else {
        const size_t rowg=(size_t)bh*SEQ+256*j+32*gi+row; const size_t tok=(size_t)b*SEQ+256*j+32*gi+row; const int nr=((const int*)wsr)[row*8+4];
        float a8[8];
        #pragma unroll
        for(int e=0;e<4;++e){ a8[2*e]=__uint_as_float(v[e]<<16); a8[2*e+1]=__uint_as_float(v[e]&0xffff0000u); }
        const bf16*op=A.OP+(rowg*3)*64+ch*8;
        u32x4 pk[3];
        #pragma unroll
        for(int k=0;k<3;++k) pk[k]=*(const u32x4*)(op+k*64);
        #pragma unroll
        for(int k=0;k<3;++k){ const float f=wsr[row*8+1+k]; const u32x4 p=(k<nr)?pk[k]:(u32x4){0u,0u,0u,0u};
          #pragma unroll
          for(int e=0;e<4;++e){ a8[2*e]+=f*__uint_as_float(p[e]<<16); a8[2*e+1]+=f*__uint_as_float(p[e]&0xffff0000u); } }
        const u32x4 z=*(const u32x4*)(A.ZA+tok*512+h*64+ch*8); u32x4 w;
        #pragma unroll
        for(int e=0;e<4;++e) w[e]=cvtpk_s(a8[2*e]*__uint_as_float(z[e]<<16),a8[2*e+1]*__uint_as_float(z[e]&0xffff0000u));
        *(u32x4*)(A.Y+tok*1024+h*64+ch*8)=w;
      } } }
  asm volatile("s_waitcnt lgkmcnt(0)":::"memory");
}
template<bool OWN> __device__ __forceinline__ void kv_unit(int bh,int j,const AB&A,char*shm,int&pend_x){
  const int tid=threadIdx.x; int lane=tid&63; asm volatile("":"+v"(lane));
  const int wid=__builtin_amdgcn_readfirstlane(tid>>6); const int h=bh&7;
  const unsigned lds0=(unsigned)(uintptr_t)shm;
  const bf16*Kh=A.KA+((size_t)bh*SEQ+(size_t)j*256)*PITCH,*Vh=A.VA+((size_t)bh*SEQ+(size_t)j*256)*PITCH;
  const bf16*ksrc=Kh+(long)lane*PITCH+wid*8;
  const bf16*vsrc=Vh+(long)(16*(wid&3)+(lane>>2))*PITCH+(wid>>2)*32+(lane&3)*8;
  const unsigned kdst=lds0+LDS_K+wid*1024, vdst=lds0+LDS_V+wid*1024;
  #pragma unroll
  for(int t=0;t<NKT;++t){ glds16(ksrc+(long)t*KVBLK*PITCH,(unsigned)__builtin_amdgcn_readfirstlane(kdst+t*SLOTB)); glds16(vsrc+(long)t*KVBLK*PITCH,(unsigned)__builtin_amdgcn_readfirstlane(vdst+t*SLOTB)); }
  float*tb=(float*)(shm+LDS_TB);
  if(tid<128) tb[tid]=(A.rel_bias[t5_bucket_dev(tid)*8+h]-A.rel_bias[31*8+h])*1.4426950408889634f;
  CBAR_ALL();
  if(pend_x>=0){ if(tid==0)__hip_atomic_fetch_add(A.qctl+512+64*pend_x,1u,__ATOMIC_RELAXED,__HIP_MEMORY_SCOPE_AGENT); pend_x=-1; CBAR_LDS(); }
  const int r32_=lane&31,hi_=lane>>5;
  #define LOADQ(dst,row) do{ const bf16*q_=A.QA+((size_t)bh*SEQ+(row))*PITCH+hi_*8; _Pragma("unroll") for(int d0=0;d0<4;++d0)(dst)[d0]=*reinterpret_cast<const bf16x8*>(q_+d0*16); }while(0)
  if((A.dbg&1)||(OWN&&(A.dbg&2))||(!OWN&&(A.dbg&4))){}
  else if(OWN){ bf16x8 qr[4]; LOADQ(qr,256*j+32*wid+r32_); attn_group<2>(bh,j,(unsigned)wid,256u,0u,qr,A,shm); }
  else {
    const unsigned short*lst=A.LIST+((size_t)bh*32+j)*LISTCAP;
    const unsigned cf=A.CNT[bh*32+j], cp=A.CNT[1024+bh*32+j];
    const unsigned nf=cf<(unsigned)(LISTCAP-PREVCAP)?cf:(unsigned)(LISTCAP-PREVCAP), np=cp<(unsigned)PREVCAP?cp:(unsigned)PREVCAP;
    const unsigned gp=(np+31u)>>5, gf=(nf+31u)>>5, gt=gp+gf;
    #define LOADE(gi_) (((gi_)<gp)?lst[(LISTCAP-PREVCAP)+((32u*(gi_)+r32_<np)?32u*(gi_)+r32_:0u)]:lst[((32u*((gi_)-gp)+r32_<nf)?32u*((gi_)-gp)+r32_:0u)])
    unsigned gi=wid;
    if(gi<gt){
      unsigned e_cur=LOADE(gi); unsigned e_nxt=(gi+NW<gt)?LOADE(gi+NW):0u;
      bf16x8 q_cur[4],q_nxt[4]; LOADQ(q_cur,e_cur&8191u);
      for(;gi<gt;gi+=NW){
        if(gi+NW<gt)LOADQ(q_nxt,e_nxt&8191u);
        const unsigned e_nn=(gi+2*NW<gt)?LOADE(gi+2*NW):0u;
        if(gi<gp) attn_group<1>(bh,j,gi,np,e_cur,q_cur,A,shm);
        else attn_group<0>(bh,j,gi-gp,nf,e_cur,q_cur,A,shm);
        e_cur=e_nxt; e_nxt=e_nn;
        #pragma unroll
        for(int d0=0;d0<4;++d0)q_cur[d0]=q_nxt[d0];
      }
    }
    #undef LOADE
  }
  #undef LOADQ
  CBAR_LDS();
  if(!OWN)pend_x=bh&7;
}
__device__ __forceinline__ void flush_pending(const AB&A,int&pend_x){
  if(pend_x>=0){ CBAR_ALL(); if(threadIdx.x==0)__hip_atomic_fetch_add(A.qctl+512+64*pend_x,1u,__ATOMIC_RELAXED,__HIP_MEMORY_SCOPE_AGENT); pend_x=-1; CBAR_LDS(); }
}
__device__ __forceinline__ void moba_phase(char*lds,const AB&A){
  const int tid=threadIdx.x; volatile unsigned*uw=(volatile unsigned*)(lds+LDS_UNIT);
  const unsigned x0=xb_xcc_id()&7u; unsigned acquired=0u; int pend_x=-1;
  bool pf_valid=false; unsigned pf_k=0u;
  for(unsigned qi=0;qi<8u;){
    const unsigned x=(x0+qi)&7u;
    unsigned k;
    if(pf_valid){ k=pf_k; pf_valid=false; }
    else {
      if(tid==0){ const unsigned k0=__hip_atomic_fetch_add(A.qctl+64*x,1u,__ATOMIC_RELAXED,__HIP_MEMORY_SCOPE_AGENT); uw[0]=k0; }
      CBAR_ALL();
      k=(unsigned)__builtin_amdgcn_readfirstlane((int)uw[0]);
      CBAR_LDS();
    }
    constexpr unsigned T=124u;
    if(k>=T+128u){ ++qi; continue; }
    unsigned pfr=0u;
    if(tid==0)pfr=__hip_atomic_fetch_add(A.qctl+64*x,1u,__ATOMIC_RELAXED,__HIP_MEMORY_SCOPE_AGENT);
    if(k<T){ kv_unit<false>((int)x+8*(int)(k&3u),(int)(k>>2),A,lds,pend_x); }
    else {
      const unsigned ko=k-T;
      if(!((acquired>>x)&1u)){
        flush_pending(A,pend_x);
        if(tid<64){ unsigned sp=0u; while(__builtin_amdgcn_readfirstlane(__hip_atomic_load(A.qctl+512+64*x,__ATOMIC_RELAXED,__HIP_MEMORY_SCOPE_AGENT))<T){ __builtin_amdgcn_s_sleep(2); if(++sp>(1u<<19))break; }
          __builtin_amdgcn_fence(__ATOMIC_ACQUIRE,"agent"); asm volatile("s_waitcnt vmcnt(0)":::"memory"); }
        CBAR_LDS();
        acquired|=1u<<x; }
      kv_unit<true>((int)x+8*(int)(ko&3u),31-(int)(ko>>2),A,lds,pend_x);
    }
    if(tid==0)uw[1]=pfr;
    CBAR_ALL();
    pf_k=(unsigned)__builtin_amdgcn_readfirstlane((int)uw[1]); pf_valid=true;
    CBAR_LDS();
  }
  flush_pending(A,pend_x);
}
#undef SBAR
#undef WAIT_BAR
}
constexpr int CW_AQ = 16384, CW_CNT = 20480, CW_RT = 22592, CW_GQ = 22656, CW_GQ2 = 22720, CW_G1B = 22784, CW_FLAGS = 24576;
__device__ __forceinline__ void p0_phase(const Ptrs& P, LAS unsigned char* lds, int tid, int G) {
    const int lane = tid & 63, wave = tid >> 6;
    LAS float* scr = (LAS float*)lds;
    for (int it = blockIdx.x; it < 1024 + 256; it += G) {
        const bool first = it < 1024; const int r = first ? it : it - 1024; const int kb = r & 15, pb = r >> 4;
        const float* W = first ? P.w_in : P.w_out; const int ldw = first ? NCOL : DM; bf16_t* WT = first ? P.WT1 : P.WT2;
#pragma unroll 4
        for (int i = 0; i < 8; ++i) { const int kk = i * 8 + (tid >> 6), pp = tid & 63, p = pb * 64 + pp; const int c = first ? wt1_logical(p) : p;
            scr[kk * 65 + pp] = W[(size_t)(kb * 64 + kk) * ldw + c]; }
        __syncthreads();
#pragma unroll 4
        for (int i = 0; i < 8; ++i) { const int pp = i * 8 + (tid >> 6), kk = tid & 63;
            WT[(size_t)(pb * 64 + pp) * 1024 + kb * 64 + kk] = f2bf(scr[kk * 65 + pp]); }
        __syncthreads();
    }
    LAS float* w8 = (LAS float*)(lds + 32768);
    for (int i = tid; i < 1024 * 8; i += 512) w8[i] = P.w_in[(size_t)(i >> 3) * NCOL + 4096 + (i & 7)];
    __syncthreads();
    f32x4 nw[4];
#pragma unroll
    for (int j = 0; j < 4; ++j) nw[j] = ((const f32x4*)P.norm_w)[lane + 64 * j];
    const int gw = blockIdx.x * NWAVES + wave, ngw = G * NWAVES;
    for (int row = gw; row < MTOK; row += ngw) {
        const f32x4* xr = (const f32x4*)(P.x + (size_t)row * DM) + lane;
        f32x4 v[4]; float ss = 0.f;
#pragma unroll
        for (int j = 0; j < 4; ++j) { v[j] = xr[64 * j]; ss += v[j][0] * v[j][0] + v[j][1] * v[j][1] + v[j][2] * v[j][2] + v[j][3] * v[j][3]; }
        ss = wave_sum(ss);
        const float rstd = 1.0f / sqrtf(ss * (1.0f / DM) + EPS);
        float d[8];
#pragma unroll
        for (int c = 0; c < 8; ++c) d[c] = 0.f;
#pragma unroll
        for (int j = 0; j < 4; ++j) {
            f32x4 h = v[j] * rstd * nw[j];
            unsigned lo = (unsigned)f2bf(h[0]) | ((unsigned)f2bf(h[1]) << 16), hi = (unsigned)f2bf(h[2]) | ((unsigned)f2bf(h[3]) << 16);
            *(uint2*)(P.HN + (size_t)row * DM + 4 * (lane + 64 * j)) = make_uint2(lo, hi);
#pragma unroll
            for (int e = 0; e < 4; ++e) { const LAS f32x4* wr = (const LAS f32x4*)(w8 + (4 * (lane + 64 * j) + e) * 8); const f32x4 wa = wr[0], wb = wr[1];
#pragma unroll
                for (int c = 0; c < 4; ++c) { d[c] += h[e] * wa[c]; d[4 + c] += h[e] * wb[c]; } }
        }
#pragma unroll
        for (int c = 0; c < 8; ++c) d[c] = wave_sum(d[c]);
        if (lane < 4) {
            const int hh = lane; float bd = d[0], ad = d[4];
            if (hh == 1) { bd = d[1]; ad = d[5]; } else if (hh == 2) { bd = d[2]; ad = d[6]; } else if (hh == 3) { bd = d[3]; ad = d[7]; }
            const float beta = 1.0f / (1.0f + expf(-bd));
            const float z = ad + P.dt_bias[hh];
            const float sp = fmaxf(z, 0.f) + log1pf(expf(-fabsf(z)));
            const float g = -expf(P.a_log[hh]) * sp;
            const int b = row / SEQ, s = row % SEQ;
            P.BETA[(size_t)(b * DH + hh) * SEQ + s] = beta; P.GDEC[(size_t)(b * DH + hh) * SEQ + s] = g;
        }
    }
    __syncthreads();
}

struct Args { const float* in[11]; float* out; unsigned char* ws; int ph_lo, ph_hi, qoff, li; };
__global__ void __launch_bounds__(NWAVES * 64, 2) mega(Args args) {
    extern __shared__ __attribute__((aligned(16))) unsigned char lds_raw[];
    LAS unsigned char* lds = (LAS unsigned char*)lds_raw;
    const int tid = threadIdx.x, G = gridDim.x;
    void* din[11];
#pragma unroll
    for (int i = 0; i < 11; ++i) din[i] = (void*)args.in[i];
    const Ptrs P = make_ptrs(din, args.out, args.ws);
    volatile LAS unsigned* MISC = (volatile LAS unsigned*)(lds + MISC_OFF);
    for (int u = tid; u < (LDS_BYTES - LDSCTL_OFF) / 4; u += NWAVES * 64) ((LAS unsigned*)(lds + LDSCTL_OFF))[u] = 0u;
    __syncthreads();
    XcdBarrier bar = xcd_barrier_post(P.ctl + CW_BAR + args.li * XCD_BAR_WORDS, MISC + 8);
    const int lo = args.ph_lo, hi = args.ph_hi;
#define IN(k) (lo <= (k) && (k) < hi)
#define BOTH(k) (IN(k) && IN((k) + 1))
    if (IN(0)) { p0_phase(P, lds, tid, G); if (BOTH(0)) xcd_barrier(bar); }
    if (IN(1)) {
        pg8::Gemm g{P.HN, P.WT1 + (size_t)2048 * DM, MTOK, 2048, DM}; pg8::StaticOrder S; S.init(MTOK, 2048, G, (int)blockIdx.x);
        pg8::EpiProj E{P.QA, P.KA, P.VA, P.ZA, P.ZD, P.QKVD, P.KMEAN, P.qnw, P.knw, 8};
        pg8::gemm_phase<pg8::EpiProj, pg8::StaticOrder, true, true>(lds + RING_OFF, g, S, E);
        if (BOTH(1)) xcd_barrier(bar);
    }
#define GEMM1B_AND_PUBLISH() do{ \
                pg8::Gemm g{P.HN, P.WT1, MTOK, 2048, DM}; pg8::StaticOrder S; S.init(MTOK, 2048, G - 16, (int)blockIdx.x - 16); \
                pg8::EpiProj E{P.QA, P.KA, P.VA, P.ZA, P.ZD, P.QKVD, P.KMEAN, P.qnw, P.knw, 0}; \
                pg8::gemm_phase<pg8::EpiProj, pg8::StaticOrder, true, true>(lds + RING_OFF, g, S, E); \
                CBAR_ALL();                                \
                if (tid == 0) { __builtin_amdgcn_fence(__ATOMIC_RELEASE, "agent"); asm volatile("s_waitcnt vmcnt(0)" ::: "memory"); \
                    __hip_atomic_fetch_add(P.ctl + CW_G1B, 1u, __ATOMIC_RELAXED, __HIP_MEMORY_SCOPE_AGENT); } \
                CBAR_LDS(); }while(0)
    if (IN(2)) {
        const int dq = args.qoff;
        const moba::AB A{(dq >> 4) & 7, P.QA, P.KA, P.VA, P.KMEAN, P.rel_bias, P.ZA, P.Y, P.SEL, P.LIST, P.ctl + CW_CNT, P.OPART, P.LP, P.ctl + CW_AQ + (dq & ~255)};
        if (blockIdx.x < 16) {
            if (!(dq & 1)) {
#ifdef SCANDBG
                if (dq & 12) dn::scan_head<SCANDBG>((int)blockIdx.x, P.REC, P.GLB, P.dnw, P.ZD, (bf16_t*)P.out, P.ctl + CW_FLAGS, (char*)lds_raw, dq & 12); else
#endif
                dn::scan_head<0>((int)blockIdx.x, P.REC, P.GLB, P.dnw, P.ZD, (dq & 12) ? (bf16_t*)P.out : P.Y, P.ctl + CW_FLAGS, (char*)lds_raw, dq & 12); }
        } else if (!(dq & 128)) {
            volatile LAS unsigned* qw = MISC + 16;
            int pend0 = -1, pend1 = -1, carry = -1;
#ifdef PREPX
#define PREP_EXTRA dn::prep_chunk(pend0, P.QKVD, P.conv_w, P.BETA, P.GDEC, (unsigned char*)P.OPART, P.GLB + 4096, P.ctl + CW_FLAGS, lds, PREPX); dn::prep_chunk(pend1, P.QKVD, P.conv_w, P.BETA, P.GDEC, (unsigned char*)P.OPART + 131072, P.GLB + 4096, P.ctl + CW_FLAGS, lds, PREPX);
#else
#define PREP_EXTRA
#endif
#define PREP_LOOP(LIMIT) for (;;) { \
                if (tid == 0) { unsigned k; if (carry >= 0) k = (unsigned)carry; else k = __hip_atomic_fetch_add(P.ctl + CW_GQ, 1u, __ATOMIC_RELAXED, __HIP_MEMORY_SCOPE_AGENT); qw[0] = k; } \
                carry = -1; \
                CBAR_ALL(); \
                if (pend0 >= 0) { if (tid == 0) { __hip_atomic_store(P.ctl + CW_FLAGS + pend0, 1u, __ATOMIC_RELAXED, __HIP_MEMORY_SCOPE_AGENT); __hip_atomic_store(P.ctl + CW_FLAGS + pend1, 1u, __ATOMIC_RELAXED, __HIP_MEMORY_SCOPE_AGENT); } pend0 = -1; } \
                const unsigned k = (unsigned)__builtin_amdgcn_readfirstlane((int)qw[0]); \
                CBAR_LDS(); \
                if (k >= 1024u) break; \
                if (k >= (LIMIT)) { carry = (int)k; break; } \
                const unsigned cq = 2u * k; \
                pend0 = (int)(cq & 15u) * 128 + (int)(cq >> 4); pend1 = (int)((cq + 1u) & 15u) * 128 + (int)((cq + 1u) >> 4); \
                dn::prep_chunk(pend0, P.QKVD, P.conv_w, P.BETA, P.GDEC, P.REC + (size_t)pend0 * dn::REC_BYTES, P.GLB, P.ctl + CW_FLAGS, lds); \
                dn::prep_chunk(pend1, P.QKVD, P.conv_w, P.BETA, P.GDEC, P.REC + (size_t)pend1 * dn::REC_BYTES, P.GLB, P.ctl + CW_FLAGS, lds); \
                PREP_EXTRA \
            }
            PREP_LOOP(512u)
            GEMM1B_AND_PUBLISH();
            PREP_LOOP(1024u)
#undef PREP_LOOP
            if (tid < 64) { unsigned sp = 0u;
                while (__builtin_amdgcn_readfirstlane(__hip_atomic_load(P.ctl + CW_G1B, __ATOMIC_RELAXED, __HIP_MEMORY_SCOPE_AGENT)) < (unsigned)(G - 16)) { __builtin_amdgcn_s_sleep(8); if (++sp > (1u << 17)) break; }
                __builtin_amdgcn_fence(__ATOMIC_ACQUIRE, "agent"); asm volatile("s_waitcnt vmcnt(0)" ::: "memory"); }
            CBAR_LDS();
            for (;;) {
                if (tid == 0) { const unsigned k = __hip_atomic_fetch_add(P.ctl + CW_GQ2, 1u, __ATOMIC_RELAXED, __HIP_MEMORY_SCOPE_AGENT); qw[0] = k; }
                CBAR_ALL();
                const unsigned k = (unsigned)__builtin_amdgcn_readfirstlane((int)qw[0]);
                CBAR_LDS();
                if (k >= 1024u) break;
                moba::route_item((int)(k >> 5), (int)(k & 31u), A);
#ifdef ROUTE2
                { moba::AB A2 = A; A2.SEL = (unsigned*)P.LP; A2.LIST = (unsigned short*)P.OPART; A2.CNT = P.ctl + 32768; moba::route_item((int)(k >> 5), (int)(k & 31u), A2); }
#endif
                CBAR_ALL();
                if (tid == 0) __hip_atomic_fetch_add(P.ctl + CW_RT, 1u, __ATOMIC_RELAXED, __HIP_MEMORY_SCOPE_AGENT);
                CBAR_LDS();
            }
        }
        if (!(dq & 2)) {
            if (tid < 64) { unsigned sp = 0u;
                while (__builtin_amdgcn_readfirstlane(__hip_atomic_load(P.ctl + CW_RT, __ATOMIC_RELAXED, __HIP_MEMORY_SCOPE_AGENT)) < 1024u) { __builtin_amdgcn_s_sleep(8); if (++sp > (1u << 17)) break; }
                __builtin_amdgcn_fence(__ATOMIC_ACQUIRE, "agent"); asm volatile("s_waitcnt vmcnt(0)" ::: "memory"); }
            CBAR_LDS();
            moba::moba_phase((char*)lds_raw, A);
        }
        if (IN(5)) xcd_barrier(bar);
    }
    if (IN(5)) {
        pg8::Gemm g{P.Y, P.WT2, MTOK, DM, DM}; pg8::StaticOrder S; S.init(MTOK, DM, G, (int)blockIdx.x);
        pg8::EpiOut E{P.x, P.out};
        pg8::gemm_phase<pg8::EpiOut, pg8::StaticOrder, true, true>(lds + RING_OFF, g, S, E);
    }
#undef IN
#undef BOTH
}

extern "C" void kernel_launch(void* const* d_in, const int* in_sizes, int n_in, void* d_out, int out_size, void* d_ws, size_t ws_size, hipStream_t stream) {
    static int grid = 0;
    if (grid == 0) {
        if (n_in != 11 || ws_size < WS_END) { fprintf(stderr, "kernel_launch: unexpected inputs / workspace (%d, %zu)\n", n_in, ws_size); grid = -1; return; }
        int dev = 0, cus = 0;
        if (hipGetDevice(&dev) != hipSuccess || hipDeviceGetAttribute(&cus, hipDeviceAttributeMultiprocessorCount, dev) != hipSuccess) { grid = -1; return; }
        if (hipFuncSetAttribute((const void*)mega, hipFuncAttributeMaxDynamicSharedMemorySize, LDS_BYTES) != hipSuccess) { fprintf(stderr, "kernel_launch: hipFuncSetAttribute failed\n"); grid = -1; return; }
        grid = cus;
    }
    if (grid < 0) return;
    unsigned char* ws = (unsigned char*)d_ws;
    const Ptrs P = make_ptrs(d_in, d_out, ws);
    (void)hipMemsetAsync(ws + WS_CTL, 0, CTL_BYTES, stream);
    Args a{};
    for (int i = 0; i < 11; ++i) a.in[i] = (const float*)d_in[i];
    a.out = (float*)d_out; a.ws = ws;
#ifndef DUPF
#define DUPF 0
#endif
#ifndef DUPP
    a.ph_lo = 0; a.ph_hi = 6;
    hipLaunchKernelGGL(mega, dim3(grid), dim3(NWAVES * 64), LDS_BYTES, stream, a);
#else
#ifdef FIRSTF
    a.qoff = FIRSTF;
#endif
    a.ph_lo = 0; a.ph_hi = DUPP + 1;
    hipLaunchKernelGGL(mega, dim3(grid), dim3(NWAVES * 64), LDS_BYTES, stream, a);
    a.ph_lo = DUPP; a.ph_hi = DUPP + 1; a.qoff = 1024 + 128 + DUPF; a.li = 1;
    hipLaunchKernelGGL(mega, dim3(grid), dim3(NWAVES * 64), LDS_BYTES, stream, a);
    if (DUPP < 5) { a.ph_lo = DUPP + 1; a.ph_hi = 6; a.qoff = 0; a.li = 2;
    hipLaunchKernelGGL(mega, dim3(grid), dim3(NWAVES * 64), LDS_BYTES, stream, a); }
#endif
}
```

```cpp
#include <hip/hip_runtime.h>
#include <stdint.h>
#include <math.h>
#include <cstdio>

typedef unsigned short bf16_t;
typedef short bf16x8 __attribute__((ext_vector_type(8)));
typedef float f32x4 __attribute__((ext_vector_type(4)));
typedef unsigned u32x4 __attribute__((ext_vector_type(4)));

constexpr int NB = 4, SEQ = 8192, DM = 1024, MTOK = NB * SEQ;
constexpr int AH = 8, AD = 64, AW = 512, NBLK = 32;
constexpr int DH = 4, DKH = 128, NCOL = 4104, DCONV = 1536;
constexpr float EPS = 1e-6f;
constexpr float LOG2E = 1.4426950408889634f;
constexpr float QSCALE = 0.125f * LOG2E;

constexpr size_t MiB = 1u << 20;
constexpr size_t WS_CTL = 0, CTL_BYTES = 1 * MiB;
constexpr size_t WS_KMEAN = 512 * 1024;
constexpr size_t WS_WT1 = 1 * MiB;
constexpr size_t WS_WT2 = 9 * MiB;
constexpr size_t WS_BETA = 11 * MiB;
constexpr size_t WS_GDEC = 11 * MiB + 512 * 1024;
constexpr size_t WS_QA = 12 * MiB, WS_KA = 44 * MiB, WS_VA = 76 * MiB;
constexpr size_t WS_ZA = 108 * MiB, WS_ZD = 140 * MiB;
constexpr size_t WS_QKVD = 172 * MiB;
constexpr size_t WS_QD = 268 * MiB, WS_KD = 300 * MiB, WS_VD = 332 * MiB;
constexpr size_t WS_REC = 268 * MiB;
constexpr size_t WS_GLB = 256 * 1024;
constexpr size_t WS_Y = 412 * MiB;
constexpr size_t WS_END = 476 * MiB;
constexpr size_t OUT_OD = 64 * MiB;

__device__ __forceinline__ unsigned short f2bf(float f) { unsigned u = __float_as_uint(f); return (unsigned short)((u + 0x7fffu + ((u >> 16) & 1u)) >> 16); }
__device__ __forceinline__ float bf2f(unsigned short u) { return __uint_as_float(((unsigned)u) << 16); }
__device__ __forceinline__ float wave_sum(float v) {
#pragma unroll
    for (int o = 1; o < 64; o <<= 1) v += __shfl_xor(v, o);
    return v;
}
__device__ __forceinline__ float silu_f(float x) { return x / (1.0f + __expf(-x)); }
__host__ __device__ __forceinline__ int wt1_ltile(int pt) { return pt < 8 ? pt : (pt < 10 ? pt + 6 : pt - 2); }
__host__ __device__ __forceinline__ int wt1_logical(int p) { const int pn = wt1_ltile(p >> 8), t = p & 255, bj = t >> 7, wc = (t >> 5) & 3, i = t & 31; return 256 * pn + 64 * wc + 32 * bj + i; }
__host__ __device__ __forceinline__ int wt1_physical(int c) { const int ln = c >> 8, pn = ln < 8 ? ln : (ln < 14 ? ln + 2 : ln - 6), wc = (c >> 6) & 3, bj = (c >> 5) & 1, i = c & 31; return 256 * pn + 128 * bj + 32 * wc + i; }

__device__ __forceinline__ void wt_tile(const float* W, int ldw, bf16_t* WT, int kb, int pb, bool perm, float* lds, int tid) {
#pragma unroll 4
    for (int i = 0; i < 16; ++i) { const int kk = i * 4 + (tid >> 6), pp = tid & 63, p = pb * 64 + pp; const int c = perm ? wt1_logical(p) : p;
        lds[kk * 65 + pp] = W[(size_t)(kb * 64 + kk) * ldw + c]; }
    __syncthreads();
#pragma unroll 4
    for (int i = 0; i < 16; ++i) { const int pp = i * 4 + (tid >> 6), kk = tid & 63;
        WT[(size_t)(pb * 64 + pp) * 1024 + kb * 64 + kk] = f2bf(lds[kk * 65 + pp]); }
    __syncthreads();
}
__global__ void __launch_bounds__(256) k_wt(const float* w_in, const float* w_out, bf16_t* WT1, bf16_t* WT2) {
    __shared__ float lds[64 * 65];
    const int tid = threadIdx.x;
    for (int it = blockIdx.x; it < 1024 + 256; it += gridDim.x) {
        if (it < 1024) wt_tile(w_in, NCOL, WT1, it & 15, it >> 4, true, lds, tid);
        else { const int r = it - 1024; wt_tile(w_out, DM, WT2, r & 15, r >> 4, false, lds, tid); }
    }
}

__global__ void __launch_bounds__(256) k_rows(const float* x, const float* norm_w, const float* w_in, const float* a_log, const float* dt_bias,
                                              bf16_t* HN, float* BETA, float* GDEC) {
    __shared__ float w8[1024 * 8];
    const int tid = threadIdx.x, lane = tid & 63, wave = tid >> 6;
    for (int i = tid; i < 1024 * 8; i += 256) w8[i] = w_in[(size_t)(i >> 3) * NCOL + 4096 + (i & 7)];
    __syncthreads();
    f32x4 nw[4];
#pragma unroll
    for (int j = 0; j < 4; ++j) nw[j] = ((const f32x4*)norm_w)[lane + 64 * j];
    const int gw = blockIdx.x * 4 + wave, ngw = gridDim.x * 4;
    for (int row = gw; row < MTOK; row += ngw) {
        const f32x4* xr = (const f32x4*)(x + (size_t)row * DM) + lane;
        f32x4 v[4]; float ss = 0.f;
#pragma unroll
        for (int j = 0; j < 4; ++j) { v[j] = xr[64 * j]; ss += v[j][0] * v[j][0] + v[j][1] * v[j][1] + v[j][2] * v[j][2] + v[j][3] * v[j][3]; }
        ss = wave_sum(ss);
        const float rstd = 1.0f / sqrtf(ss * (1.0f / DM) + EPS);
        float d[8];
#pragma unroll
        for (int c = 0; c < 8; ++c) d[c] = 0.f;
#pragma unroll
        for (int j = 0; j < 4; ++j) {
            f32x4 h = v[j] * rstd * nw[j];
            unsigned lo = (unsigned)f2bf(h[0]) | ((unsigned)f2bf(h[1]) << 16), hi = (unsigned)f2bf(h[2]) | ((unsigned)f2bf(h[3]) << 16);
            *(uint2*)(HN + (size_t)row * DM + 4 * (lane + 64 * j)) = make_uint2(lo, hi);
#pragma unroll
            for (int e = 0; e < 4; ++e) { const float* wr = w8 + (4 * (lane + 64 * j) + e) * 8;
#pragma unroll
                for (int c = 0; c < 8; ++c) d[c] += h[e] * wr[c]; }
        }
#pragma unroll
        for (int c = 0; c < 8; ++c) d[c] = wave_sum(d[c]);
        if (lane < 4) {
            const int hh = lane; float bd = d[0], ad = d[4];
            if (hh == 1) { bd = d[1]; ad = d[5]; } else if (hh == 2) { bd = d[2]; ad = d[6]; } else if (hh == 3) { bd = d[3]; ad = d[7]; }
            const float beta = 1.0f / (1.0f + expf(-bd));
            const float z = ad + dt_bias[hh];
            const float sp = fmaxf(z, 0.f) + log1pf(expf(-fabsf(z)));
            const float g = -expf(a_log[hh]) * sp;
            const int b = row / SEQ, s = row % SEQ;
            BETA[(size_t)(b * DH + hh) * SEQ + s] = beta; GDEC[(size_t)(b * DH + hh) * SEQ + s] = g;
        }
    }
}

struct G1Out { bf16_t *QA, *KA, *VA, *ZA, *ZD, *QKVD; float* KMEAN; const float *qnw, *knw; };
__global__ void __launch_bounds__(256) k_gemm1(const bf16_t* HN, const bf16_t* WT1, G1Out o) {
    const int tid = threadIdx.x, lane = tid & 63, wave = tid >> 6, fr = lane & 15, fq = lane >> 4;
    const int rt = blockIdx.x >> 4, gq = blockIdx.x & 15, cg = gq * 4 + wave;
    f32x4 acc[2][4];
#pragma unroll
    for (int m = 0; m < 2; ++m)
#pragma unroll
        for (int n = 0; n < 4; ++n) acc[m][n] = (f32x4){0.f, 0.f, 0.f, 0.f};
    const bf16_t* ap[2]; const bf16_t* bp[4];
#pragma unroll
    for (int m = 0; m < 2; ++m) ap[m] = HN + (size_t)(rt * 32 + m * 16 + fr) * DM + 8 * fq;
#pragma unroll
    for (int n = 0; n < 4; ++n) bp[n] = WT1 + (size_t)wt1_physical(cg * 64 + n * 16 + fr) * DM + 8 * fq;
    for (int k0 = 0; k0 < DM; k0 += 32) {
        bf16x8 a[2], b[4];
#pragma unroll
        for (int m = 0; m < 2; ++m) a[m] = *(const bf16x8*)(ap[m] + k0);
#pragma unroll
        for (int n = 0; n < 4; ++n) b[n] = *(const bf16x8*)(bp[n] + k0);
#pragma unroll
        for (int m = 0; m < 2; ++m)
#pragma unroll
            for (int n = 0; n < 4; ++n) acc[m][n] = __builtin_amdgcn_mfma_f32_16x16x32_bf16(a[m], b[n], acc[m][n], 0, 0, 0);
    }
    const int row_base = rt * 32, b_ = row_base / SEQ;
    if (cg < 16) {
        const bool isq = cg < 8; const int head = cg & 7; const float* nwp = isq ? o.qnw : o.knw;
        float nwv[4];
#pragma unroll
        for (int n = 0; n < 4; ++n) nwv[n] = nwp[n * 16 + fr];
        float ksum[4] = {0.f, 0.f, 0.f, 0.f};
#pragma unroll
        for (int m = 0; m < 2; ++m)
#pragma unroll
            for (int r = 0; r < 4; ++r) {
                float ss = 0.f;
#pragma unroll
                for (int n = 0; n < 4; ++n) ss += acc[m][n][r] * acc[m][n][r];
                ss += __shfl_xor(ss, 1); ss += __shfl_xor(ss, 2); ss += __shfl_xor(ss, 4); ss += __shfl_xor(ss, 8);
                const float rs = 1.0f / sqrtf(ss * (1.0f / 64.0f) + EPS);
                const int row = row_base + m * 16 + fq * 4 + r, s = row % SEQ;
                bf16_t* dst = (isq ? o.QA : o.KA) + ((size_t)(b_ * AH + head) * SEQ + s) * AD;
#pragma unroll
                for (int n = 0; n < 4; ++n) { const float val = acc[m][n][r] * rs * nwv[n]; ksum[n] += val; dst[n * 16 + fr] = f2bf(isq ? val * QSCALE : val); }
            }
        if (!isq) {
            const int blk = (row_base % SEQ) >> 8;
#pragma unroll
            for (int n = 0; n < 4; ++n) { float t = ksum[n]; t += __shfl_xor(t, 16); t += __shfl_xor(t, 32);
                if (fq == 0) atomicAdd(o.KMEAN + ((size_t)(b_ * AH + head) * NBLK + blk) * AD + n * 16 + fr, t * (1.0f / 256.0f)); }
        }
    } else {
#pragma unroll
        for (int m = 0; m < 2; ++m)
#pragma unroll
            for (int r = 0; r < 4; ++r) {
                const int row = row_base + m * 16 + fq * 4 + r, s = row % SEQ;
#pragma unroll
                for (int n = 0; n < 4; ++n) {
                    const int c = cg * 64 + n * 16 + fr; const float val = acc[m][n][r];
                    if (c < 1536) { const int head = (c - 1024) >> 6; o.VA[((size_t)(b_ * AH + head) * SEQ + s) * AD + (c & 63)] = f2bf(val); }
                    else if (c < 2048) o.ZA[(size_t)row * AW + (c - 1536)] = f2bf(silu_f(val));
                    else if (c < 3584) o.QKVD[(size_t)row * DCONV + (c - 2048)] = f2bf(val);
                    else o.ZD[(size_t)row * AW + (c - 3584)] = f2bf(silu_f(val));
                }
            }
    }
}

__global__ void __launch_bounds__(256) k_gemm2(const bf16_t* Y, const bf16_t* WT2, const float* x, float* out) {
    const int tid = threadIdx.x, lane = tid & 63, wave = tid >> 6, fr = lane & 15, fq = lane >> 4;
    const int rt = blockIdx.x >> 2, gq = blockIdx.x & 3, cg = gq * 4 + wave;
    f32x4 acc[2][4];
#pragma unroll
    for (int m = 0; m < 2; ++m)
#pragma unroll
        for (int n = 0; n < 4; ++n) acc[m][n] = (f32x4){0.f, 0.f, 0.f, 0.f};
    const bf16_t* ap[2]; const bf16_t* bp[4];
#pragma unroll
    for (int m = 0; m < 2; ++m) ap[m] = Y + (size_t)(rt * 32 + m * 16 + fr) * DM + 8 * fq;
#pragma unroll
    for (int n = 0; n < 4; ++n) bp[n] = WT2 + (size_t)(cg * 64 + n * 16 + fr) * DM + 8 * fq;
    for (int k0 = 0; k0 < DM; k0 += 32) {
        bf16x8 a[2], b[4];
#pragma unroll
        for (int m = 0; m < 2; ++m) a[m] = *(const bf16x8*)(ap[m] + k0);
#pragma unroll
        for (int n = 0; n < 4; ++n) b[n] = *(const bf16x8*)(bp[n] + k0);
#pragma unroll
        for (int m = 0; m < 2; ++m)
#pragma unroll
            for (int n = 0; n < 4; ++n) acc[m][n] = __builtin_amdgcn_mfma_f32_16x16x32_bf16(a[m], b[n], acc[m][n], 0, 0, 0);
    }
#pragma unroll
    for (int m = 0; m < 2; ++m)
#pragma unroll
        for (int r = 0; r < 4; ++r) {
            const size_t row = rt * 32 + m * 16 + fq * 4 + r;
#pragma unroll
            for (int n = 0; n < 4; ++n) { const size_t idx = row * DM + cg * 64 + n * 16 + fr; out[idx] = x[idx] + acc[m][n][r]; }
        }
}

__global__ void __launch_bounds__(256) k_dn_prep(const bf16_t* QKVD, const float* conv_w, bf16_t* QD, bf16_t* KD, bf16_t* VD) {
    const int tid = threadIdx.x, lane = tid & 63, wave = tid >> 6;
    const int gw = blockIdx.x * 4 + wave, ngw = gridDim.x * 4;
    for (int it = gw; it < MTOK * DH; it += ngw) {
        const int row = it >> 2, hh = it & 3, b = row / SEQ, s = row % SEQ;
        float val[3][2];
#pragma unroll
        for (int part = 0; part < 3; ++part)
#pragma unroll
            for (int e = 0; e < 2; ++e) {
                const int cc = part * 512 + hh * 128 + lane + 64 * e; float a = 0.f;
#pragma unroll
                for (int j = 0; j < 4; ++j) { const int sj = s - 3 + j; if (sj >= 0) a += conv_w[j * DCONV + cc] * bf2f(QKVD[(size_t)(row - 3 + j) * DCONV + cc]); }
                val[part][e] = silu_f(a);
            }
        float sq = wave_sum(val[0][0] * val[0][0] + val[0][1] * val[0][1]);
        float sk = wave_sum(val[1][0] * val[1][0] + val[1][1] * val[1][1]);
        const float rq = (1.0f / sqrtf(sq + EPS)) * 0.08838834764831845f, rk = 1.0f / sqrtf(sk + EPS);
        const size_t base = ((size_t)(b * DH + hh) * SEQ + s) * DKH;
#pragma unroll
        for (int e = 0; e < 2; ++e) { QD[base + lane + 64 * e] = f2bf(val[0][e] * rq); KD[base + lane + 64 * e] = f2bf(val[1][e] * rk); VD[base + lane + 64 * e] = f2bf(val[2][e]); }
    }
}
__global__ void __launch_bounds__(128) k_dn_seq(const bf16_t* QD, const bf16_t* KD, const bf16_t* VD, const float* BETA, const float* GDEC, float* OD) {
    __shared__ __attribute__((aligned(16))) float kq[2][256];
    const int e = threadIdx.x, bh = blockIdx.x, b = bh >> 2, hh = bh & 3;
    float S[128];
#pragma unroll
    for (int d = 0; d < 128; ++d) S[d] = 0.f;
    const size_t base = (size_t)bh * SEQ * DKH;
    float kn = bf2f(KD[base + e]), qn = bf2f(QD[base + e]), vn_ = bf2f(VD[base + e]), gn = GDEC[(size_t)bh * SEQ], bn = BETA[(size_t)bh * SEQ];
    for (int t = 0; t < SEQ; ++t) {
        float* buf = kq[t & 1];
        buf[e] = kn; buf[128 + e] = qn;
        const float vt = vn_, alpha = __expf(gn), beta = bn;
        if (t + 1 < SEQ) { const size_t nx = base + (size_t)(t + 1) * DKH + e; kn = bf2f(KD[nx]); qn = bf2f(QD[nx]); vn_ = bf2f(VD[nx]); gn = GDEC[(size_t)bh * SEQ + t + 1]; bn = BETA[(size_t)bh * SEQ + t + 1]; }
        __syncthreads();
        float ks = 0.f;
#pragma unroll
        for (int d = 0; d < 128; d += 4) { const f32x4 k4 = *(const f32x4*)(buf + d); ks += k4[0] * S[d] + k4[1] * S[d + 1] + k4[2] * S[d + 2] + k4[3] * S[d + 3]; }
        const float vnew = beta * (vt - alpha * ks);
        float o = 0.f;
#pragma unroll
        for (int d = 0; d < 128; d += 4) { const f32x4 k4 = *(const f32x4*)(buf + d), q4 = *(const f32x4*)(buf + 128 + d);
#pragma unroll
            for (int i = 0; i < 4; ++i) { S[d + i] = alpha * S[d + i] + k4[i] * vnew; o += q4[i] * S[d + i]; } }
        OD[((size_t)b * SEQ + t) * AW + hh * 128 + e] = o;
    }
}

__device__ __forceinline__ int t5_bucket_dev(int n) {
    if (n < 16) return n;
    int bkt = 16;
    bkt += (n >= 19) + (n >= 21) + (n >= 24) + (n >= 27) + (n >= 31) + (n >= 35) + (n >= 40) + (n >= 46) + (n >= 52) + (n >= 59) + (n >= 67) + (n >= 77) + (n >= 87) + (n >= 99) + (n >= 113);
    return bkt;
}
__global__ void __launch_bounds__(256) k_attn(const bf16_t* QA, const bf16_t* KA, const bf16_t* VA, const float* KMEAN, const float* rel_bias,
                                              const float* qnw, const float* knw, const bf16_t* ZA, bf16_t* Y) {
    __shared__ float qs_all[4][64];
    __shared__ float bias_all[4][32];
    const int tid = threadIdx.x, lane = tid & 63, wave = tid >> 6;
    float* qs = qs_all[wave]; float* bt = bias_all[wave];
    const int gq = blockIdx.x * 4 + wave;
    const int bh = gq / SEQ, s = gq % SEQ, h = bh & 7, b = bh >> 3, own = s >> 8;
    float mq = fabsf(qnw[lane]), mk = fabsf(knw[lane]), mb = (lane < 32) ? rel_bias[lane * AH + h] : -1e30f;
#pragma unroll
    for (int o = 1; o < 64; o <<= 1) { mq = fmaxf(mq, __shfl_xor(mq, o)); mk = fmaxf(mk, __shfl_xor(mk, o)); mb = fmaxf(mb, __shfl_xor(mb, o)); }
    const float mref = (8.0f * mq * mk + mb) * LOG2E;
    qs[lane] = bf2f(QA[(size_t)gq * AD + lane]);
    if (lane < 32) bt[lane] = rel_bias[lane * AH + h] * LOG2E;
    __syncthreads();
    float gate = -INFINITY;
    if (lane < own) { const float* km = KMEAN + ((size_t)bh * NBLK + lane) * AD; float a = 0.f;
        for (int d = 0; d < 64; ++d) a += qs[d] * km[d];
        gate = a; }
    unsigned selmask = 0u;
    for (int r = 0; r < 3; ++r) {
        float bv = gate; int bi = lane;
#pragma unroll
        for (int o = 1; o < 64; o <<= 1) { const float ov = __shfl_xor(bv, o); const int oi = __shfl_xor(bi, o); if (ov > bv || (ov == bv && oi < bi)) { bv = ov; bi = oi; } }
        if (bv > -INFINITY) { selmask |= 1u << bi; if (lane == bi) gate = -INFINITY; }
    }
    selmask |= 1u << own;
    float l = 0.f, oacc = 0.f;
    const bf16_t* Kb = KA + (size_t)bh * SEQ * AD; const bf16_t* Vb = VA + (size_t)bh * SEQ * AD;
    for (int j = 0; j <= own; ++j) {
        if (!((selmask >> j) & 1u)) continue;
        for (int t4 = 0; t4 < 4; ++t4) {
            const int kpos = j * 256 + t4 * 64 + lane;
            const bf16_t* kr = Kb + (size_t)kpos * AD; float sc = 0.f;
#pragma unroll
            for (int c = 0; c < 8; ++c) { const bf16x8 kv = *(const bf16x8*)(kr + c * 8);
#pragma unroll
                for (int i = 0; i < 8; ++i) sc += qs[c * 8 + i] * bf2f((unsigned short)kv[i]); }
            const int dist = s - kpos; float p = 0.f;
            if (dist >= 0) p = exp2f(sc + bt[t5_bucket_dev(dist)] - mref);
            l += p;
            const bf16_t* vr = Vb + (size_t)(j * 256 + t4 * 64) * AD + lane;
#pragma unroll 8
            for (int k = 0; k < 64; ++k) oacc += __shfl(p, k) * bf2f(vr[(size_t)k * AD]);
        }
    }
    l = wave_sum(l);
    const size_t tok = (size_t)b * SEQ + s;
    const float yv = (oacc / l) * bf2f(ZA[tok * AW + h * 64 + lane]);
    Y[tok * DM + h * 64 + lane] = f2bf(yv);
}

__global__ void __launch_bounds__(256) k_ycomb(const float* OD, const float* dnw, const bf16_t* ZD, bf16_t* Y) {
    const int tid = threadIdx.x, lane = tid & 63, wave = tid >> 6;
    const int gw = blockIdx.x * 4 + wave, ngw = gridDim.x * 4;
    for (int it = gw; it < MTOK * DH; it += ngw) {
        const int row = it >> 2, hh = it & 3;
        const float a0 = OD[(size_t)row * AW + hh * 128 + lane], a1 = OD[(size_t)row * AW + hh * 128 + 64 + lane];
        const float ss = wave_sum(a0 * a0 + a1 * a1);
        const float rs = 1.0f / sqrtf(ss * (1.0f / 128.0f) + EPS);
        Y[(size_t)row * DM + 512 + hh * 128 + lane] = f2bf(a0 * rs * dnw[lane] * bf2f(ZD[(size_t)row * AW + hh * 128 + lane]));
        Y[(size_t)row * DM + 512 + hh * 128 + 64 + lane] = f2bf(a1 * rs * dnw[64 + lane] * bf2f(ZD[(size_t)row * AW + hh * 128 + 64 + lane]));
    }
}


#define CBAR_ALL() do{ asm volatile("s_waitcnt vmcnt(0) lgkmcnt(0)":::"memory"); __builtin_amdgcn_s_barrier(); asm volatile("":::"memory"); }while(0)
#define CBAR_LDS() do{ asm volatile("s_waitcnt lgkmcnt(0)":::"memory"); __builtin_amdgcn_s_barrier(); asm volatile("":::"memory"); }while(0)
namespace pg8 {
#define PG8_LAS __attribute__((address_space(3)))
constexpr int BM = 256, BK = 64, HALF = 128, HTB = HALF * BK * 2  , STAGE_BYTES = 8 * HTB, NXCD = 8, WGM = 8;

__host__ __device__ __forceinline__ int lds_byte(int r, int c) { const int st = (r >> 4) * 2 + (c >> 5), rr = r & 15, cc = c & 31, ob = rr * 64 + cc * 2; return st * 1024 + (ob ^ (((ob >> 9) & 1) << 5)); }
__host__ __device__ __forceinline__ void stage_rc(int b, int& R, int& C) { const int st = b / 1024, sb = b % 1024, swz = sb ^ (((sb >> 9) & 1) << 5); R = (st >> 1) * 16 + swz / 64; C = (st & 1) * 32 + (swz % 64) / 2; }
__host__ __device__ __forceinline__ int perm32(int rho) { const int n = rho >> 4, i = rho & 15; return 8 * (i >> 2) + 4 * n + (i & 3); }

struct Unit { int pm, pn; };
struct Gemm { const bf16_t* A; const bf16_t* Bt; int M, N, K; };

struct StaticOrder {
    int nM, nN, nwg, G, c;
    __host__ __device__ void init(int M, int N, int G_, int c_) { nM = M / BM; nN = N / BM; nwg = nM * nN; G = G_; c = c_; }
    __host__ __device__ bool next(int i, Unit& u) const {
        const long L = (long)i * G + c; if (L >= nwg) return false;
        int wgid = (int)L; { const int q = nwg / NXCD, r = nwg % NXCD, xcd = wgid % NXCD, off = wgid / NXCD; wgid = (xcd < r ? xcd * (q + 1) : r * (q + 1) + (xcd - r) * q) + off; }
        const int nig = WGM * nN, gid = wgid / nig, fm = gid * WGM, gsz = (nM - fm) < WGM ? (nM - fm) : WGM;
        u.pm = fm + ((wgid % nig) % gsz); u.pn = (wgid % nig) / gsz; return true;
    }
    __device__ __forceinline__ void a_ready(const Unit&) const {}
    __device__ __forceinline__ void done(const Unit&) const {}
};

__device__ __forceinline__ unsigned cvt_pk_bf16(float lo, float hi) { unsigned r; asm volatile("v_cvt_pk_bf16_f32 %0, %1, %2" : "=v"(r) : "v"(lo), "v"(hi)); return r; }
typedef float f32x2 __attribute__((ext_vector_type(2)));
template <class Epi, class Sched, bool ALIGN_EPI = false, bool SP2 = false>
__device__ __forceinline__ void gemm_phase(PG8_LAS unsigned char* lds, const Gemm g, const Sched& S, const Epi& E) {
    const int tid = threadIdx.x, wid = __builtin_amdgcn_readfirstlane(tid >> 6), lane = tid & 63, wr = wid >> 2, wc = wid & 3, fr = lane & 15, fq = lane >> 4;
    const int K = g.K, nt = K / BK;
    unsigned voffA[2], voffB[2];
#pragma unroll
    for (int i = 0; i < 2; ++i) { int R, C; stage_rc(tid * 16 + i * 8192, R, C); const int Rb = Epi::PERM ? ((R & ~31) + perm32(R & 31)) : R;
        voffA[i] = (unsigned)(R * K + C) * 2u; voffB[i] = (unsigned)(Rb * K + C) * 2u; }
    const size_t kstep = (size_t)(BK * 2);
    const size_t hstep = (size_t)HALF * K * 2;
    const size_t tstep = 2 * hstep;
    const unsigned ldsw = (unsigned)wid * 1024u;
    const int aoff = lds_byte(wr * 64 + fr, fq * 8), boff = lds_byte(wc * 32 + fr, fq * 8);
#define PG8_SA(b, h) (((b) * 2 + (h)) * HTB)
#define PG8_SB(b, h) ((4 + (b) * 2 + (h)) * HTB)
#define PG8_STAGE(bufoff, gbase, voff) do { _Pragma("unroll") for (int _i = 0; _i < 2; ++_i) \
        __builtin_amdgcn_global_load_lds((const unsigned*)((const char*)(gbase) + (voff)[_i]), (PG8_LAS unsigned*)(lds + (bufoff) + ldsw + _i * 8192), 16, 0, 0); } while (0)
#define PG8_LDA(dst, b, h) do { _Pragma("unroll") for (int m = 0; m < 4; ++m) _Pragma("unroll") for (int k = 0; k < 2; ++k) dst[m][k] = *(const PG8_LAS bf16x8*)(lds + PG8_SA(b, h) + aoff + m * 2048 + k * 1024); } while (0)
#define PG8_LDB(dst, b, h) do { _Pragma("unroll") for (int n = 0; n < 2; ++n) _Pragma("unroll") for (int k = 0; k < 2; ++k) dst[n][k] = *(const PG8_LAS bf16x8*)(lds + PG8_SB(b, h) + boff + n * 2048 + k * 1024); } while (0)
#define PG8_MMA(ai, bj, At, Bt) do { __builtin_amdgcn_s_setprio(1); _Pragma("unroll") for (int m = 0; m < 4; ++m) _Pragma("unroll") for (int n = 0; n < 2; ++n) _Pragma("unroll") for (int k = 0; k < 2; ++k) \
        acc[ai][bj][m][n] = __builtin_amdgcn_mfma_f32_16x16x32_bf16(Bt[n][k], At[m][k], acc[ai][bj][m][n], 0, 0, 0); __builtin_amdgcn_s_setprio(0); } while (0)
#define PG8_WAIT_V(n) asm volatile("s_waitcnt vmcnt(" #n ")" ::: "memory")
#define PG8_WAIT_L(n) asm volatile("s_waitcnt lgkmcnt(" #n ")" ::: "memory")
#define PG8_BAR __builtin_amdgcn_s_barrier()
#define PG8_SCHED __builtin_amdgcn_sched_barrier(0)
    Unit cur, nxt; int ui = 0;
    if (!S.next(0, cur)) return;
    f32x4 acc[2][2][4][2];
#pragma unroll
    for (int a = 0; a < 2; ++a)
#pragma unroll
        for (int b = 0; b < 2; ++b)
#pragma unroll
            for (int m = 0; m < 4; ++m)
#pragma unroll
                for (int n = 0; n < 2; ++n) acc[a][b][m][n] = (f32x4){0.f, 0.f, 0.f, 0.f};
    bf16x8 At[4][2], B0[2][2], B1[2][2];
    const char* cA = (const char*)g.A + (size_t)cur.pm * tstep; const char* cB = (const char*)g.Bt + (size_t)cur.pn * tstep;
    S.a_ready(cur);
    if constexpr (SP2) {
        PG8_STAGE(PG8_SB(0, 0), cB, voffB); PG8_STAGE(PG8_SB(0, 1), cB + hstep, voffB); PG8_STAGE(PG8_SA(0, 0), cA, voffA); PG8_STAGE(PG8_SA(0, 1), cA + hstep, voffA);
        if (wr == 1) PG8_BAR;
        PG8_WAIT_V(2); PG8_BAR;
        PG8_STAGE(PG8_SB(1, 0), cB + kstep, voffB); PG8_STAGE(PG8_SA(1, 0), cA + kstep, voffA); PG8_STAGE(PG8_SB(1, 1), cB + hstep + kstep, voffB);
        PG8_WAIT_V(6); PG8_BAR;
    } else {
        PG8_STAGE(PG8_SB(0, 0), cB, voffB); PG8_STAGE(PG8_SA(0, 0), cA, voffA); PG8_STAGE(PG8_SB(0, 1), cB + hstep, voffB); PG8_STAGE(PG8_SA(0, 1), cA + hstep, voffA);
        if (wr == 1) PG8_BAR;
        PG8_WAIT_V(4); PG8_BAR;
        PG8_STAGE(PG8_SB(1, 0), cB + kstep, voffB); PG8_STAGE(PG8_SA(1, 0), cA + kstep, voffA); PG8_STAGE(PG8_SB(1, 1), cB + hstep + kstep, voffB);
        PG8_WAIT_V(6); PG8_BAR;
    }
    for (;;) {
        const bool has_next = S.next(ui + 1, nxt);
        const char* nA = has_next ? (const char*)g.A + (size_t)nxt.pm * tstep : cA; const char* nB = has_next ? (const char*)g.Bt + (size_t)nxt.pn * tstep : cB;
        for (int t = 0; t < nt; t += 2) {
            const bool last = (t == nt - 2);
            const char* a1 = cA + (size_t)(t + 1) * kstep;
            const char* a2 = last ? nA : cA + (size_t)(t + 2) * kstep; const char* b2 = last ? nB : cB + (size_t)(t + 2) * kstep;
            const char* a3 = a2 + kstep; const char* b3 = b2 + kstep;
            if (last && has_next) S.a_ready(nxt);
            if constexpr (SP2) {
            PG8_LDB(B0, 0, 0); PG8_LDB(B1, 0, 1); PG8_SCHED; PG8_LDA(At, 0, 0); PG8_STAGE(PG8_SA(1, 1), a1 + hstep, voffA);
            PG8_WAIT_V(8); PG8_WAIT_L(0); PG8_BAR; PG8_MMA(0, 0, At, B0); PG8_MMA(0, 1, At, B1); PG8_BAR; PG8_SCHED;
            PG8_LDA(At, 0, 1); PG8_STAGE(PG8_SB(0, 0), b2, voffB); PG8_STAGE(PG8_SB(0, 1), b2 + hstep, voffB); PG8_STAGE(PG8_SA(0, 0), a2, voffA);
            PG8_WAIT_V(8); PG8_WAIT_L(0); PG8_BAR; PG8_MMA(1, 0, At, B0); PG8_MMA(1, 1, At, B1); PG8_BAR; PG8_SCHED;
            PG8_LDB(B0, 1, 0); PG8_LDB(B1, 1, 1); PG8_SCHED; PG8_LDA(At, 1, 0); PG8_STAGE(PG8_SA(0, 1), a2 + hstep, voffA);
            PG8_WAIT_V(8); PG8_WAIT_L(0); PG8_BAR; PG8_MMA(0, 0, At, B0); PG8_MMA(0, 1, At, B1); PG8_BAR; PG8_SCHED;
            PG8_LDA(At, 1, 1); PG8_STAGE(PG8_SB(1, 0), b3, voffB); PG8_STAGE(PG8_SB(1, 1), b3 + hstep, voffB); PG8_STAGE(PG8_SA(1, 0), a3, voffA);
            PG8_WAIT_V(8); PG8_WAIT_L(0); PG8_BAR; PG8_MMA(1, 0, At, B0); PG8_MMA(1, 1, At, B1); PG8_BAR; PG8_SCHED;
            } else {
            PG8_LDB(B0, 0, 0); PG8_SCHED; PG8_LDA(At, 0, 0); PG8_STAGE(PG8_SA(1, 1), a1 + hstep, voffA);
            PG8_WAIT_L(8); PG8_BAR; PG8_WAIT_L(0); PG8_MMA(0, 0, At, B0); PG8_BAR; PG8_SCHED;
            PG8_LDB(B1, 0, 1); PG8_STAGE(PG8_SB(0, 0), b2, voffB);
            PG8_BAR; PG8_WAIT_L(0); PG8_MMA(0, 1, At, B1); PG8_BAR;
            PG8_LDA(At, 0, 1); PG8_STAGE(PG8_SA(0, 0), a2, voffA);
            PG8_BAR; PG8_WAIT_L(0); PG8_MMA(1, 0, At, B0); PG8_BAR; PG8_SCHED;
            PG8_STAGE(PG8_SB(0, 1), b2 + hstep, voffB);
            PG8_WAIT_V(6); PG8_BAR; PG8_MMA(1, 1, At, B1); PG8_BAR;
            PG8_LDB(B0, 1, 0); PG8_SCHED; PG8_LDA(At, 1, 0); PG8_STAGE(PG8_SA(0, 1), a2 + hstep, voffA);
            PG8_WAIT_L(8); PG8_BAR; PG8_WAIT_L(0); PG8_MMA(0, 0, At, B0); PG8_BAR; PG8_SCHED;
            PG8_LDB(B1, 1, 1); PG8_STAGE(PG8_SB(1, 0), b3, voffB);
            PG8_BAR; PG8_WAIT_L(0); PG8_MMA(0, 1, At, B1); PG8_BAR;
            PG8_LDA(At, 1, 1); PG8_STAGE(PG8_SA(1, 0), a3, voffA);
            PG8_BAR; PG8_WAIT_L(0); PG8_MMA(1, 0, At, B0); PG8_BAR; PG8_SCHED;
            PG8_STAGE(PG8_SB(1, 1), b3 + hstep, voffB);
            PG8_WAIT_V(6); PG8_BAR; PG8_MMA(1, 1, At, B1); PG8_BAR;
            }
        }
        if constexpr (ALIGN_EPI) { if (wr == 0) PG8_BAR; }
        if constexpr (!Epi::AFTER_DRAIN) { E(acc, cur, wr, wc, fr, fq); S.done(cur); }
        if (!has_next) break;
#pragma unroll
        for (int a = 0; a < 2; ++a)
#pragma unroll
            for (int b = 0; b < 2; ++b)
#pragma unroll
                for (int m = 0; m < 4; ++m)
#pragma unroll
                    for (int n = 0; n < 2; ++n) acc[a][b][m][n] = (f32x4){0.f, 0.f, 0.f, 0.f};
        cur = nxt; cA = nA; cB = nB; ++ui;
        if constexpr (ALIGN_EPI) { if (wr == 1) PG8_BAR; }
    }
    PG8_WAIT_V(0);
    if constexpr (!ALIGN_EPI) { if (wr == 0) PG8_BAR; }
    PG8_BAR;
    if constexpr (Epi::AFTER_DRAIN) { E.fused(acc, cur, wr, wc, fr, fq, lds, wid, lane); S.done(cur); }
#undef PG8_SA
#undef PG8_SB
#undef PG8_STAGE
#undef PG8_LDA
#undef PG8_LDB
#undef PG8_MMA
#undef PG8_WAIT_V
#undef PG8_WAIT_L
#undef PG8_BAR
#undef PG8_SCHED
}
}

namespace pg8 {
__device__ __forceinline__ float fast_silu(float x) { return x * __builtin_amdgcn_rcpf(1.0f + __expf(-x)); }
struct EpiProj {
    static constexpr bool PERM = true, AFTER_DRAIN = false;
    bf16_t *QA, *KA, *VA, *ZA, *ZD, *QKVD; float* KMEAN; const float *qnw, *knw; int pt_off;
    __device__ __forceinline__ void operator()(const f32x4 (&acc)[2][2][4][2], const Unit& u, int wr, int wc, int fr, int fq) const {
        const int pn = wt1_ltile(u.pn + pt_off), b = u.pm >> 5, blk = u.pm & 31;
        const int s0 = blk * 256 + wr * 64 + fr;
        const int row0 = u.pm * BM + wr * 64 + fr;
        if (pn < 4) {
            const bool isq = pn < 2; const int head = (pn & 1) * 4 + wc; const float* nwp = isq ? qnw : knw;
            f32x4 nw[2][2];
#pragma unroll
            for (int bj = 0; bj < 2; ++bj)
#pragma unroll
                for (int n = 0; n < 2; ++n) nw[bj][n] = *(const f32x4*)(nwp + 32 * bj + 8 * fq + 4 * n);
            f32x4 ksum[2][2];
#pragma unroll
            for (int bj = 0; bj < 2; ++bj)
#pragma unroll
                for (int n = 0; n < 2; ++n) ksum[bj][n] = (f32x4){0.f, 0.f, 0.f, 0.f};
            bf16_t* dbase = (isq ? QA : KA) + ((size_t)(b * 8 + head) * 8192) * 64 + 8 * fq;
            const float sc = isq ? 0.125f * 1.4426950408889634f : 1.0f;
#pragma unroll
            for (int ai = 0; ai < 2; ++ai)
#pragma unroll
                for (int m = 0; m < 4; ++m) {
                    float ss = 0.f;
#pragma unroll
                    for (int bj = 0; bj < 2; ++bj)
#pragma unroll
                        for (int n = 0; n < 2; ++n) { const f32x4 v = acc[ai][bj][m][n]; ss += (v[0] * v[0] + v[1] * v[1]) + (v[2] * v[2] + v[3] * v[3]); }
                    ss += __shfl_xor(ss, 16); ss += __shfl_xor(ss, 32);
                    const float rs = (1.0f / sqrtf(ss * (1.0f / 64.0f) + 1e-6f));
                    bf16_t* dst = dbase + (size_t)(s0 + ai * 128 + m * 16) * 64;
#pragma unroll
                    for (int bj = 0; bj < 2; ++bj) {
                        const f32x4 v0 = acc[ai][bj][m][0] * rs * nw[bj][0], v1 = acc[ai][bj][m][1] * rs * nw[bj][1];
                        ksum[bj][0] += v0; ksum[bj][1] += v1;
                        u32x4 w; w.x = cvt_pk_bf16(v0[0] * sc, v0[1] * sc); w.y = cvt_pk_bf16(v0[2] * sc, v0[3] * sc); w.z = cvt_pk_bf16(v1[0] * sc, v1[1] * sc); w.w = cvt_pk_bf16(v1[2] * sc, v1[3] * sc);
                        *(u32x4*)(dst + 32 * bj) = w;
                    }
                }
            if (!isq) {
                float* km = KMEAN + ((size_t)(b * 8 + head) * 32 + blk) * 64 + 8 * fq;
#pragma unroll
                for (int bj = 0; bj < 2; ++bj)
#pragma unroll
                    for (int n = 0; n < 2; ++n)
#pragma unroll
                        for (int e = 0; e < 4; ++e) {
                            float t = ksum[bj][n][e];
                            t += __shfl_xor(t, 1); t += __shfl_xor(t, 2); t += __shfl_xor(t, 4); t += __shfl_xor(t, 8);
                            if (fr == 0) atomicAdd(km + 32 * bj + 4 * n + e, t * (1.0f / 256.0f));
                        }
            }
        } else {
            bf16_t* dbase; size_t ld; int colb; bool act;
            if (pn < 6) { const int head = (pn - 4) * 4 + wc; dbase = VA + ((size_t)(b * 8 + head) * 8192 + blk * 256) * 64; ld = 64; colb = 0; act = false; }
            else if (pn < 8) { dbase = ZA + (size_t)(u.pm * BM) * 512; ld = 512; colb = (pn - 6) * 256 + wc * 64; act = true; }
            else if (pn < 14) { dbase = QKVD + (size_t)(u.pm * BM) * 1536; ld = 1536; colb = (pn - 8) * 256 + wc * 64; act = false; }
            else { dbase = ZD + (size_t)(u.pm * BM) * 512; ld = 512; colb = (pn - 14) * 256 + wc * 64; act = true; }
            const int rloc = wr * 64 + fr;
#pragma unroll
            for (int ai = 0; ai < 2; ++ai)
#pragma unroll
                for (int m = 0; m < 4; ++m) {
                    bf16_t* dst = dbase + (size_t)(rloc + ai * 128 + m * 16) * ld + colb + 8 * fq;
#pragma unroll
                    for (int bj = 0; bj < 2; ++bj) {
                        f32x4 v0 = acc[ai][bj][m][0], v1 = acc[ai][bj][m][1];
                        if (act) {
#pragma unroll
                            for (int e = 0; e < 4; ++e) { v0[e] = fast_silu(v0[e]); v1[e] = fast_silu(v1[e]); }
                        }
                        u32x4 w; w.x = cvt_pk_bf16(v0[0], v0[1]); w.y = cvt_pk_bf16(v0[2], v0[3]); w.z = cvt_pk_bf16(v1[0], v1[1]); w.w = cvt_pk_bf16(v1[2], v1[3]);
                        *(u32x4*)(dst + 32 * bj) = w;
                    }
                }
        }
        (void)row0;
    }
};
struct EpiOut {
    static constexpr bool PERM = false, AFTER_DRAIN = false;
    const float* X; float* O;
    __device__ __forceinline__ void operator()(const f32x4 (&acc)[2][2][4][2], const Unit& u, int wr, int wc, int fr, int fq) const {
        const int row0 = u.pm * BM + wr * 64 + fr, col0 = u.pn * BM + wc * 32 + 4 * fq;
#pragma unroll
        for (int ai = 0; ai < 2; ++ai)
#pragma unroll
            for (int m = 0; m < 4; ++m) { const size_t off = (size_t)(row0 + ai * HALF + m * 16) * 1024 + col0;
#pragma unroll
                for (int bj = 0; bj < 2; ++bj)
#pragma unroll
                    for (int n = 0; n < 2; ++n) { const f32x4 xv = *(const f32x4*)(X + off + bj * HALF + n * 16); *(f32x4*)(O + off + bj * HALF + n * 16) = xv + acc[ai][bj][m][n]; } }
    }
};
}

#define LAS __attribute__((address_space(3)))
constexpr int NWAVES = 8;
constexpr int RING_OFF = 0;
constexpr int LDS_BYTES = 163840;
constexpr int LDSCTL_OFF = LDS_BYTES - 1024, MISC_OFF = LDSCTL_OFF + 320;
constexpr int CW_BAR = 4096;

#define XB_TMO      128
#define XB_XCNT(j)  (256  + 64 * (j))
#define XB_XSUB(j)  (1280 + 64 * (j))
#define XB_XGEN(j)  (2304 + 64 * (j))
#define XB_TOP      3328
#define XB_TOPGEN   3392
#define XCD_BAR_WORDS 3456
#define XB_SPIN_CAP (1u << 18)
__device__ __forceinline__ unsigned xb_ld(unsigned* p)              { return __hip_atomic_load(p, __ATOMIC_RELAXED, __HIP_MEMORY_SCOPE_AGENT); }
__device__ __forceinline__ unsigned xb_add(unsigned* p, unsigned v) { return __hip_atomic_fetch_add(p, v, __ATOMIC_RELAXED, __HIP_MEMORY_SCOPE_AGENT); }
__device__ __forceinline__ unsigned xb_xcc_id() { return (unsigned)__builtin_amdgcn_s_getreg((3 << 11) | 20) & 0xFu; }
#define XB_SPIN(cond, bar) do { unsigned _sp = 0; while (cond) { __builtin_amdgcn_s_sleep(1); \
    if ((++_sp & 255u) == 0u) { if (xb_ld(&(bar)[XB_TMO])) break; if (_sp > XB_SPIN_CAP) { atomicAdd(&(bar)[XB_TMO], 1u); break; } } } } while (0)
struct XcdBarrier { unsigned* bar; unsigned x; volatile LAS unsigned* st; };
__device__ __forceinline__ XcdBarrier xcd_barrier_post(unsigned* bar, volatile LAS unsigned* st) {
    XcdBarrier b; b.bar = bar; b.x = xb_xcc_id(); b.st = st;
    if (threadIdx.x == 0) (void)xb_add(&bar[XB_XCNT(b.x)], 1u);
    return b;
}
__device__ __forceinline__ void xcd_barrier_complete(unsigned* bar, unsigned x, unsigned& nloc, unsigned& nx) {
    const unsigned G = gridDim.x * gridDim.y * gridDim.z;
    unsigned sum, cnt, mine, sp = 0u;
    for (;;) {
        sum = 0u; cnt = 0u; mine = 0u;
#pragma unroll
        for (unsigned j = 0; j < 16; ++j) { const unsigned c = xb_ld(&bar[XB_XCNT(j)]); sum += c; cnt += (c > 0u) ? 1u : 0u; mine = (j == x) ? c : mine; }
        if (sum == G) break;
        __builtin_amdgcn_s_sleep(1);
        if ((++sp & 255u) == 0u) { if (xb_ld(&bar[XB_TMO])) break; if (sp > XB_SPIN_CAP) { atomicAdd(&bar[XB_TMO], 1u); break; } }
    }
    nloc = mine > 0u ? mine : 1u; nx = cnt > 0u ? cnt : 1u;
}
__device__ __forceinline__ void xcd_barrier(const XcdBarrier& b) {
    asm volatile("s_waitcnt vmcnt(0)" ::: "memory");
    __syncthreads();
    if (threadIdx.x == 0) {
        unsigned* bar = b.bar;
        __builtin_amdgcn_s_waitcnt(0);
        unsigned nloc = b.st[0], nx = b.st[1];
        if (nloc == 0u) { xcd_barrier_complete(bar, b.x, nloc, nx); b.st[0] = nloc; b.st[1] = nx; }
        const unsigned old = xb_add(&bar[XB_XSUB(b.x)], 1u);
        const unsigned gen = old / nloc;
        if (old + 1u == (gen + 1u) * nloc) {
            __builtin_amdgcn_fence(__ATOMIC_RELEASE, "agent");
            asm volatile("s_waitcnt vmcnt(0)" ::: "memory");
            const unsigned og = xb_add(&bar[XB_TOP], 1u);
            const unsigned tg = og / nx;
            if (og + 1u == (tg + 1u) * nx) xb_add(&bar[XB_TOPGEN], 1u);
            else XB_SPIN(xb_ld(&bar[XB_TOPGEN]) == tg, bar);
            __builtin_amdgcn_fence(__ATOMIC_ACQUIRE, "agent");
            xb_add(&bar[XB_XGEN(b.x)], 1u);
            asm volatile("s_waitcnt vmcnt(0)" ::: "memory");
        } else {
            XB_SPIN(xb_ld(&bar[XB_XGEN(b.x)]) == gen, bar);
            __builtin_amdgcn_fence(__ATOMIC_ACQUIRE, "agent");
            asm volatile("s_waitcnt vmcnt(0)" ::: "memory");
        }
    }
    __syncthreads();
}

struct Ptrs {
    const float *x, *rel_bias, *norm_w, *w_in, *qnw, *knw, *conv_w, *a_log, *dt_bias, *dnw, *w_out;
    float* out; bf16_t* HN; bf16_t *WT1, *WT2; float *BETA, *GDEC, *KMEAN; bf16_t *QA, *KA, *VA, *ZA, *ZD, *QKVD, *QD, *KD, *VD; float* OD; bf16_t* Y; unsigned* ctl; unsigned char* REC; float* GLB; unsigned* SEL; unsigned short* LIST; float* LP; bf16_t* OPART;
};
__host__ __device__ inline Ptrs make_ptrs(void* const* d_in, void* d_out, unsigned char* ws) {
    Ptrs p;
    p.x = (const float*)d_in[0]; p.rel_bias = (const float*)d_in[1]; p.norm_w = (const float*)d_in[2]; p.w_in = (const float*)d_in[3]; p.qnw = (const float*)d_in[4]; p.knw = (const float*)d_in[5];
    p.conv_w = (const float*)d_in[6]; p.a_log = (const float*)d_in[7]; p.dt_bias = (const float*)d_in[8]; p.dnw = (const float*)d_in[9]; p.w_out = (const float*)d_in[10];
    p.out = (float*)d_out; p.HN = (bf16_t*)d_out;
    p.WT1 = (bf16_t*)(ws + WS_WT1); p.WT2 = (bf16_t*)(ws + WS_WT2); p.BETA = (float*)(ws + WS_BETA); p.GDEC = (float*)(ws + WS_GDEC); p.KMEAN = (float*)(ws + WS_KMEAN);
    p.QA = (bf16_t*)(ws + WS_QA); p.KA = (bf16_t*)(ws + WS_KA); p.VA = (bf16_t*)(ws + WS_VA); p.ZA = (bf16_t*)(ws + WS_ZA); p.ZD = (bf16_t*)(ws + WS_ZD); p.QKVD = (bf16_t*)(ws + WS_QKVD);
    p.QD = (bf16_t*)(ws + WS_QD); p.KD = (bf16_t*)(ws + WS_KD); p.VD = (bf16_t*)(ws + WS_VD); p.OD = (float*)((unsigned char*)d_out + OUT_OD); p.Y = (bf16_t*)(ws + WS_Y); p.ctl = (unsigned*)(ws + WS_CTL); p.REC = ws + WS_REC; p.GLB = (float*)(ws + WS_GLB);
    { unsigned char* o8 = (unsigned char*)d_out; p.SEL = (unsigned*)o8; p.LIST = (unsigned short*)(o8 + 1 * MiB); p.LP = (float*)(o8 + 17 * MiB); p.OPART = (bf16_t*)(o8 + 21 * MiB); }
    return p;
}


namespace dn {
using f32x16=__attribute__((ext_vector_type(16)))float;
typedef unsigned u32x2v __attribute__((ext_vector_type(2)));
constexpr int REC_NW=0, REC_QD=16384, REC_KT=32768, REC_AI=49152, REC_U=57344, REC_BYTES=73728;
constexpr int CH=64;
__device__ __forceinline__ int crow(int r,int hi){return (r&3)+8*(r>>2)+4*hi;}
typedef float f32x2_t __attribute__((ext_vector_type(2))); typedef __bf16 bf16x2_t __attribute__((ext_vector_type(2)));
__device__ __forceinline__ unsigned cvtpk(float lo,float hi){f32x2_t v={lo,hi};bf16x2_t b=__builtin_convertvector(v,bf16x2_t);return __builtin_bit_cast(unsigned,b);}
__device__ __forceinline__ float bflo(unsigned w){return __uint_as_float(w<<16);}
__device__ __forceinline__ float bfhi(unsigned w){return __uint_as_float(w&0xffff0000u);}
#define DN_MFMA32(a,b,c) __builtin_amdgcn_mfma_f32_32x32x16_bf16((a),(b),(c),0,0,0)
#ifndef SCANDBG
#define SCANDBG 0
#endif
#define DN_MFMA4(a,b,c) __builtin_amdgcn_mfma_f32_16x16x4f32((a),(b),(c),0,0,0)
#define DN_BAR() CBAR_ALL()
__device__ __forceinline__ void st16_wt(void*p,u32x4 v){ asm volatile("global_store_dwordx4 %0, %1, off sc1\n\ts_nop 1"::"v"(p),"v"(v):"memory"); }
__device__ __forceinline__ void st8_wt(void*p,unsigned lo,unsigned hi){ __hip_atomic_store((unsigned long long*)p,((unsigned long long)hi<<32)|lo,__ATOMIC_RELAXED,__HIP_MEMORY_SCOPE_AGENT); }

constexpr int P_QI=0, P_KI=16384, P_XT=32768, XT_LD=68, P_LF=P_XT+256*XT_LD*4, LF_LD=68, P_DF=P_LF+64*LF_LD*4, DF_LD=20, P_GC=P_DF+4*16*DF_LD*4, P_EG=P_GC+256, P_EKD=P_EG+256, P_BETA=P_EKD+256, P_END=P_BETA+256;
static_assert(P_END<=131072,"prep LDS");

__device__ __forceinline__ void prep_chunk(int c,const bf16_t*QKVD,const float*conv_w,const float*BETA,const float*GDEC,unsigned char*rec,float*GLB,unsigned*flags,LAS unsigned char*lds,int pdbg=0){
  const int tid=threadIdx.x; int lane=tid&63; asm volatile("":"+v"(lane));
  const int wid=__builtin_amdgcn_readfirstlane(tid>>6);
  const int bh=c>>7,n=c&127,b=bh>>2,h=bh&3,s0=n*CH; const size_t tok0=(size_t)b*SEQ+s0;
  LAS float*GC=(LAS float*)(lds+P_GC); LAS float*EG=(LAS float*)(lds+P_EG); LAS float*EKD=(LAS float*)(lds+P_EKD); LAS float*BT=(LAS float*)(lds+P_BETA);
  LAS float*XT=(LAS float*)(lds+P_XT); LAS float*LF=(LAS float*)(lds+P_LF); LAS float*DF=(LAS float*)(lds+P_DF);
  float g_l=GDEC[(size_t)bh*SEQ+s0+lane]; const float bt_l=BETA[(size_t)bh*SEQ+s0+lane];
  #pragma unroll
  for(int o=1;o<64;o<<=1){ const float t=__shfl_up(g_l,o); if(lane>=o)g_l+=t; }
  const float eg_l=__expf(g_l);
  if(wid==0){
    const float gl=__shfl(g_l,63);
    GC[lane]=g_l; EG[lane]=eg_l; EKD[lane]=__expf(gl-g_l); BT[lane]=bt_l;
    if(lane==63)__hip_atomic_store(GLB+c,eg_l,__ATOMIC_RELAXED,__HIP_MEMORY_SCOPE_AGENT);
  }
  {
    float cw[3][4][2];
    #pragma unroll
    for(int p=0;p<3;++p)
      #pragma unroll
      for(int j=0;j<4;++j){ const float2 w2=*(const float2*)(conv_w+j*DCONV+p*512+h*128+2*lane); cw[p][j][0]=w2.x; cw[p][j][1]=w2.y; }
    unsigned xr[3][11];
    #pragma unroll
    for(int rr=0;rr<11;++rr){ const int sp=s0+8*wid-3+rr;
      #pragma unroll
      for(int p=0;p<3;++p) xr[p][rr]=(sp>=0)?*(const unsigned*)(QKVD+(tok0+8*wid-3+rr)*DCONV+p*512+h*128+2*lane):0u; }
    #pragma unroll
    for(int i=0;i<8;++i){
      const int pos=8*wid+i;
      float v[3][2];
      #pragma unroll
      for(int p=0;p<3;++p){ float a0=0.f,a1=0.f;
        #pragma unroll
        for(int j=0;j<4;++j){ a0+=cw[p][j][0]*bflo(xr[p][i+j]); a1+=cw[p][j][1]*bfhi(xr[p][i+j]); }
        v[p][0]=a0*__builtin_amdgcn_rcpf(1.0f+__expf(-a0)); v[p][1]=a1*__builtin_amdgcn_rcpf(1.0f+__expf(-a1)); }
      const float sq=wave_sum(v[0][0]*v[0][0]+v[0][1]*v[0][1]), sk=wave_sum(v[1][0]*v[1][0]+v[1][1]*v[1][1]);
      const float rq=(1.0f/sqrtf(sq+EPS))*0.08838834764831845f, rk=1.0f/sqrtf(sk+EPS);
      const float q0=v[0][0]*rq,q1=v[0][1]*rq,k0=v[1][0]*rk,k1=v[1][1]*rk;
      const int ch=2*lane; const int off=((ch>>3)*64+pos)*16+(ch&7)*2;
      *(LAS unsigned*)(lds+P_QI+off)=cvtpk(q0,q1);
      *(LAS unsigned*)(lds+P_KI+off)=cvtpk(k0,k1);
      const float bt=__shfl(bt_l,pos), be=bt*__shfl(eg_l,pos);
      XT[(ch)*XT_LD+pos]=v[2][0]*bt; XT[(ch+1)*XT_LD+pos]=v[2][1]*bt;
      XT[(128+ch)*XT_LD+pos]=k0*be; XT[(128+ch+1)*XT_LD+pos]=k1*be;
    }
  }
  CBAR_LDS();
  {
    const int r32=lane&31,hi=lane>>5;
    if(wid<6){
      const int kind=wid/3, w3=wid%3;
      const int ta=(kind==0)?(w3==0?0:1):(w3==2?1:0);
      const int tb=(kind==0)?(w3==2?1:0):(w3==0?0:1);
      const LAS unsigned char*Ab=lds+P_KI+(32*ta+r32)*16+hi*1024;
      const LAS unsigned char*Bb=lds+(kind==0?P_KI:P_QI)+(32*tb+r32)*16+hi*1024;
      f32x16 acc=f32x16{};
      #pragma unroll
      for(int ks=0;ks<8;++ks){ const bf16x8 a=*(const LAS bf16x8*)(Ab+ks*2048), bb=*(const LAS bf16x8*)(Bb+ks*2048); acc=DN_MFMA32(a,bb,acc); }
      if(kind==0){
        const int j=32*tb+r32; const float gj=GC[j];
        #pragma unroll
        for(int r=0;r<16;++r){ const int i=32*ta+crow(r,0)+4*hi; const float val=(j<i)?BT[i]*acc[r]*__expf(GC[i]-gj):0.f; LF[i*LF_LD+j]=val; }
      } else {
        const int i=32*tb+r32; const float gi=GC[i];
        float o_[16];
        #pragma unroll
        for(int r=0;r<16;++r){ const int j=32*ta+crow(r,0)+4*hi; o_[r]=(j<=i)?acc[r]*__expf(gi-GC[j]):0.f; }
        #pragma unroll
        for(int s=0;s<2;++s){ u32x4 w; w.x=cvtpk(o_[8*s],o_[8*s+1]); w.y=cvtpk(o_[8*s+2],o_[8*s+3]); w.z=cvtpk(o_[8*s+4],o_[8*s+5]); w.w=cvtpk(o_[8*s+6],o_[8*s+7]);
          st16_wt(rec+REC_AI+((tb*4+2*ta+s)*64+lane)*16,w); }
      }
    }
  }
  CBAR_LDS();
  if(pdbg&2){} else
  if(wid==0){
    const int bb=lane>>4,j=lane&15; float t[16];
    const LAS float*Lb=LF+(16*bb)*LF_LD+16*bb;
    f32x4 rw[16][4];
    #pragma unroll
    for(int i=1;i<16;++i)
      #pragma unroll
      for(int q=0;q<(i+3)/4;++q) rw[i][q]=*(const LAS f32x4*)(Lb+i*LF_LD+4*q);
    #pragma unroll
    for(int i=0;i<16;++i){ float s=(i==j)?1.0f:0.0f;
      #pragma unroll
      for(int m=0;m<i;++m) s-=rw[i][m>>2][m&3]*t[m];
      t[i]=s; DF[(bb*16+i)*DF_LD+j]=s; }
  } else {
    const int r32=lane&31,hi=lane>>5;
    for(int f=wid-1;f<32;f+=7){
      if(f<16){
        const int i2=f>>3,ks=f&7,pos=32*i2+r32; const float e=EG[pos];
        const u32x2v lo=*(const LAS u32x2v*)(lds+P_QI+((2*ks)*64+pos)*16+8*hi), hi2=*(const LAS u32x2v*)(lds+P_QI+((2*ks+1)*64+pos)*16+8*hi);
        u32x4 w; w.x=cvtpk(bflo(lo.x)*e,bfhi(lo.x)*e); w.y=cvtpk(bflo(lo.y)*e,bfhi(lo.y)*e); w.z=cvtpk(bflo(hi2.x)*e,bfhi(hi2.x)*e); w.w=cvtpk(bflo(hi2.y)*e,bfhi(hi2.y)*e);
        st16_wt(rec+REC_QD+(f*64+lane)*16,w);
      } else {
        const int f2=f-16,t=f2>>2,ks=f2&3,dk=32*t+r32; const LAS unsigned short*kp=(const LAS unsigned short*)(lds+P_KI+(dk>>3)*1024+(dk&7)*2);
        const f32x4 e0=*(const LAS f32x4*)(EKD+16*ks+4*hi), e1=*(const LAS f32x4*)(EKD+16*ks+8+4*hi);
        float x[8];
        #pragma unroll
        for(int j=0;j<8;++j){ const int pos=16*ks+8*(j>>2)+4*hi+(j&3); x[j]=__uint_as_float(((unsigned)kp[pos*8])<<16)*((j<4)?e0[j&3]:e1[j&3]); }
        u32x4 w; w.x=cvtpk(x[0],x[1]); w.y=cvtpk(x[2],x[3]); w.z=cvtpk(x[4],x[5]); w.w=cvtpk(x[6],x[7]);
        st16_wt(rec+REC_KT+(f2*64+lane)*16,w);
      }
    }
  }
  CBAR_LDS();
  if(!(pdbg&1))
  {
    const int cl=lane&15,g=lane>>4;
    #define PK4(v) cvtpk((v)[0],(v)[1]),cvtpk((v)[2],(v)[3])
    #define FRAG(a_,b_) __builtin_bit_cast(bf16x8,(u32x4){PK4(a_),PK4(b_)})
    #define DN_MFMA16(a,b,c) __builtin_amdgcn_mfma_f32_16x16x32_bf16((a),(b),(c),0,0,0)
    const f32x4 z4=(f32x4){0.f,0.f,0.f,0.f};
    #pragma unroll 1
    for(int cc=0;cc<2;++cc){
      const int ct=2*wid+cc, col=16*ct+cl;
      f32x4 Y[4];
      #pragma unroll
      for(int bb=0;bb<4;++bb){
        f32x4 acc=*(const LAS f32x4*)(XT+col*XT_LD+16*bb+4*g);
        const LAS float*Lr=LF+(16*bb+cl)*LF_LD+4*g;
        if(bb==1){ const f32x4 l0=-*(const LAS f32x4*)(Lr); acc=DN_MFMA16(FRAG(l0,z4),FRAG(Y[0],z4),acc); }
        if(bb==2){ const f32x4 l0=-*(const LAS f32x4*)(Lr), l1=-*(const LAS f32x4*)(Lr+16); acc=DN_MFMA16(FRAG(l0,l1),FRAG(Y[0],Y[1]),acc); }
        if(bb==3){ const f32x4 l0=-*(const LAS f32x4*)(Lr), l1=-*(const LAS f32x4*)(Lr+16), l2=-*(const LAS f32x4*)(Lr+32);
          acc=DN_MFMA16(FRAG(l0,l1),FRAG(Y[0],Y[1]),acc); acc=DN_MFMA16(FRAG(l2,z4),FRAG(Y[2],z4),acc); }
        const f32x4 Da=*(const LAS f32x4*)(DF+(bb*16+cl)*DF_LD+4*g);
        Y[bb]=DN_MFMA16(FRAG(Da,z4),FRAG(acc,z4),z4);
      }
      if(ct<8){
        const int dv=col,c4=dv>>5,r32=dv&31;
        #pragma unroll
        for(int bb=0;bb<4;++bb){ const int i2=bb>>1,rh=bb&1,hi2=g&1;
          st8_wt(rec+REC_U+((((c4*2+i2)*2+rh)*64+hi2*32+r32)*8+4*(g>>1))*2,cvtpk(Y[bb][0],Y[bb][1]),cvtpk(Y[bb][2],Y[bb][3])); }
      } else {
        const int kt=ct-8;
        f32x4 sel; sel[0]=(cl==4*g)?-1.f:0.f; sel[1]=(cl==4*g+1)?-1.f:0.f; sel[2]=(cl==4*g+2)?-1.f:0.f; sel[3]=(cl==4*g+3)?-1.f:0.f;
        const bf16x8 selb=FRAG(sel,z4);
        #pragma unroll
        for(int bb=0;bb<4;++bb){
          const f32x4 zt=DN_MFMA16(FRAG(Y[bb],z4),selb,z4);
          const int pos=16*bb+cl,i2=pos>>5,r32=pos&31,hi2=g&1;
          st8_wt(rec+REC_NW+(((i2*8+kt)*64+hi2*32+r32)*8+4*(g>>1))*2,cvtpk(zt[0],zt[1]),cvtpk(zt[2],zt[3])); }
      }
    }
    #undef PK4
    #undef FRAG
    #undef DN_MFMA16
  }
  CBAR_LDS();
}

__device__ __forceinline__ void glds16(const void*gsrc,unsigned lds_dst){unsigned keep;
  asm volatile("s_mov_b32 %0, m0\n\ts_mov_b32 m0, %2\n\ts_nop 0\n\tglobal_load_lds_dwordx4 %1, off\n\ts_mov_b32 m0, %0":"=&s"(keep):"v"(gsrc),"s"(lds_dst):"memory");}
__device__ __forceinline__ void glds4(const void*gsrc,unsigned lds_dst){unsigned keep;
  asm volatile("s_mov_b32 %0, m0\n\ts_mov_b32 m0, %2\n\ts_nop 0\n\tglobal_load_lds_dword %1, off\n\ts_mov_b32 m0, %0":"=&s"(keep):"v"(gsrc),"s"(lds_dst):"memory");}
__device__ __forceinline__ bf16x8 pack8(const f32x16&x,int s){ u32x4 p; p.x=cvtpk(x[8*s],x[8*s+1]); p.y=cvtpk(x[8*s+2],x[8*s+3]); p.z=cvtpk(x[8*s+4],x[8*s+5]); p.w=cvtpk(x[8*s+6],x[8*s+7]); return __builtin_bit_cast(bf16x8,p); }

__device__ __forceinline__ void scan_wait_batch(const unsigned*rdy,int bh,int m0){
  if((threadIdx.x>>6)==4){
    const int l_=threadIdx.x&63; unsigned sp=0u;
    for(;;){ unsigned ok=1u; if(l_<16)ok=__hip_atomic_load(rdy+bh*128+m0+l_,__ATOMIC_RELAXED,__HIP_MEMORY_SCOPE_AGENT);
      if(__all(ok!=0u))break; __builtin_amdgcn_s_sleep(8); if(++sp>(1u<<17))break; }
    __builtin_amdgcn_fence(__ATOMIC_ACQUIRE,"agent"); asm volatile("s_waitcnt vmcnt(0)":::"memory");
  }
  CBAR_LDS();
}
#define DN_M(a,b,c) ((DBG&1)?(c):DN_MFMA32(a,b,c))
constexpr int SC_RING=2*REC_U, SC_STG=SC_RING, STG_LD=80, STG_BYTES=4*64*STG_LD, SC_SSQ=SC_STG+2*STG_BYTES, SC_TCH=SC_SSQ+2*4*64*4, SC_END=SC_TCH+512;
static_assert(SC_END<=160*1024-1024,"scan LDS");
template<int DBG> __device__ __forceinline__ void scan_head(int bh,const unsigned char*REC,const float*GLB,const float*dnw,const bf16_t*ZD,bf16_t*Y,const unsigned*rdy,char*shm,int flags){
  const int tid=threadIdx.x; int lane=tid&63; asm volatile("":"+v"(lane));
  const int wid=__builtin_amdgcn_readfirstlane(tid>>6);
  const int b=bh>>2,h=bh&3;
  const unsigned lds0=(unsigned)(uintptr_t)shm;
  const LAS unsigned char*ldsb=(const LAS unsigned char*)shm;
  const unsigned char*recb=REC+(size_t)bh*128*REC_BYTES;
  const size_t tokb=(size_t)b*SEQ;
  scan_wait_batch(rdy,bh,0);
  if(wid>=4&&wid<6){
    const int lw=wid-4;
    #define DN_FILL(nn,bufoff) do{ const unsigned char*src_=recb+(size_t)(nn)*REC_BYTES+lane*16; \
      _Pragma("unroll") for(int p=0;p<28;++p) glds16(src_+(lw+2*p)*1024,(unsigned)__builtin_amdgcn_readfirstlane(lds0+(bufoff)+(lw+2*p)*1024)); }while(0)
    if(!(flags&4)){ DN_FILL(0,0); }
    DN_BAR();
    for(int n=0;n<=128;++n){
      if(n<128){
        if(((n+1)&15)==0&&n+1<128)scan_wait_batch(rdy,bh,n+1);
        if(n+1<128&&!(flags&4)){ DN_FILL(n+1,((n+1)&1)*REC_U); }
      }
      DN_BAR();
    }
    #undef DN_FILL
  } else if(wid>=6){
    const int ow=wid-6;
    const int rrow=lane>>2,rch=lane&3;
    const bf16_t*zdp=ZD+(tokb+rrow)*AW+h*128+64*ow+8*rch; bf16_t*yp=Y+(tokb+rrow)*DM+512+h*128+64*ow+8*rch;
    f32x4 wv[2][2];
    #pragma unroll
    for(int c=0;c<2;++c){ wv[c][0]=*(const f32x4*)(dnw+64*ow+32*c+8*rch); wv[c][1]=*(const f32x4*)(dnw+64*ow+32*c+8*rch+4); }
    u32x4 zn[2][4],zq[2][4];
    #pragma unroll
    for(int c=0;c<2;++c)
      #pragma unroll
      for(int q=0;q<4;++q) zn[c][q]=*(const u32x4*)(zdp+(size_t)(16*q)*AW+32*c);
    asm volatile("s_waitcnt lgkmcnt(0)\n\ts_barrier":::"memory");
    for(int n=0;n<=128;++n){
      if(n<128&&((n+1)&15)==0&&n+1<128)scan_wait_batch(rdy,bh,n+1);
      if(n>0&&n<128&&!(DBG&2)){
        #pragma unroll
        for(int c=0;c<2;++c)
          #pragma unroll
          for(int q=0;q<4;++q) zq[c][q]=*(const u32x4*)(zdp+(size_t)(n*CH+16*q)*AW+32*c);
      }
      if(n>0&&!(DBG&2)){
        const LAS float*sq=(const LAS float*)(ldsb+SC_SSQ)+((n-1)&1)*256;
        #pragma unroll
        for(int it=0;it<4;++it){
          const int pos=16*it+rrow;
          const float tot=(sq[pos]+sq[64+pos])+(sq[128+pos]+sq[192+pos]);
          const float rs=1.0f/sqrtf(tot*(1.0f/128.0f)+EPS);
          #pragma unroll
          for(int c=0;c<2;++c){
            const LAS unsigned char*stg=ldsb+SC_STG+((n-1)&1)*STG_BYTES+(2*ow+c)*64*STG_LD;
            const u32x4 v=*(const LAS u32x4*)(stg+pos*STG_LD+rch*16); const u32x4 z=zn[c][it]; const f32x4 w0=wv[c][0],w1=wv[c][1]; u32x4 w;
            w[0]=cvtpk(bflo(v[0])*rs*w0[0]*bflo(z[0]),bfhi(v[0])*rs*w0[1]*bfhi(z[0])); w[1]=cvtpk(bflo(v[1])*rs*w0[2]*bflo(z[1]),bfhi(v[1])*rs*w0[3]*bfhi(z[1]));
            w[2]=cvtpk(bflo(v[2])*rs*w1[0]*bflo(z[2]),bfhi(v[2])*rs*w1[1]*bfhi(z[2])); w[3]=cvtpk(bflo(v[3])*rs*w1[2]*bflo(z[3]),bfhi(v[3])*rs*w1[3]*bfhi(z[3]));
            *(u32x4*)(yp+(size_t)((n-1)*CH+16*it)*DM+32*c)=w;
          }
        }
        #pragma unroll
        for(int c=0;c<2;++c)
          #pragma unroll
          for(int q=0;q<4;++q) zn[c][q]=zq[c][q];
      }
      asm volatile("s_waitcnt lgkmcnt(0)\n\ts_barrier":::"memory");
    }
  } else if(flags&8){
    asm volatile("s_waitcnt lgkmcnt(0)\n\ts_barrier":::"memory");
    for(int n=0;n<128;++n){ if(((n+1)&15)==0&&n+1<128)scan_wait_batch(rdy,bh,n+1); asm volatile("s_waitcnt lgkmcnt(0)\n\ts_barrier":::"memory"); }
    asm volatile("s_waitcnt lgkmcnt(0)\n\ts_barrier":::"memory");
  } else {
    const int c4=wid,r32=lane&31,hi=lane>>5;
    f32x16 S[4];
    #pragma unroll
    for(int t=0;t<4;++t)S[t]=f32x16{};
    const unsigned char*up=recb+REC_U+(size_t)(c4*4)*1024+lane*16;
    u32x4 un[4];
    #pragma unroll
    for(int q=0;q<4;++q) un[q]=*(const u32x4*)(up+q*1024);
    float gl_next=__hip_atomic_load(GLB+bh*128,__ATOMIC_RELAXED,__HIP_MEMORY_SCOPE_AGENT);
    asm volatile("s_waitcnt lgkmcnt(0)\n\ts_barrier":::"memory");
    for(int n=0;n<128;++n){
      if(((n+1)&15)==0&&n+1<128)scan_wait_batch(rdy,bh,n+1);
      const LAS unsigned char*rb=ldsb+(n&1)*REC_U+lane*16;
      const float gl=gl_next; gl_next=__hip_atomic_load(GLB+bh*128+((n+1)&127),__ATOMIC_RELAXED,__HIP_MEMORY_SCOPE_AGENT);
      f32x16 av[2],ao[2];
      #pragma unroll
      for(int i2=0;i2<2;++i2)
        #pragma unroll
        for(int rh=0;rh<2;++rh){ const u32x4 u=un[i2*2+rh];
          #pragma unroll
          for(int q=0;q<4;++q){ av[i2][8*rh+2*q]=bflo(u[q]); av[i2][8*rh+2*q+1]=bfhi(u[q]); } }
      { const unsigned char*upn=up+(size_t)((n+1)&127)*REC_BYTES;
        #pragma unroll
        for(int q=0;q<4;++q) un[q]=*(const u32x4*)(upn+q*1024); }
      ao[0]=f32x16{}; ao[1]=f32x16{};
      #define FR(off) (*(const LAS bf16x8*)(rb+(off)))
      #define SB0() __builtin_amdgcn_sched_barrier(0)
      bf16x8 fa[4],fb[4],Sb[8];
      #pragma unroll
      for(int ks=0;ks<8;++ks)Sb[ks]=pack8(S[ks>>1],ks&1);
      #define LDN(B,k0) do{ B[0]=FR(REC_NW+(k0)*1024); B[1]=FR(REC_NW+(8+(k0))*1024); B[2]=FR(REC_NW+((k0)+1)*1024); B[3]=FR(REC_NW+(9+(k0))*1024); }while(0)
      #define MMN(B,k0) do{ av[0]=DN_M(B[0],Sb[k0],av[0]); av[1]=DN_M(B[1],Sb[k0],av[1]); av[0]=DN_M(B[2],Sb[(k0)+1],av[0]); av[1]=DN_M(B[3],Sb[(k0)+1],av[1]); }while(0)
      #define LDQ(B,k0) do{ B[0]=FR(REC_QD+(k0)*1024); B[1]=FR(REC_QD+(8+(k0))*1024); B[2]=FR(REC_QD+((k0)+1)*1024); B[3]=FR(REC_QD+(9+(k0))*1024); }while(0)
      #define MMQ(B,k0) do{ ao[0]=DN_M(Sb[k0],B[0],ao[0]); ao[1]=DN_M(Sb[k0],B[1],ao[1]); ao[0]=DN_M(Sb[(k0)+1],B[2],ao[0]); ao[1]=DN_M(Sb[(k0)+1],B[3],ao[1]); }while(0)
      LDN(fa,0); SB0();
      LDN(fb,2); SB0(); MMN(fa,0); SB0();
      LDN(fa,4); SB0(); MMN(fb,2); SB0();
      LDN(fb,6); SB0(); MMN(fa,4); SB0();
      LDQ(fa,0); SB0(); MMN(fb,6); SB0();
      LDQ(fb,2); SB0(); MMQ(fa,0); SB0();
      #pragma unroll
      for(int t=0;t<4;++t)S[t]=S[t]*gl;
      LDQ(fa,4); SB0(); MMQ(fb,2); SB0();
      bf16x8 vb[2][2];
      #pragma unroll
      for(int i2=0;i2<2;++i2){ vb[i2][0]=pack8(av[i2],0); vb[i2][1]=pack8(av[i2],1); }
      LDQ(fb,6); SB0(); MMQ(fa,4); SB0();
      fa[0]=FR(REC_AI+0*1024); fa[1]=FR(REC_AI+1*1024); fa[2]=FR(REC_AI+4*1024); fa[3]=FR(REC_AI+5*1024); SB0();
      MMQ(fb,6); SB0();
      fb[0]=FR(REC_AI+6*1024); fb[1]=FR(REC_AI+7*1024); fb[2]=FR(REC_KT+0*1024); fb[3]=FR(REC_KT+1*1024); SB0();
      ao[0]=DN_M(vb[0][0],fa[0],ao[0]); ao[0]=DN_M(vb[0][1],fa[1],ao[0]); ao[1]=DN_M(vb[0][0],fa[2],ao[1]); ao[1]=DN_M(vb[0][1],fa[3],ao[1]); SB0();
      fa[0]=FR(REC_KT+2*1024); fa[1]=FR(REC_KT+3*1024); fa[2]=FR(REC_KT+4*1024); fa[3]=FR(REC_KT+5*1024); SB0();
      ao[1]=DN_M(vb[1][0],fb[0],ao[1]); ao[1]=DN_M(vb[1][1],fb[1],ao[1]); S[0]=DN_M(fb[2],vb[0][0],S[0]); S[0]=DN_M(fb[3],vb[0][1],S[0]); SB0();
      fb[0]=FR(REC_KT+6*1024); fb[1]=FR(REC_KT+7*1024); fb[2]=FR(REC_KT+8*1024); fb[3]=FR(REC_KT+9*1024); SB0();
      S[0]=DN_M(fa[0],vb[1][0],S[0]); S[0]=DN_M(fa[1],vb[1][1],S[0]); S[1]=DN_M(fa[2],vb[0][0],S[1]); S[1]=DN_M(fa[3],vb[0][1],S[1]); SB0();
      fa[0]=FR(REC_KT+10*1024); fa[1]=FR(REC_KT+11*1024); fa[2]=FR(REC_KT+12*1024); fa[3]=FR(REC_KT+13*1024); SB0();
      S[1]=DN_M(fb[0],vb[1][0],S[1]); S[1]=DN_M(fb[1],vb[1][1],S[1]); S[2]=DN_M(fb[2],vb[0][0],S[2]); S[2]=DN_M(fb[3],vb[0][1],S[2]); SB0();
      fb[0]=FR(REC_KT+14*1024); fb[1]=FR(REC_KT+15*1024); SB0();
      S[2]=DN_M(fa[0],vb[1][0],S[2]); S[2]=DN_M(fa[1],vb[1][1],S[2]); S[3]=DN_M(fa[2],vb[0][0],S[3]); S[3]=DN_M(fa[3],vb[0][1],S[3]); SB0();
      S[3]=DN_M(fb[0],vb[1][0],S[3]); S[3]=DN_M(fb[1],vb[1][1],S[3]);
      #undef FR
      #undef LDN
      #undef MMN
      #undef LDQ
      #undef MMQ
      #undef SB0
      { LAS unsigned char*stg=(LAS unsigned char*)(ldsb+SC_STG)+(n&1)*STG_BYTES+c4*64*STG_LD; LAS float*ssq=(LAS float*)(ldsb+SC_SSQ)+(n&1)*256+c4*64;
        #pragma unroll
        for(int i2=0;i2<2;++i2){ float p=0.f; const int pos=32*i2+r32;
          #pragma unroll
          for(int r=0;r<16;++r)p+=ao[i2][r]*ao[i2][r];
          p+=__shfl_xor(p,32);
          if(hi==0)ssq[pos]=p;
          #pragma unroll
          for(int rq=0;rq<4;++rq) *(LAS u32x2v*)(stg+pos*STG_LD+(8*rq+4*hi)*2)=(u32x2v){cvtpk(ao[i2][4*rq],ao[i2][4*rq+1]),cvtpk(ao[i2][4*rq+2],ao[i2][4*rq+3])}; } }
      asm volatile("s_waitcnt lgkmcnt(0)\n\ts_barrier":::"memory");
    }
    asm volatile("s_waitcnt lgkmcnt(0)\n\ts_barrier":::"memory");
  }
}
#undef DN_MFMA32
#undef DN_MFMA4
#undef DN_BAR
}

namespace moba {
using bf16=unsigned short;
using s16x4=__attribute__((ext_vector_type(4)))short;
using f32x16=__attribute__((ext_vector_type(16)))float;
constexpr int D=64,NW=8,QBLK=32,QB=QBLK*NW,KVBLK=64,PITCH=64;
__device__ __forceinline__ int crow(int r,int hi){return (r&3)+8*(r>>2)+4*hi;}
#define SBAR() __builtin_amdgcn_sched_barrier(0)
constexpr int NSLOT=3, SLOTB=8192;
constexpr int NKT=4, LDS_K=0, LDS_V=NKT*SLOTB, LDS_WS=2*NKT*SLOTB, WSW=1024, LDS_OST=LDS_WS+NW*WSW, LDS_TB=LDS_OST+NW*4096, LDS_UNIT=LDS_TB+512, LDS_PFX=LDS_UNIT+64, LDS_BYTES=LDS_PFX+8*132*4;
struct AB { int dbg; const bf16*QA; const bf16*KA; const bf16*VA; const float*KMEAN; const float*rel_bias; const bf16*ZA; bf16*Y; unsigned*SEL; unsigned short*LIST; unsigned*CNT; bf16*OP; float*LP; unsigned*qctl; };
constexpr int LISTCAP=8192, PREVCAP=256;
constexpr float NEGBIG=-1.0e30f;
__device__ __forceinline__ void glds16(const void*gsrc,unsigned lds_dst){unsigned keep;
  asm volatile("s_mov_b32 %0, m0\n\ts_mov_b32 m0, %2\n\ts_nop 0\n\tglobal_load_lds_dwordx4 %1, off\n\ts_mov_b32 m0, %0":"=&s"(keep):"v"(gsrc),"s"(lds_dst):"memory");}
typedef float f32x2_t __attribute__((ext_vector_type(2))); typedef __bf16 bf16x2_t __attribute__((ext_vector_type(2)));
__device__ __forceinline__ unsigned cvtpk_s(float lo,float hi){f32x2_t v={lo,hi};bf16x2_t b=__builtin_convertvector(v,bf16x2_t);return __builtin_bit_cast(unsigned,b);}
#define WAIT_BAR(N) asm volatile("s_waitcnt vmcnt(" #N ") lgkmcnt(0)\n\ts_barrier":::"memory")
__device__ __forceinline__ void qkt(f32x16&p0,f32x16&p1,const char*Kslot,const bf16x8*qr,int r32,int hi){
  const f32x16 negm=f32x16{};
  const char*kb=Kslot+hi*1024+r32*16;
  #pragma unroll
  for(int d0=0;d0<4;++d0){
    const bf16x8 b0=*reinterpret_cast<const bf16x8*>(kb+d0*2048);
    const bf16x8 b1=*reinterpret_cast<const bf16x8*>(kb+d0*2048+512);
    if(d0==0){p0=__builtin_amdgcn_mfma_f32_32x32x16_bf16(b0,qr[0],negm,0,0,0);p1=__builtin_amdgcn_mfma_f32_32x32x16_bf16(b1,qr[0],negm,0,0,0);}
    else{p0=__builtin_amdgcn_mfma_f32_32x32x16_bf16(b0,qr[d0],p0,0,0,0);p1=__builtin_amdgcn_mfma_f32_32x32x16_bf16(b1,qr[d0],p1,0,0,0);}}
}
typedef __attribute__((address_space(3))) const char* lds_cptr;
typedef short v4i16_t __attribute__((ext_vector_type(4)));
__device__ __forceinline__ void kload8(bf16x8*kf,lds_cptr kp){
  kf[0]=*(const __attribute__((address_space(3))) bf16x8*)(kp);      kf[1]=*(const __attribute__((address_space(3))) bf16x8*)(kp+512);
  kf[2]=*(const __attribute__((address_space(3))) bf16x8*)(kp+2048); kf[3]=*(const __attribute__((address_space(3))) bf16x8*)(kp+2560);
  kf[4]=*(const __attribute__((address_space(3))) bf16x8*)(kp+4096); kf[5]=*(const __attribute__((address_space(3))) bf16x8*)(kp+4608);
  kf[6]=*(const __attribute__((address_space(3))) bf16x8*)(kp+6144); kf[7]=*(const __attribute__((address_space(3))) bf16x8*)(kp+6656);
}
__device__ __forceinline__ void kload2(bf16x8*kf,lds_cptr kp,int j){ kf[2*j]=*(const __attribute__((address_space(3))) bf16x8*)(kp+j*2048); kf[2*j+1]=*(const __attribute__((address_space(3))) bf16x8*)(kp+j*2048+512); }
__device__ __forceinline__ s16x4 vtr(lds_cptr p){ return __builtin_bit_cast(s16x4,__builtin_amdgcn_ds_read_tr16_b64_v4i16((__attribute__((address_space(3))) v4i16_t*)p)); }
__device__ __forceinline__ void pv(f32x16*o,int vb,bf16x8 pa0,bf16x8 pa1,bf16x8 pa2,bf16x8 pa3){
  #pragma unroll
  for(int d0=0;d0<2;++d0){s16x4 lo[4],hi[4];
    #pragma unroll
    for(int ks=0;ks<4;++ks){
      asm volatile("ds_read_b64_tr_b16 %0,%1 offset:%c2":"=&v"(lo[ks]):"v"(vb),"i"(d0*4096+ks*1024):"memory");
      asm volatile("ds_read_b64_tr_b16 %0,%1 offset:%c2":"=&v"(hi[ks]):"v"(vb),"i"(d0*4096+ks*1024+512):"memory");}
    asm volatile("s_waitcnt lgkmcnt(0)":::"memory");SBAR();
    #define PK(k) (bf16x8){lo[k][0],lo[k][1],lo[k][2],lo[k][3],hi[k][0],hi[k][1],hi[k][2],hi[k][3]}
    o[d0]=__builtin_amdgcn_mfma_f32_32x32x16_bf16(pa0,PK(0),o[d0],0,0,0);
    o[d0]=__builtin_amdgcn_mfma_f32_32x32x16_bf16(pa1,PK(1),o[d0],0,0,0);
    o[d0]=__builtin_amdgcn_mfma_f32_32x32x16_bf16(pa2,PK(2),o[d0],0,0,0);
    o[d0]=__builtin_amdgcn_mfma_f32_32x32x16_bf16(pa3,PK(3),o[d0],0,0,0);
    #undef PK
  }
}
__device__ __forceinline__ void bandfix(f32x16&p0,f32x16&p1,int t,int qpos,int hi,const float*tb){
  const int kb=64*t+4*hi;
  #pragma unroll
  for(int r=0;r<16;++r){ const int kv=kb+(r&3)+8*(r>>2); const int d0=qpos-kv, d1=d0-32;
    const float b0=tb[d0<0?0:(d0>127?127:d0)], b1=tb[d1<0?0:(d1>127?127:d1)];
    p0[r]=d0<0?NEGBIG:p0[r]+b0; p1[r]=d1<0?NEGBIG:p1[r]+b1; if((r&3)==3)SBAR(); }
}


__device__ __forceinline__ unsigned gate_select(const float*KMEAN,int bh,int qb,const bf16x8*qr,int r32,int hi){
  f32x16 gt=f32x16{};
  const float*km=KMEAN+((size_t)bh*32+r32)*64+hi*8;
  #pragma unroll
  for(int d0=0;d0<4;++d0){ const f32x4 ka=*(const f32x4*)(km+d0*16), kb_=*(const f32x4*)(km+d0*16+4);
    u32x4 w; w.x=cvtpk_s(ka[0],ka[1]); w.y=cvtpk_s(ka[2],ka[3]); w.z=cvtpk_s(kb_[0],kb_[1]); w.w=cvtpk_s(kb_[2],kb_[3]);
    gt=__builtin_amdgcn_mfma_f32_32x32x16_bf16(__builtin_bit_cast(bf16x8,w),qr[d0],gt,0,0,0); }
  float a1=-INFINITY,a2=-INFINITY,a3=-INFINITY;
  const int qbh=qb-4*hi;
  #pragma unroll
  for(int r=0;r<16;++r){ float x=gt[r]; if(crow(r,0)>=qbh)x=-INFINITY; gt[r]=x;
    const float t_=fminf(a1,x); a1=fmaxf(a1,x); const float u_=fminf(a2,t_); a2=fmaxf(a2,t_); a3=fmaxf(a3,u_); }
  const float b1=__shfl_xor(a1,32),b2=__shfl_xor(a2,32),b3=__shfl_xor(a3,32);
  const float th=fmaxf(fmaxf(a3,b3),fmaxf(fminf(a2,b1),fminf(a1,b2)));
  unsigned m_=0u;
  #pragma unroll
  for(int r=0;r<16;++r){ if(gt[r]>=th&&gt[r]>-INFINITY)m_|=1u<<crow(r,0); }
  m_<<=4*hi;
  return m_|(unsigned)__shfl_xor((int)m_,32);
}
__device__ __forceinline__ void route_item(int bh,int qb,const AB&A){
  const int tid=threadIdx.x; int lane=tid&63; asm volatile("":"+v"(lane));
  const int r32=lane&31,hi=lane>>5; const int wid=__builtin_amdgcn_readfirstlane(tid>>6);
  const int s=qb*QB+wid*QBLK+r32;
  const bf16*Qw=A.QA+((size_t)bh*SEQ+s)*PITCH;
  bf16x8 qr[4];
  #pragma unroll
  for(int d0=0;d0<4;++d0)qr[d0]=*reinterpret_cast<const bf16x8*>(&Qw[d0*16+hi*8]);
  const unsigned selmask=gate_select(A.KMEAN,bh,qb,qr,r32,hi);
  if(hi==0)__hip_atomic_store(A.SEL+(size_t)bh*SEQ+s,selmask,__ATOMIC_RELAXED,__HIP_MEMORY_SCOPE_AGENT);
  const unsigned rb=(qb>=1&&hi==0)?(selmask&((1u<<qb)-1u)):0u;
  if(qb>=1){
    unsigned mymask=0u;
    for(int j=0;j<qb;++j){ const unsigned bal=(unsigned)__ballot((rb>>j)&1u); if(lane==j)mymask=bal; }
    unsigned base=0u;
    if(mymask)base=__hip_atomic_fetch_add(A.CNT+((lane==qb-1)?1024:0)+bh*32+lane,(unsigned)__popc(mymask),__ATOMIC_RELAXED,__HIP_MEMORY_SCOPE_AGENT);
    unsigned rbt=rb;
    #pragma unroll
    for(int k=0;k<3;++k){
      const int jj=rbt?(__ffs((int)rbt)-1):0; const bool act=rbt!=0u; rbt&=rbt-1u;
      const unsigned mj=(unsigned)__shfl((int)mymask,jj), bj=(unsigned)__shfl((int)base,jj);
      if(act){ const unsigned pos=bj+(unsigned)__popc(mj&((1u<<r32)-1u)); const bool prev=(jj==qb-1);
        if(pos<(unsigned)(prev?PREVCAP:LISTCAP-PREVCAP)){ unsigned short*dst_=A.LIST+((size_t)bh*32+jj)*LISTCAP+(prev?LISTCAP-PREVCAP:0)+pos; const unsigned val_=(unsigned)(s|(k<<13));
          asm volatile("global_store_short %0, %1, off sc1"::"v"(dst_),"v"(val_):"memory"); } }
    }
  }
}
template<int KIND> __device__ __forceinline__ void attn_group(int bh,int j,unsigned gi,unsigned cnt,unsigned entry,const bf16x8(&qr)[4],const AB&A,char*shm){
  const int tid=threadIdx.x; int lane=tid&63; asm volatile("":"+v"(lane));
  const int r32=lane&31,hi=lane>>5; const int wid=__builtin_amdgcn_readfirstlane(tid>>6);
  const int b=bh>>3,h=bh&7;
  const unsigned lds0=(unsigned)(uintptr_t)shm;
  const float*tb=(const float*)(shm+LDS_TB);
  const int srow=(KIND<2)?(int)(entry&8191u):(256*j+32*(int)gi+r32);
  const int vb0=(int)(lds0+LDS_V)+((lane>>4)&1)*32+(lane&3)*8+(4*hi+((lane&15)>>2))*64;
  const char*Kbase=shm+LDS_K; bf16x8 kf[8];
  const lds_cptr shm3=(lds_cptr)shm; const lds_cptr kp0=shm3+LDS_K+hi*1024+r32*16; const lds_cptr vp0=shm3+LDS_V+((lane>>4)&1)*32+(lane&3)*8+(4*hi+((lane&15)>>2))*64;
  constexpr int NT=4;
  float l_reg=0.f;f32x16 o[2];o[0]=f32x16{};o[1]=f32x16{};
  const int qpos=srow;
  #define BANDFIX(P0,P1,t) do{ if(KIND==2||(KIND==1&&(t)>=2)){ bandfix(P0,P1,4*j+(t),qpos,hi,tb); } }while(0)
  f32x16 pA0,pA1,pB0,pB1;
  qkt(pA0,pA1,Kbase,qr,r32,hi);asm volatile("s_nop 15\n\ts_nop 7":"+v"(pA0),"+v"(pA1));BANDFIX(pA0,pA1,0);
  _Pragma("unroll") for(int r=0;r<16;++r)pA0[r]=__builtin_amdgcn_exp2f(pA0[r]);
  _Pragma("unroll") for(int r=0;r<16;++r)pA1[r]=__builtin_amdgcn_exp2f(pA1[r]);
  kload8(kf,kp0+SLOTB);
  s16x4 vlo[8],vhi[8]; u32x4 pw0,pw1,pw2,pw3;
  #define PKW(P,B) cvtpk_s(P[B],P[B+1])
  #define PAF(k) __builtin_bit_cast(bf16x8,pw##k)
  #define VFR(i) (bf16x8){vlo[i][0],vlo[i][1],vlo[i][2],vlo[i][3],vhi[i][0],vhi[i][1],vhi[i][2],vhi[i][3]}
  #define PIN(x) asm volatile("":"+v"(x))
  #define GAPA(MF,A0,A1,A2,A3,W0,W1,PW) do{ MF; sacc+=A0; sacc+=A1; sacc+=A2; sacc+=A3; PIN(sacc); W0; W1; PIN(PW); SBAR(); }while(0)
  #define EX(v) __builtin_amdgcn_exp2f(v)
  #define GAPB(MF,X,B) do{ MF; X[B]=EX(X[B]); X[B+1]=EX(X[B+1]); X[B+2]=EX(X[B+2]); X[B+3]=EX(X[B+3]); PIN(X); SBAR(); }while(0)
  #define VRD(i) do{ vlo[i]=vtr(vp_+(((i)>>2)*4096+((i)&3)*1024)); vhi[i]=vtr(vp_+(((i)>>2)*4096+((i)&3)*1024+512)); }while(0)
  #define KRD(G,jj) do{ if(G){ kload2(kf,kp0+((t_)+1)*SLOTB,jj); SBAR(); } }while(0)
  #define STEP(C0,C1,P0,P1,t,GL) do{ SBAR(); constexpr int t_=(t); \
    const lds_cptr vp_=vp0+(t_-1)*SLOTB; const f32x16 zc_=f32x16{}; \
    VRD(0); SBAR(); float sacc=(P0[0]+P0[1]); \
    GAPA(C0=__builtin_amdgcn_mfma_f32_32x32x16_bf16(kf[0],qr[0],zc_,0,0,0), P0[2],P0[3],P0[4],P0[5],     pw0[0]=PKW(P0,0), pw0[1]=PKW(P0,2), pw0); \
    VRD(4); SBAR(); GAPA(C1=__builtin_amdgcn_mfma_f32_32x32x16_bf16(kf[1],qr[0],zc_,0,0,0), P0[6],P0[7],P0[8],P0[9],     pw0[2]=PKW(P0,4), pw0[3]=PKW(P0,6), pw0); \
    VRD(1); SBAR(); GAPA(C0=__builtin_amdgcn_mfma_f32_32x32x16_bf16(kf[2],qr[1],C0,0,0,0),   P0[10],P0[11],P0[12],P0[13], pw1[0]=PKW(P0,8), pw1[1]=PKW(P0,10), pw1); \
    VRD(5); SBAR(); GAPA(C1=__builtin_amdgcn_mfma_f32_32x32x16_bf16(kf[3],qr[1],C1,0,0,0),   P0[14],P0[15],P1[0],P1[1],   pw1[2]=PKW(P0,12),pw1[3]=PKW(P0,14), pw1); \
    VRD(2); SBAR(); GAPA(C0=__builtin_amdgcn_mfma_f32_32x32x16_bf16(kf[4],qr[2],C0,0,0,0),   P1[2],P1[3],P1[4],P1[5],     pw2[0]=PKW(P1,0), pw2[1]=PKW(P1,2), pw2); \
    VRD(6); SBAR(); GAPA(C1=__builtin_amdgcn_mfma_f32_32x32x16_bf16(kf[5],qr[2],C1,0,0,0),   P1[6],P1[7],P1[8],P1[9],     pw2[2]=PKW(P1,4), pw2[3]=PKW(P1,6), pw2); \
    VRD(3); SBAR(); GAPA(C0=__builtin_amdgcn_mfma_f32_32x32x16_bf16(kf[6],qr[3],C0,0,0,0),   P1[10],P1[11],P1[12],P1[13], pw3[0]=PKW(P1,8), pw3[1]=PKW(P1,10), pw3); \
    VRD(7); SBAR(); GAPA(C1=__builtin_amdgcn_mfma_f32_32x32x16_bf16(kf[7],qr[3],C1,0,0,0),   P1[14],P1[15],0.f,0.f,       pw3[2]=PKW(P1,12),pw3[3]=PKW(P1,14), pw3); \
    l_reg+=sacc; \
    BANDFIX(C0,C1,t_); \
    SBAR(); \
    GAPB(o[0]=__builtin_amdgcn_mfma_f32_32x32x16_bf16(PAF(0),VFR(0),o[0],0,0,0), C0,0); \
    GAPB(o[1]=__builtin_amdgcn_mfma_f32_32x32x16_bf16(PAF(0),VFR(4),o[1],0,0,0), C0,4); \
    KRD(GL,0); GAPB(o[0]=__builtin_amdgcn_mfma_f32_32x32x16_bf16(PAF(1),VFR(1),o[0],0,0,0), C0,8); \
    KRD(GL,1); GAPB(o[1]=__builtin_amdgcn_mfma_f32_32x32x16_bf16(PAF(1),VFR(5),o[1],0,0,0), C0,12); \
    KRD(GL,2); GAPB(o[0]=__builtin_amdgcn_mfma_f32_32x32x16_bf16(PAF(2),VFR(2),o[0],0,0,0), C1,0); \
    KRD(GL,3); GAPB(o[1]=__builtin_amdgcn_mfma_f32_32x32x16_bf16(PAF(2),VFR(6),o[1],0,0,0), C1,4); \
    GAPB(o[0]=__builtin_amdgcn_mfma_f32_32x32x16_bf16(PAF(3),VFR(3),o[0],0,0,0), C1,8); \
    GAPB(o[1]=__builtin_amdgcn_mfma_f32_32x32x16_bf16(PAF(3),VFR(7),o[1],0,0,0), C1,12); \
    }while(0)
  STEP(pB0,pB1,pA0,pA1,1,true);
  STEP(pA0,pA1,pB0,pB1,2,true);
  STEP(pB0,pB1,pA0,pA1,3,false);
  { float sacc=pB0[0]+pB0[1]; _Pragma("unroll") for(int r=2;r<16;++r)sacc+=pB0[r]; _Pragma("unroll") for(int r=0;r<16;++r)sacc+=pB1[r]; l_reg+=sacc;
    pw0=(u32x4){PKW(pB0,0),PKW(pB0,2),PKW(pB0,4),PKW(pB0,6)};pw1=(u32x4){PKW(pB0,8),PKW(pB0,10),PKW(pB0,12),PKW(pB0,14)};pw2=(u32x4){PKW(pB1,0),PKW(pB1,2),PKW(pB1,4),PKW(pB1,6)};pw3=(u32x4){PKW(pB1,8),PKW(pB1,10),PKW(pB1,12),PKW(pB1,14)};
    SBAR(); pv(o,vb0+(NT-1)*SLOTB,PAF(0),PAF(1),PAF(2),PAF(3)); }
  #undef PKW
  #undef PAF
  #undef VFR
  #undef PIN
  #undef GAPA
  #undef GAPB
  #undef EX
  #undef VRD
  #undef KRD
  #undef STEP
  #undef BANDFIX
  l_reg+=__shfl_xor(l_reg,32);
  int lane2=threadIdx.x&63; asm volatile("":"+v"(lane2));
  const int r32e=lane2&31,hie=lane2>>5;
  float*wsr=(float*)(shm+LDS_WS)+wid*(WSW/4);
  if(KIND<2){
    if(hie==0){ wsr[r32e*8]=__builtin_amdgcn_rcpf(l_reg); wsr[r32e*8+1]=l_reg; ((unsigned*)wsr)[r32e*8+2]=entry; }
  } else {
    if(hie==0){
      const unsigned selmask=A.SEL[(size_t)bh*SEQ+srow];
      const unsigned rbits=(j>=1)?(selmask&((1u<<j)-1u)):0u; const int nr=__popc(rbits);
      const float*lp=A.LP+((size_t)bh*SEQ+srow)*3; float lk[3]; float lt=l_reg;
      #pragma unroll
      for(int k=0;k<3;++k){ const float t_=lp[k]; lk[k]=(k<nr)?t_:0.f; lt+=lk[k]; }
      const float inv=1.0f/lt;
      wsr[r32e*8]=inv; wsr[r32e*8+1]=lk[0]*inv; wsr[r32e*8+2]=lk[1]*inv; wsr[r32e*8+3]=lk[2]*inv; ((int*)wsr)[r32e*8+4]=nr;
    }
  }
  asm volatile("s_waitcnt lgkmcnt(0)":::"memory");
  float rli[16];
  #pragma unroll
  for(int r=0;r<16;++r)rli[r]=wsr[(crow(r,0)+4*hie)*8];
  { bf16*stg=(bf16*)(shm+LDS_OST)+wid*2048;
    bf16*stgw=stg+(4*hie)*64+r32e;
    #pragma unroll
    for(int r=0;r<16;++r){
      #pragma unroll
      for(int d0=0;d0<2;++d0)stgw[crow(r,0)*64+d0*32]=f2bf(o[d0][r]*rli[r]);}
    asm volatile("s_waitcnt lgkmcnt(0)":::"memory");
    #pragma unroll
    for(int i=0;i<4;++i){const int row=i*8+(lane2>>3),ch=lane2&7; const u32x4 v=*(const u32x4*)(stg+row*64+ch*8);
      if(KIND<2){
        const unsigned e_=((const unsigned*)wsr)[row*8+2]; const unsigned idx=32u*gi+row;
        if(idx<cnt){ const size_t slot=((size_t)bh*SEQ+(e_&8191u))*3+(e_>>13);
          bf16*dst=A.OP+slot*64+ch*8;
          asm volatile("global_store_dwordx4 %0, %1, off sc1\n\ts_nop 1"::"v"(dst),"v"(v):"memory");
          if(ch==0)__hip_atomic_store(A.LP+slot,wsr[row*8+1],__ATOMIC_RELAXED,__HIP_MEMORY_SCOPE_AGENT); }
      } else {
        const size_t rowg=(size_t)bh*SEQ+256*j+32*gi+row; const size_t tok=(size_t)b*SEQ+256*j+32*gi+row; const int nr=((const int*)wsr)[row*8+4];
        float a8[8];
        #pragma unroll
        for(int e=0;e<4;++e){ a8[2*e]=__uint_as_float(v[e]<<16); a8[2*e+1]=__uint_as_float(v[e]&0xffff0000u); }
        const bf16*op=A.OP+(rowg*3)*64+ch*8;
        u32x4 pk[3];
        #pragma unroll
        for(int k=0;k<3;++k) pk[k]=*(const u32x4*)(op+k*64);
        #pragma unroll
        for(int k=0;k<3;++k){ const float f=wsr[row*8+1+k]; const u32x4 p=(k<nr)?pk[k]:(u32x4){0u,0u,0u,0u};
          #pragma unroll
          for(int e=0;e<4;++e){ a8[2*e]+=f*__uint_as_float(p[e]<<16); a8[2*e+1]+=f*__uint_as_float(p[e]&0xffff0000u); } }
        const u32x4 z=*(const u32x4*)(A.ZA+tok*512+h*64+ch*8); u32x4 w;
        #pragma unroll
        for(int e=0;e<4;++e) w[e]=cvtpk_s(a8[2*e]*__uint_as_float(z[e]<<16),a8[2*e+1]*__uint_as_float(z[e]&0xffff0000u));
        *(u32x4*)(A.Y+tok*1024+h*64+ch*8)=w;
      } } }
  asm volatile("s_waitcnt lgkmcnt(0)":::"memory");
}
template<bool OWN> __device__ __forceinline__ void kv_unit(int bh,int j,const AB&A,char*shm,int&pend_x){
  const int tid=threadIdx.x; int lane=tid&63; asm volatile("":"+v"(lane));
  const int wid=__builtin_amdgcn_readfirstlane(tid>>6); const int h=bh&7;
  const unsigned lds0=(unsigned)(uintptr_t)shm;
  const bf16*Kh=A.KA+((size_t)bh*SEQ+(size_t)j*256)*PITCH,*Vh=A.VA+((size_t)bh*SEQ+(size_t)j*256)*PITCH;
  const bf16*ksrc=Kh+(long)lane*PITCH+wid*8;
  const bf16*vsrc=Vh+(long)(16*(wid&3)+(lane>>2))*PITCH+(wid>>2)*32+(lane&3)*8;
  const unsigned kdst=lds0+LDS_K+wid*1024, vdst=lds0+LDS_V+wid*1024;
  #pragma unroll
  for(int t=0;t<NKT;++t){ glds16(ksrc+(long)t*KVBLK*PITCH,(unsigned)__builtin_amdgcn_readfirstlane(kdst+t*SLOTB)); glds16(vsrc+(long)t*KVBLK*PITCH,(unsigned)__builtin_amdgcn_readfirstlane(vdst+t*SLOTB)); }
  float*tb=(float*)(shm+LDS_TB);
  if(tid<128) tb[tid]=(A.rel_bias[t5_bucket_dev(tid)*8+h]-A.rel_bias[31*8+h])*1.4426950408889634f;
  CBAR_ALL();
  if(pend_x>=0){ if(tid==0)__hip_atomic_fetch_add(A.qctl+512+64*pend_x,1u,__ATOMIC_RELAXED,__HIP_MEMORY_SCOPE_AGENT); pend_x=-1; CBAR_LDS(); }
  const int r32_=lane&31,hi_=lane>>5;
  #define LOADQ(dst,row) do{ const bf16*q_=A.QA+((size_t)bh*SEQ+(row))*PITCH+hi_*8; _Pragma("unroll") for(int d0=0;d0<4;++d0)(dst)[d0]=*reinterpret_cast<const bf16x8*>(q_+d0*16); }while(0)
  if((A.dbg&1)||(OWN&&(A.dbg&2))||(!OWN&&(A.dbg&4))){}
  else if(OWN){ bf16x8 qr[4]; LOADQ(qr,256*j+32*wid+r32_); attn_group<2>(bh,j,(unsigned)wid,256u,0u,qr,A,shm); }
  else {
    const unsigned short*lst=A.LIST+((size_t)bh*32+j)*LISTCAP;
    const unsigned cf=A.CNT[bh*32+j], cp=A.CNT[1024+bh*32+j];
    const unsigned nf=cf<(unsigned)(LISTCAP-PREVCAP)?cf:(unsigned)(LISTCAP-PREVCAP), np=cp<(unsigned)PREVCAP?cp:(unsigned)PREVCAP;
    const unsigned gp=(np+31u)>>5, gf=(nf+31u)>>5, gt=gp+gf;
    #define LOADE(gi_) (((gi_)<gp)?lst[(LISTCAP-PREVCAP)+((32u*(gi_)+r32_<np)?32u*(gi_)+r32_:0u)]:lst[((32u*((gi_)-gp)+r32_<nf)?32u*((gi_)-gp)+r32_:0u)])
    unsigned gi=wid;
    if(gi<gt){
      unsigned e_cur=LOADE(gi); unsigned e_nxt=(gi+NW<gt)?LOADE(gi+NW):0u;
      bf16x8 q_cur[4],q_nxt[4]; LOADQ(q_cur,e_cur&8191u);
      for(;gi<gt;gi+=NW){
        if(gi+NW<gt)LOADQ(q_nxt,e_nxt&8191u);
        const unsigned e_nn=(gi+2*NW<gt)?LOADE(gi+2*NW):0u;
        if(gi<gp) attn_group<1>(bh,j,gi,np,e_cur,q_cur,A,shm);
        else attn_group<0>(bh,j,gi-gp,nf,e_cur,q_cur,A,shm);
        e_cur=e_nxt; e_nxt=e_nn;
        #pragma unroll
        for(int d0=0;d0<4;++d0)q_cur[d0]=q_nxt[d0];
      }
    }
    #undef LOADE
  }
  #undef LOADQ
  CBAR_LDS();
  if(!OWN)pend_x=bh&7;
}
__device__ __forceinline__ void flush_pending(const AB&A,int&pend_x){
  if(pend_x>=0){ CBAR_ALL(); if(threadIdx.x==0)__hip_atomic_fetch_add(A.qctl+512+64*pend_x,1u,__ATOMIC_RELAXED,__HIP_MEMORY_SCOPE_AGENT); pend_x=-1; CBAR_LDS(); }
}
__device__ __forceinline__ void moba_phase(char*lds,const AB&A){
  const int tid=threadIdx.x; volatile unsigned*uw=(volatile unsigned*)(lds+LDS_UNIT);
  const unsigned x0=xb_xcc_id()&7u; unsigned acquired=0u; int pend_x=-1;
  bool pf_valid=false; unsigned pf_k=0u;
  for(unsigned qi=0;qi<8u;){
    const unsigned x=(x0+qi)&7u;
    unsigned k;
    if(pf_valid){ k=pf_k; pf_valid=false; }
    else {
      if(tid==0){ const unsigned k0=__hip_atomic_fetch_add(A.qctl+64*x,1u,__ATOMIC_RELAXED,__HIP_MEMORY_SCOPE_AGENT); uw[0]=k0; }
      CBAR_ALL();
      k=(unsigned)__builtin_amdgcn_readfirstlane((int)uw[0]);
      CBAR_LDS();
    }
    constexpr unsigned T=124u;
    if(k>=T+128u){ ++qi; continue; }
    unsigned pfr=0u;
    if(tid==0)pfr=__hip_atomic_fetch_add(A.qctl+64*x,1u,__ATOMIC_RELAXED,__HIP_MEMORY_SCOPE_AGENT);
    if(k<T){ kv_unit<false>((int)x+8*(int)(k&3u),(int)(k>>2),A,lds,pend_x); }
    else {
      const unsigned ko=k-T;
      if(!((acquired>>x)&1u)){
        flush_pending(A,pend_x);
        if(tid<64){ unsigned sp=0u; while(__builtin_amdgcn_readfirstlane(__hip_atomic_load(A.qctl+512+64*x,__ATOMIC_RELAXED,__HIP_MEMORY_SCOPE_AGENT))<T){ __builtin_amdgcn_s_sleep(2); if(++sp>(1u<<19))break; }
          __builtin_amdgcn_fence(__ATOMIC_ACQUIRE,"agent"); asm volatile("s_waitcnt vmcnt(0)":::"memory"); }
        CBAR_LDS();
        acquired|=1u<<x; }
      kv_unit<true>((int)x+8*(int)(ko&3u),31-(int)(ko>>2),A,lds,pend_x);
    }
    if(tid==0)uw[1]=pfr;
    CBAR_ALL();
    pf_k=(unsigned)__builtin_amdgcn_readfirstlane((int)uw[1]); pf_valid=true;
    CBAR_LDS();
  }
  flush_pending(A,pend_x);
}
#undef SBAR
#undef WAIT_BAR
}
constexpr int CW_AQ = 16384, CW_CNT = 20480, CW_RT = 22592, CW_GQ = 22656, CW_GQ2 = 22720, CW_G1B = 22784, CW_FLAGS = 24576;
__device__ __forceinline__ void p0_phase(const Ptrs& P, LAS unsigned char* lds, int tid, int G) {
    const int lane = tid & 63, wave = tid >> 6;
    {
        LAS float* scr = (LAS float*)(lds + wave * 16640);
        for (int it = blockIdx.x * NWAVES + wave; it < 1024 + 256; it += G * NWAVES) {
            const bool first = it < 1024; const int r = first ? it : it - 1024; const int kb = r & 15, pb = r >> 4;
            const float* W = first ? P.w_in : P.w_out; const int ldw = first ? NCOL : DM; bf16_t* WT = first ? P.WT1 : P.WT2;
            const int p = pb * 64 + lane; const int c = first ? wt1_logical(p) : p;
#pragma unroll 8
            for (int kk = 0; kk < 64; ++kk) scr[kk * 65 + lane] = W[(size_t)(kb * 64 + kk) * ldw + c];
            asm volatile("s_waitcnt lgkmcnt(0)" ::: "memory");
#pragma unroll 8
            for (int pp = 0; pp < 64; ++pp) WT[(size_t)(pb * 64 + pp) * 1024 + kb * 64 + lane] = f2bf(scr[lane * 65 + pp]);
            asm volatile("s_waitcnt lgkmcnt(0)" ::: "memory");
        }
        __syncthreads();
    }
    LAS float* w8 = (LAS float*)(lds + 32768);
    for (int i = tid; i < 1024 * 8; i += 512) w8[i] = P.w_in[(size_t)(i >> 3) * NCOL + 4096 + (i & 7)];
    __syncthreads();
    f32x4 nw[4];
#pragma unroll
    for (int j = 0; j < 4; ++j) nw[j] = ((const f32x4*)P.norm_w)[lane + 64 * j];
    const int gw = blockIdx.x * NWAVES + wave, ngw = G * NWAVES;
    f32x4 vn[4];
    if (gw < MTOK) { const f32x4* xr0 = (const f32x4*)(P.x + (size_t)gw * DM) + lane;
#pragma unroll
        for (int j = 0; j < 4; ++j) vn[j] = xr0[64 * j]; }
    for (int row = gw; row < MTOK; row += ngw) {
        f32x4 v[4]; float ss = 0.f;
#pragma unroll
        for (int j = 0; j < 4; ++j) v[j] = vn[j];
        if (row + ngw < MTOK) { const f32x4* xr1 = (const f32x4*)(P.x + (size_t)(row + ngw) * DM) + lane;
#pragma unroll
            for (int j = 0; j < 4; ++j) vn[j] = xr1[64 * j]; }
#pragma unroll
        for (int j = 0; j < 4; ++j) ss += v[j][0] * v[j][0] + v[j][1] * v[j][1] + v[j][2] * v[j][2] + v[j][3] * v[j][3];
        ss = wave_sum(ss);
        const float rstd = 1.0f / sqrtf(ss * (1.0f / DM) + EPS);
        float d[8];
#pragma unroll
        for (int c = 0; c < 8; ++c) d[c] = 0.f;
#pragma unroll
        for (int j = 0; j < 4; ++j) {
            f32x4 h = v[j] * rstd * nw[j];
            unsigned lo = (unsigned)f2bf(h[0]) | ((unsigned)f2bf(h[1]) << 16), hi = (unsigned)f2bf(h[2]) | ((unsigned)f2bf(h[3]) << 16);
            *(uint2*)(P.HN + (size_t)row * DM + 4 * (lane + 64 * j)) = make_uint2(lo, hi);
#pragma unroll
            for (int e = 0; e < 4; ++e) { const LAS f32x4* wr = (const LAS f32x4*)(w8 + (4 * (lane + 64 * j) + e) * 8); const f32x4 wa = wr[0], wb = wr[1];
#pragma unroll
                for (int c = 0; c < 4; ++c) { d[c] += h[e] * wa[c]; d[4 + c] += h[e] * wb[c]; } }
        }
#pragma unroll
        for (int c = 0; c < 8; ++c) d[c] = wave_sum(d[c]);
        if (lane < 4) {
            const int hh = lane; float bd = d[0], ad = d[4];
            if (hh == 1) { bd = d[1]; ad = d[5]; } else if (hh == 2) { bd = d[2]; ad = d[6]; } else if (hh == 3) { bd = d[3]; ad = d[7]; }
            const float beta = 1.0f / (1.0f + expf(-bd));
            const float z = ad + P.dt_bias[hh];
            const float sp = fmaxf(z, 0.f) + log1pf(expf(-fabsf(z)));
            const float g = -expf(P.a_log[hh]) * sp;
            const int b = row / SEQ, s = row % SEQ;
            P.BETA[(size_t)(b * DH + hh) * SEQ + s] = beta; P.GDEC[(size_t)(b * DH + hh) * SEQ + s] = g;
        }
    }
    __syncthreads();
}

struct Args { const float* in[11]; float* out; unsigned char* ws; int ph_lo, ph_hi, qoff, li; };
__global__ void __launch_bounds__(NWAVES * 64, 2) mega(Args args) {
    extern __shared__ __attribute__((aligned(16))) unsigned char lds_raw[];
    LAS unsigned char* lds = (LAS unsigned char*)lds_raw;
    const int tid = threadIdx.x, G = gridDim.x;
    void* din[11];
#pragma unroll
    for (int i = 0; i < 11; ++i) din[i] = (void*)args.in[i];
    const Ptrs P = make_ptrs(din, args.out, args.ws);
    volatile LAS unsigned* MISC = (volatile LAS unsigned*)(lds + MISC_OFF);
    for (int u = tid; u < (LDS_BYTES - LDSCTL_OFF) / 4; u += NWAVES * 64) ((LAS unsigned*)(lds + LDSCTL_OFF))[u] = 0u;
    __syncthreads();
    XcdBarrier bar = xcd_barrier_post(P.ctl + CW_BAR + args.li * XCD_BAR_WORDS, MISC + 8);
    const int lo = args.ph_lo, hi = args.ph_hi;
#define IN(k) (lo <= (k) && (k) < hi)
#define BOTH(k) (IN(k) && IN((k) + 1))
    if (IN(0)) { p0_phase(P, lds, tid, G); if (BOTH(0)) xcd_barrier(bar); }
    if (IN(1)) {
        pg8::Gemm g{P.HN, P.WT1 + (size_t)2048 * DM, MTOK, 2048, DM}; pg8::StaticOrder S; S.init(MTOK, 2048, G, (int)blockIdx.x);
        pg8::EpiProj E{P.QA, P.KA, P.VA, P.ZA, P.ZD, P.QKVD, P.KMEAN, P.qnw, P.knw, 8};
        pg8::gemm_phase<pg8::EpiProj, pg8::StaticOrder, true, true>(lds + RING_OFF, g, S, E);
        if (BOTH(1)) xcd_barrier(bar);
    }
#define GEMM1B_AND_PUBLISH() do{ \
                pg8::Gemm g{P.HN, P.WT1, MTOK, 2048, DM}; pg8::StaticOrder S; S.init(MTOK, 2048, G - 16, (int)blockIdx.x - 16); \
                pg8::EpiProj E{P.QA, P.KA, P.VA, P.ZA, P.ZD, P.QKVD, P.KMEAN, P.qnw, P.knw, 0}; \
                pg8::gemm_phase<pg8::EpiProj, pg8::StaticOrder, true, true>(lds + RING_OFF, g, S, E); \
                CBAR_ALL();                                \
                if (tid == 0) { __builtin_amdgcn_fence(__ATOMIC_RELEASE, "agent"); asm volatile("s_waitcnt vmcnt(0)" ::: "memory"); \
                    __hip_atomic_fetch_add(P.ctl + CW_G1B, 1u, __ATOMIC_RELAXED, __HIP_MEMORY_SCOPE_AGENT); } \
                CBAR_LDS(); }while(0)
    if (IN(2)) {
        const int dq = args.qoff;
        const moba::AB A{(dq >> 4) & 7, P.QA, P.KA, P.VA, P.KMEAN, P.rel_bias, P.ZA, P.Y, P.SEL, P.LIST, P.ctl + CW_CNT, P.OPART, P.LP, P.ctl + CW_AQ + (dq & ~255)};
        if (blockIdx.x < 16) {
            if (!(dq & 1)) {
#ifdef SCANDBG
                if (dq & 12) dn::scan_head<SCANDBG>((int)blockIdx.x, P.REC, P.GLB, P.dnw, P.ZD, (bf16_t*)P.out, P.ctl + CW_FLAGS, (char*)lds_raw, dq & 12); else
#endif
                dn::scan_head<0>((int)blockIdx.x, P.REC, P.GLB, P.dnw, P.ZD, (dq & 12) ? (bf16_t*)P.out : P.Y, P.ctl + CW_FLAGS, (char*)lds_raw, dq & 12); }
        } else if (!(dq & 128)) {
            volatile LAS unsigned* qw = MISC + 16;
            int pend0 = -1, pend1 = -1, carry = -1;
#ifdef PREPX
#define PREP_EXTRA dn::prep_chunk(pend0, P.QKVD, P.conv_w, P.BETA, P.GDEC, (unsigned char*)P.OPART, P.GLB + 4096, P.ctl + CW_FLAGS, lds, PREPX); dn::prep_chunk(pend1, P.QKVD, P.conv_w, P.BETA, P.GDEC, (unsigned char*)P.OPART + 131072, P.GLB + 4096, P.ctl + CW_FLAGS, lds, PREPX);
#else
#define PREP_EXTRA
#endif
#define PREP_LOOP(LIMIT) for (;;) { \
                if (tid == 0) { unsigned k; if (carry >= 0) k = (unsigned)carry; else k = __hip_atomic_fetch_add(P.ctl + CW_GQ, 1u, __ATOMIC_RELAXED, __HIP_MEMORY_SCOPE_AGENT); qw[0] = k; } \
                carry = -1; \
                CBAR_ALL(); \
                if (pend0 >= 0) { if (tid == 0) { __hip_atomic_store(P.ctl + CW_FLAGS + pend0, 1u, __ATOMIC_RELAXED, __HIP_MEMORY_SCOPE_AGENT); __hip_atomic_store(P.ctl + CW_FLAGS + pend1, 1u, __ATOMIC_RELAXED, __HIP_MEMORY_SCOPE_AGENT); } pend0 = -1; } \
                const unsigned k = (unsigned)__builtin_amdgcn_readfirstlane((int)qw[0]); \
                CBAR_LDS(); \
                if (k >= 1024u) break; \
                if (k >= (LIMIT)) { carry = (int)k; break; } \
                const unsigned cq = 2u * k; \
                pend0 = (int)(cq & 15u) * 128 + (int)(cq >> 4); pend1 = (int)((cq + 1u) & 15u) * 128 + (int)((cq + 1u) >> 4); \
                dn::prep_chunk(pend0, P.QKVD, P.conv_w, P.BETA, P.GDEC, P.REC + (size_t)pend0 * dn::REC_BYTES, P.GLB, P.ctl + CW_FLAGS, lds); \
                dn::prep_chunk(pend1, P.QKVD, P.conv_w, P.BETA, P.GDEC, P.REC + (size_t)pend1 * dn::REC_BYTES, P.GLB, P.ctl + CW_FLAGS, lds); \
                PREP_EXTRA \
            }
            PREP_LOOP(512u)
            GEMM1B_AND_PUBLISH();
            PREP_LOOP(1024u)
#undef PREP_LOOP
            if (tid < 64) { unsigned sp = 0u;
                while (__builtin_amdgcn_readfirstlane(__hip_atomic_load(P.ctl + CW_G1B, __ATOMIC_RELAXED, __HIP_MEMORY_SCOPE_AGENT)) < (unsigned)(G - 16)) { __builtin_amdgcn_s_sleep(8); if (++sp > (1u << 17)) break; }
                __builtin_amdgcn_fence(__ATOMIC_ACQUIRE, "agent"); asm volatile("s_waitcnt vmcnt(0)" ::: "memory"); }
            CBAR_LDS();
            for (;;) {
                if (tid == 0) { const unsigned k = __hip_atomic_fetch_add(P.ctl + CW_GQ2, 1u, __ATOMIC_RELAXED, __HIP_MEMORY_SCOPE_AGENT); qw[0] = k; }
                CBAR_ALL();
                const unsigned k = (unsigned)__builtin_amdgcn_readfirstlane((int)qw[0]);
                CBAR_LDS();
                if (k >= 1024u) break;
                moba::route_item((int)(k >> 5), (int)(k & 31u), A);
#ifdef ROUTE2
                { moba::AB A2 = A; A2.SEL = (unsigned*)P.LP; A2.LIST = (unsigned short*)P.OPART; A2.CNT = P.ctl + 32768; moba::route_item((int)(k >> 5), (int)(k & 31u), A2); }
#endif
                CBAR_ALL();
                if (tid == 0) __hip_atomic_fetch_add(P.ctl + CW_RT, 1u, __ATOMIC_RELAXED, __HIP_MEMORY_SCOPE_AGENT);
                CBAR_LDS();
            }
        }
#ifdef NOJOIN
        if (blockIdx.x >= 16)
#endif
        if (!(dq & 2)) {
            if (tid < 64) { unsigned sp = 0u;
                while (__builtin_amdgcn_readfirstlane(__hip_atomic_load(P.ctl + CW_RT, __ATOMIC_RELAXED, __HIP_MEMORY_SCOPE_AGENT)) < 1024u) { __builtin_amdgcn_s_sleep(8); if (++sp > (1u << 17)) break; }
                __builtin_amdgcn_fence(__ATOMIC_ACQUIRE, "agent"); asm volatile("s_waitcnt vmcnt(0)" ::: "memory"); }
            CBAR_LDS();
            moba::moba_phase((char*)lds_raw, A);
        }
        if (IN(5)) xcd_barrier(bar);
    }
    if (IN(5)) {
        pg8::Gemm g{P.Y, P.WT2, MTOK, DM, DM}; pg8::StaticOrder S; S.init(MTOK, DM, G, (int)blockIdx.x);
        pg8::EpiOut E{P.x, P.out};
        pg8::gemm_phase<pg8::EpiOut, pg8::StaticOrder, true, true>(lds + RING_OFF, g, S, E);
    }
#undef IN
#undef BOTH
}

extern "C" void kernel_launch(void* const* d_in, const int* in_sizes, int n_in, void* d_out, int out_size, void* d_ws, size_t ws_size, hipStream_t stream) {
    static int grid = 0;
    if (grid == 0) {
        if (n_in != 11 || ws_size < WS_END) { fprintf(stderr, "kernel_launch: unexpected inputs / workspace (%d, %zu)\n", n_in, ws_size); grid = -1; return; }
        int dev = 0, cus = 0;
        if (hipGetDevice(&dev) != hipSuccess || hipDeviceGetAttribute(&cus, hipDeviceAttributeMultiprocessorCount, dev) != hipSuccess) { grid = -1; return; }
        if (hipFuncSetAttribute((const void*)mega, hipFuncAttributeMaxDynamicSharedMemorySize, LDS_BYTES) != hipSuccess) { fprintf(stderr, "kernel_launch: hipFuncSetAttribute failed\n"); grid = -1; return; }
        grid = cus;
    }
    if (grid < 0) return;
    unsigned char* ws = (unsigned char*)d_ws;
    const Ptrs P = make_ptrs(d_in, d_out, ws);
    (void)hipMemsetAsync(ws + WS_CTL, 0, CTL_BYTES, stream);
    Args a{};
    for (int i = 0; i < 11; ++i) a.in[i] = (const float*)d_in[i];
    a.out = (float*)d_out; a.ws = ws;
#ifndef DUPF
#define DUPF 0
#endif
#ifndef DUPP
    a.ph_lo = 0; a.ph_hi = 6;
    hipLaunchKernelGGL(mega, dim3(grid), dim3(NWAVES * 64), LDS_BYTES, stream, a);
#else
#ifdef FIRSTF
    a.qoff = FIRSTF;
#endif
    a.ph_lo = 0; a.ph_hi = DUPP + 1;
    hipLaunchKernelGGL(mega, dim3(grid), dim3(NWAVES * 64), LDS_BYTES, stream, a);
    a.ph_lo = DUPP; a.ph_hi = DUPP + 1; a.qoff = 1024 + 128 + DUPF; a.li = 1;
    hipLaunchKernelGGL(mega, dim3(grid), dim3(NWAVES * 64), LDS_BYTES, stream, a);
    if (DUPP < 5) { a.ph_lo = DUPP + 1; a.ph_hi = 6; a.qoff = 0; a.li = 2;
    hipLaunchKernelGGL(mega, dim3(grid), dim3(NWAVES * 64), LDS_BYTES, stream, a); }
#endif
}
```

```cpp
#include <hip/hip_runtime.h>
#include <stdint.h>
#include <math.h>
#include <cstdio>

typedef unsigned short bf16_t;
typedef short bf16x8 __attribute__((ext_vector_type(8)));
typedef float f32x4 __attribute__((ext_vector_type(4)));
typedef unsigned u32x4 __attribute__((ext_vector_type(4)));

constexpr int NB = 4, SEQ = 8192, DM = 1024, MTOK = NB * SEQ;
constexpr int AH = 8, AD = 64, AW = 512, NBLK = 32;
constexpr int DH = 4, DKH = 128, NCOL = 4104, DCONV = 1536;
constexpr float EPS = 1e-6f;
constexpr float LOG2E = 1.4426950408889634f;
constexpr float QSCALE = 0.125f * LOG2E;

constexpr size_t MiB = 1u << 20;
constexpr size_t WS_CTL = 0, CTL_BYTES = 1 * MiB;
constexpr size_t WS_KMEAN = 512 * 1024;
constexpr size_t WS_WT1 = 1 * MiB;
constexpr size_t WS_WT2 = 9 * MiB;
constexpr size_t WS_BETA = 11 * MiB;
constexpr size_t WS_GDEC = 11 * MiB + 512 * 1024;
constexpr size_t WS_QA = 12 * MiB, WS_KA = 44 * MiB, WS_VA = 76 * MiB;
constexpr size_t WS_ZA = 108 * MiB, WS_ZD = 140 * MiB;
constexpr size_t WS_QKVD = 172 * MiB;
constexpr size_t WS_QD = 268 * MiB, WS_KD = 300 * MiB, WS_VD = 332 * MiB;
constexpr size_t WS_REC = 268 * MiB;
constexpr size_t WS_GLB = 256 * 1024;
constexpr size_t WS_Y = 412 * MiB;
constexpr size_t WS_END = 476 * MiB;
constexpr size_t OUT_OD = 64 * MiB;

__device__ __forceinline__ unsigned short f2bf(float f) { unsigned u = __float_as_uint(f); return (unsigned short)((u + 0x7fffu + ((u >> 16) & 1u)) >> 16); }
__device__ __forceinline__ float bf2f(unsigned short u) { return __uint_as_float(((unsigned)u) << 16); }
__device__ __forceinline__ float wave_sum(float v) {
#pragma unroll
    for (int o = 1; o < 64; o <<= 1) v += __shfl_xor(v, o);
    return v;
}
__device__ __forceinline__ float silu_f(float x) { return x / (1.0f + __expf(-x)); }
__host__ __device__ __forceinline__ int wt1_ltile(int pt) { return pt < 8 ? pt : (pt < 10 ? pt + 6 : pt - 2); }
__host__ __device__ __forceinline__ int wt1_logical(int p) { const int pn = wt1_ltile(p >> 8), t = p & 255, bj = t >> 7, wc = (t >> 5) & 3, i = t & 31; return 256 * pn + 64 * wc + 32 * bj + i; }
__host__ __device__ __forceinline__ int wt1_physical(int c) { const int ln = c >> 8, pn = ln < 8 ? ln : (ln < 14 ? ln + 2 : ln - 6), wc = (c >> 6) & 3, bj = (c >> 5) & 1, i = c & 31; return 256 * pn + 128 * bj + 32 * wc + i; }

__device__ __forceinline__ void wt_tile(const float* W, int ldw, bf16_t* WT, int kb, int pb, bool perm, float* lds, int tid) {
#pragma unroll 4
    for (int i = 0; i < 16; ++i) { const int kk = i * 4 + (tid >> 6), pp = tid & 63, p = pb * 64 + pp; const int c = perm ? wt1_logical(p) : p;
        lds[kk * 65 + pp] = W[(size_t)(kb * 64 + kk) * ldw + c]; }
    __syncthreads();
#pragma unroll 4
    for (int i = 0; i < 16; ++i) { const int pp = i * 4 + (tid >> 6), kk = tid & 63;
        WT[(size_t)(pb * 64 + pp) * 1024 + kb * 64 + kk] = f2bf(lds[kk * 65 + pp]); }
    __syncthreads();
}
__global__ void __launch_bounds__(256) k_wt(const float* w_in, const float* w_out, bf16_t* WT1, bf16_t* WT2) {
    __shared__ float lds[64 * 65];
    const int tid = threadIdx.x;
    for (int it = blockIdx.x; it < 1024 + 256; it += gridDim.x) {
        if (it < 1024) wt_tile(w_in, NCOL, WT1, it & 15, it >> 4, true, lds, tid);
        else { const int r = it - 1024; wt_tile(w_out, DM, WT2, r & 15, r >> 4, false, lds, tid); }
    }
}

__global__ void __launch_bounds__(256) k_rows(const float* x, const float* norm_w, const float* w_in, const float* a_log, const float* dt_bias,
                                              bf16_t* HN, float* BETA, float* GDEC) {
    __shared__ float w8[1024 * 8];
    const int tid = threadIdx.x, lane = tid & 63, wave = tid >> 6;
    for (int i = tid; i < 1024 * 8; i += 256) w8[i] = w_in[(size_t)(i >> 3) * NCOL + 4096 + (i & 7)];
    __syncthreads();
    f32x4 nw[4];
#pragma unroll
    for (int j = 0; j < 4; ++j) nw[j] = ((const f32x4*)norm_w)[lane + 64 * j];
    const int gw = blockIdx.x * 4 + wave, ngw = gridDim.x * 4;
    for (int row = gw; row < MTOK; row += ngw) {
        const f32x4* xr = (const f32x4*)(x + (size_t)row * DM) + lane;
        f32x4 v[4]; float ss = 0.f;
#pragma unroll
        for (int j = 0; j < 4; ++j) { v[j] = xr[64 * j]; ss += v[j][0] * v[j][0] + v[j][1] * v[j][1] + v[j][2] * v[j][2] + v[j][3] * v[j][3]; }
        ss = wave_sum(ss);
        const float rstd = 1.0f / sqrtf(ss * (1.0f / DM) + EPS);
        float d[8];
#pragma unroll
        for (int c = 0; c < 8; ++c) d[c] = 0.f;
#pragma unroll
        for (int j = 0; j < 4; ++j) {
            f32x4 h = v[j] * rstd * nw[j];
            unsigned lo = (unsigned)f2bf(h[0]) | ((unsigned)f2bf(h[1]) << 16), hi = (unsigned)f2bf(h[2]) | ((unsigned)f2bf(h[3]) << 16);
            *(uint2*)(HN + (size_t)row * DM + 4 * (lane + 64 * j)) = make_uint2(lo, hi);
#pragma unroll
            for (int e = 0; e < 4; ++e) { const float* wr = w8 + (4 * (lane + 64 * j) + e) * 8;
#pragma unroll
                for (int c = 0; c < 8; ++c) d[c] += h[e] * wr[c]; }
        }
#pragma unroll
        for (int c = 0; c < 8; ++c) d[c] = wave_sum(d[c]);
        if (lane < 4) {
            const int hh = lane; float bd = d[0], ad = d[4];
            if (hh == 1) { bd = d[1]; ad = d[5]; } else if (hh == 2) { bd = d[2]; ad = d[6]; } else if (hh == 3) { bd = d[3]; ad = d[7]; }
            const float beta = 1.0f / (1.0f + expf(-bd));
            const float z = ad + dt_bias[hh];
            const float sp = fmaxf(z, 0.f) + log1pf(expf(-fabsf(z)));
            const float g = -expf(a_log[hh]) * sp;
            const int b = row / SEQ, s = row % SEQ;
            BETA[(size_t)(b * DH + hh) * SEQ + s] = beta; GDEC[(size_t)(b * DH + hh) * SEQ + s] = g;
        }
    }
}

struct G1Out { bf16_t *QA, *KA, *VA, *ZA, *ZD, *QKVD; float* KMEAN; const float *qnw, *knw; };
__global__ void __launch_bounds__(256) k_gemm1(const bf16_t* HN, const bf16_t* WT1, G1Out o) {
    const int tid = threadIdx.x, lane = tid & 63, wave = tid >> 6, fr = lane & 15, fq = lane >> 4;
    const int rt = blockIdx.x >> 4, gq = blockIdx.x & 15, cg = gq * 4 + wave;
    f32x4 acc[2][4];
#pragma unroll
    for (int m = 0; m < 2; ++m)
#pragma unroll
        for (int n = 0; n < 4; ++n) acc[m][n] = (f32x4){0.f, 0.f, 0.f, 0.f};
    const bf16_t* ap[2]; const bf16_t* bp[4];
#pragma unroll
    for (int m = 0; m < 2; ++m) ap[m] = HN + (size_t)(rt * 32 + m * 16 + fr) * DM + 8 * fq;
#pragma unroll
    for (int n = 0; n < 4; ++n) bp[n] = WT1 + (size_t)wt1_physical(cg * 64 + n * 16 + fr) * DM + 8 * fq;
    for (int k0 = 0; k0 < DM; k0 += 32) {
        bf16x8 a[2], b[4];
#pragma unroll
        for (int m = 0; m < 2; ++m) a[m] = *(const bf16x8*)(ap[m] + k0);
#pragma unroll
        for (int n = 0; n < 4; ++n) b[n] = *(const bf16x8*)(bp[n] + k0);
#pragma unroll
        for (int m = 0; m < 2; ++m)
#pragma unroll
            for (int n = 0; n < 4; ++n) acc[m][n] = __builtin_amdgcn_mfma_f32_16x16x32_bf16(a[m], b[n], acc[m][n], 0, 0, 0);
    }
    const int row_base = rt * 32, b_ = row_base / SEQ;
    if (cg < 16) {
        const bool isq = cg < 8; const int head = cg & 7; const float* nwp = isq ? o.qnw : o.knw;
        float nwv[4];
#pragma unroll
        for (int n = 0; n < 4; ++n) nwv[n] = nwp[n * 16 + fr];
        float ksum[4] = {0.f, 0.f, 0.f, 0.f};
#pragma unroll
        for (int m = 0; m < 2; ++m)
#pragma unroll
            for (int r = 0; r < 4; ++r) {
                float ss = 0.f;
#pragma unroll
                for (int n = 0; n < 4; ++n) ss += acc[m][n][r] * acc[m][n][r];
                ss += __shfl_xor(ss, 1); ss += __shfl_xor(ss, 2); ss += __shfl_xor(ss, 4); ss += __shfl_xor(ss, 8);
                const float rs = 1.0f / sqrtf(ss * (1.0f / 64.0f) + EPS);
                const int row = row_base + m * 16 + fq * 4 + r, s = row % SEQ;
                bf16_t* dst = (isq ? o.QA : o.KA) + ((size_t)(b_ * AH + head) * SEQ + s) * AD;
#pragma unroll
                for (int n = 0; n < 4; ++n) { const float val = acc[m][n][r] * rs * nwv[n]; ksum[n] += val; dst[n * 16 + fr] = f2bf(isq ? val * QSCALE : val); }
            }
        if (!isq) {
            const int blk = (row_base % SEQ) >> 8;
#pragma unroll
            for (int n = 0; n < 4; ++n) { float t = ksum[n]; t += __shfl_xor(t, 16); t += __shfl_xor(t, 32);
                if (fq == 0) atomicAdd(o.KMEAN + ((size_t)(b_ * AH + head) * NBLK + blk) * AD + n * 16 + fr, t * (1.0f / 256.0f)); }
        }
    } else {
#pragma unroll
        for (int m = 0; m < 2; ++m)
#pragma unroll
            for (int r = 0; r < 4; ++r) {
                const int row = row_base + m * 16 + fq * 4 + r, s = row % SEQ;
#pragma unroll
                for (int n = 0; n < 4; ++n) {
                    const int c = cg * 64 + n * 16 + fr; const float val = acc[m][n][r];
                    if (c < 1536) { const int head = (c - 1024) >> 6; o.VA[((size_t)(b_ * AH + head) * SEQ + s) * AD + (c & 63)] = f2bf(val); }
                    else if (c < 2048) o.ZA[(size_t)row * AW + (c - 1536)] = f2bf(silu_f(val));
                    else if (c < 3584) o.QKVD[(size_t)row * DCONV + (c - 2048)] = f2bf(val);
                    else o.ZD[(size_t)row * AW + (c - 3584)] = f2bf(silu_f(val));
                }
            }
    }
}

__global__ void __launch_bounds__(256) k_gemm2(const bf16_t* Y, const bf16_t* WT2, const float* x, float* out) {
    const int tid = threadIdx.x, lane = tid & 63, wave = tid >> 6, fr = lane & 15, fq = lane >> 4;
    const int rt = blockIdx.x >> 2, gq = blockIdx.x & 3, cg = gq * 4 + wave;
    f32x4 acc[2][4];
#pragma unroll
    for (int m = 0; m < 2; ++m)
#pragma unroll
        for (int n = 0; n < 4; ++n) acc[m][n] = (f32x4){0.f, 0.f, 0.f, 0.f};
    const bf16_t* ap[2]; const bf16_t* bp[4];
#pragma unroll
    for (int m = 0; m < 2; ++m) ap[m] = Y + (size_t)(rt * 32 + m * 16 + fr) * DM + 8 * fq;
#pragma unroll
    for (int n = 0; n < 4; ++n) bp[n] = WT2 + (size_t)(cg * 64 + n * 16 + fr) * DM + 8 * fq;
    for (int k0 = 0; k0 < DM; k0 += 32) {
        bf16x8 a[2], b[4];
#pragma unroll
        for (int m = 0; m < 2; ++m) a[m] = *(const bf16x8*)(ap[m] + k0);
#pragma unroll
        for (int n = 0; n < 4; ++n) b[n] = *(const bf16x8*)(bp[n] + k0);
#pragma unroll
        for (int m = 0; m < 2; ++m)
#pragma unroll
            for (int n = 0; n < 4; ++n) acc[m][n] = __builtin_amdgcn_mfma_f32_16x16x32_bf16(a[m], b[n], acc[m][n], 0, 0, 0);
    }
#pragma unroll
    for (int m = 0; m < 2; ++m)
#pragma unroll
        for (int r = 0; r < 4; ++r) {
            const size_t row = rt * 32 + m * 16 + fq * 4 + r;
#pragma unroll
            for (int n = 0; n < 4; ++n) { const size_t idx = row * DM + cg * 64 + n * 16 + fr; out[idx] = x[idx] + acc[m][n][r]; }
        }
}

__global__ void __launch_bounds__(256) k_dn_prep(const bf16_t* QKVD, const float* conv_w, bf16_t* QD, bf16_t* KD, bf16_t* VD) {
    const int tid = threadIdx.x, lane = tid & 63, wave = tid >> 6;
    const int gw = blockIdx.x * 4 + wave, ngw = gridDim.x * 4;
    for (int it = gw; it < MTOK * DH; it += ngw) {
        const int row = it >> 2, hh = it & 3, b = row / SEQ, s = row % SEQ;
        float val[3][2];
#pragma unroll
        for (int part = 0; part < 3; ++part)
#pragma unroll
            for (int e = 0; e < 2; ++e) {
                const int cc = part * 512 + hh * 128 + lane + 64 * e; float a = 0.f;
#pragma unroll
                for (int j = 0; j < 4; ++j) { const int sj = s - 3 + j; if (sj >= 0) a += conv_w[j * DCONV + cc] * bf2f(QKVD[(size_t)(row - 3 + j) * DCONV + cc]); }
                val[part][e] = silu_f(a);
            }
        float sq = wave_sum(val[0][0] * val[0][0] + val[0][1] * val[0][1]);
        float sk = wave_sum(val[1][0] * val[1][0] + val[1][1] * val[1][1]);
        const float rq = (1.0f / sqrtf(sq + EPS)) * 0.08838834764831845f, rk = 1.0f / sqrtf(sk + EPS);
        const size_t base = ((size_t)(b * DH + hh) * SEQ + s) * DKH;
#pragma unroll
        for (int e = 0; e < 2; ++e) { QD[base + lane + 64 * e] = f2bf(val[0][e] * rq); KD[base + lane + 64 * e] = f2bf(val[1][e] * rk); VD[base + lane + 64 * e] = f2bf(val[2][e]); }
    }
}
__global__ void __launch_bounds__(128) k_dn_seq(const bf16_t* QD, const bf16_t* KD, const bf16_t* VD, const float* BETA, const float* GDEC, float* OD) {
    __shared__ __attribute__((aligned(16))) float kq[2][256];
    const int e = threadIdx.x, bh = blockIdx.x, b = bh >> 2, hh = bh & 3;
    float S[128];
#pragma unroll
    for (int d = 0; d < 128; ++d) S[d] = 0.f;
    const size_t base = (size_t)bh * SEQ * DKH;
    float kn = bf2f(KD[base + e]), qn = bf2f(QD[base + e]), vn_ = bf2f(VD[base + e]), gn = GDEC[(size_t)bh * SEQ], bn = BETA[(size_t)bh * SEQ];
    for (int t = 0; t < SEQ; ++t) {
        float* buf = kq[t & 1];
        buf[e] = kn; buf[128 + e] = qn;
        const float vt = vn_, alpha = __expf(gn), beta = bn;
        if (t + 1 < SEQ) { const size_t nx = base + (size_t)(t + 1) * DKH + e; kn = bf2f(KD[nx]); qn = bf2f(QD[nx]); vn_ = bf2f(VD[nx]); gn = GDEC[(size_t)bh * SEQ + t + 1]; bn = BETA[(size_t)bh * SEQ + t + 1]; }
        __syncthreads();
        float ks = 0.f;
#pragma unroll
        for (int d = 0; d < 128; d += 4) { const f32x4 k4 = *(const f32x4*)(buf + d); ks += k4[0] * S[d] + k4[1] * S[d + 1] + k4[2] * S[d + 2] + k4[3] * S[d + 3]; }
        const float vnew = beta * (vt - alpha * ks);
        float o = 0.f;
#pragma unroll
        for (int d = 0; d < 128; d += 4) { const f32x4 k4 = *(const f32x4*)(buf + d), q4 = *(const f32x4*)(buf + 128 + d);
#pragma unroll
            for (int i = 0; i < 4; ++i) { S[d + i] = alpha * S[d + i] + k4[i] * vnew; o += q4[i] * S[d + i]; } }
        OD[((size_t)b * SEQ + t) * AW + hh * 128 + e] = o;
    }
}

__device__ __forceinline__ int t5_bucket_dev(int n) {
    if (n < 16) return n;
    int bkt = 16;
    bkt += (n >= 19) + (n >= 21) + (n >= 24) + (n >= 27) + (n >= 31) + (n >= 35) + (n >= 40) + (n >= 46) + (n >= 52) + (n >= 59) + (n >= 67) + (n >= 77) + (n >= 87) + (n >= 99) + (n >= 113);
    return bkt;
}
__global__ void __launch_bounds__(256) k_attn(const bf16_t* QA, const bf16_t* KA, const bf16_t* VA, const float* KMEAN, const float* rel_bias,
                                              const float* qnw, const float* knw, const bf16_t* ZA, bf16_t* Y) {
    __shared__ float qs_all[4][64];
    __shared__ float bias_all[4][32];
    const int tid = threadIdx.x, lane = tid & 63, wave = tid >> 6;
    float* qs = qs_all[wave]; float* bt = bias_all[wave];
    const int gq = blockIdx.x * 4 + wave;
    const int bh = gq / SEQ, s = gq % SEQ, h = bh & 7, b = bh >> 3, own = s >> 8;
    float mq = fabsf(qnw[lane]), mk = fabsf(knw[lane]), mb = (lane < 32) ? rel_bias[lane * AH + h] : -1e30f;
#pragma unroll
    for (int o = 1; o < 64; o <<= 1) { mq = fmaxf(mq, __shfl_xor(mq, o)); mk = fmaxf(mk, __shfl_xor(mk, o)); mb = fmaxf(mb, __shfl_xor(mb, o)); }
    const float mref = (8.0f * mq * mk + mb) * LOG2E;
    qs[lane] = bf2f(QA[(size_t)gq * AD + lane]);
    if (lane < 32) bt[lane] = rel_bias[lane * AH + h] * LOG2E;
    __syncthreads();
    float gate = -INFINITY;
    if (lane < own) { const float* km = KMEAN + ((size_t)bh * NBLK + lane) * AD; float a = 0.f;
        for (int d = 0; d < 64; ++d) a += qs[d] * km[d];
        gate = a; }
    unsigned selmask = 0u;
    for (int r = 0; r < 3; ++r) {
        float bv = gate; int bi = lane;
#pragma unroll
        for (int o = 1; o < 64; o <<= 1) { const float ov = __shfl_xor(bv, o); const int oi = __shfl_xor(bi, o); if (ov > bv || (ov == bv && oi < bi)) { bv = ov; bi = oi; } }
        if (bv > -INFINITY) { selmask |= 1u << bi; if (lane == bi) gate = -INFINITY; }
    }
    selmask |= 1u << own;
    float l = 0.f, oacc = 0.f;
    const bf16_t* Kb = KA + (size_t)bh * SEQ * AD; const bf16_t* Vb = VA + (size_t)bh * SEQ * AD;
    for (int j = 0; j <= own; ++j) {
        if (!((selmask >> j) & 1u)) continue;
        for (int t4 = 0; t4 < 4; ++t4) {
            const int kpos = j * 256 + t4 * 64 + lane;
            const bf16_t* kr = Kb + (size_t)kpos * AD; float sc = 0.f;
#pragma unroll
            for (int c = 0; c < 8; ++c) { const bf16x8 kv = *(const bf16x8*)(kr + c * 8);
#pragma unroll
                for (int i = 0; i < 8; ++i) sc += qs[c * 8 + i] * bf2f((unsigned short)kv[i]); }
            const int dist = s - kpos; float p = 0.f;
            if (dist >= 0) p = exp2f(sc + bt[t5_bucket_dev(dist)] - mref);
            l += p;
            const bf16_t* vr = Vb + (size_t)(j * 256 + t4 * 64) * AD + lane;
#pragma unroll 8
            for (int k = 0; k < 64; ++k) oacc += __shfl(p, k) * bf2f(vr[(size_t)k * AD]);
        }
    }
    l = wave_sum(l);
    const size_t tok = (size_t)b * SEQ + s;
    const float yv = (oacc / l) * bf2f(ZA[tok * AW + h * 64 + lane]);
    Y[tok * DM + h * 64 + lane] = f2bf(yv);
}

__global__ void __launch_bounds__(256) k_ycomb(const float* OD, const float* dnw, const bf16_t* ZD, bf16_t* Y) {
    const int tid = threadIdx.x, lane = tid & 63, wave = tid >> 6;
    const int gw = blockIdx.x * 4 + wave, ngw = gridDim.x * 4;
    for (int it = gw; it < MTOK * DH; it += ngw) {
        const int row = it >> 2, hh = it & 3;
        const float a0 = OD[(size_t)row * AW + hh * 128 + lane], a1 = OD[(size_t)row * AW + hh * 128 + 64 + lane];
        const float ss = wave_sum(a0 * a0 + a1 * a1);
        const float rs = 1.0f / sqrtf(ss * (1.0f / 128.0f) + EPS);
        Y[(size_t)row * DM + 512 + hh * 128 + lane] = f2bf(a0 * rs * dnw[lane] * bf2f(ZD[(size_t)row * AW + hh * 128 + lane]));
        Y[(size_t)row * DM + 512 + hh * 128 + 64 + lane] = f2bf(a1 * rs * dnw[64 + lane] * bf2f(ZD[(size_t)row * AW + hh * 128 + 64 + lane]));
    }
}


#define CBAR_ALL() do{ asm volatile("s_waitcnt vmcnt(0) lgkmcnt(0)":::"memory"); __builtin_amdgcn_s_barrier(); asm volatile("":::"memory"); }while(0)
#define CBAR_LDS() do{ asm volatile("s_waitcnt lgkmcnt(0)":::"memory"); __builtin_amdgcn_s_barrier(); asm volatile("":::"memory"); }while(0)
namespace pg8 {
#define PG8_LAS __attribute__((address_space(3)))
constexpr int BM = 256, BK = 64, HALF = 128, HTB = HALF * BK * 2  , STAGE_BYTES = 8 * HTB, NXCD = 8, WGM = 8;

__host__ __device__ __forceinline__ int lds_byte(int r, int c) { const int st = (r >> 4) * 2 + (c >> 5), rr = r & 15, cc = c & 31, ob = rr * 64 + cc * 2; return st * 1024 + (ob ^ (((ob >> 9) & 1) << 5)); }
__host__ __device__ __forceinline__ void stage_rc(int b, int& R, int& C) { const int st = b / 1024, sb = b % 1024, swz = sb ^ (((sb >> 9) & 1) << 5); R = (st >> 1) * 16 + swz / 64; C = (st & 1) * 32 + (swz % 64) / 2; }
__host__ __device__ __forceinline__ int perm32(int rho) { const int n = rho >> 4, i = rho & 15; return 8 * (i >> 2) + 4 * n + (i & 3); }

struct Unit { int pm, pn; };
struct Gemm { const bf16_t* A; const bf16_t* Bt; int M, N, K; };

struct StaticOrder {
    int nM, nN, nwg, G, c;
    __host__ __device__ void init(int M, int N, int G_, int c_) { nM = M / BM; nN = N / BM; nwg = nM * nN; G = G_; c = c_; }
    __host__ __device__ bool next(int i, Unit& u) const {
        const long L = (long)i * G + c; if (L >= nwg) return false;
        int wgid = (int)L; { const int q = nwg / NXCD, r = nwg % NXCD, xcd = wgid % NXCD, off = wgid / NXCD; wgid = (xcd < r ? xcd * (q + 1) : r * (q + 1) + (xcd - r) * q) + off; }
        const int nig = WGM * nN, gid = wgid / nig, fm = gid * WGM, gsz = (nM - fm) < WGM ? (nM - fm) : WGM;
        u.pm = fm + ((wgid % nig) % gsz); u.pn = (wgid % nig) / gsz; return true;
    }
    __device__ __forceinline__ void a_ready(const Unit&) const {}
    __device__ __forceinline__ void done(const Unit&) const {}
};

__device__ __forceinline__ unsigned cvt_pk_bf16(float lo, float hi) { unsigned r; asm volatile("v_cvt_pk_bf16_f32 %0, %1, %2" : "=v"(r) : "v"(lo), "v"(hi)); return r; }
typedef float f32x2 __attribute__((ext_vector_type(2)));
template <class Epi, class Sched, bool ALIGN_EPI = false, bool SP2 = false>
__device__ __forceinline__ void gemm_phase(PG8_LAS unsigned char* lds, const Gemm g, const Sched& S, const Epi& E) {
    const int tid = threadIdx.x, wid = __builtin_amdgcn_readfirstlane(tid >> 6), lane = tid & 63, wr = wid >> 2, wc = wid & 3, fr = lane & 15, fq = lane >> 4;
    const int K = g.K, nt = K / BK;
    unsigned voffA[2], voffB[2];
#pragma unroll
    for (int i = 0; i < 2; ++i) { int R, C; stage_rc(tid * 16 + i * 8192, R, C); const int Rb = Epi::PERM ? ((R & ~31) + perm32(R & 31)) : R;
        voffA[i] = (unsigned)(R * K + C) * 2u; voffB[i] = (unsigned)(Rb * K + C) * 2u; }
    const size_t kstep = (size_t)(BK * 2);
    const size_t hstep = (size_t)HALF * K * 2;
    const size_t tstep = 2 * hstep;
    const unsigned ldsw = (unsigned)wid * 1024u;
    const int aoff = lds_byte(wr * 64 + fr, fq * 8), boff = lds_byte(wc * 32 + fr, fq * 8);
#define PG8_SA(b, h) (((b) * 2 + (h)) * HTB)
#define PG8_SB(b, h) ((4 + (b) * 2 + (h)) * HTB)
#define PG8_STAGE(bufoff, gbase, voff) do { _Pragma("unroll") for (int _i = 0; _i < 2; ++_i) \
        __builtin_amdgcn_global_load_lds((const unsigned*)((const char*)(gbase) + (voff)[_i]), (PG8_LAS unsigned*)(lds + (bufoff) + ldsw + _i * 8192), 16, 0, 0); } while (0)
#define PG8_LDA(dst, b, h) do { _Pragma("unroll") for (int m = 0; m < 4; ++m) _Pragma("unroll") for (int k = 0; k < 2; ++k) dst[m][k] = *(const PG8_LAS bf16x8*)(lds + PG8_SA(b, h) + aoff + m * 2048 + k * 1024); } while (0)
#define PG8_LDB(dst, b, h) do { _Pragma("unroll") for (int n = 0; n < 2; ++n) _Pragma("unroll") for (int k = 0; k < 2; ++k) dst[n][k] = *(const PG8_LAS bf16x8*)(lds + PG8_SB(b, h) + boff + n * 2048 + k * 1024); } while (0)
#define PG8_MMA(ai, bj, At, Bt) do { __builtin_amdgcn_s_setprio(1); _Pragma("unroll") for (int m = 0; m < 4; ++m) _Pragma("unroll") for (int n = 0; n < 2; ++n) _Pragma("unroll") for (int k = 0; k < 2; ++k) \
        acc[ai][bj][m][n] = __builtin_amdgcn_mfma_f32_16x16x32_bf16(Bt[n][k], At[m][k], acc[ai][bj][m][n], 0, 0, 0); __builtin_amdgcn_s_setprio(0); } while (0)
#define PG8_WAIT_V(n) asm volatile("s_waitcnt vmcnt(" #n ")" ::: "memory")
#define PG8_WAIT_L(n) asm volatile("s_waitcnt lgkmcnt(" #n ")" ::: "memory")
#define PG8_BAR __builtin_amdgcn_s_barrier()
#define PG8_SCHED __builtin_amdgcn_sched_barrier(0)
    Unit cur, nxt; int ui = 0;
    if (!S.next(0, cur)) return;
    f32x4 acc[2][2][4][2];
#pragma unroll
    for (int a = 0; a < 2; ++a)
#pragma unroll
        for (int b = 0; b < 2; ++b)
#pragma unroll
            for (int m = 0; m < 4; ++m)
#pragma unroll
                for (int n = 0; n < 2; ++n) acc[a][b][m][n] = (f32x4){0.f, 0.f, 0.f, 0.f};
    bf16x8 At[4][2], B0[2][2], B1[2][2];
    const char* cA = (const char*)g.A + (size_t)cur.pm * tstep; const char* cB = (const char*)g.Bt + (size_t)cur.pn * tstep;
    S.a_ready(cur);
    if constexpr (SP2) {
        PG8_STAGE(PG8_SB(0, 0), cB, voffB); PG8_STAGE(PG8_SB(0, 1), cB + hstep, voffB); PG8_STAGE(PG8_SA(0, 0), cA, voffA); PG8_STAGE(PG8_SA(0, 1), cA + hstep, voffA);
        if (wr == 1) PG8_BAR;
        PG8_WAIT_V(2); PG8_BAR;
        PG8_STAGE(PG8_SB(1, 0), cB + kstep, voffB); PG8_STAGE(PG8_SA(1, 0), cA + kstep, voffA); PG8_STAGE(PG8_SB(1, 1), cB + hstep + kstep, voffB);
        PG8_WAIT_V(6); PG8_BAR;
    } else {
        PG8_STAGE(PG8_SB(0, 0), cB, voffB); PG8_STAGE(PG8_SA(0, 0), cA, voffA); PG8_STAGE(PG8_SB(0, 1), cB + hstep, voffB); PG8_STAGE(PG8_SA(0, 1), cA + hstep, voffA);
        if (wr == 1) PG8_BAR;
        PG8_WAIT_V(4); PG8_BAR;
        PG8_STAGE(PG8_SB(1, 0), cB + kstep, voffB); PG8_STAGE(PG8_SA(1, 0), cA + kstep, voffA); PG8_STAGE(PG8_SB(1, 1), cB + hstep + kstep, voffB);
        PG8_WAIT_V(6); PG8_BAR;
    }
    for (;;) {
        const bool has_next = S.next(ui + 1, nxt);
        const char* nA = has_next ? (const char*)g.A + (size_t)nxt.pm * tstep : cA; const char* nB = has_next ? (const char*)g.Bt + (size_t)nxt.pn * tstep : cB;
        for (int t = 0; t < nt; t += 2) {
            const bool last = (t == nt - 2);
            const char* a1 = cA + (size_t)(t + 1) * kstep;
            const char* a2 = last ? nA : cA + (size_t)(t + 2) * kstep; const char* b2 = last ? nB : cB + (size_t)(t + 2) * kstep;
            const char* a3 = a2 + kstep; const char* b3 = b2 + kstep;
            if (last && has_next) S.a_ready(nxt);
            if constexpr (SP2) {
            PG8_LDB(B0, 0, 0); PG8_LDB(B1, 0, 1); PG8_SCHED; PG8_LDA(At, 0, 0); PG8_STAGE(PG8_SA(1, 1), a1 + hstep, voffA);
            PG8_WAIT_V(8); PG8_WAIT_L(0); PG8_BAR; PG8_MMA(0, 0, At, B0); PG8_MMA(0, 1, At, B1); PG8_BAR; PG8_SCHED;
            PG8_LDA(At, 0, 1); PG8_STAGE(PG8_SB(0, 0), b2, voffB); PG8_STAGE(PG8_SB(0, 1), b2 + hstep, voffB); PG8_STAGE(PG8_SA(0, 0), a2, voffA);
            PG8_WAIT_V(8); PG8_WAIT_L(0); PG8_BAR; PG8_MMA(1, 0, At, B0); PG8_MMA(1, 1, At, B1); PG8_BAR; PG8_SCHED;
            PG8_LDB(B0, 1, 0); PG8_LDB(B1, 1, 1); PG8_SCHED; PG8_LDA(At, 1, 0); PG8_STAGE(PG8_SA(0, 1), a2 + hstep, voffA);
            PG8_WAIT_V(8); PG8_WAIT_L(0); PG8_BAR; PG8_MMA(0, 0, At, B0); PG8_MMA(0, 1, At, B1); PG8_BAR; PG8_SCHED;
            PG8_LDA(At, 1, 1); PG8_STAGE(PG8_SB(1, 0), b3, voffB); PG8_STAGE(PG8_SB(1, 1), b3 + hstep, voffB); PG8_STAGE(PG8_SA(1, 0), a3, voffA);
            PG8_WAIT_V(8); PG8_WAIT_L(0); PG8_BAR; PG8_MMA(1, 0, At, B0); PG8_MMA(1, 1, At, B1); PG8_BAR; PG8_SCHED;
            } else {
            PG8_LDB(B0, 0, 0); PG8_SCHED; PG8_LDA(At, 0, 0); PG8_STAGE(PG8_SA(1, 1), a1 + hstep, voffA);
            PG8_WAIT_L(8); PG8_BAR; PG8_WAIT_L(0); PG8_MMA(0, 0, At, B0); PG8_BAR; PG8_SCHED;
            PG8_LDB(B1, 0, 1); PG8_STAGE(PG8_SB(0, 0), b2, voffB);
            PG8_BAR; PG8_WAIT_L(0); PG8_MMA(0, 1, At, B1); PG8_BAR;
            PG8_LDA(At, 0, 1); PG8_STAGE(PG8_SA(0, 0), a2, voffA);
            PG8_BAR; PG8_WAIT_L(0); PG8_MMA(1, 0, At, B0); PG8_BAR; PG8_SCHED;
            PG8_STAGE(PG8_SB(0, 1), b2 + hstep, voffB);
            PG8_WAIT_V(6); PG8_BAR; PG8_MMA(1, 1, At, B1); PG8_BAR;
            PG8_LDB(B0, 1, 0); PG8_SCHED; PG8_LDA(At, 1, 0); PG8_STAGE(PG8_SA(0, 1), a2 + hstep, voffA);
            PG8_WAIT_L(8); PG8_BAR; PG8_WAIT_L(0); PG8_MMA(0, 0, At, B0); PG8_BAR; PG8_SCHED;
            PG8_LDB(B1, 1, 1); PG8_STAGE(PG8_SB(1, 0), b3, voffB);
            PG8_BAR; PG8_WAIT_L(0); PG8_MMA(0, 1, At, B1); PG8_BAR;
            PG8_LDA(At, 1, 1); PG8_STAGE(PG8_SA(1, 0), a3, voffA);
            PG8_BAR; PG8_WAIT_L(0); PG8_MMA(1, 0, At, B0); PG8_BAR; PG8_SCHED;
            PG8_STAGE(PG8_SB(1, 1), b3 + hstep, voffB);
            PG8_WAIT_V(6); PG8_BAR; PG8_MMA(1, 1, At, B1); PG8_BAR;
            }
        }
        if constexpr (ALIGN_EPI) { if (wr == 0) PG8_BAR; }
        if constexpr (!Epi::AFTER_DRAIN) { E(acc, cur, wr, wc, fr, fq); S.done(cur); }
        if (!has_next) break;
#pragma unroll
        for (int a = 0; a < 2; ++a)
#pragma unroll
            for (int b = 0; b < 2; ++b)
#pragma unroll
                for (int m = 0; m < 4; ++m)
#pragma unroll
                    for (int n = 0; n < 2; ++n) acc[a][b][m][n] = (f32x4){0.f, 0.f, 0.f, 0.f};
        cur = nxt; cA = nA; cB = nB; ++ui;
        if constexpr (ALIGN_EPI) { if (wr == 1) PG8_BAR; }
    }
    PG8_WAIT_V(0);
    if constexpr (!ALIGN_EPI) { if (wr == 0) PG8_BAR; }
    PG8_BAR;
    if constexpr (Epi::AFTER_DRAIN) { E.fused(acc, cur, wr, wc, fr, fq, lds, wid, lane); S.done(cur); }
#undef PG8_SA
#undef PG8_SB
#undef PG8_STAGE
#undef PG8_LDA
#undef PG8_LDB
#undef PG8_MMA
#undef PG8_WAIT_V
#undef PG8_WAIT_L
#undef PG8_BAR
#undef PG8_SCHED
}
}

namespace pg8 {
__device__ __forceinline__ float fast_silu(float x) { return x * __builtin_amdgcn_rcpf(1.0f + __expf(-x)); }
struct EpiProj {
    static constexpr bool PERM = true, AFTER_DRAIN = false;
    bf16_t *QA, *KA, *VA, *ZA, *ZD, *QKVD; float* KMEAN; const float *qnw, *knw; int pt_off;
    __device__ __forceinline__ void operator()(const f32x4 (&acc)[2][2][4][2], const Unit& u, int wr, int wc, int fr, int fq) const {
        const int pn = wt1_ltile(u.pn + pt_off), b = u.pm >> 5, blk = u.pm & 31;
        const int s0 = blk * 256 + wr * 64 + fr;
        const int row0 = u.pm * BM + wr * 64 + fr;
        if (pn < 4) {
            const bool isq = pn < 2; const int head = (pn & 1) * 4 + wc; const float* nwp = isq ? qnw : knw;
            f32x4 nw[2][2];
#pragma unroll
            for (int bj = 0; bj < 2; ++bj)
#pragma unroll
                for (int n = 0; n < 2; ++n) nw[bj][n] = *(const f32x4*)(nwp + 32 * bj + 8 * fq + 4 * n);
            f32x4 ksum[2][2];
#pragma unroll
            for (int bj = 0; bj < 2; ++bj)
#pragma unroll
                for (int n = 0; n < 2; ++n) ksum[bj][n] = (f32x4){0.f, 0.f, 0.f, 0.f};
            bf16_t* dbase = (isq ? QA : KA) + ((size_t)(b * 8 + head) * 8192) * 64 + 8 * fq;
            const float sc = isq ? 0.125f * 1.4426950408889634f : 1.0f;
#pragma unroll
            for (int ai = 0; ai < 2; ++ai)
#pragma unroll
                for (int m = 0; m < 4; ++m) {
                    float ss = 0.f;
#pragma unroll
                    for (int bj = 0; bj < 2; ++bj)
#pragma unroll
                        for (int n = 0; n < 2; ++n) { const f32x4 v = acc[ai][bj][m][n]; ss += (v[0] * v[0] + v[1] * v[1]) + (v[2] * v[2] + v[3] * v[3]); }
                    ss += __shfl_xor(ss, 16); ss += __shfl_xor(ss, 32);
                    const float rs = (1.0f / sqrtf(ss * (1.0f / 64.0f) + 1e-6f));
                    bf16_t* dst = dbase + (size_t)(s0 + ai * 128 + m * 16) * 64;
#pragma unroll
                    for (int bj = 0; bj < 2; ++bj) {
                        const f32x4 v0 = acc[ai][bj][m][0] * rs * nw[bj][0], v1 = acc[ai][bj][m][1] * rs * nw[bj][1];
                        ksum[bj][0] += v0; ksum[bj][1] += v1;
                        u32x4 w; w.x = cvt_pk_bf16(v0[0] * sc, v0[1] * sc); w.y = cvt_pk_bf16(v0[2] * sc, v0[3] * sc); w.z = cvt_pk_bf16(v1[0] * sc, v1[1] * sc); w.w = cvt_pk_bf16(v1[2] * sc, v1[3] * sc);
                        *(u32x4*)(dst + 32 * bj) = w;
                    }
                }
            if (!isq) {
                float* km = KMEAN + ((size_t)(b * 8 + head) * 32 + blk) * 64 + 8 * fq;
#pragma unroll
                for (int bj = 0; bj < 2; ++bj)
#pragma unroll
                    for (int n = 0; n < 2; ++n)
#pragma unroll
                        for (int e = 0; e < 4; ++e) {
                            float t = ksum[bj][n][e];
                            t += __shfl_xor(t, 1); t += __shfl_xor(t, 2); t += __shfl_xor(t, 4); t += __shfl_xor(t, 8);
                            if (fr == 0) atomicAdd(km + 32 * bj + 4 * n + e, t * (1.0f / 256.0f));
                        }
            }
        } else {
            bf16_t* dbase; size_t ld; int colb; bool act;
            if (pn < 6) { const int head = (pn - 4) * 4 + wc; dbase = VA + ((size_t)(b * 8 + head) * 8192 + blk * 256) * 64; ld = 64; colb = 0; act = false; }
            else if (pn < 8) { dbase = ZA + (size_t)(u.pm * BM) * 512; ld = 512; colb = (pn - 6) * 256 + wc * 64; act = true; }
            else if (pn < 14) { dbase = QKVD + (size_t)(u.pm * BM) * 1536; ld = 1536; colb = (pn - 8) * 256 + wc * 64; act = false; }
            else { dbase = ZD + (size_t)(u.pm * BM) * 512; ld = 512; colb = (pn - 14) * 256 + wc * 64; act = true; }
            const int rloc = wr * 64 + fr;
#pragma unroll
            for (int ai = 0; ai < 2; ++ai)
#pragma unroll
                for (int m = 0; m < 4; ++m) {
                    bf16_t* dst = dbase + (size_t)(rloc + ai * 128 + m * 16) * ld + colb + 8 * fq;
#pragma unroll
                    for (int bj = 0; bj < 2; ++bj) {
                        f32x4 v0 = acc[ai][bj][m][0], v1 = acc[ai][bj][m][1];
                        if (act) {
#pragma unroll
                            for (int e = 0; e < 4; ++e) { v0[e] = fast_silu(v0[e]); v1[e] = fast_silu(v1[e]); }
                        }
                        u32x4 w; w.x = cvt_pk_bf16(v0[0], v0[1]); w.y = cvt_pk_bf16(v0[2], v0[3]); w.z = cvt_pk_bf16(v1[0], v1[1]); w.w = cvt_pk_bf16(v1[2], v1[3]);
                        *(u32x4*)(dst + 32 * bj) = w;
                    }
                }
        }
        (void)row0;
    }
};
struct EpiOut {
    static constexpr bool PERM = false, AFTER_DRAIN = false;
    const float* X; float* O;
    __device__ __forceinline__ void operator()(const f32x4 (&acc)[2][2][4][2], const Unit& u, int wr, int wc, int fr, int fq) const {
        const int row0 = u.pm * BM + wr * 64 + fr, col0 = u.pn * BM + wc * 32 + 4 * fq;
#pragma unroll
        for (int ai = 0; ai < 2; ++ai)
#pragma unroll
            for (int m = 0; m < 4; ++m) { const size_t off = (size_t)(row0 + ai * HALF + m * 16) * 1024 + col0;
#pragma unroll
                for (int bj = 0; bj < 2; ++bj)
#pragma unroll
                    for (int n = 0; n < 2; ++n) { const f32x4 xv = *(const f32x4*)(X + off + bj * HALF + n * 16); *(f32x4*)(O + off + bj * HALF + n * 16) = xv + acc[ai][bj][m][n]; } }
    }
};
}

#define LAS __attribute__((address_space(3)))
constexpr int NWAVES = 8;
constexpr int RING_OFF = 0;
constexpr int LDS_BYTES = 163840;
constexpr int LDSCTL_OFF = LDS_BYTES - 1024, MISC_OFF = LDSCTL_OFF + 320;
constexpr int CW_BAR = 4096;

#define XB_TMO      128
#define XB_XCNT(j)  (256  + 64 * (j))
#define XB_XSUB(j)  (1280 + 64 * (j))
#define XB_XGEN(j)  (2304 + 64 * (j))
#define XB_TOP      3328
#define XB_TOPGEN   3392
#define XCD_BAR_WORDS 3456
#define XB_SPIN_CAP (1u << 18)
__device__ __forceinline__ unsigned xb_ld(unsigned* p)              { return __hip_atomic_load(p, __ATOMIC_RELAXED, __HIP_MEMORY_SCOPE_AGENT); }
__device__ __forceinline__ unsigned xb_add(unsigned* p, unsigned v) { return __hip_atomic_fetch_add(p, v, __ATOMIC_RELAXED, __HIP_MEMORY_SCOPE_AGENT); }
__device__ __forceinline__ unsigned xb_xcc_id() { return (unsigned)__builtin_amdgcn_s_getreg((3 << 11) | 20) & 0xFu; }
#define XB_SPIN(cond, bar) do { unsigned _sp = 0; while (cond) { __builtin_amdgcn_s_sleep(1); \
    if ((++_sp & 255u) == 0u) { if (xb_ld(&(bar)[XB_TMO])) break; if (_sp > XB_SPIN_CAP) { atomicAdd(&(bar)[XB_TMO], 1u); break; } } } } while (0)
struct XcdBarrier { unsigned* bar; unsigned x; volatile LAS unsigned* st; };
__device__ __forceinline__ XcdBarrier xcd_barrier_post(unsigned* bar, volatile LAS unsigned* st) {
    XcdBarrier b; b.bar = bar; b.x = xb_xcc_id(); b.st = st;
    if (threadIdx.x == 0) (void)xb_add(&bar[XB_XCNT(b.x)], 1u);
    return b;
}
__device__ __forceinline__ void xcd_barrier_complete(unsigned* bar, unsigned x, unsigned& nloc, unsigned& nx) {
    const unsigned G = gridDim.x * gridDim.y * gridDim.z;
    unsigned sum, cnt, mine, sp = 0u;
    for (;;) {
        sum = 0u; cnt = 0u; mine = 0u;
#pragma unroll
        for (unsigned j = 0; j < 16; ++j) { const unsigned c = xb_ld(&bar[XB_XCNT(j)]); sum += c; cnt += (c > 0u) ? 1u : 0u; mine = (j == x) ? c : mine; }
        if (sum == G) break;
        __builtin_amdgcn_s_sleep(1);
        if ((++sp & 255u) == 0u) { if (xb_ld(&bar[XB_TMO])) break; if (sp > XB_SPIN_CAP) { atomicAdd(&bar[XB_TMO], 1u); break; } }
    }
    nloc = mine > 0u ? mine : 1u; nx = cnt > 0u ? cnt : 1u;
}
__device__ __forceinline__ void xcd_barrier(const XcdBarrier& b) {
    asm volatile("s_waitcnt vmcnt(0)" ::: "memory");
    __syncthreads();
    if (threadIdx.x == 0) {
        unsigned* bar = b.bar;
        __builtin_amdgcn_s_waitcnt(0);
        unsigned nloc = b.st[0], nx = b.st[1];
        if (nloc == 0u) { xcd_barrier_complete(bar, b.x, nloc, nx); b.st[0] = nloc; b.st[1] = nx; }
        const unsigned old = xb_add(&bar[XB_XSUB(b.x)], 1u);
        const unsigned gen = old / nloc;
        if (old + 1u == (gen + 1u) * nloc) {
            __builtin_amdgcn_fence(__ATOMIC_RELEASE, "agent");
            asm volatile("s_waitcnt vmcnt(0)" ::: "memory");
            const unsigned og = xb_add(&bar[XB_TOP], 1u);
            const unsigned tg = og / nx;
            if (og + 1u == (tg + 1u) * nx) xb_add(&bar[XB_TOPGEN], 1u);
            else XB_SPIN(xb_ld(&bar[XB_TOPGEN]) == tg, bar);
            __builtin_amdgcn_fence(__ATOMIC_ACQUIRE, "agent");
            xb_add(&bar[XB_XGEN(b.x)], 1u);
            asm volatile("s_waitcnt vmcnt(0)" ::: "memory");
        } else {
            XB_SPIN(xb_ld(&bar[XB_XGEN(b.x)]) == gen, bar);
            __builtin_amdgcn_fence(__ATOMIC_ACQUIRE, "agent");
            asm volatile("s_waitcnt vmcnt(0)" ::: "memory");
        }
    }
    __syncthreads();
}

struct Ptrs {
    const float *x, *rel_bias, *norm_w, *w_in, *qnw, *knw, *conv_w, *a_log, *dt_bias, *dnw, *w_out;
    float* out; bf16_t* HN; bf16_t *WT1, *WT2; float *BETA, *GDEC, *KMEAN; bf16_t *QA, *KA, *VA, *ZA, *ZD, *QKVD, *QD, *KD, *VD; float* OD; bf16_t* Y; unsigned* ctl; unsigned char* REC; float* GLB; unsigned* SEL; unsigned short* LIST; float* LP; bf16_t* OPART;
};
__host__ __device__ inline Ptrs make_ptrs(void* const* d_in, void* d_out, unsigned char* ws) {
    Ptrs p;
    p.x = (const float*)d_in[0]; p.rel_bias = (const float*)d_in[1]; p.norm_w = (const float*)d_in[2]; p.w_in = (const float*)d_in[3]; p.qnw = (const float*)d_in[4]; p.knw = (const float*)d_in[5];
    p.conv_w = (const float*)d_in[6]; p.a_log = (const float*)d_in[7]; p.dt_bias = (const float*)d_in[8]; p.dnw = (const float*)d_in[9]; p.w_out = (const float*)d_in[10];
    p.out = (float*)d_out; p.HN = (bf16_t*)d_out;
    p.WT1 = (bf16_t*)(ws + WS_WT1); p.WT2 = (bf16_t*)(ws + WS_WT2); p.BETA = (float*)(ws + WS_BETA); p.GDEC = (float*)(ws + WS_GDEC); p.KMEAN = (float*)(ws + WS_KMEAN);
    p.QA = (bf16_t*)(ws + WS_QA); p.KA = (bf16_t*)(ws + WS_KA); p.VA = (bf16_t*)(ws + WS_VA); p.ZA = (bf16_t*)(ws + WS_ZA); p.ZD = (bf16_t*)(ws + WS_ZD); p.QKVD = (bf16_t*)(ws + WS_QKVD);
    p.QD = (bf16_t*)(ws + WS_QD); p.KD = (bf16_t*)(ws + WS_KD); p.VD = (bf16_t*)(ws + WS_VD); p.OD = (float*)((unsigned char*)d_out + OUT_OD); p.Y = (bf16_t*)(ws + WS_Y); p.ctl = (unsigned*)(ws + WS_CTL); p.REC = ws + WS_REC; p.GLB = (float*)(ws + WS_GLB);
    { unsigned char* o8 = (unsigned char*)d_out; p.SEL = (unsigned*)o8; p.LIST = (unsigned short*)(o8 + 1 * MiB); p.LP = (float*)(o8 + 17 * MiB); p.OPART = (bf16_t*)(o8 + 21 * MiB); }
    return p;
}


namespace dn {
using f32x16=__attribute__((ext_vector_type(16)))float;
typedef unsigned u32x2v __attribute__((ext_vector_type(2)));
constexpr int REC_NW=0, REC_QD=16384, REC_KT=32768, REC_AI=49152, REC_U=57344, REC_BYTES=73728;
constexpr int CH=64;
__device__ __forceinline__ int crow(int r,int hi){return (r&3)+8*(r>>2)+4*hi;}
typedef float f32x2_t __attribute__((ext_vector_type(2))); typedef __bf16 bf16x2_t __attribute__((ext_vector_type(2)));
__device__ __forceinline__ unsigned cvtpk(float lo,float hi){f32x2_t v={lo,hi};bf16x2_t b=__builtin_convertvector(v,bf16x2_t);return __builtin_bit_cast(unsigned,b);}
__device__ __forceinline__ float bflo(unsigned w){return __uint_as_float(w<<16);}
__device__ __forceinline__ float bfhi(unsigned w){return __uint_as_float(w&0xffff0000u);}
#define DN_MFMA32(a,b,c) __builtin_amdgcn_mfma_f32_32x32x16_bf16((a),(b),(c),0,0,0)
#ifndef SCANDBG
#define SCANDBG 0
#endif
#define DN_MFMA4(a,b,c) __builtin_amdgcn_mfma_f32_16x16x4f32((a),(b),(c),0,0,0)
#define DN_BAR() CBAR_ALL()
__device__ __forceinline__ void st16_wt(void*p,u32x4 v){ asm volatile("global_store_dwordx4 %0, %1, off sc1\n\ts_nop 1"::"v"(p),"v"(v):"memory"); }
__device__ __forceinline__ void st8_wt(void*p,unsigned lo,unsigned hi){ __hip_atomic_store((unsigned long long*)p,((unsigned long long)hi<<32)|lo,__ATOMIC_RELAXED,__HIP_MEMORY_SCOPE_AGENT); }

constexpr int P_QI=0, P_KI=16384, P_XT=32768, XT_LD=68, P_LF=P_XT+256*XT_LD*4, LF_LD=68, P_DF=P_LF+64*LF_LD*4, DF_LD=20, P_GC=P_DF+4*16*DF_LD*4, P_EG=P_GC+256, P_EKD=P_EG+256, P_BETA=P_EKD+256, P_END=P_BETA+256;
static_assert(P_END<=131072,"prep LDS");

__device__ __forceinline__ void prep_chunk(int c,const bf16_t*QKVD,const float*conv_w,const float*BETA,const float*GDEC,unsigned char*rec,float*GLB,unsigned*flags,LAS unsigned char*lds,int pdbg=0){
  const int tid=threadIdx.x; int lane=tid&63; asm volatile("":"+v"(lane));
  const int wid=__builtin_amdgcn_readfirstlane(tid>>6);
  const int bh=c>>7,n=c&127,b=bh>>2,h=bh&3,s0=n*CH; const size_t tok0=(size_t)b*SEQ+s0;
  LAS float*GC=(LAS float*)(lds+P_GC); LAS float*EG=(LAS float*)(lds+P_EG); LAS float*EKD=(LAS float*)(lds+P_EKD); LAS float*BT=(LAS float*)(lds+P_BETA);
  LAS float*XT=(LAS float*)(lds+P_XT); LAS float*LF=(LAS float*)(lds+P_LF); LAS float*DF=(LAS float*)(lds+P_DF);
  float g_l=GDEC[(size_t)bh*SEQ+s0+lane]; const float bt_l=BETA[(size_t)bh*SEQ+s0+lane];
  #pragma unroll
  for(int o=1;o<64;o<<=1){ const float t=__shfl_up(g_l,o); if(lane>=o)g_l+=t; }
  const float eg_l=__expf(g_l);
  if(wid==0){
    const float gl=__shfl(g_l,63);
    GC[lane]=g_l; EG[lane]=eg_l; EKD[lane]=__expf(gl-g_l); BT[lane]=bt_l;
    if(lane==63)__hip_atomic_store(GLB+c,eg_l,__ATOMIC_RELAXED,__HIP_MEMORY_SCOPE_AGENT);
  }
  {
    float cw[3][4][2];
    #pragma unroll
    for(int p=0;p<3;++p)
      #pragma unroll
      for(int j=0;j<4;++j){ const float2 w2=*(const float2*)(conv_w+j*DCONV+p*512+h*128+2*lane); cw[p][j][0]=w2.x; cw[p][j][1]=w2.y; }
    unsigned xr[3][11];
    #pragma unroll
    for(int rr=0;rr<11;++rr){ const int sp=s0+8*wid-3+rr;
      #pragma unroll
      for(int p=0;p<3;++p) xr[p][rr]=(sp>=0)?*(const unsigned*)(QKVD+(tok0+8*wid-3+rr)*DCONV+p*512+h*128+2*lane):0u; }
    #pragma unroll
    for(int i=0;i<8;++i){
      const int pos=8*wid+i;
      float v[3][2];
      #pragma unroll
      for(int p=0;p<3;++p){ float a0=0.f,a1=0.f;
        #pragma unroll
        for(int j=0;j<4;++j){ a0+=cw[p][j][0]*bflo(xr[p][i+j]); a1+=cw[p][j][1]*bfhi(xr[p][i+j]); }
        v[p][0]=a0*__builtin_amdgcn_rcpf(1.0f+__expf(-a0)); v[p][1]=a1*__builtin_amdgcn_rcpf(1.0f+__expf(-a1)); }
      const float sq=wave_sum(v[0][0]*v[0][0]+v[0][1]*v[0][1]), sk=wave_sum(v[1][0]*v[1][0]+v[1][1]*v[1][1]);
      const float rq=(1.0f/sqrtf(sq+EPS))*0.08838834764831845f, rk=1.0f/sqrtf(sk+EPS);
      const float q0=v[0][0]*rq,q1=v[0][1]*rq,k0=v[1][0]*rk,k1=v[1][1]*rk;
      const int ch=2*lane; const int off=((ch>>3)*64+pos)*16+(ch&7)*2;
      *(LAS unsigned*)(lds+P_QI+off)=cvtpk(q0,q1);
      *(LAS unsigned*)(lds+P_KI+off)=cvtpk(k0,k1);
      const float bt=__shfl(bt_l,pos), be=bt*__shfl(eg_l,pos);
      XT[(ch)*XT_LD+pos]=v[2][0]*bt; XT[(ch+1)*XT_LD+pos]=v[2][1]*bt;
      XT[(128+ch)*XT_LD+pos]=k0*be; XT[(128+ch+1)*XT_LD+pos]=k1*be;
    }
  }
  CBAR_LDS();
  {
    const int r32=lane&31,hi=lane>>5;
    if(wid<6){
      const int kind=wid/3, w3=wid%3;
      const int ta=(kind==0)?(w3==0?0:1):(w3==2?1:0);
      const int tb=(kind==0)?(w3==2?1:0):(w3==0?0:1);
      const LAS unsigned char*Ab=lds+P_KI+(32*ta+r32)*16+hi*1024;
      const LAS unsigned char*Bb=lds+(kind==0?P_KI:P_QI)+(32*tb+r32)*16+hi*1024;
      f32x16 acc=f32x16{};
      #pragma unroll
      for(int ks=0;ks<8;++ks){ const bf16x8 a=*(const LAS bf16x8*)(Ab+ks*2048), bb=*(const LAS bf16x8*)(Bb+ks*2048); acc=DN_MFMA32(a,bb,acc); }
      if(kind==0){
        const int j=32*tb+r32; const float gj=GC[j];
        #pragma unroll
        for(int r=0;r<16;++r){ const int i=32*ta+crow(r,0)+4*hi; const float val=(j<i)?BT[i]*acc[r]*__expf(GC[i]-gj):0.f; LF[i*LF_LD+j]=val; }
      } else {
        const int i=32*tb+r32; const float gi=GC[i];
        float o_[16];
        #pragma unroll
        for(int r=0;r<16;++r){ const int j=32*ta+crow(r,0)+4*hi; o_[r]=(j<=i)?acc[r]*__expf(gi-GC[j]):0.f; }
        #pragma unroll
        for(int s=0;s<2;++s){ u32x4 w; w.x=cvtpk(o_[8*s],o_[8*s+1]); w.y=cvtpk(o_[8*s+2],o_[8*s+3]); w.z=cvtpk(o_[8*s+4],o_[8*s+5]); w.w=cvtpk(o_[8*s+6],o_[8*s+7]);
          st16_wt(rec+REC_AI+((tb*4+2*ta+s)*64+lane)*16,w); }
      }
    }
  }
  CBAR_LDS();
  if(pdbg&2){} else
  if(wid==0){
    const int bb=lane>>4,j=lane&15; float t[16];
    const LAS float*Lb=LF+(16*bb)*LF_LD+16*bb;
    f32x4 rw[16][4];
    #pragma unroll
    for(int i=1;i<16;++i)
      #pragma unroll
      for(int q=0;q<(i+3)/4;++q) rw[i][q]=*(const LAS f32x4*)(Lb+i*LF_LD+4*q);
    #pragma unroll
    for(int i=0;i<16;++i){ float s=(i==j)?1.0f:0.0f;
      #pragma unroll
      for(int m=0;m<i;++m) s-=rw[i][m>>2][m&3]*t[m];
      t[i]=s; DF[(bb*16+i)*DF_LD+j]=s; }
  } else {
    const int r32=lane&31,hi=lane>>5;
    for(int f=wid-1;f<32;f+=7){
      if(f<16){
        const int i2=f>>3,ks=f&7,pos=32*i2+r32; const float e=EG[pos];
        const u32x2v lo=*(const LAS u32x2v*)(lds+P_QI+((2*ks)*64+pos)*16+8*hi), hi2=*(const LAS u32x2v*)(lds+P_QI+((2*ks+1)*64+pos)*16+8*hi);
        u32x4 w; w.x=cvtpk(bflo(lo.x)*e,bfhi(lo.x)*e); w.y=cvtpk(bflo(lo.y)*e,bfhi(lo.y)*e); w.z=cvtpk(bflo(hi2.x)*e,bfhi(hi2.x)*e); w.w=cvtpk(bflo(hi2.y)*e,bfhi(hi2.y)*e);
        st16_wt(rec+REC_QD+(f*64+lane)*16,w);
      } else {
        const int f2=f-16,t=f2>>2,ks=f2&3,dk=32*t+r32; const LAS unsigned short*kp=(const LAS unsigned short*)(lds+P_KI+(dk>>3)*1024+(dk&7)*2);
        const f32x4 e0=*(const LAS f32x4*)(EKD+16*ks+4*hi), e1=*(const LAS f32x4*)(EKD+16*ks+8+4*hi);
        float x[8];
        #pragma unroll
        for(int j=0;j<8;++j){ const int pos=16*ks+8*(j>>2)+4*hi+(j&3); x[j]=__uint_as_float(((unsigned)kp[pos*8])<<16)*((j<4)?e0[j&3]:e1[j&3]); }
        u32x4 w; w.x=cvtpk(x[0],x[1]); w.y=cvtpk(x[2],x[3]); w.z=cvtpk(x[4],x[5]); w.w=cvtpk(x[6],x[7]);
        st16_wt(rec+REC_KT+(f2*64+lane)*16,w);
      }
    }
  }
  CBAR_LDS();
  if(!(pdbg&1))
  {
    const int cl=lane&15,g=lane>>4;
    #define PK4(v) cvtpk((v)[0],(v)[1]),cvtpk((v)[2],(v)[3])
    #define FRAG(a_,b_) __builtin_bit_cast(bf16x8,(u32x4){PK4(a_),PK4(b_)})
    #define DN_MFMA16(a,b,c) __builtin_amdgcn_mfma_f32_16x16x32_bf16((a),(b),(c),0,0,0)
    const f32x4 z4=(f32x4){0.f,0.f,0.f,0.f};
    #pragma unroll 1
    for(int cc=0;cc<2;++cc){
      const int ct=2*wid+cc, col=16*ct+cl;
      f32x4 Y[4];
      #pragma unroll
      for(int bb=0;bb<4;++bb){
        f32x4 acc=*(const LAS f32x4*)(XT+col*XT_LD+16*bb+4*g);
        const LAS float*Lr=LF+(16*bb+cl)*LF_LD+4*g;
        if(bb==1){ const f32x4 l0=-*(const LAS f32x4*)(Lr); acc=DN_MFMA16(FRAG(l0,z4),FRAG(Y[0],z4),acc); }
        if(bb==2){ const f32x4 l0=-*(const LAS f32x4*)(Lr), l1=-*(const LAS f32x4*)(Lr+16); acc=DN_MFMA16(FRAG(l0,l1),FRAG(Y[0],Y[1]),acc); }
        if(bb==3){ const f32x4 l0=-*(const LAS f32x4*)(Lr), l1=-*(const LAS f32x4*)(Lr+16), l2=-*(const LAS f32x4*)(Lr+32);
          acc=DN_MFMA16(FRAG(l0,l1),FRAG(Y[0],Y[1]),acc); acc=DN_MFMA16(FRAG(l2,z4),FRAG(Y[2],z4),acc); }
        const f32x4 Da=*(const LAS f32x4*)(DF+(bb*16+cl)*DF_LD+4*g);
        Y[bb]=DN_MFMA16(FRAG(Da,z4),FRAG(acc,z4),z4);
      }
      if(ct<8){
        const int dv=col,c4=dv>>5,r32=dv&31;
        #pragma unroll
        for(int bb=0;bb<4;++bb){ const int i2=bb>>1,rh=bb&1,hi2=g&1;
          st8_wt(rec+REC_U+((((c4*2+i2)*2+rh)*64+hi2*32+r32)*8+4*(g>>1))*2,cvtpk(Y[bb][0],Y[bb][1]),cvtpk(Y[bb][2],Y[bb][3])); }
      } else {
        const int kt=ct-8;
        f32x4 sel; sel[0]=(cl==4*g)?-1.f:0.f; sel[1]=(cl==4*g+1)?-1.f:0.f; sel[2]=(cl==4*g+2)?-1.f:0.f; sel[3]=(cl==4*g+3)?-1.f:0.f;
        const bf16x8 selb=FRAG(sel,z4);
        #pragma unroll
        for(int bb=0;bb<4;++bb){
          const f32x4 zt=DN_MFMA16(FRAG(Y[bb],z4),selb,z4);
          const int pos=16*bb+cl,i2=pos>>5,r32=pos&31,hi2=g&1;
          st8_wt(rec+REC_NW+(((i2*8+kt)*64+hi2*32+r32)*8+4*(g>>1))*2,cvtpk(zt[0],zt[1]),cvtpk(zt[2],zt[3])); }
      }
    }
    #undef PK4
    #undef FRAG
    #undef DN_MFMA16
  }
  CBAR_LDS();
}

__device__ __forceinline__ void glds16(const void*gsrc,unsigned lds_dst){unsigned keep;
  asm volatile("s_mov_b32 %0, m0\n\ts_mov_b32 m0, %2\n\ts_nop 0\n\tglobal_load_lds_dwordx4 %1, off\n\ts_mov_b32 m0, %0":"=&s"(keep):"v"(gsrc),"s"(lds_dst):"memory");}
__device__ __forceinline__ void glds4(const void*gsrc,unsigned lds_dst){unsigned keep;
  asm volatile("s_mov_b32 %0, m0\n\ts_mov_b32 m0, %2\n\ts_nop 0\n\tglobal_load_lds_dword %1, off\n\ts_mov_b32 m0, %0":"=&s"(keep):"v"(gsrc),"s"(lds_dst):"memory");}
__device__ __forceinline__ bf16x8 pack8(const f32x16&x,int s){ u32x4 p; p.x=cvtpk(x[8*s],x[8*s+1]); p.y=cvtpk(x[8*s+2],x[8*s+3]); p.z=cvtpk(x[8*s+4],x[8*s+5]); p.w=cvtpk(x[8*s+6],x[8*s+7]); return __builtin_bit_cast(bf16x8,p); }

__device__ __forceinline__ void scan_wait_batch(const unsigned*rdy,int bh,int m0){
  if((threadIdx.x>>6)==4){
    const int l_=threadIdx.x&63; unsigned sp=0u;
    for(;;){ unsigned ok=1u; if(l_<16)ok=__hip_atomic_load(rdy+bh*128+m0+l_,__ATOMIC_RELAXED,__HIP_MEMORY_SCOPE_AGENT);
      if(__all(ok!=0u))break; __builtin_amdgcn_s_sleep(8); if(++sp>(1u<<17))break; }
    __builtin_amdgcn_fence(__ATOMIC_ACQUIRE,"agent"); asm volatile("s_waitcnt vmcnt(0)":::"memory");
  }
  CBAR_LDS();
}
#define DN_M(a,b,c) ((DBG&1)?(c):DN_MFMA32(a,b,c))
constexpr int SC_RING=2*REC_U, SC_STG=SC_RING, STG_LD=80, STG_BYTES=4*64*STG_LD, SC_SSQ=SC_STG+2*STG_BYTES, SC_TCH=SC_SSQ+2*4*64*4, SC_END=SC_TCH+512;
static_assert(SC_END<=160*1024-1024,"scan LDS");
template<int DBG> __device__ __forceinline__ void scan_head(int bh,const unsigned char*REC,const float*GLB,const float*dnw,const bf16_t*ZD,bf16_t*Y,const unsigned*rdy,char*shm,int flags){
  const int tid=threadIdx.x; int lane=tid&63; asm volatile("":"+v"(lane));
  const int wid=__builtin_amdgcn_readfirstlane(tid>>6);
  const int b=bh>>2,h=bh&3;
  const unsigned lds0=(unsigned)(uintptr_t)shm;
  const LAS unsigned char*ldsb=(const LAS unsigned char*)shm;
  const unsigned char*recb=REC+(size_t)bh*128*REC_BYTES;
  const size_t tokb=(size_t)b*SEQ;
  scan_wait_batch(rdy,bh,0);
  if(wid>=4&&wid<6){
    const int lw=wid-4;
    #define DN_PAIR "global_load_lds_dwordx4 %[vo], %[sb]\n\tglobal_load_lds_dwordx4 %[vo], %[sb] offset:2048\n\t"
    #define DN_BUMP "s_add_u32 m0, m0, 0x1000\n\tv_add_u32 %[vo], 0x1000, %[vo]\n\ts_nop 0\n\t"
    #define DN_FILL(nn,bufoff) do{ const unsigned char*b_=recb+(size_t)(nn)*REC_BYTES; unsigned keep_, vo_=(unsigned)(lane*16+lw*1024); \
      const unsigned long long sb_=((unsigned long long)(unsigned)__builtin_amdgcn_readfirstlane((int)((unsigned long long)b_>>32))<<32)|(unsigned)__builtin_amdgcn_readfirstlane((int)(unsigned)(unsigned long long)b_); \
      const unsigned dst_=(unsigned)__builtin_amdgcn_readfirstlane((int)(lds0+(bufoff)+lw*1024)); \
      asm volatile("s_mov_b32 %[keep], m0\n\ts_mov_b32 m0, %[dst]\n\ts_nop 0\n\t" \
        DN_PAIR DN_BUMP DN_PAIR DN_BUMP DN_PAIR DN_BUMP DN_PAIR DN_BUMP DN_PAIR DN_BUMP DN_PAIR DN_BUMP DN_PAIR DN_BUMP \
        DN_PAIR DN_BUMP DN_PAIR DN_BUMP DN_PAIR DN_BUMP DN_PAIR DN_BUMP DN_PAIR DN_BUMP DN_PAIR DN_BUMP DN_PAIR \
        "s_mov_b32 m0, %[keep]" : [keep]"=&s"(keep_), [vo]"+v"(vo_) : [dst]"s"(dst_), [sb]"s"(sb_) : "memory"); }while(0)
    if(!(flags&4)){ DN_FILL(0,0); }
    DN_BAR();
    for(int n=0;n<=128;++n){
      if(n<128){
        if(((n+1)&15)==0&&n+1<128)scan_wait_batch(rdy,bh,n+1);
        if(n+1<128&&!(flags&4)){ DN_FILL(n+1,((n+1)&1)*REC_U); }
      }
      DN_BAR();
    }
    #undef DN_FILL
    #undef DN_PAIR
    #undef DN_BUMP
  } else if(wid>=6){
    const int ow=wid-6;
    const int rrow=lane>>2,rch=lane&3;
    const bf16_t*zdp=ZD+(tokb+rrow)*AW+h*128+64*ow+8*rch; bf16_t*yp=Y+(tokb+rrow)*DM+512+h*128+64*ow+8*rch;
    f32x4 wv[2][2];
    #pragma unroll
    for(int c=0;c<2;++c){ wv[c][0]=*(const f32x4*)(dnw+64*ow+32*c+8*rch); wv[c][1]=*(const f32x4*)(dnw+64*ow+32*c+8*rch+4); }
    u32x4 zn[2][4],zq[2][4];
    #pragma unroll
    for(int c=0;c<2;++c)
      #pragma unroll
      for(int q=0;q<4;++q) zn[c][q]=*(const u32x4*)(zdp+(size_t)(16*q)*AW+32*c);
    asm volatile("s_waitcnt lgkmcnt(0)\n\ts_barrier":::"memory");
    for(int n=0;n<=128;++n){
      if(n<128&&((n+1)&15)==0&&n+1<128)scan_wait_batch(rdy,bh,n+1);
      if(n>0&&n<128&&!(DBG&2)){
        #pragma unroll
        for(int c=0;c<2;++c)
          #pragma unroll
          for(int q=0;q<4;++q) zq[c][q]=*(const u32x4*)(zdp+(size_t)(n*CH+16*q)*AW+32*c);
      }
      if(n>0&&!(DBG&2)){
        const LAS float*sq=(const LAS float*)(ldsb+SC_SSQ)+((n-1)&1)*256;
        #pragma unroll
        for(int it=0;it<4;++it){
          const int pos=16*it+rrow;
          const float tot=(sq[pos]+sq[64+pos])+(sq[128+pos]+sq[192+pos]);
          const float rs=1.0f/sqrtf(tot*(1.0f/128.0f)+EPS);
          #pragma unroll
          for(int c=0;c<2;++c){
            const LAS unsigned char*stg=ldsb+SC_STG+((n-1)&1)*STG_BYTES+(2*ow+c)*64*STG_LD;
            const u32x4 v=*(const LAS u32x4*)(stg+pos*STG_LD+rch*16); const u32x4 z=zn[c][it]; const f32x4 w0=wv[c][0],w1=wv[c][1]; u32x4 w;
            w[0]=cvtpk(bflo(v[0])*rs*w0[0]*bflo(z[0]),bfhi(v[0])*rs*w0[1]*bfhi(z[0])); w[1]=cvtpk(bflo(v[1])*rs*w0[2]*bflo(z[1]),bfhi(v[1])*rs*w0[3]*bfhi(z[1]));
            w[2]=cvtpk(bflo(v[2])*rs*w1[0]*bflo(z[2]),bfhi(v[2])*rs*w1[1]*bfhi(z[2])); w[3]=cvtpk(bflo(v[3])*rs*w1[2]*bflo(z[3]),bfhi(v[3])*rs*w1[3]*bfhi(z[3]));
            *(u32x4*)(yp+(size_t)((n-1)*CH+16*it)*DM+32*c)=w;
          }
        }
        #pragma unroll
        for(int c=0;c<2;++c)
          #pragma unroll
          for(int q=0;q<4;++q) zn[c][q]=zq[c][q];
      }
      asm volatile("s_waitcnt lgkmcnt(0)\n\ts_barrier":::"memory");
    }
  } else if(flags&8){
    asm volatile("s_waitcnt lgkmcnt(0)\n\ts_barrier":::"memory");
    for(int n=0;n<128;++n){ if(((n+1)&15)==0&&n+1<128)scan_wait_batch(rdy,bh,n+1); asm volatile("s_waitcnt lgkmcnt(0)\n\ts_barrier":::"memory"); }
    asm volatile("s_waitcnt lgkmcnt(0)\n\ts_barrier":::"memory");
  } else {
    const int c4=wid,r32=lane&31,hi=lane>>5;
    __builtin_amdgcn_s_setprio(3);
    f32x16 S[4];
    #pragma unroll
    for(int t=0;t<4;++t)S[t]=f32x16{};
    const unsigned char*up=recb+REC_U+(size_t)(c4*4)*1024+lane*16;
    u32x4 un[4];
    #pragma unroll
    for(int q=0;q<4;++q) un[q]=*(const u32x4*)(up+q*1024);
    float gl_next=__hip_atomic_load(GLB+bh*128,__ATOMIC_RELAXED,__HIP_MEMORY_SCOPE_AGENT);
    asm volatile("s_waitcnt lgkmcnt(0)\n\ts_barrier":::"memory");
    for(int n=0;n<128;++n){
      if(((n+1)&15)==0&&n+1<128)scan_wait_batch(rdy,bh,n+1);
      const LAS unsigned char*rb=ldsb+(n&1)*REC_U+lane*16;
      const float gl=gl_next; gl_next=__hip_atomic_load(GLB+bh*128+((n+1)&127),__ATOMIC_RELAXED,__HIP_MEMORY_SCOPE_AGENT);
      f32x16 av[2],ao[2];
      #pragma unroll
      for(int i2=0;i2<2;++i2)
        #pragma unroll
        for(int rh=0;rh<2;++rh){ const u32x4 u=un[i2*2+rh];
          #pragma unroll
          for(int q=0;q<4;++q){ av[i2][8*rh+2*q]=bflo(u[q]); av[i2][8*rh+2*q+1]=bfhi(u[q]); } }
      { const unsigned char*upn=up+(size_t)((n+1)&127)*REC_BYTES;
        #pragma unroll
        for(int q=0;q<4;++q) un[q]=*(const u32x4*)(upn+q*1024); }
      ao[0]=f32x16{}; ao[1]=f32x16{};
      #define FR(off) (*(const LAS bf16x8*)(rb+(off)))
      #define SB0() __builtin_amdgcn_sched_barrier(0)
      bf16x8 fa[4],fb[4],Sb[8];
      #pragma unroll
      for(int ks=0;ks<8;++ks)Sb[ks]=pack8(S[ks>>1],ks&1);
      #define LDN(B,k0) do{ B[0]=FR(REC_NW+(k0)*1024); B[1]=FR(REC_NW+(8+(k0))*1024); B[2]=FR(REC_NW+((k0)+1)*1024); B[3]=FR(REC_NW+(9+(k0))*1024); }while(0)
      #define MMN(B,k0) do{ av[0]=DN_M(B[0],Sb[k0],av[0]); av[1]=DN_M(B[1],Sb[k0],av[1]); av[0]=DN_M(B[2],Sb[(k0)+1],av[0]); av[1]=DN_M(B[3],Sb[(k0)+1],av[1]); }while(0)
      #define LDQ(B,k0) do{ B[0]=FR(REC_QD+(k0)*1024); B[1]=FR(REC_QD+(8+(k0))*1024); B[2]=FR(REC_QD+((k0)+1)*1024); B[3]=FR(REC_QD+(9+(k0))*1024); }while(0)
      #define MMQ(B,k0) do{ ao[0]=DN_M(Sb[k0],B[0],ao[0]); ao[1]=DN_M(Sb[k0],B[1],ao[1]); ao[0]=DN_M(Sb[(k0)+1],B[2],ao[0]); ao[1]=DN_M(Sb[(k0)+1],B[3],ao[1]); }while(0)
      LDN(fa,0); SB0();
      LDN(fb,2); SB0(); MMN(fa,0); SB0();
      LDN(fa,4); SB0(); MMN(fb,2); SB0();
      LDN(fb,6); SB0(); MMN(fa,4); SB0();
      LDQ(fa,0); SB0(); MMN(fb,6); SB0();
      LDQ(fb,2); SB0(); MMQ(fa,0); SB0();
      #pragma unroll
      for(int t=0;t<4;++t)S[t]=S[t]*gl;
      LDQ(fa,4); SB0(); MMQ(fb,2); SB0();
      bf16x8 vb[2][2];
      #pragma unroll
      for(int i2=0;i2<2;++i2){ vb[i2][0]=pack8(av[i2],0); vb[i2][1]=pack8(av[i2],1); }
      LDQ(fb,6); SB0(); MMQ(fa,4); SB0();
      fa[0]=FR(REC_AI+0*1024); fa[1]=FR(REC_AI+1*1024); fa[2]=FR(REC_AI+4*1024); fa[3]=FR(REC_AI+5*1024); SB0();
      MMQ(fb,6); SB0();
      fb[0]=FR(REC_AI+6*1024); fb[1]=FR(REC_AI+7*1024); fb[2]=FR(REC_KT+0*1024); fb[3]=FR(REC_KT+1*1024); SB0();
      ao[0]=DN_M(vb[0][0],fa[0],ao[0]); ao[0]=DN_M(vb[0][1],fa[1],ao[0]); ao[1]=DN_M(vb[0][0],fa[2],ao[1]); ao[1]=DN_M(vb[0][1],fa[3],ao[1]); SB0();
      fa[0]=FR(REC_KT+2*1024); fa[1]=FR(REC_KT+3*1024); fa[2]=FR(REC_KT+4*1024); fa[3]=FR(REC_KT+5*1024); SB0();
      ao[1]=DN_M(vb[1][0],fb[0],ao[1]); ao[1]=DN_M(vb[1][1],fb[1],ao[1]); S[0]=DN_M(fb[2],vb[0][0],S[0]); S[0]=DN_M(fb[3],vb[0][1],S[0]); SB0();
      fb[0]=FR(REC_KT+6*1024); fb[1]=FR(REC_KT+7*1024); fb[2]=FR(REC_KT+8*1024); fb[3]=FR(REC_KT+9*1024); SB0();
      S[0]=DN_M(fa[0],vb[1][0],S[0]); S[0]=DN_M(fa[1],vb[1][1],S[0]); S[1]=DN_M(fa[2],vb[0][0],S[1]); S[1]=DN_M(fa[3],vb[0][1],S[1]); SB0();
      fa[0]=FR(REC_KT+10*1024); fa[1]=FR(REC_KT+11*1024); fa[2]=FR(REC_KT+12*1024); fa[3]=FR(REC_KT+13*1024); SB0();
      S[1]=DN_M(fb[0],vb[1][0],S[1]); S[1]=DN_M(fb[1],vb[1][1],S[1]); S[2]=DN_M(fb[2],vb[0][0],S[2]); S[2]=DN_M(fb[3],vb[0][1],S[2]); SB0();
      fb[0]=FR(REC_KT+14*1024); fb[1]=FR(REC_KT+15*1024); SB0();
      S[2]=DN_M(fa[0],vb[1][0],S[2]); S[2]=DN_M(fa[1],vb[1][1],S[2]); S[3]=DN_M(fa[2],vb[0][0],S[3]); S[3]=DN_M(fa[3],vb[0][1],S[3]); SB0();
      S[3]=DN_M(fb[0],vb[1][0],S[3]); S[3]=DN_M(fb[1],vb[1][1],S[3]);
      #undef FR
      #undef LDN
      #undef MMN
      #undef LDQ
      #undef MMQ
      #undef SB0
      { LAS unsigned char*stg=(LAS unsigned char*)(ldsb+SC_STG)+(n&1)*STG_BYTES+c4*64*STG_LD; LAS float*ssq=(LAS float*)(ldsb+SC_SSQ)+(n&1)*256+c4*64;
        #pragma unroll
        for(int i2=0;i2<2;++i2){ float p=0.f; const int pos=32*i2+r32;
          #pragma unroll
          for(int r=0;r<16;++r)p+=ao[i2][r]*ao[i2][r];
          p+=__shfl_xor(p,32);
          if(hi==0)ssq[pos]=p;
          #pragma unroll
          for(int rq=0;rq<4;++rq) *(LAS u32x2v*)(stg+pos*STG_LD+(8*rq+4*hi)*2)=(u32x2v){cvtpk(ao[i2][4*rq],ao[i2][4*rq+1]),cvtpk(ao[i2][4*rq+2],ao[i2][4*rq+3])}; } }
      asm volatile("s_waitcnt lgkmcnt(0)\n\ts_barrier":::"memory");
    }
    __builtin_amdgcn_s_setprio(0);
    asm volatile("s_waitcnt lgkmcnt(0)\n\ts_barrier":::"memory");
  }
}
#undef DN_MFMA32
#undef DN_MFMA4
#undef DN_BAR
}

namespace moba {
using bf16=unsigned short;
using s16x4=__attribute__((ext_vector_type(4)))short;
using f32x16=__attribute__((ext_vector_type(16)))float;
constexpr int D=64,NW=8,QBLK=32,QB=QBLK*NW,KVBLK=64,PITCH=64;
__device__ __forceinline__ int crow(int r,int hi){return (r&3)+8*(r>>2)+4*hi;}
#define SBAR() __builtin_amdgcn_sched_barrier(0)
constexpr int NSLOT=3, SLOTB=8192;
constexpr int NKT=4, LDS_K=0, LDS_V=NKT*SLOTB, LDS_WS=2*NKT*SLOTB, WSW=1024, LDS_OST=LDS_WS+NW*WSW, LDS_TB=LDS_OST+NW*4096, LDS_UNIT=LDS_TB+512, LDS_PFX=LDS_UNIT+64, LDS_BYTES=LDS_PFX+8*132*4;
struct AB { int dbg; const bf16*QA; const bf16*KA; const bf16*VA; const float*KMEAN; const float*rel_bias; const bf16*ZA; bf16*Y; unsigned*SEL; unsigned short*LIST; unsigned*CNT; bf16*OP; float*LP; unsigned*qctl; };
constexpr int LISTCAP=8192, PREVCAP=256;
constexpr float NEGBIG=-1.0e30f;
__device__ __forceinline__ void glds16(const void*gsrc,unsigned lds_dst){unsigned keep;
  asm volatile("s_mov_b32 %0, m0\n\ts_mov_b32 m0, %2\n\ts_nop 0\n\tglobal_load_lds_dwordx4 %1, off\n\ts_mov_b32 m0, %0":"=&s"(keep):"v"(gsrc),"s"(lds_dst):"memory");}
typedef float f32x2_t __attribute__((ext_vector_type(2))); typedef __bf16 bf16x2_t __attribute__((ext_vector_type(2)));
__device__ __forceinline__ unsigned cvtpk_s(float lo,float hi){f32x2_t v={lo,hi};bf16x2_t b=__builtin_convertvector(v,bf16x2_t);return __builtin_bit_cast(unsigned,b);}
#define WAIT_BAR(N) asm volatile("s_waitcnt vmcnt(" #N ") lgkmcnt(0)\n\ts_barrier":::"memory")
__device__ __forceinline__ void qkt(f32x16&p0,f32x16&p1,const char*Kslot,const bf16x8*qr,int r32,int hi){
  const f32x16 negm=f32x16{};
  const char*kb=Kslot+hi*1024+r32*16;
  #pragma unroll
  for(int d0=0;d0<4;++d0){
    const bf16x8 b0=*reinterpret_cast<const bf16x8*>(kb+d0*2048);
    const bf16x8 b1=*reinterpret_cast<const bf16x8*>(kb+d0*2048+512);
    if(d0==0){p0=__builtin_amdgcn_mfma_f32_32x32x16_bf16(b0,qr[0],negm,0,0,0);p1=__builtin_amdgcn_mfma_f32_32x32x16_bf16(b1,qr[0],negm,0,0,0);}
    else{p0=__builtin_amdgcn_mfma_f32_32x32x16_bf16(b0,qr[d0],p0,0,0,0);p1=__builtin_amdgcn_mfma_f32_32x32x16_bf16(b1,qr[d0],p1,0,0,0);}}
}
typedef __attribute__((address_space(3))) const char* lds_cptr;
typedef short v4i16_t __attribute__((ext_vector_type(4)));
__device__ __forceinline__ void kload8(bf16x8*kf,lds_cptr kp){
  kf[0]=*(const __attribute__((address_space(3))) bf16x8*)(kp);      kf[1]=*(const __attribute__((address_space(3))) bf16x8*)(kp+512);
  kf[2]=*(const __attribute__((address_space(3))) bf16x8*)(kp+2048); kf[3]=*(const __attribute__((address_space(3))) bf16x8*)(kp+2560);
  kf[4]=*(const __attribute__((address_space(3))) bf16x8*)(kp+4096); kf[5]=*(const __attribute__((address_space(3))) bf16x8*)(kp+4608);
  kf[6]=*(const __attribute__((address_space(3))) bf16x8*)(kp+6144); kf[7]=*(const __attribute__((address_space(3))) bf16x8*)(kp+6656);
}
__device__ __forceinline__ void kload2(bf16x8*kf,lds_cptr kp,int j){ kf[2*j]=*(const __attribute__((address_space(3))) bf16x8*)(kp+j*2048); kf[2*j+1]=*(const __attribute__((address_space(3))) bf16x8*)(kp+j*2048+512); }
__device__ __forceinline__ s16x4 vtr(lds_cptr p){ return __builtin_bit_cast(s16x4,__builtin_amdgcn_ds_read_tr16_b64_v4i16((__attribute__((address_space(3))) v4i16_t*)p)); }
__device__ __forceinline__ void pv(f32x16*o,int vb,bf16x8 pa0,bf16x8 pa1,bf16x8 pa2,bf16x8 pa3){
  #pragma unroll
  for(int d0=0;d0<2;++d0){s16x4 lo[4],hi[4];
    #pragma unroll
    for(int ks=0;ks<4;++ks){
      asm volatile("ds_read_b64_tr_b16 %0,%1 offset:%c2":"=&v"(lo[ks]):"v"(vb),"i"(d0*4096+ks*1024):"memory");
      asm volatile("ds_read_b64_tr_b16 %0,%1 offset:%c2":"=&v"(hi[ks]):"v"(vb),"i"(d0*4096+ks*1024+512):"memory");}
    asm volatile("s_waitcnt lgkmcnt(0)":::"memory");SBAR();
    #define PK(k) (bf16x8){lo[k][0],lo[k][1],lo[k][2],lo[k][3],hi[k][0],hi[k][1],hi[k][2],hi[k][3]}
    o[d0]=__builtin_amdgcn_mfma_f32_32x32x16_bf16(pa0,PK(0),o[d0],0,0,0);
    o[d0]=__builtin_amdgcn_mfma_f32_32x32x16_bf16(pa1,PK(1),o[d0],0,0,0);
    o[d0]=__builtin_amdgcn_mfma_f32_32x32x16_bf16(pa2,PK(2),o[d0],0,0,0);
    o[d0]=__builtin_amdgcn_mfma_f32_32x32x16_bf16(pa3,PK(3),o[d0],0,0,0);
    #undef PK
  }
}
__device__ __forceinline__ void bandfix(f32x16&p0,f32x16&p1,int t,int qpos,int hi,const float*tb){
  const int kb=64*t+4*hi;
  #pragma unroll
  for(int r=0;r<16;++r){ const int kv=kb+(r&3)+8*(r>>2); const int d0=qpos-kv, d1=d0-32;
    const float b0=tb[d0<0?0:(d0>127?127:d0)], b1=tb[d1<0?0:(d1>127?127:d1)];
    p0[r]=d0<0?NEGBIG:p0[r]+b0; p1[r]=d1<0?NEGBIG:p1[r]+b1; if((r&3)==3)SBAR(); }
}


__device__ __forceinline__ unsigned gate_select(const float*KMEAN,int bh,int qb,const bf16x8*qr,int r32,int hi){
  f32x16 gt=f32x16{};
  const float*km=KMEAN+((size_t)bh*32+r32)*64+hi*8;
  #pragma unroll
  for(int d0=0;d0<4;++d0){ const f32x4 ka=*(const f32x4*)(km+d0*16), kb_=*(const f32x4*)(km+d0*16+4);
    u32x4 w; w.x=cvtpk_s(ka[0],ka[1]); w.y=cvtpk_s(ka[2],ka[3]); w.z=cvtpk_s(kb_[0],kb_[1]); w.w=cvtpk_s(kb_[2],kb_[3]);
    gt=__builtin_amdgcn_mfma_f32_32x32x16_bf16(__builtin_bit_cast(bf16x8,w),qr[d0],gt,0,0,0); }
  float a1=-INFINITY,a2=-INFINITY,a3=-INFINITY;
  const int qbh=qb-4*hi;
  #pragma unroll
  for(int r=0;r<16;++r){ float x=gt[r]; if(crow(r,0)>=qbh)x=-INFINITY; gt[r]=x;
    const float t_=fminf(a1,x); a1=fmaxf(a1,x); const float u_=fminf(a2,t_); a2=fmaxf(a2,t_); a3=fmaxf(a3,u_); }
  const float b1=__shfl_xor(a1,32),b2=__shfl_xor(a2,32),b3=__shfl_xor(a3,32);
  const float th=fmaxf(fmaxf(a3,b3),fmaxf(fminf(a2,b1),fminf(a1,b2)));
  unsigned m_=0u;
  #pragma unroll
  for(int r=0;r<16;++r){ if(gt[r]>=th&&gt[r]>-INFINITY)m_|=1u<<crow(r,0); }
  m_<<=4*hi;
  return m_|(unsigned)__shfl_xor((int)m_,32);
}
__device__ __forceinline__ void route_item(int bh,int qb,const AB&A){
  const int tid=threadIdx.x; int lane=tid&63; asm volatile("":"+v"(lane));
  const int r32=lane&31,hi=lane>>5; const int wid=__builtin_amdgcn_readfirstlane(tid>>6);
  const int s=qb*QB+wid*QBLK+r32;
  const bf16*Qw=A.QA+((size_t)bh*SEQ+s)*PITCH;
  bf16x8 qr[4];
  #pragma unroll
  for(int d0=0;d0<4;++d0)qr[d0]=*reinterpret_cast<const bf16x8*>(&Qw[d0*16+hi*8]);
  const unsigned selmask=gate_select(A.KMEAN,bh,qb,qr,r32,hi);
  if(hi==0)__hip_atomic_store(A.SEL+(size_t)bh*SEQ+s,selmask,__ATOMIC_RELAXED,__HIP_MEMORY_SCOPE_AGENT);
  const unsigned rb=(qb>=1&&hi==0)?(selmask&((1u<<qb)-1u)):0u;
  if(qb>=1){
    unsigned mymask=0u;
    for(int j=0;j<qb;++j){ const unsigned bal=(unsigned)__ballot((rb>>j)&1u); if(lane==j)mymask=bal; }
    unsigned base=0u;
    if(mymask)base=__hip_atomic_fetch_add(A.CNT+((lane==qb-1)?1024:0)+bh*32+lane,(unsigned)__popc(mymask),__ATOMIC_RELAXED,__HIP_MEMORY_SCOPE_AGENT);
    unsigned rbt=rb;
    #pragma unroll
    for(int k=0;k<3;++k){
      const int jj=rbt?(__ffs((int)rbt)-1):0; const bool act=rbt!=0u; rbt&=rbt-1u;
      const unsigned mj=(unsigned)__shfl((int)mymask,jj), bj=(unsigned)__shfl((int)base,jj);
      if(act){ const unsigned pos=bj+(unsigned)__popc(mj&((1u<<r32)-1u)); const bool prev=(jj==qb-1);
        if(pos<(unsigned)(prev?PREVCAP:LISTCAP-PREVCAP)){ unsigned short*dst_=A.LIST+((size_t)bh*32+jj)*LISTCAP+(prev?LISTCAP-PREVCAP:0)+pos; const unsigned val_=(unsigned)(s|(k<<13));
          asm volatile("global_store_short %0, %1, off sc1"::"v"(dst_),"v"(val_):"memory"); } }
    }
  }
}
template<int KIND> __device__ __forceinline__ void attn_group(int bh,int j,unsigned gi,unsigned cnt,unsigned entry,const bf16x8(&qr)[4],const AB&A,char*shm){
  const int tid=threadIdx.x; int lane=tid&63; asm volatile("":"+v"(lane));
  const int r32=lane&31,hi=lane>>5; const int wid=__builtin_amdgcn_readfirstlane(tid>>6);
  const int b=bh>>3,h=bh&7;
  const unsigned lds0=(unsigned)(uintptr_t)shm;
  const float*tb=(const float*)(shm+LDS_TB);
  const int srow=(KIND<2)?(int)(entry&8191u):(256*j+32*(int)gi+r32);
  const int vb0=(int)(lds0+LDS_V)+((lane>>4)&1)*32+(lane&3)*8+(4*hi+((lane&15)>>2))*64;
  const char*Kbase=shm+LDS_K; bf16x8 kf[8];
  const lds_cptr shm3=(lds_cptr)shm; const lds_cptr kp0=shm3+LDS_K+hi*1024+r32*16; const lds_cptr vp0=shm3+LDS_V+((lane>>4)&1)*32+(lane&3)*8+(4*hi+((lane&15)>>2))*64;
  constexpr int NT=4;
  float l_reg=0.f;f32x16 o[2];o[0]=f32x16{};o[1]=f32x16{};
  const int qpos=srow;
  #define BANDFIX(P0,P1,t) do{ if(KIND==2||(KIND==1&&(t)>=2)){ bandfix(P0,P1,4*j+(t),qpos,hi,tb); } }while(0)
  f32x16 pA0,pA1,pB0,pB1;
  qkt(pA0,pA1,Kbase,qr,r32,hi);asm volatile("s_nop 15\n\ts_nop 7":"+v"(pA0),"+v"(pA1));BANDFIX(pA0,pA1,0);
  _Pragma("unroll") for(int r=0;r<16;++r)pA0[r]=__builtin_amdgcn_exp2f(pA0[r]);
  _Pragma("unroll") for(int r=0;r<16;++r)pA1[r]=__builtin_amdgcn_exp2f(pA1[r]);
  kload8(kf,kp0+SLOTB);
  s16x4 vlo[8],vhi[8]; u32x4 pw0,pw1,pw2,pw3;
  #define PKW(P,B) cvtpk_s(P[B],P[B+1])
  #define PAF(k) __builtin_bit_cast(bf16x8,pw##k)
  #define VFR(i) (bf16x8){vlo[i][0],vlo[i][1],vlo[i][2],vlo[i][3],vhi[i][0],vhi[i][1],vhi[i][2],vhi[i][3]}
  #define PIN(x) asm volatile("":"+v"(x))
  #define GAPA(MF,A0,A1,A2,A3,W0,W1,PW) do{ MF; sacc+=A0; sacc+=A1; sacc+=A2; sacc+=A3; PIN(sacc); W0; W1; PIN(PW); SBAR(); }while(0)
  #define EX(v) __builtin_amdgcn_exp2f(v)
  #define GAPB(MF,X,B) do{ MF; X[B]=EX(X[B]); X[B+1]=EX(X[B+1]); X[B+2]=EX(X[B+2]); X[B+3]=EX(X[B+3]); PIN(X); SBAR(); }while(0)
  #define VRD(i) do{ vlo[i]=vtr(vp_+(((i)>>2)*4096+((i)&3)*1024)); vhi[i]=vtr(vp_+(((i)>>2)*4096+((i)&3)*1024+512)); }while(0)
  #define KRD(G,jj) do{ if(G){ kload2(kf,kp0+((t_)+1)*SLOTB,jj); SBAR(); } }while(0)
  #define STEP(C0,C1,P0,P1,t,GL) do{ SBAR(); constexpr int t_=(t); \
    const lds_cptr vp_=vp0+(t_-1)*SLOTB; const f32x16 zc_=f32x16{}; \
    VRD(0); SBAR(); float sacc=(P0[0]+P0[1]); \
    GAPA(C0=__builtin_amdgcn_mfma_f32_32x32x16_bf16(kf[0],qr[0],zc_,0,0,0), P0[2],P0[3],P0[4],P0[5],     pw0[0]=PKW(P0,0), pw0[1]=PKW(P0,2), pw0); \
    VRD(4); SBAR(); GAPA(C1=__builtin_amdgcn_mfma_f32_32x32x16_bf16(kf[1],qr[0],zc_,0,0,0), P0[6],P0[7],P0[8],P0[9],     pw0[2]=PKW(P0,4), pw0[3]=PKW(P0,6), pw0); \
    VRD(1); SBAR(); GAPA(C0=__builtin_amdgcn_mfma_f32_32x32x16_bf16(kf[2],qr[1],C0,0,0,0),   P0[10],P0[11],P0[12],P0[13], pw1[0]=PKW(P0,8), pw1[1]=PKW(P0,10), pw1); \
    VRD(5); SBAR(); GAPA(C1=__builtin_amdgcn_mfma_f32_32x32x16_bf16(kf[3],qr[1],C1,0,0,0),   P0[14],P0[15],P1[0],P1[1],   pw1[2]=PKW(P0,12),pw1[3]=PKW(P0,14), pw1); \
    VRD(2); SBAR(); GAPA(C0=__builtin_amdgcn_mfma_f32_32x32x16_bf16(kf[4],qr[2],C0,0,0,0),   P1[2],P1[3],P1[4],P1[5],     pw2[0]=PKW(P1,0), pw2[1]=PKW(P1,2), pw2); \
    VRD(6); SBAR(); GAPA(C1=__builtin_amdgcn_mfma_f32_32x32x16_bf16(kf[5],qr[2],C1,0,0,0),   P1[6],P1[7],P1[8],P1[9],     pw2[2]=PKW(P1,4), pw2[3]=PKW(P1,6), pw2); \
    VRD(3); SBAR(); GAPA(C0=__builtin_amdgcn_mfma_f32_32x32x16_bf16(kf[6],qr[3],C0,0,0,0),   P1[10],P1[11],P1[12],P1[13], pw3[0]=PKW(P1,8), pw3[1]=PKW(P1,10), pw3); \
    VRD(7); SBAR(); GAPA(C1=__builtin_amdgcn_mfma_f32_32x32x16_bf16(kf[7],qr[3],C1,0,0,0),   P1[14],P1[15],0.f,0.f,       pw3[2]=PKW(P1,12),pw3[3]=PKW(P1,14), pw3); \
    l_reg+=sacc; \
    BANDFIX(C0,C1,t_); \
    SBAR(); \
    GAPB(o[0]=__builtin_amdgcn_mfma_f32_32x32x16_bf16(PAF(0),VFR(0),o[0],0,0,0), C0,0); \
    GAPB(o[1]=__builtin_amdgcn_mfma_f32_32x32x16_bf16(PAF(0),VFR(4),o[1],0,0,0), C0,4); \
    KRD(GL,0); GAPB(o[0]=__builtin_amdgcn_mfma_f32_32x32x16_bf16(PAF(1),VFR(1),o[0],0,0,0), C0,8); \
    KRD(GL,1); GAPB(o[1]=__builtin_amdgcn_mfma_f32_32x32x16_bf16(PAF(1),VFR(5),o[1],0,0,0), C0,12); \
    KRD(GL,2); GAPB(o[0]=__builtin_amdgcn_mfma_f32_32x32x16_bf16(PAF(2),VFR(2),o[0],0,0,0), C1,0); \
    KRD(GL,3); GAPB(o[1]=__builtin_amdgcn_mfma_f32_32x32x16_bf16(PAF(2),VFR(6),o[1],0,0,0), C1,4); \
    GAPB(o[0]=__builtin_amdgcn_mfma_f32_32x32x16_bf16(PAF(3),VFR(3),o[0],0,0,0), C1,8); \
    GAPB(o[1]=__builtin_amdgcn_mfma_f32_32x32x16_bf16(PAF(3),VFR(7),o[1],0,0,0), C1,12); \
    }while(0)
  STEP(pB0,pB1,pA0,pA1,1,true);
  STEP(pA0,pA1,pB0,pB1,2,true);
  STEP(pB0,pB1,pA0,pA1,3,false);
  { float sacc=pB0[0]+pB0[1]; _Pragma("unroll") for(int r=2;r<16;++r)sacc+=pB0[r]; _Pragma("unroll") for(int r=0;r<16;++r)sacc+=pB1[r]; l_reg+=sacc;
    pw0=(u32x4){PKW(pB0,0),PKW(pB0,2),PKW(pB0,4),PKW(pB0,6)};pw1=(u32x4){PKW(pB0,8),PKW(pB0,10),PKW(pB0,12),PKW(pB0,14)};pw2=(u32x4){PKW(pB1,0),PKW(pB1,2),PKW(pB1,4),PKW(pB1,6)};pw3=(u32x4){PKW(pB1,8),PKW(pB1,10),PKW(pB1,12),PKW(pB1,14)};
    SBAR(); pv(o,vb0+(NT-1)*SLOTB,PAF(0),PAF(1),PAF(2),PAF(3)); }
  #undef PKW
  #undef PAF
  #undef VFR
  #undef PIN
  #undef GAPA
  #undef GAPB
  #undef EX
  #undef VRD
  #undef KRD
  #undef STEP
  #undef BANDFIX
  l_reg+=__shfl_xor(l_reg,32);
  int lane2=threadIdx.x&63; asm volatile("":"+v"(lane2));
  const int r32e=lane2&31,hie=lane2>>5;
  float*wsr=(float*)(shm+LDS_WS)+wid*(WSW/4);
  if(KIND<2){
    if(hie==0){ wsr[r32e*8]=__builtin_amdgcn_rcpf(l_reg); wsr[r32e*8+1]=l_reg; ((unsigned*)wsr)[r32e*8+2]=entry; }
  } else {
    if(hie==0){
      const unsigned selmask=A.SEL[(size_t)bh*SEQ+srow];
      const unsigned rbits=(j>=1)?(selmask&((1u<<j)-1u)):0u; const int nr=__popc(rbits);
      const float*lp=A.LP+((size_t)bh*SEQ+srow)*3; float lk[3]; float lt=l_reg;
      #pragma unroll
      for(int k=0;k<3;++k){ const float t_=lp[k]; lk[k]=(k<nr)?t_:0.f; lt+=lk[k]; }
      const float inv=1.0f/lt;
      wsr[r32e*8]=inv; wsr[r32e*8+1]=lk[0]*inv; wsr[r32e*8+2]=lk[1]*inv; wsr[r32e*8+3]=lk[2]*inv; ((int*)wsr)[r32e*8+4]=nr;
    }
  }
  asm volatile("s_waitcnt lgkmcnt(0)":::"memory");
  float rli[16];
  #pragma unroll
  for(int r=0;r<16;++r)rli[r]=wsr[(crow(r,0)+4*hie)*8];
  { bf16*stg=(bf16*)(shm+LDS_OST)+wid*2048;
    bf16*stgw=stg+(4*hie)*64+r32e;
    #pragma unroll
    for(int r=0;r<16;++r){
      #pragma unroll
      for(int d0=0;d0<2;++d0)stgw[crow(r,0)*64+d0*32]=f2bf(o[d0][r]*rli[r]);}
    asm volatile("s_waitcnt lgkmcnt(0)":::"memory");
    #pragma unroll
    for(int i=0;i<4;++i){const int row=i*8+(lane2>>3),ch=lane2&7; const u32x4 v=*(const u32x4*)(stg+row*64+ch*8);
      if(KIND<2){
        const unsigned e_=((const unsigned*)wsr)[row*8+2]; const unsigned idx=32u*gi+row;
        if(idx<cnt){ const size_t slot=((size_t)bh*SEQ+(e_&8191u))*3+(e_>>13);
          bf16*dst=A.OP+slot*64+ch*8;
          asm volatile("global_store_dwordx4 %0, %1, off sc1\n\ts_nop 1"::"v"(dst),"v"(v):"memory");
          if(ch==0)__hip_atomic_store(A.LP+slot,wsr[row*8+1],__ATOMIC_RELAXED,__HIP_MEMORY_SCOPE_AGENT); }
      } else {
        const size_t rowg=(size_t)bh*SEQ+256*j+32*gi+row; const size_t tok=(size_t)b*SEQ+256*j+32*gi+row; const int nr=((const int*)wsr)[row*8+4];
        float a8[8];
        #pragma unroll
        for(int e=0;e<4;++e){ a8[2*e]=__uint_as_float(v[e]<<16); a8[2*e+1]=__uint_as_float(v[e]&0xffff0000u); }
        const bf16*op=A.OP+(rowg*3)*64+ch*8;
        u32x4 pk[3];
        #pragma unroll
        for(int k=0;k<3;++k) pk[k]=*(const u32x4*)(op+k*64);
        #pragma unroll
        for(int k=0;k<3;++k){ const float f=wsr[row*8+1+k]; const u32x4 p=(k<nr)?pk[k]:(u32x4){0u,0u,0u,0u};
          #pragma unroll
          for(int e=0;e<4;++e){ a8[2*e]+=f*__uint_as_float(p[e]<<16); a8[2*e+1]+=f*__uint_as_float(p[e]&0xffff0000u); } }
        const u32x4 z=*(const u32x4*)(A.ZA+tok*512+h*64+ch*8); u32x4 w;
        #pragma unroll
        for(int e=0;e<4;++e) w[e]=cvtpk_s(a8[2*e]*__uint_as_float(z[e]<<16),a8[2*e+1]*__uint_as_float(z[e]&0xffff0000u));
        *(u32x4*)(A.Y+tok*1024+h*64+ch*8)=w;
      } } }
  asm volatile("s_waitcnt lgkmcnt(0)":::"memory");
}
template<bool OWN> __device__ __forceinline__ void kv_unit(int bh,int j,const AB&A,char*shm,int&pend_x){
  const int tid=threadIdx.x; int lane=tid&63; asm volatile("":"+v"(lane));
  const int wid=__builtin_amdgcn_readfirstlane(tid>>6); const int h=bh&7;
  const unsigned lds0=(unsigned)(uintptr_t)shm;
  const bf16*Kh=A.KA+((size_t)bh*SEQ+(size_t)j*256)*PITCH,*Vh=A.VA+((size_t)bh*SEQ+(size_t)j*256)*PITCH;
  const bf16*ksrc=Kh+(long)lane*PITCH+wid*8;
  const bf16*vsrc=Vh+(long)(16*(wid&3)+(lane>>2))*PITCH+(wid>>2)*32+(lane&3)*8;
  const unsigned kdst=lds0+LDS_K+wid*1024, vdst=lds0+LDS_V+wid*1024;
  #pragma unroll
  for(int t=0;t<NKT;++t){ glds16(ksrc+(long)t*KVBLK*PITCH,(unsigned)__builtin_amdgcn_readfirstlane(kdst+t*SLOTB)); glds16(vsrc+(long)t*KVBLK*PITCH,(unsigned)__builtin_amdgcn_readfirstlane(vdst+t*SLOTB)); }
  float*tb=(float*)(shm+LDS_TB);
  if(tid<128) tb[tid]=(A.rel_bias[t5_bucket_dev(tid)*8+h]-A.rel_bias[31*8+h])*1.4426950408889634f;
  CBAR_ALL();
  if(pend_x>=0){ if(tid==0)__hip_atomic_fetch_add(A.qctl+512+64*pend_x,1u,__ATOMIC_RELAXED,__HIP_MEMORY_SCOPE_AGENT); pend_x=-1; CBAR_LDS(); }
  const int r32_=lane&31,hi_=lane>>5;
  #define LOADQ(dst,row) do{ const bf16*q_=A.QA+((size_t)bh*SEQ+(row))*PITCH+hi_*8; _Pragma("unroll") for(int d0=0;d0<4;++d0)(dst)[d0]=*reinterpret_cast<const bf16x8*>(q_+d0*16); }while(0)
  if((A.dbg&1)||(OWN&&(A.dbg&2))||(!OWN&&(A.dbg&4))){}
  else if(OWN){ bf16x8 qr[4]; LOADQ(qr,256*j+32*wid+r32_); attn_group<2>(bh,j,(unsigned)wid,256u,0u,qr,A,shm); }
  else {
    const unsigned short*lst=A.LIST+((size_t)bh*32+j)*LISTCAP;
    const unsigned cf=A.CNT[bh*32+j], cp=A.CNT[1024+bh*32+j];
    const unsigned nf=cf<(unsigned)(LISTCAP-PREVCAP)?cf:(unsigned)(LISTCAP-PREVCAP), np=cp<(unsigned)PREVCAP?cp:(unsigned)PREVCAP;
    const unsigned gp=(np+31u)>>5, gf=(nf+31u)>>5, gt=gp+gf;
    #define LOADE(gi_) (((gi_)<gp)?lst[(LISTCAP-PREVCAP)+((32u*(gi_)+r32_<np)?32u*(gi_)+r32_:0u)]:lst[((32u*((gi_)-gp)+r32_<nf)?32u*((gi_)-gp)+r32_:0u)])
    unsigned gi=wid;
    if(gi<gt){
      unsigned e_cur=LOADE(gi); unsigned e_nxt=(gi+NW<gt)?LOADE(gi+NW):0u;
      bf16x8 q_cur[4],q_nxt[4]; LOADQ(q_cur,e_cur&8191u);
      for(;gi<gt;gi+=NW){
        if(gi+NW<gt)LOADQ(q_nxt,e_nxt&8191u);
        const unsigned e_nn=(gi+2*NW<gt)?LOADE(gi+2*NW):0u;
        if(gi<gp) attn_group<1>(bh,j,gi,np,e_cur,q_cur,A,shm);
        else attn_group<0>(bh,j,gi-gp,nf,e_cur,q_cur,A,shm);
        e_cur=e_nxt; e_nxt=e_nn;
        #pragma unroll
        for(int d0=0;d0<4;++d0)q_cur[d0]=q_nxt[d0];
      }
    }
    #undef LOADE
  }
  #undef LOADQ
  CBAR_LDS();
  if(!OWN)pend_x=bh&7;
}
__device__ __forceinline__ void flush_pending(const AB&A,int&pend_x){
  if(pend_x>=0){ CBAR_ALL(); if(threadIdx.x==0)__hip_atomic_fetch_add(A.qctl+512+64*pend_x,1u,__ATOMIC_RELAXED,__HIP_MEMORY_SCOPE_AGENT); pend_x=-1; CBAR_LDS(); }
}
__device__ __forceinline__ void moba_phase(char*lds,const AB&A){
  const int tid=threadIdx.x; volatile unsigned*uw=(volatile unsigned*)(lds+LDS_UNIT);
  const unsigned x0=xb_xcc_id()&7u; unsigned acquired=0u; int pend_x=-1;
  bool pf_valid=false; unsigned pf_k=0u;
  for(unsigned qi=0;qi<8u;){
    const unsigned x=(x0+qi)&7u;
    unsigned k;
    if(pf_valid){ k=pf_k; pf_valid=false; }
    else {
      if(tid==0){ const unsigned k0=__hip_atomic_fetch_add(A.qctl+64*x,1u,__ATOMIC_RELAXED,__HIP_MEMORY_SCOPE_AGENT); uw[0]=k0; }
      CBAR_ALL();
      k=(unsigned)__builtin_amdgcn_readfirstlane((int)uw[0]);
      CBAR_LDS();
    }
    constexpr unsigned T=124u;
    if(k>=T+128u){ ++qi; continue; }
    unsigned pfr=0u;
    if(tid==0)pfr=__hip_atomic_fetch_add(A.qctl+64*x,1u,__ATOMIC_RELAXED,__HIP_MEMORY_SCOPE_AGENT);
    if(k<T){ kv_unit<false>((int)x+8*(int)(k&3u),(int)(k>>2),A,lds,pend_x); }
    else {
      const unsigned ko=k-T;
      if(!((acquired>>x)&1u)){
        flush_pending(A,pend_x);
        if(tid<64){ unsigned sp=0u; while(__builtin_amdgcn_readfirstlane(__hip_atomic_load(A.qctl+512+64*x,__ATOMIC_RELAXED,__HIP_MEMORY_SCOPE_AGENT))<T){ __builtin_amdgcn_s_sleep(2); if(++sp>(1u<<19))break; }
          __builtin_amdgcn_fence(__ATOMIC_ACQUIRE,"agent"); asm volatile("s_waitcnt vmcnt(0)":::"memory"); }
        CBAR_LDS();
        acquired|=1u<<x; }
      kv_unit<true>((int)x+8*(int)(ko&3u),31-(int)(ko>>2),A,lds,pend_x);
    }
    if(tid==0)uw[1]=pfr;
    CBAR_ALL();
    pf_k=(unsigned)__builtin_amdgcn_readfirstlane((int)uw[1]); pf_valid=true;
    CBAR_LDS();
  }
  flush_pending(A,pend_x);
}
#undef SBAR
#undef WAIT_BAR
}
constexpr int CW_AQ = 16384, CW_CNT = 20480, CW_RT = 22592, CW_GQ = 22656, CW_GQ2 = 22720, CW_G1B = 22784, CW_FLAGS = 24576;
__device__ __forceinline__ void p0_phase(const Ptrs& P, LAS unsigned char* lds, int tid, int G) {
    const int lane = tid & 63, wave = tid >> 6;
    {
        LAS float* scr = (LAS float*)(lds + wave * 16640);
        for (int it = blockIdx.x * NWAVES + wave; it < 1024 + 256; it += G * NWAVES) {
            const bool first = it < 1024; const int r = first ? it : it - 1024; const int kb = r & 15, pb = r >> 4;
            const float* W = first ? P.w_in : P.w_out; const int ldw = first ? NCOL : DM; bf16_t* WT = first ? P.WT1 : P.WT2;
            const int p = pb * 64 + lane; const int c = first ? wt1_logical(p) : p;
#pragma unroll 8
            for (int kk = 0; kk < 64; ++kk) scr[kk * 65 + lane] = W[(size_t)(kb * 64 + kk) * ldw + c];
            asm volatile("s_waitcnt lgkmcnt(0)" ::: "memory");
#pragma unroll 8
            for (int pp = 0; pp < 64; ++pp) WT[(size_t)(pb * 64 + pp) * 1024 + kb * 64 + lane] = f2bf(scr[lane * 65 + pp]);
            asm volatile("s_waitcnt lgkmcnt(0)" ::: "memory");
        }
        __syncthreads();
    }
    LAS float* w8 = (LAS float*)(lds + 32768);
    for (int i = tid; i < 1024 * 8; i += 512) w8[i] = P.w_in[(size_t)(i >> 3) * NCOL + 4096 + (i & 7)];
    __syncthreads();
    f32x4 nw[4];
#pragma unroll
    for (int j = 0; j < 4; ++j) nw[j] = ((const f32x4*)P.norm_w)[lane + 64 * j];
    const int gw = blockIdx.x * NWAVES + wave, ngw = G * NWAVES;
    f32x4 vn[4];
    if (gw < MTOK) { const f32x4* xr0 = (const f32x4*)(P.x + (size_t)gw * DM) + lane;
#pragma unroll
        for (int j = 0; j < 4; ++j) vn[j] = xr0[64 * j]; }
    for (int row = gw; row < MTOK; row += ngw) {
        f32x4 v[4]; float ss = 0.f;
#pragma unroll
        for (int j = 0; j < 4; ++j) v[j] = vn[j];
        if (row + ngw < MTOK) { const f32x4* xr1 = (const f32x4*)(P.x + (size_t)(row + ngw) * DM) + lane;
#pragma unroll
            for (int j = 0; j < 4; ++j) vn[j] = xr1[64 * j]; }
#pragma unroll
        for (int j = 0; j < 4; ++j) ss += v[j][0] * v[j][0] + v[j][1] * v[j][1] + v[j][2] * v[j][2] + v[j][3] * v[j][3];
        ss = wave_sum(ss);
        const float rstd = 1.0f / sqrtf(ss * (1.0f / DM) + EPS);
        float d[8];
#pragma unroll
        for (int c = 0; c < 8; ++c) d[c] = 0.f;
#pragma unroll
        for (int j = 0; j < 4; ++j) {
            f32x4 h = v[j] * rstd * nw[j];
            unsigned lo = (unsigned)f2bf(h[0]) | ((unsigned)f2bf(h[1]) << 16), hi = (unsigned)f2bf(h[2]) | ((unsigned)f2bf(h[3]) << 16);
            *(uint2*)(P.HN + (size_t)row * DM + 4 * (lane + 64 * j)) = make_uint2(lo, hi);
#pragma unroll
            for (int e = 0; e < 4; ++e) { const LAS f32x4* wr = (const LAS f32x4*)(w8 + (4 * (lane + 64 * j) + e) * 8); const f32x4 wa = wr[0], wb = wr[1];
#pragma unroll
                for (int c = 0; c < 4; ++c) { d[c] += h[e] * wa[c]; d[4 + c] += h[e] * wb[c]; } }
        }
#pragma unroll
        for (int c = 0; c < 8; ++c) d[c] = wave_sum(d[c]);
        if (lane < 4) {
            const int hh = lane; float bd = d[0], ad = d[4];
            if (hh == 1) { bd = d[1]; ad = d[5]; } else if (hh == 2) { bd = d[2]; ad = d[6]; } else if (hh == 3) { bd = d[3]; ad = d[7]; }
            const float beta = 1.0f / (1.0f + expf(-bd));
            const float z = ad + P.dt_bias[hh];
            const float sp = fmaxf(z, 0.f) + log1pf(expf(-fabsf(z)));
            const float g = -expf(P.a_log[hh]) * sp;
            const int b = row / SEQ, s = row % SEQ;
            P.BETA[(size_t)(b * DH + hh) * SEQ + s] = beta; P.GDEC[(size_t)(b * DH + hh) * SEQ + s] = g;
        }
    }
    __syncthreads();
}

struct Args { const float* in[11]; float* out; unsigned char* ws; int ph_lo, ph_hi, qoff, li; };
__global__ void __launch_bounds__(NWAVES * 64, 2) mega(Args args) {
    extern __shared__ __attribute__((aligned(16))) unsigned char lds_raw[];
    LAS unsigned char* lds = (LAS unsigned char*)lds_raw;
    const int tid = threadIdx.x, G = gridDim.x;
    void* din[11];
#pragma unroll
    for (int i = 0; i < 11; ++i) din[i] = (void*)args.in[i];
    const Ptrs P = make_ptrs(din, args.out, args.ws);
    volatile LAS unsigned* MISC = (volatile LAS unsigned*)(lds + MISC_OFF);
    for (int u = tid; u < (LDS_BYTES - LDSCTL_OFF) / 4; u += NWAVES * 64) ((LAS unsigned*)(lds + LDSCTL_OFF))[u] = 0u;
    __syncthreads();
    XcdBarrier bar = xcd_barrier_post(P.ctl + CW_BAR + args.li * XCD_BAR_WORDS, MISC + 8);
    const int lo = args.ph_lo, hi = args.ph_hi;
#define IN(k) (lo <= (k) && (k) < hi)
#define BOTH(k) (IN(k) && IN((k) + 1))
    if (IN(0)) { p0_phase(P, lds, tid, G); if (BOTH(0)) xcd_barrier(bar); }
    if (IN(1)) {
        pg8::Gemm g{P.HN, P.WT1 + (size_t)2048 * DM, MTOK, 2048, DM}; pg8::StaticOrder S; S.init(MTOK, 2048, G, (int)blockIdx.x);
        pg8::EpiProj E{P.QA, P.KA, P.VA, P.ZA, P.ZD, P.QKVD, P.KMEAN, P.qnw, P.knw, 8};
        pg8::gemm_phase<pg8::EpiProj, pg8::StaticOrder, true, true>(lds + RING_OFF, g, S, E);
        if (BOTH(1)) xcd_barrier(bar);
    }
#define GEMM1B_AND_PUBLISH() do{ \
                pg8::Gemm g{P.HN, P.WT1, MTOK, 2048, DM}; pg8::StaticOrder S; S.init(MTOK, 2048, G - 16, (int)blockIdx.x - 16); \
                pg8::EpiProj E{P.QA, P.KA, P.VA, P.ZA, P.ZD, P.QKVD, P.KMEAN, P.qnw, P.knw, 0}; \
                pg8::gemm_phase<pg8::EpiProj, pg8::StaticOrder, true, true>(lds + RING_OFF, g, S, E); \
                CBAR_ALL();                                \
                if (tid == 0) { __builtin_amdgcn_fence(__ATOMIC_RELEASE, "agent"); asm volatile("s_waitcnt vmcnt(0)" ::: "memory"); \
                    __hip_atomic_fetch_add(P.ctl + CW_G1B, 1u, __ATOMIC_RELAXED, __HIP_MEMORY_SCOPE_AGENT); } \
                CBAR_LDS(); }while(0)
    if (IN(2)) {
        const int dq = args.qoff;
        const moba::AB A{(dq >> 4) & 7, P.QA, P.KA, P.VA, P.KMEAN, P.rel_bias, P.ZA, P.Y, P.SEL, P.LIST, P.ctl + CW_CNT, P.OPART, P.LP, P.ctl + CW_AQ + (dq & ~255)};
        if (blockIdx.x < 16) {
            if (!(dq & 1)) {
#ifdef SCANDBG
                if (dq & 12) dn::scan_head<SCANDBG>((int)blockIdx.x, P.REC, P.GLB, P.dnw, P.ZD, (bf16_t*)P.out, P.ctl + CW_FLAGS, (char*)lds_raw, dq & 12); else
#endif
                dn::scan_head<0>((int)blockIdx.x, P.REC, P.GLB, P.dnw, P.ZD, (dq & 12) ? (bf16_t*)P.out : P.Y, P.ctl + CW_FLAGS, (char*)lds_raw, dq & 12); }
        } else if (!(dq & 128)) {
            volatile LAS unsigned* qw = MISC + 16;
            int pend0 = -1, pend1 = -1, carry = -1;
#ifdef PREPX
#define PREP_EXTRA dn::prep_chunk(pend0, P.QKVD, P.conv_w, P.BETA, P.GDEC, (unsigned char*)P.OPART, P.GLB + 4096, P.ctl + CW_FLAGS, lds, PREPX); dn::prep_chunk(pend1, P.QKVD, P.conv_w, P.BETA, P.GDEC, (unsigned char*)P.OPART + 131072, P.GLB + 4096, P.ctl + CW_FLAGS, lds, PREPX);
#else
#define PREP_EXTRA
#endif
#define PREP_LOOP(LIMIT) for (;;) { \
                if (tid == 0) { unsigned k; if (carry >= 0) k = (unsigned)carry; else k = __hip_atomic_fetch_add(P.ctl + CW_GQ, 1u, __ATOMIC_RELAXED, __HIP_MEMORY_SCOPE_AGENT); qw[0] = k; } \
                carry = -1; \
                CBAR_ALL(); \
                if (pend0 >= 0) { if (tid == 0) { __hip_atomic_store(P.ctl + CW_FLAGS + pend0, 1u, __ATOMIC_RELAXED, __HIP_MEMORY_SCOPE_AGENT); __hip_atomic_store(P.ctl + CW_FLAGS + pend1, 1u, __ATOMIC_RELAXED, __HIP_MEMORY_SCOPE_AGENT); } pend0 = -1; } \
                const unsigned k = (unsigned)__builtin_amdgcn_readfirstlane((int)qw[0]); \
                CBAR_LDS(); \
                if (k >= 1024u) break; \
                if (k >= (LIMIT)) { carry = (int)k; break; } \
                const unsigned cq = 2u * k; \
                pend0 = (int)(cq & 15u) * 128 + (int)(cq >> 4); pend1 = (int)((cq + 1u) & 15u) * 128 + (int)((cq + 1u) >> 4); \
                dn::prep_chunk(pend0, P.QKVD, P.conv_w, P.BETA, P.GDEC, P.REC + (size_t)pend0 * dn::REC_BYTES, P.GLB, P.ctl + CW_FLAGS, lds); \
                dn::prep_chunk(pend1, P.QKVD, P.conv_w, P.BETA, P.GDEC, P.REC + (size_t)pend1 * dn::REC_BYTES, P.GLB, P.ctl + CW_FLAGS, lds); \
                PREP_EXTRA \
            }
            PREP_LOOP(512u)
            GEMM1B_AND_PUBLISH();
            PREP_LOOP(1024u)
#undef PREP_LOOP
            if (tid < 64) { unsigned sp = 0u;
                while (__builtin_amdgcn_readfirstlane(__hip_atomic_load(P.ctl + CW_G1B, __ATOMIC_RELAXED, __HIP_MEMORY_SCOPE_AGENT)) < (unsigned)(G - 16)) { __builtin_amdgcn_s_sleep(8); if (++sp > (1u << 17)) break; }
                __builtin_amdgcn_fence(__ATOMIC_ACQUIRE, "agent"); asm volatile("s_waitcnt vmcnt(0)" ::: "memory"); }
            CBAR_LDS();
            for (;;) {
                if (tid == 0) { const unsigned k = __hip_atomic_fetch_add(P.ctl + CW_GQ2, 1u, __ATOMIC_RELAXED, __HIP_MEMORY_SCOPE_AGENT); qw[0] = k; }
                CBAR_ALL();
                const unsigned k = (unsigned)__builtin_amdgcn_readfirstlane((int)qw[0]);
                CBAR_LDS();
                if (k >= 256u) break;
#pragma unroll 1
                for (unsigned i4 = 0; i4 < 4u; ++i4) { const unsigned it = 4u * k + i4; moba::route_item((int)(it >> 5), (int)(it & 31u), A); }
                CBAR_ALL();
                if (tid == 0) __hip_atomic_fetch_add(P.ctl + CW_RT, 4u, __ATOMIC_RELAXED, __HIP_MEMORY_SCOPE_AGENT);
                CBAR_LDS();
            }
        }
#ifdef NOJOIN
        if (blockIdx.x >= 16)
#endif
        if (!(dq & 2)) {
            if (tid < 64) { unsigned sp = 0u;
                while (__builtin_amdgcn_readfirstlane(__hip_atomic_load(P.ctl + CW_RT, __ATOMIC_RELAXED, __HIP_MEMORY_SCOPE_AGENT)) < 1024u) { __builtin_amdgcn_s_sleep(8); if (++sp > (1u << 17)) break; }
                __builtin_amdgcn_fence(__ATOMIC_ACQUIRE, "agent"); asm volatile("s_waitcnt vmcnt(0)" ::: "memory"); }
            CBAR_LDS();
            moba::moba_phase((char*)lds_raw, A);
        }
        if (IN(5)) xcd_barrier(bar);
    }
    if (IN(5)) {
        pg8::Gemm g{P.Y, P.WT2, MTOK, DM, DM}; pg8::StaticOrder S; S.init(MTOK, DM, G, (int)blockIdx.x);
        pg8::EpiOut E{P.x, P.out};
        pg8::gemm_phase<pg8::EpiOut, pg8::StaticOrder, true, true>(lds + RING_OFF, g, S, E);
    }
#undef IN
#undef BOTH
}

extern "C" void kernel_launch(void* const* d_in, const int* in_sizes, int n_in, void* d_out, int out_size, void* d_ws, size_t ws_size, hipStream_t stream) {
    static int grid = 0;
    if (grid == 0) {
        if (n_in != 11 || ws_size < WS_END) { fprintf(stderr, "kernel_launch: unexpected inputs / workspace (%d, %zu)\n", n_in, ws_size); grid = -1; return; }
        int dev = 0, cus = 0;
        if (hipGetDevice(&dev) != hipSuccess || hipDeviceGetAttribute(&cus, hipDeviceAttributeMultiprocessorCount, dev) != hipSuccess) { grid = -1; return; }
        if (hipFuncSetAttribute((const void*)mega, hipFuncAttributeMaxDynamicSharedMemorySize, LDS_BYTES) != hipSuccess) { fprintf(stderr, "kernel_launch: hipFuncSetAttribute failed\n"); grid = -1; return; }
        grid = cus;
    }
    if (grid < 0) return;
    unsigned char* ws = (unsigned char*)d_ws;
    const Ptrs P = make_ptrs(d_in, d_out, ws);
    (void)hipMemsetAsync(ws + WS_CTL, 0, CTL_BYTES, stream);
    Args a{};
    for (int i = 0; i < 11; ++i) a.in[i] = (const float*)d_in[i];
    a.out = (float*)d_out; a.ws = ws;
#ifndef DUPF
#define DUPF 0
#endif
#ifndef DUPP
    a.ph_lo = 0; a.ph_hi = 6;
    hipLaunchKernelGGL(mega, dim3(grid), dim3(NWAVES * 64), LDS_BYTES, stream, a);
#else
#ifdef FIRSTF
    a.qoff = FIRSTF;
#endif
    a.ph_lo = 0; a.ph_hi = DUPP + 1;
    hipLaunchKernelGGL(mega, dim3(grid), dim3(NWAVES * 64), LDS_BYTES, stream, a);
    a.ph_lo = DUPP; a.ph_hi = DUPP + 1; a.qoff = 1024 + 128 + DUPF; a.li = 1;
    hipLaunchKernelGGL(mega, dim3(grid), dim3(NWAVES * 64), LDS_BYTES, stream, a);
    if (DUPP < 5) { a.ph_lo = DUPP + 1; a.ph_hi = 6; a.qoff = 0; a.li = 2;
    hipLaunchKernelGGL(mega, dim3(grid), dim3(NWAVES * 64), LDS_BYTES, stream, a); }
#endif
}
```

```cpp
#include <hip/hip_runtime.h>
#include <stdint.h>
#include <math.h>
#include <cstdio>

typedef unsigned short bf16_t;
typedef short bf16x8 __attribute__((ext_vector_type(8)));
typedef float f32x4 __attribute__((ext_vector_type(4)));
typedef unsigned u32x4 __attribute__((ext_vector_type(4)));

constexpr int NB = 4, SEQ = 8192, DM = 1024, MTOK = NB * SEQ;
constexpr int AH = 8, AD = 64, AW = 512, NBLK = 32;
constexpr int DH = 4, DKH = 128, NCOL = 4104, DCONV = 1536;
constexpr float EPS = 1e-6f;
constexpr float LOG2E = 1.4426950408889634f;
constexpr float QSCALE = 0.125f * LOG2E;

constexpr size_t MiB = 1u << 20;
constexpr size_t WS_CTL = 0, CTL_BYTES = 1 * MiB;
constexpr size_t WS_KMEAN = 512 * 1024;
constexpr size_t WS_WT1 = 1 * MiB;
constexpr size_t WS_WT2 = 9 * MiB;
constexpr size_t WS_BETA = 11 * MiB;
constexpr size_t WS_GDEC = 11 * MiB + 512 * 1024;
constexpr size_t WS_QA = 12 * MiB, WS_KA = 44 * MiB, WS_VA = 76 * MiB;
constexpr size_t WS_ZA = 108 * MiB, WS_ZD = 140 * MiB;
constexpr size_t WS_QKVD = 172 * MiB;
constexpr size_t WS_QD = 268 * MiB, WS_KD = 300 * MiB, WS_VD = 332 * MiB;
constexpr size_t WS_REC = 268 * MiB;
constexpr size_t WS_GLB = 256 * 1024;
constexpr size_t WS_Y = 412 * MiB;
constexpr size_t WS_END = 476 * MiB;
constexpr size_t OUT_OD = 64 * MiB;

__device__ __forceinline__ unsigned short f2bf(float f) { unsigned u = __float_as_uint(f); return (unsigned short)((u + 0x7fffu + ((u >> 16) & 1u)) >> 16); }
__device__ __forceinline__ float bf2f(unsigned short u) { return __uint_as_float(((unsigned)u) << 16); }
__device__ __forceinline__ float wave_sum(float v) {
#pragma unroll
    for (int o = 1; o < 64; o <<= 1) v += __shfl_xor(v, o);
    return v;
}
__device__ __forceinline__ float silu_f(float x) { return x / (1.0f + __expf(-x)); }
__host__ __device__ __forceinline__ int wt1_ltile(int pt) { return pt < 8 ? pt : (pt < 10 ? pt + 6 : pt - 2); }
__host__ __device__ __forceinline__ int wt1_logical(int p) { const int pn = wt1_ltile(p >> 8), t = p & 255, bj = t >> 7, wc = (t >> 5) & 3, i = t & 31; return 256 * pn + 64 * wc + 32 * bj + i; }
__host__ __device__ __forceinline__ int wt1_physical(int c) { const int ln = c >> 8, pn = ln < 8 ? ln : (ln < 14 ? ln + 2 : ln - 6), wc = (c >> 6) & 3, bj = (c >> 5) & 1, i = c & 31; return 256 * pn + 128 * bj + 32 * wc + i; }

__device__ __forceinline__ void wt_tile(const float* W, int ldw, bf16_t* WT, int kb, int pb, bool perm, float* lds, int tid) {
#pragma unroll 4
    for (int i = 0; i < 16; ++i) { const int kk = i * 4 + (tid >> 6), pp = tid & 63, p = pb * 64 + pp; const int c = perm ? wt1_logical(p) : p;
        lds[kk * 65 + pp] = W[(size_t)(kb * 64 + kk) * ldw + c]; }
    __syncthreads();
#pragma unroll 4
    for (int i = 0; i < 16; ++i) { const int pp = i * 4 + (tid >> 6), kk = tid & 63;
        WT[(size_t)(pb * 64 + pp) * 1024 + kb * 64 + kk] = f2bf(lds[kk * 65 + pp]); }
    __syncthreads();
}
__global__ void __launch_bounds__(256) k_wt(const float* w_in, const float* w_out, bf16_t* WT1, bf16_t* WT2) {
    __shared__ float lds[64 * 65];
    const int tid = threadIdx.x;
    for (int it = blockIdx.x; it < 1024 + 256; it += gridDim.x) {
        if (it < 1024) wt_tile(w_in, NCOL, WT1, it & 15, it >> 4, true, lds, tid);
        else { const int r = it - 1024; wt_tile(w_out, DM, WT2, r & 15, r >> 4, false, lds, tid); }
    }
}

__global__ void __launch_bounds__(256) k_rows(const float* x, const float* norm_w, const float* w_in, const float* a_log, const float* dt_bias,
                                              bf16_t* HN, float* BETA, float* GDEC) {
    __shared__ float w8[1024 * 8];
    const int tid = threadIdx.x, lane = tid & 63, wave = tid >> 6;
    for (int i = tid; i < 1024 * 8; i += 256) w8[i] = w_in[(size_t)(i >> 3) * NCOL + 4096 + (i & 7)];
    __syncthreads();
    f32x4 nw[4];
#pragma unroll
    for (int j = 0; j < 4; ++j) nw[j] = ((const f32x4*)norm_w)[lane + 64 * j];
    const int gw = blockIdx.x * 4 + wave, ngw = gridDim.x * 4;
    for (int row = gw; row < MTOK; row += ngw) {
        const f32x4* xr = (const f32x4*)(x + (size_t)row * DM) + lane;
        f32x4 v[4]; float ss = 0.f;
#pragma unroll
        for (int j = 0; j < 4; ++j) { v[j] = xr[64 * j]; ss += v[j][0] * v[j][0] + v[j][1] * v[j][1] + v[j][2] * v[j][2] + v[j][3] * v[j][3]; }
        ss = wave_sum(ss);
        const float rstd = 1.0f / sqrtf(ss * (1.0f / DM) + EPS);
        float d[8];
#pragma unroll
        for (int c = 0; c < 8; ++c) d[c] = 0.f;
#pragma unroll
        for (int j = 0; j < 4; ++j) {
            f32x4 h = v[j] * rstd * nw[j];
            unsigned lo = (unsigned)f2bf(h[0]) | ((unsigned)f2bf(h[1]) << 16), hi = (unsigned)f2bf(h[2]) | ((unsigned)f2bf(h[3]) << 16);
            *(uint2*)(HN + (size_t)row * DM + 4 * (lane + 64 * j)) = make_uint2(lo, hi);
#pragma unroll
            for (int e = 0; e < 4; ++e) { const float* wr = w8 + (4 * (lane + 64 * j) + e) * 8;
#pragma unroll
                for (int c = 0; c < 8; ++c) d[c] += h[e] * wr[c]; }
        }
#pragma unroll
        for (int c = 0; c < 8; ++c) d[c] = wave_sum(d[c]);
        if (lane < 4) {
            const int hh = lane; float bd = d[0], ad = d[4];
            if (hh == 1) { bd = d[1]; ad = d[5]; } else if (hh == 2) { bd = d[2]; ad = d[6]; } else if (hh == 3) { bd = d[3]; ad = d[7]; }
            const float beta = 1.0f / (1.0f + expf(-bd));
            const float z = ad + dt_bias[hh];
            const float sp = fmaxf(z, 0.f) + log1pf(expf(-fabsf(z)));
            const float g = -expf(a_log[hh]) * sp;
            const int b = row / SEQ, s = row % SEQ;
            BETA[(size_t)(b * DH + hh) * SEQ + s] = beta; GDEC[(size_t)(b * DH + hh) * SEQ + s] = g;
        }
    }
}

struct G1Out { bf16_t *QA, *KA, *VA, *ZA, *ZD, *QKVD; float* KMEAN; const float *qnw, *knw; };
__global__ void __launch_bounds__(256) k_gemm1(const bf16_t* HN, const bf16_t* WT1, G1Out o) {
    const int tid = threadIdx.x, lane = tid & 63, wave = tid >> 6, fr = lane & 15, fq = lane >> 4;
    const int rt = blockIdx.x >> 4, gq = blockIdx.x & 15, cg = gq * 4 + wave;
    f32x4 acc[2][4];
#pragma unroll
    for (int m = 0; m < 2; ++m)
#pragma unroll
        for (int n = 0; n < 4; ++n) acc[m][n] = (f32x4){0.f, 0.f, 0.f, 0.f};
    const bf16_t* ap[2]; const bf16_t* bp[4];
#pragma unroll
    for (int m = 0; m < 2; ++m) ap[m] = HN + (size_t)(rt * 32 + m * 16 + fr) * DM + 8 * fq;
#pragma unroll
    for (int n = 0; n < 4; ++n) bp[n] = WT1 + (size_t)wt1_physical(cg * 64 + n * 16 + fr) * DM + 8 * fq;
    for (int k0 = 0; k0 < DM; k0 += 32) {
        bf16x8 a[2], b[4];
#pragma unroll
        for (int m = 0; m < 2; ++m) a[m] = *(const bf16x8*)(ap[m] + k0);
#pragma unroll
        for (int n = 0; n < 4; ++n) b[n] = *(const bf16x8*)(bp[n] + k0);
#pragma unroll
        for (int m = 0; m < 2; ++m)
#pragma unroll
            for (int n = 0; n < 4; ++n) acc[m][n] = __builtin_amdgcn_mfma_f32_16x16x32_bf16(a[m], b[n], acc[m][n], 0, 0, 0);
    }
    const int row_base = rt * 32, b_ = row_base / SEQ;
    if (cg < 16) {
        const bool isq = cg < 8; const int head = cg & 7; const float* nwp = isq ? o.qnw : o.knw;
        float nwv[4];
#pragma unroll
        for (int n = 0; n < 4; ++n) nwv[n] = nwp[n * 16 + fr];
        float ksum[4] = {0.f, 0.f, 0.f, 0.f};
#pragma unroll
        for (int m = 0; m < 2; ++m)
#pragma unroll
            for (int r = 0; r < 4; ++r) {
                float ss = 0.f;
#pragma unroll
                for (int n = 0; n < 4; ++n) ss += acc[m][n][r] * acc[m][n][r];
                ss += __shfl_xor(ss, 1); ss += __shfl_xor(ss, 2); ss += __shfl_xor(ss, 4); ss += __shfl_xor(ss, 8);
                const float rs = 1.0f / sqrtf(ss * (1.0f / 64.0f) + EPS);
                const int row = row_base + m * 16 + fq * 4 + r, s = row % SEQ;
                bf16_t* dst = (isq ? o.QA : o.KA) + ((size_t)(b_ * AH + head) * SEQ + s) * AD;
#pragma unroll
                for (int n = 0; n < 4; ++n) { const float val = acc[m][n][r] * rs * nwv[n]; ksum[n] += val; dst[n * 16 + fr] = f2bf(isq ? val * QSCALE : val); }
            }
        if (!isq) {
            const int blk = (row_base % SEQ) >> 8;
#pragma unroll
            for (int n = 0; n < 4; ++n) { float t = ksum[n]; t += __shfl_xor(t, 16); t += __shfl_xor(t, 32);
                if (fq == 0) atomicAdd(o.KMEAN + ((size_t)(b_ * AH + head) * NBLK + blk) * AD + n * 16 + fr, t * (1.0f / 256.0f)); }
        }
    } else {
#pragma unroll
        for (int m = 0; m < 2; ++m)
#pragma unroll
            for (int r = 0; r < 4; ++r) {
                const int row = row_base + m * 16 + fq * 4 + r, s = row % SEQ;
#pragma unroll
                for (int n = 0; n < 4; ++n) {
                    const int c = cg * 64 + n * 16 + fr; const float val = acc[m][n][r];
                    if (c < 1536) { const int head = (c - 1024) >> 6; o.VA[((size_t)(b_ * AH + head) * SEQ + s) * AD + (c & 63)] = f2bf(val); }
                    else if (c < 2048) o.ZA[(size_t)row * AW + (c - 1536)] = f2bf(silu_f(val));
                    else if (c < 3584) o.QKVD[(size_t)row * DCONV + (c - 2048)] = f2bf(val);
                    else o.ZD[(size_t)row * AW + (c - 3584)] = f2bf(silu_f(val));
                }
            }
    }
}

__global__ void __launch_bounds__(256) k_gemm2(const bf16_t* Y, const bf16_t* WT2, const float* x, float* out) {
    const int tid = threadIdx.x, lane = tid & 63, wave = tid >> 6, fr = lane & 15, fq = lane >> 4;
    const int rt = blockIdx.x >> 2, gq = blockIdx.x & 3, cg = gq * 4 + wave;
    f32x4 acc[2][4];
#pragma unroll
    for (int m = 0; m < 2; ++m)
#pragma unroll
        for (int n = 0; n < 4; ++n) acc[m][n] = (f32x4){0.f, 0.f, 0.f, 0.f};
    const bf16_t* ap[2]; const bf16_t* bp[4];
#pragma unroll
    for (int m = 0; m < 2; ++m) ap[m] = Y + (size_t)(rt * 32 + m * 16 + fr) * DM + 8 * fq;
#pragma unroll
    for (int n = 0; n < 4; ++n) bp[n] = WT2 + (size_t)(cg * 64 + n * 16 + fr) * DM + 8 * fq;
    for (int k0 = 0; k0 < DM; k0 += 32) {
        bf16x8 a[2], b[4];
#pragma unroll
        for (int m = 0; m < 2; ++m) a[m] = *(const bf16x8*)(ap[m] + k0);
#pragma unroll
        for (int n = 0; n < 4; ++n) b[n] = *(const bf16x8*)(bp[n] + k0);
#pragma unroll
        for (int m = 0; m < 2; ++m)
#pragma unroll
            for (int n = 0; n < 4; ++n) acc[m][n] = __builtin_amdgcn_mfma_f32_16x16x32_bf16(a[m], b[n], acc[m][n], 0, 0, 0);
    }
#pragma unroll
    for (int m = 0; m < 2; ++m)
#pragma unroll
        for (int r = 0; r < 4; ++r) {
            const size_t row = rt * 32 + m * 16 + fq * 4 + r;
#pragma unroll
            for (int n = 0; n < 4; ++n) { const size_t idx = row * DM + cg * 64 + n * 16 + fr; out[idx] = x[idx] + acc[m][n][r]; }
        }
}

__global__ void __launch_bounds__(256) k_dn_prep(const bf16_t* QKVD, const float* conv_w, bf16_t* QD, bf16_t* KD, bf16_t* VD) {
    const int tid = threadIdx.x, lane = tid & 63, wave = tid >> 6;
    const int gw = blockIdx.x * 4 + wave, ngw = gridDim.x * 4;
    for (int it = gw; it < MTOK * DH; it += ngw) {
        const int row = it >> 2, hh = it & 3, b = row / SEQ, s = row % SEQ;
        float val[3][2];
#pragma unroll
        for (int part = 0; part < 3; ++part)
#pragma unroll
            for (int e = 0; e < 2; ++e) {
                const int cc = part * 512 + hh * 128 + lane + 64 * e; float a = 0.f;
#pragma unroll
                for (int j = 0; j < 4; ++j) { const int sj = s - 3 + j; if (sj >= 0) a += conv_w[j * DCONV + cc] * bf2f(QKVD[(size_t)(row - 3 + j) * DCONV + cc]); }
                val[part][e] = silu_f(a);
            }
        float sq = wave_sum(val[0][0] * val[0][0] + val[0][1] * val[0][1]);
        float sk = wave_sum(val[1][0] * val[1][0] + val[1][1] * val[1][1]);
        const float rq = (1.0f / sqrtf(sq + EPS)) * 0.08838834764831845f, rk = 1.0f / sqrtf(sk + EPS);
        const size_t base = ((size_t)(b * DH + hh) * SEQ + s) * DKH;
#pragma unroll
        for (int e = 0; e < 2; ++e) { QD[base + lane + 64 * e] = f2bf(val[0][e] * rq); KD[base + lane + 64 * e] = f2bf(val[1][e] * rk); VD[base + lane + 64 * e] = f2bf(val[2][e]); }
    }
}
__global__ void __launch_bounds__(128) k_dn_seq(const bf16_t* QD, const bf16_t* KD, const bf16_t* VD, const float* BETA, const float* GDEC, float* OD) {
    __shared__ __attribute__((aligned(16))) float kq[2][256];
    const int e = threadIdx.x, bh = blockIdx.x, b = bh >> 2, hh = bh & 3;
    float S[128];
#pragma unroll
    for (int d = 0; d < 128; ++d) S[d] = 0.f;
    const size_t base = (size_t)bh * SEQ * DKH;
    float kn = bf2f(KD[base + e]), qn = bf2f(QD[base + e]), vn_ = bf2f(VD[base + e]), gn = GDEC[(size_t)bh * SEQ], bn = BETA[(size_t)bh * SEQ];
    for (int t = 0; t < SEQ; ++t) {
        float* buf = kq[t & 1];
        buf[e] = kn; buf[128 + e] = qn;
        const float vt = vn_, alpha = __expf(gn), beta = bn;
        if (t + 1 < SEQ) { const size_t nx = base + (size_t)(t + 1) * DKH + e; kn = bf2f(KD[nx]); qn = bf2f(QD[nx]); vn_ = bf2f(VD[nx]); gn = GDEC[(size_t)bh * SEQ + t + 1]; bn = BETA[(size_t)bh * SEQ + t + 1]; }
        __syncthreads();
        float ks = 0.f;
#pragma unroll
        for (int d = 0; d < 128; d += 4) { const f32x4 k4 = *(const f32x4*)(buf + d); ks += k4[0] * S[d] + k4[1] * S[d + 1] + k4[2] * S[d + 2] + k4[3] * S[d + 3]; }
        const float vnew = beta * (vt - alpha * ks);
        float o = 0.f;
#pragma unroll
        for (int d = 0; d < 128; d += 4) { const f32x4 k4 = *(const f32x4*)(buf + d), q4 = *(const f32x4*)(buf + 128 + d);
#pragma unroll
            for (int i = 0; i < 4; ++i) { S[d + i] = alpha * S[d + i] + k4[i] * vnew; o += q4[i] * S[d + i]; } }
        OD[((size_t)b * SEQ + t) * AW + hh * 128 + e] = o;
    }
}

__device__ __forceinline__ int t5_bucket_dev(int n) {
    if (n < 16) return n;
    int bkt = 16;
    bkt += (n >= 19) + (n >= 21) + (n >= 24) + (n >= 27) + (n >= 31) + (n >= 35) + (n >= 40) + (n >= 46) + (n >= 52) + (n >= 59) + (n >= 67) + (n >= 77) + (n >= 87) + (n >= 99) + (n >= 113);
    return bkt;
}
__global__ void __launch_bounds__(256) k_attn(const bf16_t* QA, const bf16_t* KA, const bf16_t* VA, const float* KMEAN, const float* rel_bias,
                                              const float* qnw, const float* knw, const bf16_t* ZA, bf16_t* Y) {
    __shared__ float qs_all[4][64];
    __shared__ float bias_all[4][32];
    const int tid = threadIdx.x, lane = tid & 63, wave = tid >> 6;
    float* qs = qs_all[wave]; float* bt = bias_all[wave];
    const int gq = blockIdx.x * 4 + wave;
    const int bh = gq / SEQ, s = gq % SEQ, h = bh & 7, b = bh >> 3, own = s >> 8;
    float mq = fabsf(qnw[lane]), mk = fabsf(knw[lane]), mb = (lane < 32) ? rel_bias[lane * AH + h] : -1e30f;
#pragma unroll
    for (int o = 1; o < 64; o <<= 1) { mq = fmaxf(mq, __shfl_xor(mq, o)); mk = fmaxf(mk, __shfl_xor(mk, o)); mb = fmaxf(mb, __shfl_xor(mb, o)); }
    const float mref = (8.0f * mq * mk + mb) * LOG2E;
    qs[lane] = bf2f(QA[(size_t)gq * AD + lane]);
    if (lane < 32) bt[lane] = rel_bias[lane * AH + h] * LOG2E;
    __syncthreads();
    float gate = -INFINITY;
    if (lane < own) { const float* km = KMEAN + ((size_t)bh * NBLK + lane) * AD; float a = 0.f;
        for (int d = 0; d < 64; ++d) a += qs[d] * km[d];
        gate = a; }
    unsigned selmask = 0u;
    for (int r = 0; r < 3; ++r) {
        float bv = gate; int bi = lane;
#pragma unroll
        for (int o = 1; o < 64; o <<= 1) { const float ov = __shfl_xor(bv, o); const int oi = __shfl_xor(bi, o); if (ov > bv || (ov == bv && oi < bi)) { bv = ov; bi = oi; } }
        if (bv > -INFINITY) { selmask |= 1u << bi; if (lane == bi) gate = -INFINITY; }
    }
    selmask |= 1u << own;
    float l = 0.f, oacc = 0.f;
    const bf16_t* Kb = KA + (size_t)bh * SEQ * AD; const bf16_t* Vb = VA + (size_t)bh * SEQ * AD;
    for (int j = 0; j <= own; ++j) {
        if (!((selmask >> j) & 1u)) continue;
        for (int t4 = 0; t4 < 4; ++t4) {
            const int kpos = j * 256 + t4 * 64 + lane;
            const bf16_t* kr = Kb + (size_t)kpos * AD; float sc = 0.f;
#pragma unroll
            for (int c = 0; c < 8; ++c) { const bf16x8 kv = *(const bf16x8*)(kr + c * 8);
#pragma unroll
                for (int i = 0; i < 8; ++i) sc += qs[c * 8 + i] * bf2f((unsigned short)kv[i]); }
            const int dist = s - kpos; float p = 0.f;
            if (dist >= 0) p = exp2f(sc + bt[t5_bucket_dev(dist)] - mref);
            l += p;
            const bf16_t* vr = Vb + (size_t)(j * 256 + t4 * 64) * AD + lane;
#pragma unroll 8
            for (int k = 0; k < 64; ++k) oacc += __shfl(p, k) * bf2f(vr[(size_t)k * AD]);
        }
    }
    l = wave_sum(l);
    const size_t tok = (size_t)b * SEQ + s;
    const float yv = (oacc / l) * bf2f(ZA[tok * AW + h * 64 + lane]);
    Y[tok * DM + h * 64 + lane] = f2bf(yv);
}

__global__ void __launch_bounds__(256) k_ycomb(const float* OD, const float* dnw, const bf16_t* ZD, bf16_t* Y) {
    const int tid = threadIdx.x, lane = tid & 63, wave = tid >> 6;
    const int gw = blockIdx.x * 4 + wave, ngw = gridDim.x * 4;
    for (int it = gw; it < MTOK * DH; it += ngw) {
        const int row = it >> 2, hh = it & 3;
        const float a0 = OD[(size_t)row * AW + hh * 128 + lane], a1 = OD[(size_t)row * AW + hh * 128 + 64 + lane];
        const float ss = wave_sum(a0 * a0 + a1 * a1);
        const float rs = 1.0f / sqrtf(ss * (1.0f / 128.0f) + EPS);
        Y[(size_t)row * DM + 512 + hh * 128 + lane] = f2bf(a0 * rs * dnw[lane] * bf2f(ZD[(size_t)row * AW + hh * 128 + lane]));
        Y[(size_t)row * DM + 512 + hh * 128 + 64 + lane] = f2bf(a1 * rs * dnw[64 + lane] * bf2f(ZD[(size_t)row * AW + hh * 128 + 64 + lane]));
    }
}


#define CBAR_ALL() do{ asm volatile("s_waitcnt vmcnt(0) lgkmcnt(0)":::"memory"); __builtin_amdgcn_s_barrier(); asm volatile("":::"memory"); }while(0)
#define CBAR_LDS() do{ asm volatile("s_waitcnt lgkmcnt(0)":::"memory"); __builtin_amdgcn_s_barrier(); asm volatile("":::"memory"); }while(0)
namespace pg8 {
#define PG8_LAS __attribute__((address_space(3)))
constexpr int BM = 256, BK = 64, HALF = 128, HTB = HALF * BK * 2  , STAGE_BYTES = 8 * HTB, NXCD = 8, WGM = 8;

__host__ __device__ __forceinline__ int lds_byte(int r, int c) { const int st = (r >> 4) * 2 + (c >> 5), rr = r & 15, cc = c & 31, ob = rr * 64 + cc * 2; return st * 1024 + (ob ^ (((ob >> 9) & 1) << 5)); }
__host__ __device__ __forceinline__ void stage_rc(int b, int& R, int& C) { const int st = b / 1024, sb = b % 1024, swz = sb ^ (((sb >> 9) & 1) << 5); R = (st >> 1) * 16 + swz / 64; C = (st & 1) * 32 + (swz % 64) / 2; }
__host__ __device__ __forceinline__ int perm32(int rho) { const int n = rho >> 4, i = rho & 15; return 8 * (i >> 2) + 4 * n + (i & 3); }

struct Unit { int pm, pn; };
struct Gemm { const bf16_t* A; const bf16_t* Bt; int M, N, K; };

struct StaticOrder {
    int nM, nN, nwg, G, c;
    __host__ __device__ void init(int M, int N, int G_, int c_) { nM = M / BM; nN = N / BM; nwg = nM * nN; G = G_; c = c_; }
    __host__ __device__ bool next(int i, Unit& u) const {
        const long L = (long)i * G + c; if (L >= nwg) return false;
        int wgid = (int)L; { const int q = nwg / NXCD, r = nwg % NXCD, xcd = wgid % NXCD, off = wgid / NXCD; wgid = (xcd < r ? xcd * (q + 1) : r * (q + 1) + (xcd - r) * q) + off; }
        const int nig = WGM * nN, gid = wgid / nig, fm = gid * WGM, gsz = (nM - fm) < WGM ? (nM - fm) : WGM;
        u.pm = fm + ((wgid % nig) % gsz); u.pn = (wgid % nig) / gsz; return true;
    }
    __device__ __forceinline__ void a_ready(const Unit&) const {}
    __device__ __forceinline__ void done(const Unit&) const {}
};

__device__ __forceinline__ unsigned cvt_pk_bf16(float lo, float hi) { unsigned r; asm volatile("v_cvt_pk_bf16_f32 %0, %1, %2" : "=v"(r) : "v"(lo), "v"(hi)); return r; }
typedef float f32x2 __attribute__((ext_vector_type(2)));
template <class Epi, class Sched, bool ALIGN_EPI = false, bool SP2 = false>
__device__ __forceinline__ void gemm_phase(PG8_LAS unsigned char* lds, const Gemm g, const Sched& S, const Epi& E) {
    const int tid = threadIdx.x, wid = __builtin_amdgcn_readfirstlane(tid >> 6), lane = tid & 63, wr = wid >> 2, wc = wid & 3, fr = lane & 15, fq = lane >> 4;
    const int K = g.K, nt = K / BK;
    unsigned voffA[2], voffB[2];
#pragma unroll
    for (int i = 0; i < 2; ++i) { int R, C; stage_rc(tid * 16 + i * 8192, R, C); const int Rb = Epi::PERM ? ((R & ~31) + perm32(R & 31)) : R;
        voffA[i] = (unsigned)(R * K + C) * 2u; voffB[i] = (unsigned)(Rb * K + C) * 2u; }
    const size_t kstep = (size_t)(BK * 2);
    const size_t hstep = (size_t)HALF * K * 2;
    const size_t tstep = 2 * hstep;
    const unsigned ldsw = (unsigned)wid * 1024u;
    const int aoff = lds_byte(wr * 64 + fr, fq * 8), boff = lds_byte(wc * 32 + fr, fq * 8);
#define PG8_SA(b, h) (((b) * 2 + (h)) * HTB)
#define PG8_SB(b, h) ((4 + (b) * 2 + (h)) * HTB)
#define PG8_STAGE(bufoff, gbase, voff) do { _Pragma("unroll") for (int _i = 0; _i < 2; ++_i) \
        __builtin_amdgcn_global_load_lds((const unsigned*)((const char*)(gbase) + (voff)[_i]), (PG8_LAS unsigned*)(lds + (bufoff) + ldsw + _i * 8192), 16, 0, 0); } while (0)
#define PG8_LDA(dst, b, h) do { _Pragma("unroll") for (int m = 0; m < 4; ++m) _Pragma("unroll") for (int k = 0; k < 2; ++k) dst[m][k] = *(const PG8_LAS bf16x8*)(lds + PG8_SA(b, h) + aoff + m * 2048 + k * 1024); } while (0)
#define PG8_LDB(dst, b, h) do { _Pragma("unroll") for (int n = 0; n < 2; ++n) _Pragma("unroll") for (int k = 0; k < 2; ++k) dst[n][k] = *(const PG8_LAS bf16x8*)(lds + PG8_SB(b, h) + boff + n * 2048 + k * 1024); } while (0)
#define PG8_MMA(ai, bj, At, Bt) do { __builtin_amdgcn_s_setprio(1); _Pragma("unroll") for (int m = 0; m < 4; ++m) _Pragma("unroll") for (int n = 0; n < 2; ++n) _Pragma("unroll") for (int k = 0; k < 2; ++k) \
        acc[ai][bj][m][n] = __builtin_amdgcn_mfma_f32_16x16x32_bf16(Bt[n][k], At[m][k], acc[ai][bj][m][n], 0, 0, 0); __builtin_amdgcn_s_setprio(0); } while (0)
#define PG8_WAIT_V(n) asm volatile("s_waitcnt vmcnt(" #n ")" ::: "memory")
#define PG8_WAIT_L(n) asm volatile("s_waitcnt lgkmcnt(" #n ")" ::: "memory")
#define PG8_BAR __builtin_amdgcn_s_barrier()
#define PG8_SCHED __builtin_amdgcn_sched_barrier(0)
    Unit cur, nxt; int ui = 0;
    if (!S.next(0, cur)) return;
    f32x4 acc[2][2][4][2];
#pragma unroll
    for (int a = 0; a < 2; ++a)
#pragma unroll
        for (int b = 0; b < 2; ++b)
#pragma unroll
            for (int m = 0; m < 4; ++m)
#pragma unroll
                for (int n = 0; n < 2; ++n) acc[a][b][m][n] = (f32x4){0.f, 0.f, 0.f, 0.f};
    bf16x8 At[4][2], B0[2][2], B1[2][2];
    const char* cA = (const char*)g.A + (size_t)cur.pm * tstep; const char* cB = (const char*)g.Bt + (size_t)cur.pn * tstep;
    S.a_ready(cur);
    if constexpr (SP2) {
        PG8_STAGE(PG8_SB(0, 0), cB, voffB); PG8_STAGE(PG8_SB(0, 1), cB + hstep, voffB); PG8_STAGE(PG8_SA(0, 0), cA, voffA); PG8_STAGE(PG8_SA(0, 1), cA + hstep, voffA);
        if (wr == 1) PG8_BAR;
        PG8_WAIT_V(2); PG8_BAR;
        PG8_STAGE(PG8_SB(1, 0), cB + kstep, voffB); PG8_STAGE(PG8_SA(1, 0), cA + kstep, voffA); PG8_STAGE(PG8_SB(1, 1), cB + hstep + kstep, voffB);
        PG8_WAIT_V(6); PG8_BAR;
    } else {
        PG8_STAGE(PG8_SB(0, 0), cB, voffB); PG8_STAGE(PG8_SA(0, 0), cA, voffA); PG8_STAGE(PG8_SB(0, 1), cB + hstep, voffB); PG8_STAGE(PG8_SA(0, 1), cA + hstep, voffA);
        if (wr == 1) PG8_BAR;
        PG8_WAIT_V(4); PG8_BAR;
        PG8_STAGE(PG8_SB(1, 0), cB + kstep, voffB); PG8_STAGE(PG8_SA(1, 0), cA + kstep, voffA); PG8_STAGE(PG8_SB(1, 1), cB + hstep + kstep, voffB);
        PG8_WAIT_V(6); PG8_BAR;
    }
    for (;;) {
        const bool has_next = S.next(ui + 1, nxt);
        const char* nA = has_next ? (const char*)g.A + (size_t)nxt.pm * tstep : cA; const char* nB = has_next ? (const char*)g.Bt + (size_t)nxt.pn * tstep : cB;
        for (int t = 0; t < nt; t += 2) {
            const bool last = (t == nt - 2);
            const char* a1 = cA + (size_t)(t + 1) * kstep;
            const char* a2 = last ? nA : cA + (size_t)(t + 2) * kstep; const char* b2 = last ? nB : cB + (size_t)(t + 2) * kstep;
            const char* a3 = a2 + kstep; const char* b3 = b2 + kstep;
            if (last && has_next) S.a_ready(nxt);
            if constexpr (SP2) {
            PG8_LDB(B0, 0, 0); PG8_LDB(B1, 0, 1); PG8_SCHED; PG8_LDA(At, 0, 0); PG8_STAGE(PG8_SA(1, 1), a1 + hstep, voffA);
            PG8_WAIT_V(8); PG8_WAIT_L(0); PG8_BAR; PG8_MMA(0, 0, At, B0); PG8_MMA(0, 1, At, B1); PG8_BAR; PG8_SCHED;
            PG8_LDA(At, 0, 1); PG8_STAGE(PG8_SB(0, 0), b2, voffB); PG8_STAGE(PG8_SB(0, 1), b2 + hstep, voffB); PG8_STAGE(PG8_SA(0, 0), a2, voffA);
            PG8_WAIT_V(8); PG8_WAIT_L(0); PG8_BAR; PG8_MMA(1, 0, At, B0); PG8_MMA(1, 1, At, B1); PG8_BAR; PG8_SCHED;
            PG8_LDB(B0, 1, 0); PG8_LDB(B1, 1, 1); PG8_SCHED; PG8_LDA(At, 1, 0); PG8_STAGE(PG8_SA(0, 1), a2 + hstep, voffA);
            PG8_WAIT_V(8); PG8_WAIT_L(0); PG8_BAR; PG8_MMA(0, 0, At, B0); PG8_MMA(0, 1, At, B1); PG8_BAR; PG8_SCHED;
            PG8_LDA(At, 1, 1); PG8_STAGE(PG8_SB(1, 0), b3, voffB); PG8_STAGE(PG8_SB(1, 1), b3 + hstep, voffB); PG8_STAGE(PG8_SA(1, 0), a3, voffA);
            PG8_WAIT_V(8); PG8_WAIT_L(0); PG8_BAR; PG8_MMA(1, 0, At, B0); PG8_MMA(1, 1, At, B1); PG8_BAR; PG8_SCHED;
            } else {
            PG8_LDB(B0, 0, 0); PG8_SCHED; PG8_LDA(At, 0, 0); PG8_STAGE(PG8_SA(1, 1), a1 + hstep, voffA);
            PG8_WAIT_L(8); PG8_BAR; PG8_WAIT_L(0); PG8_MMA(0, 0, At, B0); PG8_BAR; PG8_SCHED;
            PG8_LDB(B1, 0, 1); PG8_STAGE(PG8_SB(0, 0), b2, voffB);
            PG8_BAR; PG8_WAIT_L(0); PG8_MMA(0, 1, At, B1); PG8_BAR;
            PG8_LDA(At, 0, 1); PG8_STAGE(PG8_SA(0, 0), a2, voffA);
            PG8_BAR; PG8_WAIT_L(0); PG8_MMA(1, 0, At, B0); PG8_BAR; PG8_SCHED;
            PG8_STAGE(PG8_SB(0, 1), b2 + hstep, voffB);
            PG8_WAIT_V(6); PG8_BAR; PG8_MMA(1, 1, At, B1); PG8_BAR;
            PG8_LDB(B0, 1, 0); PG8_SCHED; PG8_LDA(At, 1, 0); PG8_STAGE(PG8_SA(0, 1), a2 + hstep, voffA);
            PG8_WAIT_L(8); PG8_BAR; PG8_WAIT_L(0); PG8_MMA(0, 0, At, B0); PG8_BAR; PG8_SCHED;
            PG8_LDB(B1, 1, 1); PG8_STAGE(PG8_SB(1, 0), b3, voffB);
            PG8_BAR; PG8_WAIT_L(0); PG8_MMA(0, 1, At, B1); PG8_BAR;
            PG8_LDA(At, 1, 1); PG8_STAGE(PG8_SA(1, 0), a3, voffA);
            PG8_BAR; PG8_WAIT_L(0); PG8_MMA(1, 0, At, B0); PG8_BAR; PG8_SCHED;
            PG8_STAGE(PG8_SB(1, 1), b3 + hstep, voffB);
            PG8_WAIT_V(6); PG8_BAR; PG8_MMA(1, 1, At, B1); PG8_BAR;
            }
        }
        if constexpr (ALIGN_EPI) { if (wr == 0) PG8_BAR; }
        if constexpr (!Epi::AFTER_DRAIN) { E(acc, cur, wr, wc, fr, fq); S.done(cur); }
        if (!has_next) break;
#pragma unroll
        for (int a = 0; a < 2; ++a)
#pragma unroll
            for (int b = 0; b < 2; ++b)
#pragma unroll
                for (int m = 0; m < 4; ++m)
#pragma unroll
                    for (int n = 0; n < 2; ++n) acc[a][b][m][n] = (f32x4){0.f, 0.f, 0.f, 0.f};
        cur = nxt; cA = nA; cB = nB; ++ui;
        if constexpr (ALIGN_EPI) { if (wr == 1) PG8_BAR; }
    }
    PG8_WAIT_V(0);
    if constexpr (!ALIGN_EPI) { if (wr == 0) PG8_BAR; }
    PG8_BAR;
    if constexpr (Epi::AFTER_DRAIN) { E.fused(acc, cur, wr, wc, fr, fq, lds, wid, lane); S.done(cur); }
#undef PG8_SA
#undef PG8_SB
#undef PG8_STAGE
#undef PG8_LDA
#undef PG8_LDB
#undef PG8_MMA
#undef PG8_WAIT_V
#undef PG8_WAIT_L
#undef PG8_BAR
#undef PG8_SCHED
}
}

namespace pg8 {
__device__ __forceinline__ float fast_silu(float x) { return x * __builtin_amdgcn_rcpf(1.0f + __expf(-x)); }
struct EpiProj {
    static constexpr bool PERM = true, AFTER_DRAIN = false;
    bf16_t *QA, *KA, *VA, *ZA, *ZD, *QKVD; float* KMEAN; const float *qnw, *knw; int pt_off;
    __device__ __forceinline__ void operator()(const f32x4 (&acc)[2][2][4][2], const Unit& u, int wr, int wc, int fr, int fq) const {
        const int pn = wt1_ltile(u.pn + pt_off), b = u.pm >> 5, blk = u.pm & 31;
        const int s0 = blk * 256 + wr * 64 + fr;
        const int row0 = u.pm * BM + wr * 64 + fr;
        if (pn < 4) {
            const bool isq = pn < 2; const int head = (pn & 1) * 4 + wc; const float* nwp = isq ? qnw : knw;
            f32x4 nw[2][2];
#pragma unroll
            for (int bj = 0; bj < 2; ++bj)
#pragma unroll
                for (int n = 0; n < 2; ++n) nw[bj][n] = *(const f32x4*)(nwp + 32 * bj + 8 * fq + 4 * n);
            f32x4 ksum[2][2];
#pragma unroll
            for (int bj = 0; bj < 2; ++bj)
#pragma unroll
                for (int n = 0; n < 2; ++n) ksum[bj][n] = (f32x4){0.f, 0.f, 0.f, 0.f};
            bf16_t* dbase = (isq ? QA : KA) + ((size_t)(b * 8 + head) * 8192) * 64 + 8 * fq;
            const float sc = isq ? 0.125f * 1.4426950408889634f : 1.0f;
#pragma unroll
            for (int ai = 0; ai < 2; ++ai)
#pragma unroll
                for (int m = 0; m < 4; ++m) {
                    float ss = 0.f;
#pragma unroll
                    for (int bj = 0; bj < 2; ++bj)
#pragma unroll
                        for (int n = 0; n < 2; ++n) { const f32x4 v = acc[ai][bj][m][n]; ss += (v[0] * v[0] + v[1] * v[1]) + (v[2] * v[2] + v[3] * v[3]); }
                    ss += __shfl_xor(ss, 16); ss += __shfl_xor(ss, 32);
                    const float rs = (1.0f / sqrtf(ss * (1.0f / 64.0f) + 1e-6f));
                    bf16_t* dst = dbase + (size_t)(s0 + ai * 128 + m * 16) * 64;
#pragma unroll
                    for (int bj = 0; bj < 2; ++bj) {
                        const f32x4 v0 = acc[ai][bj][m][0] * rs * nw[bj][0], v1 = acc[ai][bj][m][1] * rs * nw[bj][1];
                        ksum[bj][0] += v0; ksum[bj][1] += v1;
                        u32x4 w; w.x = cvt_pk_bf16(v0[0] * sc, v0[1] * sc); w.y = cvt_pk_bf16(v0[2] * sc, v0[3] * sc); w.z = cvt_pk_bf16(v1[0] * sc, v1[1] * sc); w.w = cvt_pk_bf16(v1[2] * sc, v1[3] * sc);
                        *(u32x4*)(dst + 32 * bj) = w;
                    }
                }
            if (!isq) {
                float* km = KMEAN + ((size_t)(b * 8 + head) * 32 + blk) * 64 + 8 * fq;
#pragma unroll
                for (int bj = 0; bj < 2; ++bj)
#pragma unroll
                    for (int n = 0; n < 2; ++n)
#pragma unroll
                        for (int e = 0; e < 4; ++e) {
                            float t = ksum[bj][n][e];
                            t += __shfl_xor(t, 1); t += __shfl_xor(t, 2); t += __shfl_xor(t, 4); t += __shfl_xor(t, 8);
                            if (fr == 0) atomicAdd(km + 32 * bj + 4 * n + e, t * (1.0f / 256.0f));
                        }
            }
        } else {
            bf16_t* dbase; size_t ld; int colb; bool act;
            if (pn < 6) { const int head = (pn - 4) * 4 + wc; dbase = VA + ((size_t)(b * 8 + head) * 8192 + blk * 256) * 64; ld = 64; colb = 0; act = false; }
            else if (pn < 8) { dbase = ZA + (size_t)(u.pm * BM) * 512; ld = 512; colb = (pn - 6) * 256 + wc * 64; act = true; }
            else if (pn < 14) { dbase = QKVD + (size_t)(u.pm * BM) * 1536; ld = 1536; colb = (pn - 8) * 256 + wc * 64; act = false; }
            else { dbase = ZD + (size_t)(u.pm * BM) * 512; ld = 512; colb = (pn - 14) * 256 + wc * 64; act = true; }
            const int rloc = wr * 64 + fr;
#pragma unroll
            for (int ai = 0; ai < 2; ++ai)
#pragma unroll
                for (int m = 0; m < 4; ++m) {
                    bf16_t* dst = dbase + (size_t)(rloc + ai * 128 + m * 16) * ld + colb + 8 * fq;
#pragma unroll
                    for (int bj = 0; bj < 2; ++bj) {
                        f32x4 v0 = acc[ai][bj][m][0], v1 = acc[ai][bj][m][1];
                        if (act) {
#pragma unroll
                            for (int e = 0; e < 4; ++e) { v0[e] = fast_silu(v0[e]); v1[e] = fast_silu(v1[e]); }
                        }
                        u32x4 w; w.x = cvt_pk_bf16(v0[0], v0[1]); w.y = cvt_pk_bf16(v0[2], v0[3]); w.z = cvt_pk_bf16(v1[0], v1[1]); w.w = cvt_pk_bf16(v1[2], v1[3]);
                        *(u32x4*)(dst + 32 * bj) = w;
                    }
                }
        }
        (void)row0;
    }
};
struct EpiOut {
    static constexpr bool PERM = false, AFTER_DRAIN = false;
    const float* X; float* O;
    __device__ __forceinline__ void operator()(const f32x4 (&acc)[2][2][4][2], const Unit& u, int wr, int wc, int fr, int fq) const {
        const int row0 = u.pm * BM + wr * 64 + fr, col0 = u.pn * BM + wc * 32 + 4 * fq;
        f32x4 xa[4][2][2], xb[4][2][2];
#define EPO_OFF(ai, m) ((size_t)(row0 + (ai) * HALF + (m) * 16) * 1024 + col0)
#pragma unroll
        for (int m = 0; m < 4; ++m)
#pragma unroll
            for (int bj = 0; bj < 2; ++bj)
#pragma unroll
                for (int n = 0; n < 2; ++n) xa[m][bj][n] = *(const f32x4*)(X + EPO_OFF(0, m) + bj * HALF + n * 16);
#pragma unroll
        for (int m = 0; m < 4; ++m)
#pragma unroll
            for (int bj = 0; bj < 2; ++bj)
#pragma unroll
                for (int n = 0; n < 2; ++n) xa[m][bj][n] = xa[m][bj][n] + acc[0][bj][m][n];
        __builtin_amdgcn_sched_barrier(0);
#pragma unroll
        for (int m = 0; m < 4; ++m)
#pragma unroll
            for (int bj = 0; bj < 2; ++bj)
#pragma unroll
                for (int n = 0; n < 2; ++n) xb[m][bj][n] = *(const f32x4*)(X + EPO_OFF(1, m) + bj * HALF + n * 16);
        __builtin_amdgcn_sched_barrier(0);
#pragma unroll
        for (int m = 0; m < 4; ++m)
#pragma unroll
            for (int bj = 0; bj < 2; ++bj)
#pragma unroll
                for (int n = 0; n < 2; ++n) *(f32x4*)(O + EPO_OFF(0, m) + bj * HALF + n * 16) = xa[m][bj][n];
#pragma unroll
        for (int m = 0; m < 4; ++m)
#pragma unroll
            for (int bj = 0; bj < 2; ++bj)
#pragma unroll
                for (int n = 0; n < 2; ++n) *(f32x4*)(O + EPO_OFF(1, m) + bj * HALF + n * 16) = xb[m][bj][n] + acc[1][bj][m][n];
#undef EPO_OFF
    }
};
}

#define LAS __attribute__((address_space(3)))
constexpr int NWAVES = 8;
constexpr int RING_OFF = 0;
constexpr int LDS_BYTES = 163840;
constexpr int LDSCTL_OFF = LDS_BYTES - 1024, MISC_OFF = LDSCTL_OFF + 320;
constexpr int CW_BAR = 4096;

#define XB_TMO      128
#define XB_XCNT(j)  (256  + 64 * (j))
#define XB_XSUB(j)  (1280 + 64 * (j))
#define XB_XGEN(j)  (2304 + 64 * (j))
#define XB_TOP      3328
#define XB_TOPGEN   3392
#define XCD_BAR_WORDS 3456
#define XB_SPIN_CAP (1u << 18)
__device__ __forceinline__ unsigned xb_ld(unsigned* p)              { return __hip_atomic_load(p, __ATOMIC_RELAXED, __HIP_MEMORY_SCOPE_AGENT); }
__device__ __forceinline__ unsigned xb_add(unsigned* p, unsigned v) { return __hip_atomic_fetch_add(p, v, __ATOMIC_RELAXED, __HIP_MEMORY_SCOPE_AGENT); }
__device__ __forceinline__ unsigned xb_xcc_id() { return (unsigned)__builtin_amdgcn_s_getreg((3 << 11) | 20) & 0xFu; }
#define XB_SPIN(cond, bar) do { unsigned _sp = 0; while (cond) { __builtin_amdgcn_s_sleep(1); \
    if ((++_sp & 255u) == 0u) { if (xb_ld(&(bar)[XB_TMO])) break; if (_sp > XB_SPIN_CAP) { atomicAdd(&(bar)[XB_TMO], 1u); break; } } } } while (0)
struct XcdBarrier { unsigned* bar; unsigned x; volatile LAS unsigned* st; };
__device__ __forceinline__ XcdBarrier xcd_barrier_post(unsigned* bar, volatile LAS unsigned* st) {
    XcdBarrier b; b.bar = bar; b.x = xb_xcc_id(); b.st = st;
    if (threadIdx.x == 0) (void)xb_add(&bar[XB_XCNT(b.x)], 1u);
    return b;
}
__device__ __forceinline__ void xcd_barrier_complete(unsigned* bar, unsigned x, unsigned& nloc, unsigned& nx) {
    const unsigned G = gridDim.x * gridDim.y * gridDim.z;
    unsigned sum, cnt, mine, sp = 0u;
    for (;;) {
        sum = 0u; cnt = 0u; mine = 0u;
#pragma unroll
        for (unsigned j = 0; j < 16; ++j) { const unsigned c = xb_ld(&bar[XB_XCNT(j)]); sum += c; cnt += (c > 0u) ? 1u : 0u; mine = (j == x) ? c : mine; }
        if (sum == G) break;
        __builtin_amdgcn_s_sleep(1);
        if ((++sp & 255u) == 0u) { if (xb_ld(&bar[XB_TMO])) break; if (sp > XB_SPIN_CAP) { atomicAdd(&bar[XB_TMO], 1u); break; } }
    }
    nloc = mine > 0u ? mine : 1u; nx = cnt > 0u ? cnt : 1u;
}
__device__ __forceinline__ void xcd_barrier(const XcdBarrier& b) {
    asm volatile("s_waitcnt vmcnt(0)" ::: "memory");
    __syncthreads();
    if (threadIdx.x == 0) {
        unsigned* bar = b.bar;
        __builtin_amdgcn_s_waitcnt(0);
        unsigned nloc = b.st[0], nx = b.st[1];
        if (nloc == 0u) { xcd_barrier_complete(bar, b.x, nloc, nx); b.st[0] = nloc; b.st[1] = nx; }
        const unsigned old = xb_add(&bar[XB_XSUB(b.x)], 1u);
        const unsigned gen = old / nloc;
        if (old + 1u == (gen + 1u) * nloc) {
            __builtin_amdgcn_fence(__ATOMIC_RELEASE, "agent");
            asm volatile("s_waitcnt vmcnt(0)" ::: "memory");
            const unsigned og = xb_add(&bar[XB_TOP], 1u);
            const unsigned tg = og / nx;
            if (og + 1u == (tg + 1u) * nx) xb_add(&bar[XB_TOPGEN], 1u);
            else XB_SPIN(xb_ld(&bar[XB_TOPGEN]) == tg, bar);
            __builtin_amdgcn_fence(__ATOMIC_ACQUIRE, "agent");
            xb_add(&bar[XB_XGEN(b.x)], 1u);
            asm volatile("s_waitcnt vmcnt(0)" ::: "memory");
        } else {
            XB_SPIN(xb_ld(&bar[XB_XGEN(b.x)]) == gen, bar);
            __builtin_amdgcn_fence(__ATOMIC_ACQUIRE, "agent");
            asm volatile("s_waitcnt vmcnt(0)" ::: "memory");
        }
    }
    __syncthreads();
}

struct Ptrs {
    const float *x, *rel_bias, *norm_w, *w_in, *qnw, *knw, *conv_w, *a_log, *dt_bias, *dnw, *w_out;
    float* out; bf16_t* HN; bf16_t *WT1, *WT2; float *BETA, *GDEC, *KMEAN; bf16_t *QA, *KA, *VA, *ZA, *ZD, *QKVD, *QD, *KD, *VD; float* OD; bf16_t* Y; unsigned* ctl; unsigned char* REC; float* GLB; unsigned* SEL; unsigned short* LIST; float* LP; bf16_t* OPART;
};
__host__ __device__ inline Ptrs make_ptrs(void* const* d_in, void* d_out, unsigned char* ws) {
    Ptrs p;
    p.x = (const float*)d_in[0]; p.rel_bias = (const float*)d_in[1]; p.norm_w = (const float*)d_in[2]; p.w_in = (const float*)d_in[3]; p.qnw = (const float*)d_in[4]; p.knw = (const float*)d_in[5];
    p.conv_w = (const float*)d_in[6]; p.a_log = (const float*)d_in[7]; p.dt_bias = (const float*)d_in[8]; p.dnw = (const float*)d_in[9]; p.w_out = (const float*)d_in[10];
    p.out = (float*)d_out; p.HN = (bf16_t*)d_out;
    p.WT1 = (bf16_t*)(ws + WS_WT1); p.WT2 = (bf16_t*)(ws + WS_WT2); p.BETA = (float*)(ws + WS_BETA); p.GDEC = (float*)(ws + WS_GDEC); p.KMEAN = (float*)(ws + WS_KMEAN);
    p.QA = (bf16_t*)(ws + WS_QA); p.KA = (bf16_t*)(ws + WS_KA); p.VA = (bf16_t*)(ws + WS_VA); p.ZA = (bf16_t*)(ws + WS_ZA); p.ZD = (bf16_t*)(ws + WS_ZD); p.QKVD = (bf16_t*)(ws + WS_QKVD);
    p.QD = (bf16_t*)(ws + WS_QD); p.KD = (bf16_t*)(ws + WS_KD); p.VD = (bf16_t*)(ws + WS_VD); p.OD = (float*)((unsigned char*)d_out + OUT_OD); p.Y = (bf16_t*)(ws + WS_Y); p.ctl = (unsigned*)(ws + WS_CTL); p.REC = ws + WS_REC; p.GLB = (float*)(ws + WS_GLB);
    { unsigned char* o8 = (unsigned char*)d_out; p.SEL = (unsigned*)o8; p.LIST = (unsigned short*)(o8 + 1 * MiB); p.LP = (float*)(o8 + 17 * MiB); p.OPART = (bf16_t*)(o8 + 21 * MiB); }
    return p;
}


namespace dn {
using f32x16=__attribute__((ext_vector_type(16)))float;
typedef unsigned u32x2v __attribute__((ext_vector_type(2)));
constexpr int REC_NW=0, REC_QD=16384, REC_KT=32768, REC_AI=49152, REC_U=57344, REC_BYTES=73728;
constexpr int CH=64;
__device__ __forceinline__ int crow(int r,int hi){return (r&3)+8*(r>>2)+4*hi;}
typedef float f32x2_t __attribute__((ext_vector_type(2))); typedef __bf16 bf16x2_t __attribute__((ext_vector_type(2)));
__device__ __forceinline__ unsigned cvtpk(float lo,float hi){f32x2_t v={lo,hi};bf16x2_t b=__builtin_convertvector(v,bf16x2_t);return __builtin_bit_cast(unsigned,b);}
__device__ __forceinline__ float bflo(unsigned w){return __uint_as_float(w<<16);}
__device__ __forceinline__ float bfhi(unsigned w){return __uint_as_float(w&0xffff0000u);}
#define DN_MFMA32(a,b,c) __builtin_amdgcn_mfma_f32_32x32x16_bf16((a),(b),(c),0,0,0)
#ifndef SCANDBG
#define SCANDBG 0
#endif
#define DN_MFMA4(a,b,c) __builtin_amdgcn_mfma_f32_16x16x4f32((a),(b),(c),0,0,0)
#define DN_BAR() CBAR_ALL()
__device__ __forceinline__ void st16_wt(void*p,u32x4 v){ asm volatile("global_store_dwordx4 %0, %1, off sc1\n\ts_nop 1"::"v"(p),"v"(v):"memory"); }
__device__ __forceinline__ void st8_wt(void*p,unsigned lo,unsigned hi){ __hip_atomic_store((unsigned long long*)p,((unsigned long long)hi<<32)|lo,__ATOMIC_RELAXED,__HIP_MEMORY_SCOPE_AGENT); }

constexpr int P_QI=0, P_KI=16384, P_XT=32768, XT_LD=68, P_LF=P_XT+256*XT_LD*4, LF_LD=68, P_DF=P_LF+64*LF_LD*4, DF_LD=20, P_GC=P_DF+4*16*DF_LD*4, P_EG=P_GC+256, P_EKD=P_EG+256, P_BETA=P_EKD+256, P_END=P_BETA+256;
static_assert(P_END<=131072,"prep LDS");

__device__ __forceinline__ void prep_chunk(int c,const bf16_t*QKVD,const float*conv_w,const float*BETA,const float*GDEC,unsigned char*rec,float*GLB,unsigned*flags,LAS unsigned char*lds,int pdbg=0){
  const int tid=threadIdx.x; int lane=tid&63; asm volatile("":"+v"(lane));
  const int wid=__builtin_amdgcn_readfirstlane(tid>>6);
  const int bh=c>>7,n=c&127,b=bh>>2,h=bh&3,s0=n*CH; const size_t tok0=(size_t)b*SEQ+s0;
  LAS float*GC=(LAS float*)(lds+P_GC); LAS float*EG=(LAS float*)(lds+P_EG); LAS float*EKD=(LAS float*)(lds+P_EKD); LAS float*BT=(LAS float*)(lds+P_BETA);
  LAS float*XT=(LAS float*)(lds+P_XT); LAS float*LF=(LAS float*)(lds+P_LF); LAS float*DF=(LAS float*)(lds+P_DF);
  float g_l=GDEC[(size_t)bh*SEQ+s0+lane]; const float bt_l=BETA[(size_t)bh*SEQ+s0+lane];
  #pragma unroll
  for(int o=1;o<64;o<<=1){ const float t=__shfl_up(g_l,o); if(lane>=o)g_l+=t; }
  const float eg_l=__expf(g_l);
  if(wid==0){
    const float gl=__shfl(g_l,63);
    GC[lane]=g_l; EG[lane]=eg_l; EKD[lane]=__expf(gl-g_l); BT[lane]=bt_l;
    if(lane==63)__hip_atomic_store(GLB+c,eg_l,__ATOMIC_RELAXED,__HIP_MEMORY_SCOPE_AGENT);
  }
  {
    float cw[3][4][2];
    #pragma unroll
    for(int p=0;p<3;++p)
      #pragma unroll
      for(int j=0;j<4;++j){ const float2 w2=*(const float2*)(conv_w+j*DCONV+p*512+h*128+2*lane); cw[p][j][0]=w2.x; cw[p][j][1]=w2.y; }
    unsigned xr[3][11];
    #pragma unroll
    for(int rr=0;rr<11;++rr){ const int sp=s0+8*wid-3+rr;
      #pragma unroll
      for(int p=0;p<3;++p) xr[p][rr]=(sp>=0)?*(const unsigned*)(QKVD+(tok0+8*wid-3+rr)*DCONV+p*512+h*128+2*lane):0u; }
    #pragma unroll
    for(int i=0;i<8;++i){
      const int pos=8*wid+i;
      float v[3][2];
      #pragma unroll
      for(int p=0;p<3;++p){ float a0=0.f,a1=0.f;
        #pragma unroll
        for(int j=0;j<4;++j){ a0+=cw[p][j][0]*bflo(xr[p][i+j]); a1+=cw[p][j][1]*bfhi(xr[p][i+j]); }
        v[p][0]=a0*__builtin_amdgcn_rcpf(1.0f+__expf(-a0)); v[p][1]=a1*__builtin_amdgcn_rcpf(1.0f+__expf(-a1)); }
      const float sq=wave_sum(v[0][0]*v[0][0]+v[0][1]*v[0][1]), sk=wave_sum(v[1][0]*v[1][0]+v[1][1]*v[1][1]);
      const float rq=(1.0f/sqrtf(sq+EPS))*0.08838834764831845f, rk=1.0f/sqrtf(sk+EPS);
      const float q0=v[0][0]*rq,q1=v[0][1]*rq,k0=v[1][0]*rk,k1=v[1][1]*rk;
      const int ch=2*lane; const int off=((ch>>3)*64+pos)*16+(ch&7)*2;
      *(LAS unsigned*)(lds+P_QI+off)=cvtpk(q0,q1);
      *(LAS unsigned*)(lds+P_KI+off)=cvtpk(k0,k1);
      const float bt=__shfl(bt_l,pos), be=bt*__shfl(eg_l,pos);
      XT[(ch)*XT_LD+pos]=v[2][0]*bt; XT[(ch+1)*XT_LD+pos]=v[2][1]*bt;
      XT[(128+ch)*XT_LD+pos]=k0*be; XT[(128+ch+1)*XT_LD+pos]=k1*be;
    }
  }
  CBAR_LDS();
  {
    const int r32=lane&31,hi=lane>>5;
    if(wid<6){
      const int kind=wid/3, w3=wid%3;
      const int ta=(kind==0)?(w3==0?0:1):(w3==2?1:0);
      const int tb=(kind==0)?(w3==2?1:0):(w3==0?0:1);
      const LAS unsigned char*Ab=lds+P_KI+(32*ta+r32)*16+hi*1024;
      const LAS unsigned char*Bb=lds+(kind==0?P_KI:P_QI)+(32*tb+r32)*16+hi*1024;
      f32x16 acc=f32x16{};
      #pragma unroll
      for(int ks=0;ks<8;++ks){ const bf16x8 a=*(const LAS bf16x8*)(Ab+ks*2048), bb=*(const LAS bf16x8*)(Bb+ks*2048); acc=DN_MFMA32(a,bb,acc); }
      if(kind==0){
        const int j=32*tb+r32; const float gj=GC[j];
        #pragma unroll
        for(int r=0;r<16;++r){ const int i=32*ta+crow(r,0)+4*hi; const float val=(j<i)?BT[i]*acc[r]*__expf(GC[i]-gj):0.f; LF[i*LF_LD+j]=val; }
      } else {
        const int i=32*tb+r32; const float gi=GC[i];
        float o_[16];
        #pragma unroll
        for(int r=0;r<16;++r){ const int j=32*ta+crow(r,0)+4*hi; o_[r]=(j<=i)?acc[r]*__expf(gi-GC[j]):0.f; }
        #pragma unroll
        for(int s=0;s<2;++s){ u32x4 w; w.x=cvtpk(o_[8*s],o_[8*s+1]); w.y=cvtpk(o_[8*s+2],o_[8*s+3]); w.z=cvtpk(o_[8*s+4],o_[8*s+5]); w.w=cvtpk(o_[8*s+6],o_[8*s+7]);
          st16_wt(rec+REC_AI+((tb*4+2*ta+s)*64+lane)*16,w); }
      }
    }
  }
  CBAR_LDS();
  if(pdbg&2){} else
  if(wid==0){
    const int bb=lane>>4,j=lane&15; float t[16];
    const LAS float*Lb=LF+(16*bb)*LF_LD+16*bb;
    f32x4 rw[16][4];
    #pragma unroll
    for(int i=1;i<16;++i)
      #pragma unroll
      for(int q=0;q<(i+3)/4;++q) rw[i][q]=*(const LAS f32x4*)(Lb+i*LF_LD+4*q);
    #pragma unroll
    for(int i=0;i<16;++i){ float s=(i==j)?1.0f:0.0f;
      #pragma unroll
      for(int m=0;m<i;++m) s-=rw[i][m>>2][m&3]*t[m];
      t[i]=s; DF[(bb*16+i)*DF_LD+j]=s; }
  } else {
    const int r32=lane&31,hi=lane>>5;
    for(int f=wid-1;f<32;f+=7){
      if(f<16){
        const int i2=f>>3,ks=f&7,pos=32*i2+r32; const float e=EG[pos];
        const u32x2v lo=*(const LAS u32x2v*)(lds+P_QI+((2*ks)*64+pos)*16+8*hi), hi2=*(const LAS u32x2v*)(lds+P_QI+((2*ks+1)*64+pos)*16+8*hi);
        u32x4 w; w.x=cvtpk(bflo(lo.x)*e,bfhi(lo.x)*e); w.y=cvtpk(bflo(lo.y)*e,bfhi(lo.y)*e); w.z=cvtpk(bflo(hi2.x)*e,bfhi(hi2.x)*e); w.w=cvtpk(bflo(hi2.y)*e,bfhi(hi2.y)*e);
        st16_wt(rec+REC_QD+(f*64+lane)*16,w);
      } else {
        const int f2=f-16,t=f2>>2,ks=f2&3,dk=32*t+r32; const LAS unsigned short*kp=(const LAS unsigned short*)(lds+P_KI+(dk>>3)*1024+(dk&7)*2);
        const f32x4 e0=*(const LAS f32x4*)(EKD+16*ks+4*hi), e1=*(const LAS f32x4*)(EKD+16*ks+8+4*hi);
        float x[8];
        #pragma unroll
        for(int j=0;j<8;++j){ const int pos=16*ks+8*(j>>2)+4*hi+(j&3); x[j]=__uint_as_float(((unsigned)kp[pos*8])<<16)*((j<4)?e0[j&3]:e1[j&3]); }
        u32x4 w; w.x=cvtpk(x[0],x[1]); w.y=cvtpk(x[2],x[3]); w.z=cvtpk(x[4],x[5]); w.w=cvtpk(x[6],x[7]);
        st16_wt(rec+REC_KT+(f2*64+lane)*16,w);
      }
    }
  }
  CBAR_LDS();
  if(!(pdbg&1))
  {
    const int cl=lane&15,g=lane>>4;
    #define PK4(v) cvtpk((v)[0],(v)[1]),cvtpk((v)[2],(v)[3])
    #define FRAG(a_,b_) __builtin_bit_cast(bf16x8,(u32x4){PK4(a_),PK4(b_)})
    #define DN_MFMA16(a,b,c) __builtin_amdgcn_mfma_f32_16x16x32_bf16((a),(b),(c),0,0,0)
    const f32x4 z4=(f32x4){0.f,0.f,0.f,0.f};
    #pragma unroll 1
    for(int cc=0;cc<2;++cc){
      const int ct=2*wid+cc, col=16*ct+cl;
      f32x4 Y[4];
      #pragma unroll
      for(int bb=0;bb<4;++bb){
        f32x4 acc=*(const LAS f32x4*)(XT+col*XT_LD+16*bb+4*g);
        const LAS float*Lr=LF+(16*bb+cl)*LF_LD+4*g;
        if(bb==1){ const f32x4 l0=-*(const LAS f32x4*)(Lr); acc=DN_MFMA16(FRAG(l0,z4),FRAG(Y[0],z4),acc); }
        if(bb==2){ const f32x4 l0=-*(const LAS f32x4*)(Lr), l1=-*(const LAS f32x4*)(Lr+16); acc=DN_MFMA16(FRAG(l0,l1),FRAG(Y[0],Y[1]),acc); }
        if(bb==3){ const f32x4 l0=-*(const LAS f32x4*)(Lr), l1=-*(const LAS f32x4*)(Lr+16), l2=-*(const LAS f32x4*)(Lr+32);
          acc=DN_MFMA16(FRAG(l0,l1),FRAG(Y[0],Y[1]),acc); acc=DN_MFMA16(FRAG(l2,z4),FRAG(Y[2],z4),acc); }
        const f32x4 Da=*(const LAS f32x4*)(DF+(bb*16+cl)*DF_LD+4*g);
        Y[bb]=DN_MFMA16(FRAG(Da,z4),FRAG(acc,z4),z4);
      }
      if(ct<8){
        const int dv=col,c4=dv>>5,r32=dv&31;
        #pragma unroll
        for(int bb=0;bb<4;++bb){ const int i2=bb>>1,rh=bb&1,hi2=g&1;
          st8_wt(rec+REC_U+((((c4*2+i2)*2+rh)*64+hi2*32+r32)*8+4*(g>>1))*2,cvtpk(Y[bb][0],Y[bb][1]),cvtpk(Y[bb][2],Y[bb][3])); }
      } else {
        const int kt=ct-8;
        f32x4 sel; sel[0]=(cl==4*g)?-1.f:0.f; sel[1]=(cl==4*g+1)?-1.f:0.f; sel[2]=(cl==4*g+2)?-1.f:0.f; sel[3]=(cl==4*g+3)?-1.f:0.f;
        const bf16x8 selb=FRAG(sel,z4);
        #pragma unroll
        for(int bb=0;bb<4;++bb){
          const f32x4 zt=DN_MFMA16(FRAG(Y[bb],z4),selb,z4);
          const int pos=16*bb+cl,i2=pos>>5,r32=pos&31,hi2=g&1;
          st8_wt(rec+REC_NW+(((i2*8+kt)*64+hi2*32+r32)*8+4*(g>>1))*2,cvtpk(zt[0],zt[1]),cvtpk(zt[2],zt[3])); }
      }
    }
    #undef PK4
    #undef FRAG
    #undef DN_MFMA16
  }
  CBAR_LDS();
}

__device__ __forceinline__ void glds16(const void*gsrc,unsigned lds_dst){unsigned keep;
  asm volatile("s_mov_b32 %0, m0\n\ts_mov_b32 m0, %2\n\ts_nop 0\n\tglobal_load_lds_dwordx4 %1, off\n\ts_mov_b32 m0, %0":"=&s"(keep):"v"(gsrc),"s"(lds_dst):"memory");}
__device__ __forceinline__ void glds4(const void*gsrc,unsigned lds_dst){unsigned keep;
  asm volatile("s_mov_b32 %0, m0\n\ts_mov_b32 m0, %2\n\ts_nop 0\n\tglobal_load_lds_dword %1, off\n\ts_mov_b32 m0, %0":"=&s"(keep):"v"(gsrc),"s"(lds_dst):"memory");}
__device__ __forceinline__ bf16x8 pack8(const f32x16&x,int s){ u32x4 p; p.x=cvtpk(x[8*s],x[8*s+1]); p.y=cvtpk(x[8*s+2],x[8*s+3]); p.z=cvtpk(x[8*s+4],x[8*s+5]); p.w=cvtpk(x[8*s+6],x[8*s+7]); return __builtin_bit_cast(bf16x8,p); }

__device__ __forceinline__ void scan_wait_batch(const unsigned*rdy,int bh,int m0){
  if((threadIdx.x>>6)==4){
    const int l_=threadIdx.x&63; unsigned sp=0u;
    for(;;){ unsigned ok=1u; if(l_<16)ok=__hip_atomic_load(rdy+bh*128+m0+l_,__ATOMIC_RELAXED,__HIP_MEMORY_SCOPE_AGENT);
      if(__all(ok!=0u))break; __builtin_amdgcn_s_sleep(8); if(++sp>(1u<<17))break; }
    __builtin_amdgcn_fence(__ATOMIC_ACQUIRE,"agent"); asm volatile("s_waitcnt vmcnt(0)":::"memory");
  }
  CBAR_LDS();
}
#define DN_M(a,b,c) ((DBG&1)?(c):DN_MFMA32(a,b,c))
constexpr int SC_RING=2*REC_U, SC_STG=SC_RING, STG_LD=80, STG_BYTES=4*64*STG_LD, SC_SSQ=SC_STG+2*STG_BYTES, SC_TCH=SC_SSQ+2*4*64*4, SC_END=SC_TCH+512;
static_assert(SC_END<=160*1024-1024,"scan LDS");
template<int DBG> __device__ __forceinline__ void scan_head(int bh,const unsigned char*REC,const float*GLB,const float*dnw,const bf16_t*ZD,bf16_t*Y,const unsigned*rdy,char*shm,int flags){
  const int tid=threadIdx.x; int lane=tid&63; asm volatile("":"+v"(lane));
  const int wid=__builtin_amdgcn_readfirstlane(tid>>6);
  const int b=bh>>2,h=bh&3;
  const unsigned lds0=(unsigned)(uintptr_t)shm;
  const LAS unsigned char*ldsb=(const LAS unsigned char*)shm;
  const unsigned char*recb=REC+(size_t)bh*128*REC_BYTES;
  const size_t tokb=(size_t)b*SEQ;
  scan_wait_batch(rdy,bh,0);
  if(wid>=4&&wid<6){
    const int lw=wid-4;
    #define DN_PAIR "global_load_lds_dwordx4 %[vo], %[sb]\n\tglobal_load_lds_dwordx4 %[vo], %[sb] offset:2048\n\t"
    #define DN_BUMP "s_add_u32 m0, m0, 0x1000\n\tv_add_u32 %[vo], 0x1000, %[vo]\n\ts_nop 0\n\t"
    #define DN_FILL(nn,bufoff) do{ const unsigned char*b_=recb+(size_t)(nn)*REC_BYTES; unsigned keep_, vo_=(unsigned)(lane*16+lw*1024); \
      const unsigned long long sb_=((unsigned long long)(unsigned)__builtin_amdgcn_readfirstlane((int)((unsigned long long)b_>>32))<<32)|(unsigned)__builtin_amdgcn_readfirstlane((int)(unsigned)(unsigned long long)b_); \
      const unsigned dst_=(unsigned)__builtin_amdgcn_readfirstlane((int)(lds0+(bufoff)+lw*1024)); \
      asm volatile("s_mov_b32 %[keep], m0\n\ts_mov_b32 m0, %[dst]\n\ts_nop 0\n\t" \
        DN_PAIR DN_BUMP DN_PAIR DN_BUMP DN_PAIR DN_BUMP DN_PAIR DN_BUMP DN_PAIR DN_BUMP DN_PAIR DN_BUMP DN_PAIR DN_BUMP \
        DN_PAIR DN_BUMP DN_PAIR DN_BUMP DN_PAIR DN_BUMP DN_PAIR DN_BUMP DN_PAIR DN_BUMP DN_PAIR DN_BUMP DN_PAIR \
        "s_mov_b32 m0, %[keep]" : [keep]"=&s"(keep_), [vo]"+v"(vo_) : [dst]"s"(dst_), [sb]"s"(sb_) : "memory"); }while(0)
    if(!(flags&4)){ DN_FILL(0,0); }
    DN_BAR();
    for(int n=0;n<=128;++n){
      if(n<128){
        if(((n+1)&15)==0&&n+1<128)scan_wait_batch(rdy,bh,n+1);
        if(n+1<128&&!(flags&4)){ DN_FILL(n+1,((n+1)&1)*REC_U); }
      }
      DN_BAR();
    }
    #undef DN_FILL
    #undef DN_PAIR
    #undef DN_BUMP
  } else if(wid>=6){
    const int ow=wid-6;
    const int rrow=lane>>2,rch=lane&3;
    const bf16_t*zdp=ZD+(tokb+rrow)*AW+h*128+64*ow+8*rch; bf16_t*yp=Y+(tokb+rrow)*DM+512+h*128+64*ow+8*rch;
    f32x4 wv[2][2];
    #pragma unroll
    for(int c=0;c<2;++c){ wv[c][0]=*(const f32x4*)(dnw+64*ow+32*c+8*rch); wv[c][1]=*(const f32x4*)(dnw+64*ow+32*c+8*rch+4); }
    u32x4 zn[2][4],zq[2][4];
    #pragma unroll
    for(int c=0;c<2;++c)
      #pragma unroll
      for(int q=0;q<4;++q) zn[c][q]=*(const u32x4*)(zdp+(size_t)(16*q)*AW+32*c);
    asm volatile("s_waitcnt lgkmcnt(0)\n\ts_barrier":::"memory");
    for(int n=0;n<=128;++n){
      if(n<128&&((n+1)&15)==0&&n+1<128)scan_wait_batch(rdy,bh,n+1);
      if(n>0&&n<128&&!(DBG&2)){
        #pragma unroll
        for(int c=0;c<2;++c)
          #pragma unroll
          for(int q=0;q<4;++q) zq[c][q]=*(const u32x4*)(zdp+(size_t)(n*CH+16*q)*AW+32*c);
      }
      if(n>0&&!(DBG&2)){
        const LAS float*sq=(const LAS float*)(ldsb+SC_SSQ)+((n-1)&1)*256;
        #pragma unroll
        for(int it=0;it<4;++it){
          const int pos=16*it+rrow;
          const float tot=(sq[pos]+sq[64+pos])+(sq[128+pos]+sq[192+pos]);
          const float rs=1.0f/sqrtf(tot*(1.0f/128.0f)+EPS);
          #pragma unroll
          for(int c=0;c<2;++c){
            const LAS unsigned char*stg=ldsb+SC_STG+((n-1)&1)*STG_BYTES+(2*ow+c)*64*STG_LD;
            const u32x4 v=*(const LAS u32x4*)(stg+pos*STG_LD+rch*16); const u32x4 z=zn[c][it]; const f32x4 w0=wv[c][0],w1=wv[c][1]; u32x4 w;
            w[0]=cvtpk(bflo(v[0])*rs*w0[0]*bflo(z[0]),bfhi(v[0])*rs*w0[1]*bfhi(z[0])); w[1]=cvtpk(bflo(v[1])*rs*w0[2]*bflo(z[1]),bfhi(v[1])*rs*w0[3]*bfhi(z[1]));
            w[2]=cvtpk(bflo(v[2])*rs*w1[0]*bflo(z[2]),bfhi(v[2])*rs*w1[1]*bfhi(z[2])); w[3]=cvtpk(bflo(v[3])*rs*w1[2]*bflo(z[3]),bfhi(v[3])*rs*w1[3]*bfhi(z[3]));
            *(u32x4*)(yp+(size_t)((n-1)*CH+16*it)*DM+32*c)=w;
          }
        }
        #pragma unroll
        for(int c=0;c<2;++c)
          #pragma unroll
          for(int q=0;q<4;++q) zn[c][q]=zq[c][q];
      }
      asm volatile("s_waitcnt lgkmcnt(0)\n\ts_barrier":::"memory");
    }
  } else if(flags&8){
    asm volatile("s_waitcnt lgkmcnt(0)\n\ts_barrier":::"memory");
    for(int n=0;n<128;++n){ if(((n+1)&15)==0&&n+1<128)scan_wait_batch(rdy,bh,n+1); asm volatile("s_waitcnt lgkmcnt(0)\n\ts_barrier":::"memory"); }
    asm volatile("s_waitcnt lgkmcnt(0)\n\ts_barrier":::"memory");
  } else {
    const int c4=wid,r32=lane&31,hi=lane>>5;
    __builtin_amdgcn_s_setprio(3);
    f32x16 S[4];
    #pragma unroll
    for(int t=0;t<4;++t)S[t]=f32x16{};
    const unsigned char*up=recb+REC_U+(size_t)(c4*4)*1024+lane*16;
    u32x4 un[4];
    #pragma unroll
    for(int q=0;q<4;++q) un[q]=*(const u32x4*)(up+q*1024);
    float gl_next=__hip_atomic_load(GLB+bh*128,__ATOMIC_RELAXED,__HIP_MEMORY_SCOPE_AGENT);
    asm volatile("s_waitcnt lgkmcnt(0)\n\ts_barrier":::"memory");
    for(int n=0;n<128;++n){
      if(((n+1)&15)==0&&n+1<128)scan_wait_batch(rdy,bh,n+1);
      const LAS unsigned char*rb=ldsb+(n&1)*REC_U+lane*16;
      const float gl=gl_next; gl_next=__hip_atomic_load(GLB+bh*128+((n+1)&127),__ATOMIC_RELAXED,__HIP_MEMORY_SCOPE_AGENT);
      f32x16 av[2],ao[2];
      #pragma unroll
      for(int i2=0;i2<2;++i2)
        #pragma unroll
        for(int rh=0;rh<2;++rh){ const u32x4 u=un[i2*2+rh];
          #pragma unroll
          for(int q=0;q<4;++q){ av[i2][8*rh+2*q]=bflo(u[q]); av[i2][8*rh+2*q+1]=bfhi(u[q]); } }
      { const unsigned char*upn=up+(size_t)((n+1)&127)*REC_BYTES;
        #pragma unroll
        for(int q=0;q<4;++q) un[q]=*(const u32x4*)(upn+q*1024); }
      ao[0]=f32x16{}; ao[1]=f32x16{};
      #define FR(off) (*(const LAS bf16x8*)(rb+(off)))
      #define SB0() __builtin_amdgcn_sched_barrier(0)
      bf16x8 fa[4],fb[4],fc[4],Sb[8];
      #pragma unroll
      for(int ks=0;ks<8;++ks)Sb[ks]=pack8(S[ks>>1],ks&1);
      #define LDN(B,k0) do{ B[0]=FR(REC_NW+(k0)*1024); B[1]=FR(REC_NW+(8+(k0))*1024); B[2]=FR(REC_NW+((k0)+1)*1024); B[3]=FR(REC_NW+(9+(k0))*1024); }while(0)
      #define MMN(B,k0) do{ av[0]=DN_M(B[0],Sb[k0],av[0]); av[1]=DN_M(B[1],Sb[k0],av[1]); av[0]=DN_M(B[2],Sb[(k0)+1],av[0]); av[1]=DN_M(B[3],Sb[(k0)+1],av[1]); }while(0)
      #define LDQ(B,k0) do{ B[0]=FR(REC_QD+(k0)*1024); B[1]=FR(REC_QD+(8+(k0))*1024); B[2]=FR(REC_QD+((k0)+1)*1024); B[3]=FR(REC_QD+(9+(k0))*1024); }while(0)
      #define MMQ(B,k0) do{ ao[0]=DN_M(Sb[k0],B[0],ao[0]); ao[1]=DN_M(Sb[k0],B[1],ao[1]); ao[0]=DN_M(Sb[(k0)+1],B[2],ao[0]); ao[1]=DN_M(Sb[(k0)+1],B[3],ao[1]); }while(0)
      LDN(fa,0); LDN(fb,2); SB0();
      LDN(fc,4); SB0(); MMN(fa,0); SB0();
      LDN(fa,6); SB0(); MMN(fb,2); SB0();
      LDQ(fb,0); SB0(); MMN(fc,4); SB0();
      LDQ(fc,2); SB0(); MMN(fa,6); SB0();
      LDQ(fa,4); SB0(); MMQ(fb,0); SB0();
      #pragma unroll
      for(int t=0;t<4;++t)S[t]=S[t]*gl;
      LDQ(fb,6); SB0(); MMQ(fc,2); SB0();
      bf16x8 vb[2][2];
      #pragma unroll
      for(int i2=0;i2<2;++i2){ vb[i2][0]=pack8(av[i2],0); vb[i2][1]=pack8(av[i2],1); }
      fc[0]=FR(REC_AI+0*1024); fc[1]=FR(REC_AI+1*1024); fc[2]=FR(REC_AI+4*1024); fc[3]=FR(REC_AI+5*1024); SB0();
      MMQ(fa,4); SB0();
      fa[0]=FR(REC_AI+6*1024); fa[1]=FR(REC_AI+7*1024); fa[2]=FR(REC_KT+0*1024); fa[3]=FR(REC_KT+1*1024); SB0();
      MMQ(fb,6); SB0();
      fb[0]=FR(REC_KT+2*1024); fb[1]=FR(REC_KT+3*1024); fb[2]=FR(REC_KT+4*1024); fb[3]=FR(REC_KT+5*1024); SB0();
      ao[0]=DN_M(vb[0][0],fc[0],ao[0]); ao[0]=DN_M(vb[0][1],fc[1],ao[0]); ao[1]=DN_M(vb[0][0],fc[2],ao[1]); ao[1]=DN_M(vb[0][1],fc[3],ao[1]); SB0();
      fc[0]=FR(REC_KT+6*1024); fc[1]=FR(REC_KT+7*1024); fc[2]=FR(REC_KT+8*1024); fc[3]=FR(REC_KT+9*1024); SB0();
      ao[1]=DN_M(vb[1][0],fa[0],ao[1]); ao[1]=DN_M(vb[1][1],fa[1],ao[1]); S[0]=DN_M(fa[2],vb[0][0],S[0]); S[0]=DN_M(fa[3],vb[0][1],S[0]); SB0();
      fa[0]=FR(REC_KT+10*1024); fa[1]=FR(REC_KT+11*1024); fa[2]=FR(REC_KT+12*1024); fa[3]=FR(REC_KT+13*1024); SB0();
      S[0]=DN_M(fb[0],vb[1][0],S[0]); S[0]=DN_M(fb[1],vb[1][1],S[0]); S[1]=DN_M(fb[2],vb[0][0],S[1]); S[1]=DN_M(fb[3],vb[0][1],S[1]); SB0();
      fb[0]=FR(REC_KT+14*1024); fb[1]=FR(REC_KT+15*1024); SB0();
      S[1]=DN_M(fc[0],vb[1][0],S[1]); S[1]=DN_M(fc[1],vb[1][1],S[1]); S[2]=DN_M(fc[2],vb[0][0],S[2]); S[2]=DN_M(fc[3],vb[0][1],S[2]); SB0();
      S[2]=DN_M(fa[0],vb[1][0],S[2]); S[2]=DN_M(fa[1],vb[1][1],S[2]); S[3]=DN_M(fa[2],vb[0][0],S[3]); S[3]=DN_M(fa[3],vb[0][1],S[3]); SB0();
      S[3]=DN_M(fb[0],vb[1][0],S[3]); S[3]=DN_M(fb[1],vb[1][1],S[3]);
      #undef FR
      #undef LDN
      #undef MMN
      #undef LDQ
      #undef MMQ
      #undef SB0
      { LAS unsigned char*stg=(LAS unsigned char*)(ldsb+SC_STG)+(n&1)*STG_BYTES+c4*64*STG_LD; LAS float*ssq=(LAS float*)(ldsb+SC_SSQ)+(n&1)*256+c4*64;
        #pragma unroll
        for(int i2=0;i2<2;++i2){ float p=0.f; const int pos=32*i2+r32;
          #pragma unroll
          for(int r=0;r<16;++r)p+=ao[i2][r]*ao[i2][r];
          p+=__shfl_xor(p,32);
          if(hi==0)ssq[pos]=p;
          #pragma unroll
          for(int rq=0;rq<4;++rq) *(LAS u32x2v*)(stg+pos*STG_LD+(8*rq+4*hi)*2)=(u32x2v){cvtpk(ao[i2][4*rq],ao[i2][4*rq+1]),cvtpk(ao[i2][4*rq+2],ao[i2][4*rq+3])}; } }
      asm volatile("s_waitcnt lgkmcnt(0)\n\ts_barrier":::"memory");
    }
    __builtin_amdgcn_s_setprio(0);
    asm volatile("s_waitcnt lgkmcnt(0)\n\ts_barrier":::"memory");
  }
}
#undef DN_MFMA32
#undef DN_MFMA4
#undef DN_BAR
}

namespace moba {
using bf16=unsigned short;
using s16x4=__attribute__((ext_vector_type(4)))short;
using f32x16=__attribute__((ext_vector_type(16)))float;
constexpr int D=64,NW=8,QBLK=32,QB=QBLK*NW,KVBLK=64,PITCH=64;
__device__ __forceinline__ int crow(int r,int hi){return (r&3)+8*(r>>2)+4*hi;}
#define SBAR() __builtin_amdgcn_sched_barrier(0)
constexpr int NSLOT=3, SLOTB=8192;
constexpr int NKT=4, LDS_K=0, LDS_V=NKT*SLOTB, LDS_WS=2*NKT*SLOTB, WSW=1024, LDS_OST=LDS_WS+NW*WSW, LDS_TB=LDS_OST+NW*4096, LDS_UNIT=LDS_TB+512, LDS_PFX=LDS_UNIT+64, LDS_BYTES=LDS_PFX+8*132*4;
struct AB { int dbg; const bf16*QA; const bf16*KA; const bf16*VA; const float*KMEAN; const float*rel_bias; const bf16*ZA; bf16*Y; unsigned*SEL; unsigned short*LIST; unsigned*CNT; bf16*OP; float*LP; unsigned*qctl; };
constexpr int LISTCAP=8192, PREVCAP=256;
constexpr float NEGBIG=-1.0e30f;
__device__ __forceinline__ void glds16(const void*gsrc,unsigned lds_dst){unsigned keep;
  asm volatile("s_mov_b32 %0, m0\n\ts_mov_b32 m0, %2\n\ts_nop 0\n\tglobal_load_lds_dwordx4 %1, off\n\ts_mov_b32 m0, %0":"=&s"(keep):"v"(gsrc),"s"(lds_dst):"memory");}
typedef float f32x2_t __attribute__((ext_vector_type(2))); typedef __bf16 bf16x2_t __attribute__((ext_vector_type(2)));
__device__ __forceinline__ unsigned cvtpk_s(float lo,float hi){f32x2_t v={lo,hi};bf16x2_t b=__builtin_convertvector(v,bf16x2_t);return __builtin_bit_cast(unsigned,b);}
#define WAIT_BAR(N) asm volatile("s_waitcnt vmcnt(" #N ") lgkmcnt(0)\n\ts_barrier":::"memory")
__device__ __forceinline__ void qkt(f32x16&p0,f32x16&p1,const char*Kslot,const bf16x8*qr,int r32,int hi){
  const f32x16 negm=f32x16{};
  const char*kb=Kslot+hi*1024+r32*16;
  #pragma unroll
  for(int d0=0;d0<4;++d0){
    const bf16x8 b0=*reinterpret_cast<const bf16x8*>(kb+d0*2048);
    const bf16x8 b1=*reinterpret_cast<const bf16x8*>(kb+d0*2048+512);
    if(d0==0){p0=__builtin_amdgcn_mfma_f32_32x32x16_bf16(b0,qr[0],negm,0,0,0);p1=__builtin_amdgcn_mfma_f32_32x32x16_bf16(b1,qr[0],negm,0,0,0);}
    else{p0=__builtin_amdgcn_mfma_f32_32x32x16_bf16(b0,qr[d0],p0,0,0,0);p1=__builtin_amdgcn_mfma_f32_32x32x16_bf16(b1,qr[d0],p1,0,0,0);}}
}
typedef __attribute__((address_space(3))) const char* lds_cptr;
typedef short v4i16_t __attribute__((ext_vector_type(4)));
__device__ __forceinline__ void kload8(bf16x8*kf,lds_cptr kp){
  kf[0]=*(const __attribute__((address_space(3))) bf16x8*)(kp);      kf[1]=*(const __attribute__((address_space(3))) bf16x8*)(kp+512);
  kf[2]=*(const __attribute__((address_space(3))) bf16x8*)(kp+2048); kf[3]=*(const __attribute__((address_space(3))) bf16x8*)(kp+2560);
  kf[4]=*(const __attribute__((address_space(3))) bf16x8*)(kp+4096); kf[5]=*(const __attribute__((address_space(3))) bf16x8*)(kp+4608);
  kf[6]=*(const __attribute__((address_space(3))) bf16x8*)(kp+6144); kf[7]=*(const __attribute__((address_space(3))) bf16x8*)(kp+6656);
}
__device__ __forceinline__ void kload2(bf16x8*kf,lds_cptr kp,int j){ kf[2*j]=*(const __attribute__((address_space(3))) bf16x8*)(kp+j*2048); kf[2*j+1]=*(const __attribute__((address_space(3))) bf16x8*)(kp+j*2048+512); }
__device__ __forceinline__ s16x4 vtr(lds_cptr p){ return __builtin_bit_cast(s16x4,__builtin_amdgcn_ds_read_tr16_b64_v4i16((__attribute__((address_space(3))) v4i16_t*)p)); }
__device__ __forceinline__ void pv(f32x16*o,int vb,bf16x8 pa0,bf16x8 pa1,bf16x8 pa2,bf16x8 pa3){
  #pragma unroll
  for(int d0=0;d0<2;++d0){s16x4 lo[4],hi[4];
    #pragma unroll
    for(int ks=0;ks<4;++ks){
      asm volatile("ds_read_b64_tr_b16 %0,%1 offset:%c2":"=&v"(lo[ks]):"v"(vb),"i"(d0*4096+ks*1024):"memory");
      asm volatile("ds_read_b64_tr_b16 %0,%1 offset:%c2":"=&v"(hi[ks]):"v"(vb),"i"(d0*4096+ks*1024+512):"memory");}
    asm volatile("s_waitcnt lgkmcnt(0)":::"memory");SBAR();
    #define PK(k) (bf16x8){lo[k][0],lo[k][1],lo[k][2],lo[k][3],hi[k][0],hi[k][1],hi[k][2],hi[k][3]}
    o[d0]=__builtin_amdgcn_mfma_f32_32x32x16_bf16(pa0,PK(0),o[d0],0,0,0);
    o[d0]=__builtin_amdgcn_mfma_f32_32x32x16_bf16(pa1,PK(1),o[d0],0,0,0);
    o[d0]=__builtin_amdgcn_mfma_f32_32x32x16_bf16(pa2,PK(2),o[d0],0,0,0);
    o[d0]=__builtin_amdgcn_mfma_f32_32x32x16_bf16(pa3,PK(3),o[d0],0,0,0);
    #undef PK
  }
}
__device__ __forceinline__ void bandfix(f32x16&p0,f32x16&p1,int t,int qpos,int hi,const float*tb){
  const int kb=64*t+4*hi;
  #pragma unroll
  for(int r=0;r<16;++r){ const int kv=kb+(r&3)+8*(r>>2); const int d0=qpos-kv, d1=d0-32;
    const float b0=tb[d0<0?0:(d0>127?127:d0)], b1=tb[d1<0?0:(d1>127?127:d1)];
    p0[r]=d0<0?NEGBIG:p0[r]+b0; p1[r]=d1<0?NEGBIG:p1[r]+b1; if((r&3)==3)SBAR(); }
}


__device__ __forceinline__ unsigned gate_select(const float*KMEAN,int bh,int qb,const bf16x8*qr,int r32,int hi){
  f32x16 gt=f32x16{};
  const float*km=KMEAN+((size_t)bh*32+r32)*64+hi*8;
  #pragma unroll
  for(int d0=0;d0<4;++d0){ const f32x4 ka=*(const f32x4*)(km+d0*16), kb_=*(const f32x4*)(km+d0*16+4);
    u32x4 w; w.x=cvtpk_s(ka[0],ka[1]); w.y=cvtpk_s(ka[2],ka[3]); w.z=cvtpk_s(kb_[0],kb_[1]); w.w=cvtpk_s(kb_[2],kb_[3]);
    gt=__builtin_amdgcn_mfma_f32_32x32x16_bf16(__builtin_bit_cast(bf16x8,w),qr[d0],gt,0,0,0); }
  float a1=-INFINITY,a2=-INFINITY,a3=-INFINITY;
  const int qbh=qb-4*hi;
  #pragma unroll
  for(int r=0;r<16;++r){ float x=gt[r]; if(crow(r,0)>=qbh)x=-INFINITY; gt[r]=x;
    const float t_=fminf(a1,x); a1=fmaxf(a1,x); const float u_=fminf(a2,t_); a2=fmaxf(a2,t_); a3=fmaxf(a3,u_); }
  const float b1=__shfl_xor(a1,32),b2=__shfl_xor(a2,32),b3=__shfl_xor(a3,32);
  const float th=fmaxf(fmaxf(a3,b3),fmaxf(fminf(a2,b1),fminf(a1,b2)));
  unsigned m_=0u;
  #pragma unroll
  for(int r=0;r<16;++r){ if(gt[r]>=th&&gt[r]>-INFINITY)m_|=1u<<crow(r,0); }
  m_<<=4*hi;
  return m_|(unsigned)__shfl_xor((int)m_,32);
}
__device__ __forceinline__ void route_item(int bh,int qb,const AB&A){
  const int tid=threadIdx.x; int lane=tid&63; asm volatile("":"+v"(lane));
  const int r32=lane&31,hi=lane>>5; const int wid=__builtin_amdgcn_readfirstlane(tid>>6);
  const int s=qb*QB+wid*QBLK+r32;
  const bf16*Qw=A.QA+((size_t)bh*SEQ+s)*PITCH;
  bf16x8 qr[4];
  #pragma unroll
  for(int d0=0;d0<4;++d0)qr[d0]=*reinterpret_cast<const bf16x8*>(&Qw[d0*16+hi*8]);
  const unsigned selmask=gate_select(A.KMEAN,bh,qb,qr,r32,hi);
  if(hi==0)__hip_atomic_store(A.SEL+(size_t)bh*SEQ+s,selmask,__ATOMIC_RELAXED,__HIP_MEMORY_SCOPE_AGENT);
  const unsigned rb=(qb>=1&&hi==0)?(selmask&((1u<<qb)-1u)):0u;
  if(qb>=1){
    unsigned mymask=0u;
    for(int j=0;j<qb;++j){ const unsigned bal=(unsigned)__ballot((rb>>j)&1u); if(lane==j)mymask=bal; }
    unsigned base=0u;
    if(mymask)base=__hip_atomic_fetch_add(A.CNT+((lane==qb-1)?1024:0)+bh*32+lane,(unsigned)__popc(mymask),__ATOMIC_RELAXED,__HIP_MEMORY_SCOPE_AGENT);
    unsigned rbt=rb;
    #pragma unroll
    for(int k=0;k<3;++k){
      const int jj=rbt?(__ffs((int)rbt)-1):0; const bool act=rbt!=0u; rbt&=rbt-1u;
      const unsigned mj=(unsigned)__shfl((int)mymask,jj), bj=(unsigned)__shfl((int)base,jj);
      if(act){ const unsigned pos=bj+(unsigned)__popc(mj&((1u<<r32)-1u)); const bool prev=(jj==qb-1);
        if(pos<(unsigned)(prev?PREVCAP:LISTCAP-PREVCAP)){ unsigned short*dst_=A.LIST+((size_t)bh*32+jj)*LISTCAP+(prev?LISTCAP-PREVCAP:0)+pos; const unsigned val_=(unsigned)(s|(k<<13));
          asm volatile("global_store_short %0, %1, off sc1"::"v"(dst_),"v"(val_):"memory"); } }
    }
  }
}
template<int KIND> __device__ __forceinline__ void attn_group(int bh,int j,unsigned gi,unsigned cnt,unsigned entry,const bf16x8(&qr)[4],const AB&A,char*shm){
  const int tid=threadIdx.x; int lane=tid&63; asm volatile("":"+v"(lane));
  const int r32=lane&31,hi=lane>>5; const int wid=__builtin_amdgcn_readfirstlane(tid>>6);
  const int b=bh>>3,h=bh&7;
  const unsigned lds0=(unsigned)(uintptr_t)shm;
  const float*tb=(const float*)(shm+LDS_TB);
  const int srow=(KIND<2)?(int)(entry&8191u):(256*j+32*(int)gi+r32);
  const int vb0=(int)(lds0+LDS_V)+((lane>>4)&1)*32+(lane&3)*8+(4*hi+((lane&15)>>2))*64;
  const char*Kbase=shm+LDS_K; bf16x8 kf[8];
  const lds_cptr shm3=(lds_cptr)shm; const lds_cptr kp0=shm3+LDS_K+hi*1024+r32*16; const lds_cptr vp0=shm3+LDS_V+((lane>>4)&1)*32+(lane&3)*8+(4*hi+((lane&15)>>2))*64;
  constexpr int NT=4;
  float l_reg=0.f;f32x16 o[2];o[0]=f32x16{};o[1]=f32x16{};
  const int qpos=srow;
  #define BANDFIX(P0,P1,t) do{ if(KIND==2||(KIND==1&&(t)>=2)){ bandfix(P0,P1,4*j+(t),qpos,hi,tb); } }while(0)
  f32x16 pA0,pA1,pB0,pB1;
  qkt(pA0,pA1,Kbase,qr,r32,hi);asm volatile("s_nop 15\n\ts_nop 7":"+v"(pA0),"+v"(pA1));BANDFIX(pA0,pA1,0);
  _Pragma("unroll") for(int r=0;r<16;++r)pA0[r]=__builtin_amdgcn_exp2f(pA0[r]);
  _Pragma("unroll") for(int r=0;r<16;++r)pA1[r]=__builtin_amdgcn_exp2f(pA1[r]);
  kload8(kf,kp0+SLOTB);
  s16x4 vlo[8],vhi[8]; u32x4 pw0,pw1,pw2,pw3;
  #define PKW(P,B) cvtpk_s(P[B],P[B+1])
  #define PAF(k) __builtin_bit_cast(bf16x8,pw##k)
  #define VFR(i) (bf16x8){vlo[i][0],vlo[i][1],vlo[i][2],vlo[i][3],vhi[i][0],vhi[i][1],vhi[i][2],vhi[i][3]}
  #define PIN(x) asm volatile("":"+v"(x))
  #define GAPA(MF,A0,A1,A2,A3,W0,W1,PW) do{ MF; sacc+=A0; sacc+=A1; sacc+=A2; sacc+=A3; PIN(sacc); W0; W1; PIN(PW); SBAR(); }while(0)
  #define EX(v) __builtin_amdgcn_exp2f(v)
  #define GAPB(MF,X,B) do{ MF; X[B]=EX(X[B]); X[B+1]=EX(X[B+1]); X[B+2]=EX(X[B+2]); X[B+3]=EX(X[B+3]); PIN(X); SBAR(); }while(0)
  #define VRD(i) do{ vlo[i]=vtr(vp_+(((i)>>2)*4096+((i)&3)*1024)); vhi[i]=vtr(vp_+(((i)>>2)*4096+((i)&3)*1024+512)); }while(0)
  #define KRD(G,jj) do{ if(G){ kload2(kf,kp0+((t_)+1)*SLOTB,jj); SBAR(); } }while(0)
  #define STEP(C0,C1,P0,P1,t,GL) do{ SBAR(); constexpr int t_=(t); \
    const lds_cptr vp_=vp0+(t_-1)*SLOTB; const f32x16 zc_=f32x16{}; \
    VRD(0); SBAR(); float sacc=(P0[0]+P0[1]); \
    GAPA(C0=__builtin_amdgcn_mfma_f32_32x32x16_bf16(kf[0],qr[0],zc_,0,0,0), P0[2],P0[3],P0[4],P0[5],     pw0[0]=PKW(P0,0), pw0[1]=PKW(P0,2), pw0); \
    VRD(4); SBAR(); GAPA(C1=__builtin_amdgcn_mfma_f32_32x32x16_bf16(kf[1],qr[0],zc_,0,0,0), P0[6],P0[7],P0[8],P0[9],     pw0[2]=PKW(P0,4), pw0[3]=PKW(P0,6), pw0); \
    VRD(1); SBAR(); GAPA(C0=__builtin_amdgcn_mfma_f32_32x32x16_bf16(kf[2],qr[1],C0,0,0,0),   P0[10],P0[11],P0[12],P0[13], pw1[0]=PKW(P0,8), pw1[1]=PKW(P0,10), pw1); \
    VRD(5); SBAR(); GAPA(C1=__builtin_amdgcn_mfma_f32_32x32x16_bf16(kf[3],qr[1],C1,0,0,0),   P0[14],P0[15],P1[0],P1[1],   pw1[2]=PKW(P0,12),pw1[3]=PKW(P0,14), pw1); \
    VRD(2); SBAR(); GAPA(C0=__builtin_amdgcn_mfma_f32_32x32x16_bf16(kf[4],qr[2],C0,0,0,0),   P1[2],P1[3],P1[4],P1[5],     pw2[0]=PKW(P1,0), pw2[1]=PKW(P1,2), pw2); \
    VRD(6); SBAR(); GAPA(C1=__builtin_amdgcn_mfma_f32_32x32x16_bf16(kf[5],qr[2],C1,0,0,0),   P1[6],P1[7],P1[8],P1[9],     pw2[2]=PKW(P1,4), pw2[3]=PKW(P1,6), pw2); \
    VRD(3); SBAR(); GAPA(C0=__builtin_amdgcn_mfma_f32_32x32x16_bf16(kf[6],qr[3],C0,0,0,0),   P1[10],P1[11],P1[12],P1[13], pw3[0]=PKW(P1,8), pw3[1]=PKW(P1,10), pw3); \
    VRD(7); SBAR(); GAPA(C1=__builtin_amdgcn_mfma_f32_32x32x16_bf16(kf[7],qr[3],C1,0,0,0),   P1[14],P1[15],0.f,0.f,       pw3[2]=PKW(P1,12),pw3[3]=PKW(P1,14), pw3); \
    l_reg+=sacc; \
    BANDFIX(C0,C1,t_); \
    SBAR(); \
    GAPB(o[0]=__builtin_amdgcn_mfma_f32_32x32x16_bf16(PAF(0),VFR(0),o[0],0,0,0), C0,0); \
    GAPB(o[1]=__builtin_amdgcn_mfma_f32_32x32x16_bf16(PAF(0),VFR(4),o[1],0,0,0), C0,4); \
    KRD(GL,0); GAPB(o[0]=__builtin_amdgcn_mfma_f32_32x32x16_bf16(PAF(1),VFR(1),o[0],0,0,0), C0,8); \
    KRD(GL,1); GAPB(o[1]=__builtin_amdgcn_mfma_f32_32x32x16_bf16(PAF(1),VFR(5),o[1],0,0,0), C0,12); \
    KRD(GL,2); GAPB(o[0]=__builtin_amdgcn_mfma_f32_32x32x16_bf16(PAF(2),VFR(2),o[0],0,0,0), C1,0); \
    KRD(GL,3); GAPB(o[1]=__builtin_amdgcn_mfma_f32_32x32x16_bf16(PAF(2),VFR(6),o[1],0,0,0), C1,4); \
    GAPB(o[0]=__builtin_amdgcn_mfma_f32_32x32x16_bf16(PAF(3),VFR(3),o[0],0,0,0), C1,8); \
    GAPB(o[1]=__builtin_amdgcn_mfma_f32_32x32x16_bf16(PAF(3),VFR(7),o[1],0,0,0), C1,12); \
    }while(0)
  STEP(pB0,pB1,pA0,pA1,1,true);
  STEP(pA0,pA1,pB0,pB1,2,true);
  STEP(pB0,pB1,pA0,pA1,3,false);
  { float sacc=pB0[0]+pB0[1]; _Pragma("unroll") for(int r=2;r<16;++r)sacc+=pB0[r]; _Pragma("unroll") for(int r=0;r<16;++r)sacc+=pB1[r]; l_reg+=sacc;
    pw0=(u32x4){PKW(pB0,0),PKW(pB0,2),PKW(pB0,4),PKW(pB0,6)};pw1=(u32x4){PKW(pB0,8),PKW(pB0,10),PKW(pB0,12),PKW(pB0,14)};pw2=(u32x4){PKW(pB1,0),PKW(pB1,2),PKW(pB1,4),PKW(pB1,6)};pw3=(u32x4){PKW(pB1,8),PKW(pB1,10),PKW(pB1,12),PKW(pB1,14)};
    SBAR(); pv(o,vb0+(NT-1)*SLOTB,PAF(0),PAF(1),PAF(2),PAF(3)); }
  #undef PKW
  #undef PAF
  #undef VFR
  #undef PIN
  #undef GAPA
  #undef GAPB
  #undef EX
  #undef VRD
  #undef KRD
  #undef STEP
  #undef BANDFIX
  l_reg+=__shfl_xor(l_reg,32);
  int lane2=threadIdx.x&63; asm volatile("":"+v"(lane2));
  const int r32e=lane2&31,hie=lane2>>5;
  float*wsr=(float*)(shm+LDS_WS)+wid*(WSW/4);
  if(KIND<2){
    if(hie==0){ wsr[r32e*8]=__builtin_amdgcn_rcpf(l_reg); wsr[r32e*8+1]=l_reg; ((unsigned*)wsr)[r32e*8+2]=entry; }
  } else {
    if(hie==0){
      const unsigned selmask=A.SEL[(size_t)bh*SEQ+srow];
      const unsigned rbits=(j>=1)?(selmask&((1u<<j)-1u)):0u; const int nr=__popc(rbits);
      const float*lp=A.LP+((size_t)bh*SEQ+srow)*3; float lk[3]; float lt=l_reg;
      #pragma unroll
      for(int k=0;k<3;++k){ const float t_=lp[k]; lk[k]=(k<nr)?t_:0.f; lt+=lk[k]; }
      const float inv=1.0f/lt;
      wsr[r32e*8]=inv; wsr[r32e*8+1]=lk[0]*inv; wsr[r32e*8+2]=lk[1]*inv; wsr[r32e*8+3]=lk[2]*inv; ((int*)wsr)[r32e*8+4]=nr;
    }
  }
  asm volatile("s_waitcnt lgkmcnt(0)":::"memory");
  float rli[16];
  #pragma unroll
  for(int r=0;r<16;++r)rli[r]=wsr[(crow(r,0)+4*hie)*8];
  { bf16*stg=(bf16*)(shm+LDS_OST)+wid*2048;
    bf16*stgw=stg+(4*hie)*64+r32e;
    #pragma unroll
    for(int r=0;r<16;++r){
      #pragma unroll
      for(int d0=0;d0<2;++d0)stgw[crow(r,0)*64+d0*32]=f2bf(o[d0][r]*rli[r]);}
    asm volatile("s_waitcnt lgkmcnt(0)":::"memory");
    #pragma unroll
    for(int i=0;i<4;++i){const int row=i*8+(lane2>>3),ch=lane2&7; const u32x4 v=*(const u32x4*)(stg+row*64+ch*8);
      if(KIND<2){
        const unsigned e_=((const unsigned*)wsr)[row*8+2]; const unsigned idx=32u*gi+row;
        if(idx<cnt){ const size_t slot=((size_t)bh*SEQ+(e_&8191u))*3+(e_>>13);
          bf16*dst=A.OP+slot*64+ch*8;
          asm volatile("global_store_dwordx4 %0, %1, off sc1\n\ts_nop 1"::"v"(dst),"v"(v):"memory");
          if(ch==0)__hip_atomic_store(A.LP+slot,wsr[row*8+1],__ATOMIC_RELAXED,__HIP_MEMORY_SCOPE_AGENT); }
      } else {
        const size_t rowg=(size_t)bh*SEQ+256*j+32*gi+row; const size_t tok=(size_t)b*SEQ+256*j+32*gi+row; const int nr=((const int*)wsr)[row*8+4];
        float a8[8];
        #pragma unroll
        for(int e=0;e<4;++e){ a8[2*e]=__uint_as_float(v[e]<<16); a8[2*e+1]=__uint_as_float(v[e]&0xffff0000u); }
        const bf16*op=A.OP+(rowg*3)*64+ch*8;
        u32x4 pk[3];
        #pragma unroll
        for(int k=0;k<3;++k) pk[k]=*(const u32x4*)(op+k*64);
        #pragma unroll
        for(int k=0;k<3;++k){ const float f=wsr[row*8+1+k]; const u32x4 p=(k<nr)?pk[k]:(u32x4){0u,0u,0u,0u};
          #pragma unroll
          for(int e=0;e<4;++e){ a8[2*e]+=f*__uint_as_float(p[e]<<16); a8[2*e+1]+=f*__uint_as_float(p[e]&0xffff0000u); } }
        const u32x4 z=*(const u32x4*)(A.ZA+tok*512+h*64+ch*8); u32x4 w;
        #pragma unroll
        for(int e=0;e<4;++e) w[e]=cvtpk_s(a8[2*e]*__uint_as_float(z[e]<<16),a8[2*e+1]*__uint_as_float(z[e]&0xffff0000u));
        *(u32x4*)(A.Y+tok*1024+h*64+ch*8)=w;
      } } }
  asm volatile("s_waitcnt lgkmcnt(0)":::"memory");
}
template<bool OWN> __device__ __forceinline__ void kv_unit(int bh,int j,const AB&A,char*shm,int&pend_x){
  const int tid=threadIdx.x; int lane=tid&63; asm volatile("":"+v"(lane));
  const int wid=__builtin_amdgcn_readfirstlane(tid>>6); const int h=bh&7;
  const unsigned lds0=(unsigned)(uintptr_t)shm;
  const bf16*Kh=A.KA+((size_t)bh*SEQ+(size_t)j*256)*PITCH,*Vh=A.VA+((size_t)bh*SEQ+(size_t)j*256)*PITCH;
  const bf16*ksrc=Kh+(long)lane*PITCH+wid*8;
  const bf16*vsrc=Vh+(long)(16*(wid&3)+(lane>>2))*PITCH+(wid>>2)*32+(lane&3)*8;
  const unsigned kdst=lds0+LDS_K+wid*1024, vdst=lds0+LDS_V+wid*1024;
  #pragma unroll
  for(int t=0;t<NKT;++t){ glds16(ksrc+(long)t*KVBLK*PITCH,(unsigned)__builtin_amdgcn_readfirstlane(kdst+t*SLOTB)); glds16(vsrc+(long)t*KVBLK*PITCH,(unsigned)__builtin_amdgcn_readfirstlane(vdst+t*SLOTB)); }
  float*tb=(float*)(shm+LDS_TB);
  if(tid<128) tb[tid]=(A.rel_bias[t5_bucket_dev(tid)*8+h]-A.rel_bias[31*8+h])*1.4426950408889634f;
  CBAR_ALL();
  if(pend_x>=0){ if(tid==0)__hip_atomic_fetch_add(A.qctl+512+64*pend_x,1u,__ATOMIC_RELAXED,__HIP_MEMORY_SCOPE_AGENT); pend_x=-1; CBAR_LDS(); }
  const int r32_=lane&31,hi_=lane>>5;
  #define LOADQ(dst,row) do{ const bf16*q_=A.QA+((size_t)bh*SEQ+(row))*PITCH+hi_*8; _Pragma("unroll") for(int d0=0;d0<4;++d0)(dst)[d0]=*reinterpret_cast<const bf16x8*>(q_+d0*16); }while(0)
  if((A.dbg&1)||(OWN&&(A.dbg&2))||(!OWN&&(A.dbg&4))){}
  else if(OWN){ bf16x8 qr[4]; LOADQ(qr,256*j+32*wid+r32_); attn_group<2>(bh,j,(unsigned)wid,256u,0u,qr,A,shm); }
  else {
    const unsigned short*lst=A.LIST+((size_t)bh*32+j)*LISTCAP;
    const unsigned cf=A.CNT[bh*32+j], cp=A.CNT[1024+bh*32+j];
    const unsigned nf=cf<(unsigned)(LISTCAP-PREVCAP)?cf:(unsigned)(LISTCAP-PREVCAP), np=cp<(unsigned)PREVCAP?cp:(unsigned)PREVCAP;
    const unsigned gp=(np+31u)>>5, gf=(nf+31u)>>5, gt=gp+gf;
    #define LOADE(gi_) (((gi_)<gp)?lst[(LISTCAP-PREVCAP)+((32u*(gi_)+r32_<np)?32u*(gi_)+r32_:0u)]:lst[((32u*((gi_)-gp)+r32_<nf)?32u*((gi_)-gp)+r32_:0u)])
    unsigned gi=wid;
    if(gi<gt){
      unsigned e_cur=LOADE(gi); unsigned e_nxt=(gi+NW<gt)?LOADE(gi+NW):0u;
      bf16x8 q_cur[4],q_nxt[4]; LOADQ(q_cur,e_cur&8191u);
      for(;gi<gt;gi+=NW){
        if(gi+NW<gt)LOADQ(q_nxt,e_nxt&8191u);
        const unsigned e_nn=(gi+2*NW<gt)?LOADE(gi+2*NW):0u;
        if(gi<gp) attn_group<1>(bh,j,gi,np,e_cur,q_cur,A,shm);
        else attn_group<0>(bh,j,gi-gp,nf,e_cur,q_cur,A,shm);
        e_cur=e_nxt; e_nxt=e_nn;
        #pragma unroll
        for(int d0=0;d0<4;++d0)q_cur[d0]=q_nxt[d0];
      }
    }
    #undef LOADE
  }
  #undef LOADQ
  CBAR_LDS();
  if(!OWN)pend_x=bh&7;
}
__device__ __forceinline__ void flush_pending(const AB&A,int&pend_x){
  if(pend_x>=0){ CBAR_ALL(); if(threadIdx.x==0)__hip_atomic_fetch_add(A.qctl+512+64*pend_x,1u,__ATOMIC_RELAXED,__HIP_MEMORY_SCOPE_AGENT); pend_x=-1; CBAR_LDS(); }
}
__device__ __forceinline__ void moba_phase(char*lds,const AB&A){
  const int tid=threadIdx.x; volatile unsigned*uw=(volatile unsigned*)(lds+LDS_UNIT);
  const unsigned x0=xb_xcc_id()&7u; unsigned acquired=0u; int pend_x=-1;
  bool pf_valid=false; unsigned pf_k=0u;
  for(unsigned qi=0;qi<8u;){
    const unsigned x=(x0+qi)&7u;
    unsigned k;
    if(pf_valid){ k=pf_k; pf_valid=false; }
    else {
      if(tid==0){ const unsigned k0=__hip_atomic_fetch_add(A.qctl+64*x,1u,__ATOMIC_RELAXED,__HIP_MEMORY_SCOPE_AGENT); uw[0]=k0; }
      CBAR_ALL();
      k=(unsigned)__builtin_amdgcn_readfirstlane((int)uw[0]);
      CBAR_LDS();
    }
    constexpr unsigned T=124u;
    if(k>=T+128u){ ++qi; continue; }
    unsigned pfr=0u;
    if(tid==0)pfr=__hip_atomic_fetch_add(A.qctl+64*x,1u,__ATOMIC_RELAXED,__HIP_MEMORY_SCOPE_AGENT);
    if(k<T){ kv_unit<false>((int)x+8*(int)(k&3u),(int)(k>>2),A,lds,pend_x); }
    else {
      const unsigned ko=k-T;
      if(!((acquired>>x)&1u)){
        flush_pending(A,pend_x);
        if(tid<64){ unsigned sp=0u; while(__builtin_amdgcn_readfirstlane(__hip_atomic_load(A.qctl+512+64*x,__ATOMIC_RELAXED,__HIP_MEMORY_SCOPE_AGENT))<T){ __builtin_amdgcn_s_sleep(2); if(++sp>(1u<<19))break; }
          __builtin_amdgcn_fence(__ATOMIC_ACQUIRE,"agent"); asm volatile("s_waitcnt vmcnt(0)":::"memory"); }
        CBAR_LDS();
        acquired|=1u<<x; }
      kv_unit<true>((int)x+8*(int)(ko&3u),31-(int)(ko>>2),A,lds,pend_x);
    }
    if(tid==0)uw[1]=pfr;
    CBAR_ALL();
    pf_k=(unsigned)__builtin_amdgcn_readfirstlane((int)uw[1]); pf_valid=true;
    CBAR_LDS();
  }
  flush_pending(A,pend_x);
}
#undef SBAR
#undef WAIT_BAR
}
constexpr int CW_AQ = 16384, CW_CNT = 20480, CW_RT = 22592, CW_GQ = 22656, CW_GQ2 = 22720, CW_G1B = 22784, CW_FLAGS = 24576;
__device__ __forceinline__ void p0_phase(const Ptrs& P, LAS unsigned char* lds, int tid, int G) {
    const int lane = tid & 63, wave = tid >> 6;
    {
        LAS float* scr = (LAS float*)(lds + wave * 16640);
        for (int it = blockIdx.x * NWAVES + wave; it < 1024 + 256; it += G * NWAVES) {
            const bool first = it < 1024; const int r = first ? it : it - 1024; const int kb = r & 15, pb = r >> 4;
            const float* W = first ? P.w_in : P.w_out; const int ldw = first ? NCOL : DM; bf16_t* WT = first ? P.WT1 : P.WT2;
            const int p = pb * 64 + lane; const int c = first ? wt1_logical(p) : p;
#pragma unroll 8
            for (int kk = 0; kk < 64; ++kk) scr[kk * 65 + lane] = W[(size_t)(kb * 64 + kk) * ldw + c];
            asm volatile("s_waitcnt lgkmcnt(0)" ::: "memory");
#pragma unroll 8
            for (int pp = 0; pp < 64; ++pp) WT[(size_t)(pb * 64 + pp) * 1024 + kb * 64 + lane] = f2bf(scr[lane * 65 + pp]);
            asm volatile("s_waitcnt lgkmcnt(0)" ::: "memory");
        }
        __syncthreads();
    }
    LAS float* w8 = (LAS float*)(lds + 32768);
    for (int i = tid; i < 1024 * 8; i += 512) w8[i] = P.w_in[(size_t)(i >> 3) * NCOL + 4096 + (i & 7)];
    __syncthreads();
    f32x4 nw[4];
#pragma unroll
    for (int j = 0; j < 4; ++j) nw[j] = ((const f32x4*)P.norm_w)[lane + 64 * j];
    const int gw = blockIdx.x * NWAVES + wave, ngw = G * NWAVES;
    f32x4 vn[4];
    if (gw < MTOK) { const f32x4* xr0 = (const f32x4*)(P.x + (size_t)gw * DM) + lane;
#pragma unroll
        for (int j = 0; j < 4; ++j) vn[j] = xr0[64 * j]; }
    for (int row = gw; row < MTOK; row += ngw) {
        f32x4 v[4]; float ss = 0.f;
#pragma unroll
        for (int j = 0; j < 4; ++j) v[j] = vn[j];
        if (row + ngw < MTOK) { const f32x4* xr1 = (const f32x4*)(P.x + (size_t)(row + ngw) * DM) + lane;
#pragma unroll
            for (int j = 0; j < 4; ++j) vn[j] = xr1[64 * j]; }
#pragma unroll
        for (int j = 0; j < 4; ++j) ss += v[j][0] * v[j][0] + v[j][1] * v[j][1] + v[j][2] * v[j][2] + v[j][3] * v[j][3];
        ss = wave_sum(ss);
        const float rstd = 1.0f / sqrtf(ss * (1.0f / DM) + EPS);
        float d[8];
#pragma unroll
        for (int c = 0; c < 8; ++c) d[c] = 0.f;
#pragma unroll
        for (int j = 0; j < 4; ++j) {
            f32x4 h = v[j] * rstd * nw[j];
            unsigned lo = (unsigned)f2bf(h[0]) | ((unsigned)f2bf(h[1]) << 16), hi = (unsigned)f2bf(h[2]) | ((unsigned)f2bf(h[3]) << 16);
            *(uint2*)(P.HN + (size_t)row * DM + 4 * (lane + 64 * j)) = make_uint2(lo, hi);
#pragma unroll
            for (int e = 0; e < 4; ++e) { const LAS f32x4* wr = (const LAS f32x4*)(w8 + (4 * (lane + 64 * j) + e) * 8); const f32x4 wa = wr[0], wb = wr[1];
#pragma unroll
                for (int c = 0; c < 4; ++c) { d[c] += h[e] * wa[c]; d[4 + c] += h[e] * wb[c]; } }
        }
#pragma unroll
        for (int c = 0; c < 8; ++c) d[c] = wave_sum(d[c]);
        if (lane < 4) {
            const int hh = lane; float bd = d[0], ad = d[4];
            if (hh == 1) { bd = d[1]; ad = d[5]; } else if (hh == 2) { bd = d[2]; ad = d[6]; } else if (hh == 3) { bd = d[3]; ad = d[7]; }
            const float beta = 1.0f / (1.0f + expf(-bd));
            const float z = ad + P.dt_bias[hh];
            const float sp = fmaxf(z, 0.f) + log1pf(expf(-fabsf(z)));
            const float g = -expf(P.a_log[hh]) * sp;
            const int b = row / SEQ, s = row % SEQ;
            P.BETA[(size_t)(b * DH + hh) * SEQ + s] = beta; P.GDEC[(size_t)(b * DH + hh) * SEQ + s] = g;
        }
    }
    __syncthreads();
}

struct Args { const float* in[11]; float* out; unsigned char* ws; int ph_lo, ph_hi, qoff, li; };
__global__ void __launch_bounds__(NWAVES * 64, 2) mega(Args args) {
    extern __shared__ __attribute__((aligned(16))) unsigned char lds_raw[];
    LAS unsigned char* lds = (LAS unsigned char*)lds_raw;
    const int tid = threadIdx.x, G = gridDim.x;
    void* din[11];
#pragma unroll
    for (int i = 0; i < 11; ++i) din[i] = (void*)args.in[i];
    const Ptrs P = make_ptrs(din, args.out, args.ws);
    volatile LAS unsigned* MISC = (volatile LAS unsigned*)(lds + MISC_OFF);
    for (int u = tid; u < (LDS_BYTES - LDSCTL_OFF) / 4; u += NWAVES * 64) ((LAS unsigned*)(lds + LDSCTL_OFF))[u] = 0u;
    __syncthreads();
    XcdBarrier bar = xcd_barrier_post(P.ctl + CW_BAR + args.li * XCD_BAR_WORDS, MISC + 8);
    const int lo = args.ph_lo, hi = args.ph_hi;
#define IN(k) (lo <= (k) && (k) < hi)
#define BOTH(k) (IN(k) && IN((k) + 1))
    if (IN(0)) { p0_phase(P, lds, tid, G); if (BOTH(0)) xcd_barrier(bar); }
    if (IN(1)) {
        pg8::Gemm g{P.HN, P.WT1 + (size_t)2048 * DM, MTOK, 2048, DM}; pg8::StaticOrder S; S.init(MTOK, 2048, G, (int)blockIdx.x);
        pg8::EpiProj E{P.QA, P.KA, P.VA, P.ZA, P.ZD, P.QKVD, P.KMEAN, P.qnw, P.knw, 8};
        pg8::gemm_phase<pg8::EpiProj, pg8::StaticOrder, true, true>(lds + RING_OFF, g, S, E);
        if (BOTH(1)) xcd_barrier(bar);
    }
#define GEMM1B_AND_PUBLISH() do{ \
                pg8::Gemm g{P.HN, P.WT1, MTOK, 2048, DM}; pg8::StaticOrder S; S.init(MTOK, 2048, G - 16, (int)blockIdx.x - 16); \
                pg8::EpiProj E{P.QA, P.KA, P.VA, P.ZA, P.ZD, P.QKVD, P.KMEAN, P.qnw, P.knw, 0}; \
                pg8::gemm_phase<pg8::EpiProj, pg8::StaticOrder, true, true>(lds + RING_OFF, g, S, E); \
                CBAR_ALL();                                \
                if (tid == 0) { __builtin_amdgcn_fence(__ATOMIC_RELEASE, "agent"); asm volatile("s_waitcnt vmcnt(0)" ::: "memory"); \
                    __hip_atomic_fetch_add(P.ctl + CW_G1B, 1u, __ATOMIC_RELAXED, __HIP_MEMORY_SCOPE_AGENT); } \
                CBAR_LDS(); }while(0)
    if (IN(2)) {
        const int dq = args.qoff;
        const moba::AB A{(dq >> 4) & 7, P.QA, P.KA, P.VA, P.KMEAN, P.rel_bias, P.ZA, P.Y, P.SEL, P.LIST, P.ctl + CW_CNT, P.OPART, P.LP, P.ctl + CW_AQ + (dq & ~255)};
        if (blockIdx.x < 16) {
            if (!(dq & 1)) {
#ifdef SCANDBG
                if (dq & 12) dn::scan_head<SCANDBG>((int)blockIdx.x, P.REC, P.GLB, P.dnw, P.ZD, (bf16_t*)P.out, P.ctl + CW_FLAGS, (char*)lds_raw, dq & 12); else
#endif
                dn::scan_head<0>((int)blockIdx.x, P.REC, P.GLB, P.dnw, P.ZD, (dq & 12) ? (bf16_t*)P.out : P.Y, P.ctl + CW_FLAGS, (char*)lds_raw, dq & 12); }
        } else if (!(dq & 128)) {
            volatile LAS unsigned* qw = MISC + 16;
            int pend0 = -1, pend1 = -1, carry = -1;
#ifdef PREPX
#define PREP_EXTRA dn::prep_chunk(pend0, P.QKVD, P.conv_w, P.BETA, P.GDEC, (unsigned char*)P.OPART, P.GLB + 4096, P.ctl + CW_FLAGS, lds, PREPX); dn::prep_chunk(pend1, P.QKVD, P.conv_w, P.BETA, P.GDEC, (unsigned char*)P.OPART + 131072, P.GLB + 4096, P.ctl + CW_FLAGS, lds, PREPX);
#else
#define PREP_EXTRA
#endif
#define PREP_LOOP(LIMIT) for (;;) { \
                if (tid == 0) { unsigned k; if (carry >= 0) k = (unsigned)carry; else k = __hip_atomic_fetch_add(P.ctl + CW_GQ, 1u, __ATOMIC_RELAXED, __HIP_MEMORY_SCOPE_AGENT); qw[0] = k; } \
                carry = -1; \
                CBAR_ALL(); \
                if (pend0 >= 0) { if (tid == 0) { __hip_atomic_store(P.ctl + CW_FLAGS + pend0, 1u, __ATOMIC_RELAXED, __HIP_MEMORY_SCOPE_AGENT); __hip_atomic_store(P.ctl + CW_FLAGS + pend1, 1u, __ATOMIC_RELAXED, __HIP_MEMORY_SCOPE_AGENT); } pend0 = -1; } \
                const unsigned k = (unsigned)__builtin_amdgcn_readfirstlane((int)qw[0]); \
                CBAR_LDS(); \
                if (k >= 1024u) break; \
                if (k >= (LIMIT)) { carry = (int)k; break; } \
                const unsigned cq = 2u * k; \
                pend0 = (int)(cq & 15u) * 128 + (int)(cq >> 4); pend1 = (int)((cq + 1u) & 15u) * 128 + (int)((cq + 1u) >> 4); \
                dn::prep_chunk(pend0, P.QKVD, P.conv_w, P.BETA, P.GDEC, P.REC + (size_t)pend0 * dn::REC_BYTES, P.GLB, P.ctl + CW_FLAGS, lds); \
                dn::prep_chunk(pend1, P.QKVD, P.conv_w, P.BETA, P.GDEC, P.REC + (size_t)pend1 * dn::REC_BYTES, P.GLB, P.ctl + CW_FLAGS, lds); \
                PREP_EXTRA \
            }
            PREP_LOOP(512u)
            GEMM1B_AND_PUBLISH();
            PREP_LOOP(1024u)
#undef PREP_LOOP
            if (tid < 64) { unsigned sp = 0u;
                while (__builtin_amdgcn_readfirstlane(__hip_atomic_load(P.ctl + CW_G1B, __ATOMIC_RELAXED, __HIP_MEMORY_SCOPE_AGENT)) < (unsigned)(G - 16)) { __builtin_amdgcn_s_sleep(8); if (++sp > (1u << 17)) break; }
                __builtin_amdgcn_fence(__ATOMIC_ACQUIRE, "agent"); asm volatile("s_waitcnt vmcnt(0)" ::: "memory"); }
            CBAR_LDS();
            for (;;) {
                if (tid == 0) { const unsigned k = __hip_atomic_fetch_add(P.ctl + CW_GQ2, 1u, __ATOMIC_RELAXED, __HIP_MEMORY_SCOPE_AGENT); qw[0] = k; }
                CBAR_ALL();
                const unsigned k = (unsigned)__builtin_amdgcn_readfirstlane((int)qw[0]);
                CBAR_LDS();
                if (k >= 256u) break;
#pragma unroll 1
                for (unsigned i4 = 0; i4 < 4u; ++i4) { const unsigned it = 4u * k + i4; moba::route_item((int)(it >> 5), (int)(it & 31u), A); }
                CBAR_ALL();
                if (tid == 0) __hip_atomic_fetch_add(P.ctl + CW_RT, 4u, __ATOMIC_RELAXED, __HIP_MEMORY_SCOPE_AGENT);
                CBAR_LDS();
            }
        }
#ifdef NOJOIN
        if (blockIdx.x >= 16)
#endif
        if (!(dq & 2)) {
            if (tid < 64) { unsigned sp = 0u;
                while (__builtin_amdgcn_readfirstlane(__hip_atomic_load(P.ctl + CW_RT, __ATOMIC_RELAXED, __HIP_MEMORY_SCOPE_AGENT)) < 1024u) { __builtin_amdgcn_s_sleep(8); if (++sp > (1u << 17)) break; }
                __builtin_amdgcn_fence(__ATOMIC_ACQUIRE, "agent"); asm volatile("s_waitcnt vmcnt(0)" ::: "memory"); }
            CBAR_LDS();
            moba::moba_phase((char*)lds_raw, A);
        }
        if (IN(5)) xcd_barrier(bar);
    }
    if (IN(5)) {
        pg8::Gemm g{P.Y, P.WT2, MTOK, DM, DM}; pg8::StaticOrder S; S.init(MTOK, DM, G, (int)blockIdx.x);
        pg8::EpiOut E{P.x, P.out};
        pg8::gemm_phase<pg8::EpiOut, pg8::StaticOrder, true, true>(lds + RING_OFF, g, S, E);
    }
#undef IN
#undef BOTH
}

extern "C" void kernel_launch(void* const* d_in, const int* in_sizes, int n_in, void* d_out, int out_size, void* d_ws, size_t ws_size, hipStream_t stream) {
    static int grid = 0;
    if (grid == 0) {
        if (n_in != 11 || ws_size < WS_END) { fprintf(stderr, "kernel_launch: unexpected inputs / workspace (%d, %zu)\n", n_in, ws_size); grid = -1; return; }
        int dev = 0, cus = 0;
        if (hipGetDevice(&dev) != hipSuccess || hipDeviceGetAttribute(&cus, hipDeviceAttributeMultiprocessorCount, dev) != hipSuccess) { grid = -1; return; }
        if (hipFuncSetAttribute((const void*)mega, hipFuncAttributeMaxDynamicSharedMemorySize, LDS_BYTES) != hipSuccess) { fprintf(stderr, "kernel_launch: hipFuncSetAttribute failed\n"); grid = -1; return; }
        grid = cus;
    }
    if (grid < 0) return;
    unsigned char* ws = (unsigned char*)d_ws;
    const Ptrs P = make_ptrs(d_in, d_out, ws);
    (void)hipMemsetAsync(ws + WS_CTL, 0, CTL_BYTES, stream);
    Args a{};
    for (int i = 0; i < 11; ++i) a.in[i] = (const float*)d_in[i];
    a.out = (float*)d_out; a.ws = ws;
#ifndef DUPF
#define DUPF 0
#endif
#ifndef DUPP
    a.ph_lo = 0; a.ph_hi = 6;
    hipLaunchKernelGGL(mega, dim3(grid), dim3(NWAVES * 64), LDS_BYTES, stream, a);
#else
#ifdef FIRSTF
    a.qoff = FIRSTF;
#endif
    a.ph_lo = 0; a.ph_hi = DUPP + 1;
    hipLaunchKernelGGL(mega, dim3(grid), dim3(NWAVES * 64), LDS_BYTES, stream, a);
    a.ph_lo = DUPP; a.ph_hi = DUPP + 1; a.qoff = 1024 + 128 + DUPF; a.li = 1;
    hipLaunchKernelGGL(mega, dim3(grid), dim3(NWAVES * 64), LDS_BYTES, stream, a);
    if (DUPP < 5) { a.ph_lo = DUPP + 1; a.ph_hi = 6; a.qoff = 0; a.li = 2;
    hipLaunchKernelGGL(mega, dim3(grid), dim3(NWAVES * 64), LDS_BYTES, stream, a); }
#endif
}
```

```cpp
#include <hip/hip_runtime.h>
#include <stdint.h>
#include <math.h>
#include <cstdio>

typedef unsigned short bf16_t;
typedef short bf16x8 __attribute__((ext_vector_type(8)));
typedef float f32x4 __attribute__((ext_vector_type(4)));
typedef unsigned u32x4 __attribute__((ext_vector_type(4)));

constexpr int NB = 4, SEQ = 8192, DM = 1024, MTOK = NB * SEQ;
constexpr int AH = 8, AD = 64, AW = 512, NBLK = 32;
constexpr int DH = 4, DKH = 128, NCOL = 4104, DCONV = 1536;
constexpr float EPS = 1e-6f;
constexpr float LOG2E = 1.4426950408889634f;
constexpr float QSCALE = 0.125f * LOG2E;

constexpr size_t MiB = 1u << 20;
constexpr size_t WS_CTL = 0, CTL_BYTES = 1 * MiB;
constexpr size_t WS_KMEAN = 512 * 1024;
constexpr size_t WS_WT1 = 1 * MiB;
constexpr size_t WS_WT2 = 9 * MiB;
constexpr size_t WS_BETA = 11 * MiB;
constexpr size_t WS_GDEC = 11 * MiB + 512 * 1024;
constexpr size_t WS_QA = 12 * MiB, WS_KA = 44 * MiB, WS_VA = 76 * MiB;
constexpr size_t WS_ZA = 108 * MiB, WS_ZD = 140 * MiB;
constexpr size_t WS_QKVD = 172 * MiB;
constexpr size_t WS_REC = 268 * MiB;
constexpr size_t WS_GLB = 256 * 1024;
constexpr size_t WS_Y = 412 * MiB;
constexpr size_t WS_END = 476 * MiB;

__device__ __forceinline__ unsigned short f2bf(float f) { unsigned u = __float_as_uint(f); return (unsigned short)((u + 0x7fffu + ((u >> 16) & 1u)) >> 16); }
__device__ __forceinline__ float bf2f(unsigned short u) { return __uint_as_float(((unsigned)u) << 16); }
__device__ __forceinline__ float wave_sum(float v) {
#define WS_DPP(x, ctrl, rmask) __builtin_bit_cast(float, __builtin_amdgcn_update_dpp(0, __builtin_bit_cast(int, (x)), (ctrl), (rmask), 0xF, false))
    v += WS_DPP(v, 0xB1, 0xF);
    v += WS_DPP(v, 0x4E, 0xF);
    v += WS_DPP(v, 0x141, 0xF);
    v += WS_DPP(v, 0x140, 0xF);
    v += WS_DPP(v, 0x142, 0xA);
    v += WS_DPP(v, 0x143, 0xC);
#undef WS_DPP
    return __builtin_bit_cast(float, __builtin_amdgcn_readlane(__builtin_bit_cast(int, v), 63));
}
__device__ __forceinline__ float xor32_sum(float x) { auto rr = __builtin_amdgcn_permlane32_swap(__float_as_uint(x), __float_as_uint(x), false, false);
    return __uint_as_float(rr[0]) + __uint_as_float(rr[1]); }
__device__ __forceinline__ unsigned xor32_or(unsigned x) { auto rr = __builtin_amdgcn_permlane32_swap(x, x, false, false); return rr[0] | rr[1]; }
__device__ __forceinline__ float xor16_sum(float x) { auto rr = __builtin_amdgcn_permlane16_swap(__float_as_uint(x), __float_as_uint(x), false, false);
    return __uint_as_float(rr[0]) + __uint_as_float(rr[1]); }
__device__ __forceinline__ float xor32_get(float x, bool lower_half) { auto rr = __builtin_amdgcn_permlane32_swap(__float_as_uint(x), __float_as_uint(x), false, false);
    return __uint_as_float(lower_half ? rr[1] : rr[0]); }
__device__ __forceinline__ float row_sum16(float v) {
#define WS_DPP(x, ctrl) __builtin_bit_cast(float, __builtin_amdgcn_update_dpp(0, __builtin_bit_cast(int, (x)), (ctrl), 0xF, 0xF, false))
    v += WS_DPP(v, 0xB1); v += WS_DPP(v, 0x4E); v += WS_DPP(v, 0x141); v += WS_DPP(v, 0x140);
#undef WS_DPP
    return v; }
__device__ __forceinline__ float wave_scan_incl(float v) {
#define WS_DPP(x, ctrl, rmask) __builtin_bit_cast(float, __builtin_amdgcn_update_dpp(0, __builtin_bit_cast(int, (x)), (ctrl), (rmask), 0xF, true))
    v += WS_DPP(v, 0x111, 0xF); v += WS_DPP(v, 0x112, 0xF); v += WS_DPP(v, 0x114, 0xF); v += WS_DPP(v, 0x118, 0xF);
#undef WS_DPP
#define WS_DPP(x, ctrl, rmask) __builtin_bit_cast(float, __builtin_amdgcn_update_dpp(0, __builtin_bit_cast(int, (x)), (ctrl), (rmask), 0xF, false))
    v += WS_DPP(v, 0x142, 0xA); v += WS_DPP(v, 0x143, 0xC);
#undef WS_DPP
    return v; }
__device__ __forceinline__ float silu_f(float x) { return x / (1.0f + __expf(-x)); }
__host__ __device__ __forceinline__ int wt1_ltile(int pt) { return pt < 8 ? pt : (pt < 10 ? pt + 6 : pt - 2); }
__host__ __device__ __forceinline__ int wt1_logical(int p) { const int pn = wt1_ltile(p >> 8), t = p & 255, bj = t >> 7, wc = (t >> 5) & 3, i = t & 31; return 256 * pn + 64 * wc + 32 * bj + i; }
__host__ __device__ __forceinline__ int wt1_physical(int c) { const int ln = c >> 8, pn = ln < 8 ? ln : (ln < 14 ? ln + 2 : ln - 6), wc = (c >> 6) & 3, bj = (c >> 5) & 1, i = c & 31; return 256 * pn + 128 * bj + 32 * wc + i; }

__device__ __forceinline__ void wt_tile(const float* W, int ldw, bf16_t* WT, int kb, int pb, bool perm, float* lds, int tid) {
#pragma unroll 4
    for (int i = 0; i < 16; ++i) { const int kk = i * 4 + (tid >> 6), pp = tid & 63, p = pb * 64 + pp; const int c = perm ? wt1_logical(p) : p;
        lds[kk * 65 + pp] = W[(size_t)(kb * 64 + kk) * ldw + c]; }
    __syncthreads();
#pragma unroll 4
    for (int i = 0; i < 16; ++i) { const int pp = i * 4 + (tid >> 6), kk = tid & 63;
        WT[(size_t)(pb * 64 + pp) * 1024 + kb * 64 + kk] = f2bf(lds[kk * 65 + pp]); }
    __syncthreads();
}


struct G1Out { bf16_t *QA, *KA, *VA, *ZA, *ZD, *QKVD; float* KMEAN; const float *qnw, *knw; };


__device__ __forceinline__ int t5_bucket_dev(int n) {
    if (n < 16) return n;
    int bkt = 16;
    bkt += (n >= 19) + (n >= 21) + (n >= 24) + (n >= 27) + (n >= 31) + (n >= 35) + (n >= 40) + (n >= 46) + (n >= 52) + (n >= 59) + (n >= 67) + (n >= 77) + (n >= 87) + (n >= 99) + (n >= 113);
    return bkt;
}


__device__ __forceinline__ void gst16(void*p,u32x4 v){ *(u32x4*)p=v; }
__device__ __forceinline__ void gst8(void*p,unsigned lo,unsigned hi){ *(uint2*)p=make_uint2(lo,hi); }
#define CBAR_ALL() do{ asm volatile("s_waitcnt vmcnt(0) lgkmcnt(0)":::"memory"); __builtin_amdgcn_s_barrier(); asm volatile("":::"memory"); }while(0)
#define CBAR_LDS() do{ asm volatile("s_waitcnt lgkmcnt(0)":::"memory"); __builtin_amdgcn_s_barrier(); asm volatile("":::"memory"); }while(0)
namespace pg8 {
#define PG8_LAS __attribute__((address_space(3)))
constexpr int BM = 256, BK = 64, HALF = 128, HTB = HALF * BK * 2  , STAGE_BYTES = 8 * HTB, NXCD = 8, WGM = 8;

__host__ __device__ __forceinline__ int lds_byte(int r, int c) { const int st = (r >> 4) * 2 + (c >> 5), rr = r & 15, cc = c & 31, ob = rr * 64 + cc * 2; return st * 1024 + (ob ^ (((ob >> 9) & 1) << 5)); }
__host__ __device__ __forceinline__ void stage_rc(int b, int& R, int& C) { const int st = b / 1024, sb = b % 1024, swz = sb ^ (((sb >> 9) & 1) << 5); R = (st >> 1) * 16 + swz / 64; C = (st & 1) * 32 + (swz % 64) / 2; }
__host__ __device__ __forceinline__ int perm32(int rho) { const int n = rho >> 4, i = rho & 15; return 8 * (i >> 2) + 4 * n + (i & 3); }

struct Unit { int pm, pn; };
struct Gemm { const bf16_t* A; const bf16_t* Bt; int M, N, K; };

struct StaticOrder {
    int nM, nN, nwg, G, c;
    __host__ __device__ void init(int M, int N, int G_, int c_) { nM = M / BM; nN = N / BM; nwg = nM * nN; G = G_; c = c_; }
    __host__ __device__ bool next(int i, Unit& u) const {
        const long L = (long)i * G + c; if (L >= nwg) return false;
        int wgid = (int)L; { const int q = nwg / NXCD, r = nwg % NXCD, xcd = wgid % NXCD, off = wgid / NXCD; wgid = (xcd < r ? xcd * (q + 1) : r * (q + 1) + (xcd - r) * q) + off; }
        const int nig = WGM * nN, gid = wgid / nig, fm = gid * WGM, gsz = (nM - fm) < WGM ? (nM - fm) : WGM;
        u.pm = fm + ((wgid % nig) % gsz); u.pn = (wgid % nig) / gsz; return true;
    }
    __device__ __forceinline__ void a_ready(const Unit&) const {}
    __device__ __forceinline__ void done(const Unit&) const {}
};

__device__ __forceinline__ unsigned cvt_pk_bf16(float lo, float hi) { unsigned r; asm volatile("v_cvt_pk_bf16_f32 %0, %1, %2" : "=v"(r) : "v"(lo), "v"(hi)); return r; }
typedef float f32x2 __attribute__((ext_vector_type(2)));
template <class Epi, class Sched, bool ALIGN_EPI = false, bool SP2 = false>
__device__ __forceinline__ void gemm_phase(PG8_LAS unsigned char* lds, const Gemm g, const Sched& S, const Epi& E) {
    const int tid = threadIdx.x, wid = __builtin_amdgcn_readfirstlane(tid >> 6), lane = tid & 63, wr = wid >> 2, wc = wid & 3, fr = lane & 15, fq = lane >> 4;
    const int K = g.K, nt = K / BK;
    unsigned voffA[2], voffB[2];
#pragma unroll
    for (int i = 0; i < 2; ++i) { int R, C; stage_rc(tid * 16 + i * 8192, R, C); const int Rb = Epi::PERM ? ((R & ~31) + perm32(R & 31)) : R;
        voffA[i] = (unsigned)(R * K + C) * 2u; voffB[i] = (unsigned)(Rb * K + C) * 2u; }
    const size_t kstep = (size_t)(BK * 2);
    const size_t hstep = (size_t)HALF * K * 2;
    const size_t tstep = 2 * hstep;
    const unsigned ldsw = (unsigned)wid * 1024u;
    const int aoff = lds_byte(wr * 64 + fr, fq * 8), boff = lds_byte(wc * 32 + fr, fq * 8);
#define PG8_SA(b, h) (((b) * 2 + (h)) * HTB)
#define PG8_SB(b, h) ((4 + (b) * 2 + (h)) * HTB)
#define PG8_STAGE(bufoff, gbase, voff) do { _Pragma("unroll") for (int _i = 0; _i < 2; ++_i) \
        __builtin_amdgcn_global_load_lds((const unsigned*)((const char*)(gbase) + (voff)[_i]), (PG8_LAS unsigned*)(lds + (bufoff) + ldsw + _i * 8192), 16, 0, 0); } while (0)
#define PG8_LDA(dst, b, h) do { _Pragma("unroll") for (int m = 0; m < 4; ++m) _Pragma("unroll") for (int k = 0; k < 2; ++k) dst[m][k] = *(const PG8_LAS bf16x8*)(lds + PG8_SA(b, h) + aoff + m * 2048 + k * 1024); } while (0)
#define PG8_LDB(dst, b, h) do { _Pragma("unroll") for (int n = 0; n < 2; ++n) _Pragma("unroll") for (int k = 0; k < 2; ++k) dst[n][k] = *(const PG8_LAS bf16x8*)(lds + PG8_SB(b, h) + boff + n * 2048 + k * 1024); } while (0)
#define PG8_MMA(ai, bj, At, Bt) do { __builtin_amdgcn_s_setprio(1); _Pragma("unroll") for (int m = 0; m < 4; ++m) _Pragma("unroll") for (int n = 0; n < 2; ++n) _Pragma("unroll") for (int k = 0; k < 2; ++k) \
        acc[ai][bj][m][n] = __builtin_amdgcn_mfma_f32_16x16x32_bf16(Bt[n][k], At[m][k], acc[ai][bj][m][n], 0, 0, 0); __builtin_amdgcn_s_setprio(0); } while (0)
#define PG8_WAIT_V(n) asm volatile("s_waitcnt vmcnt(" #n ")" ::: "memory")
#define PG8_WAIT_L(n) asm volatile("s_waitcnt lgkmcnt(" #n ")" ::: "memory")
#define PG8_BAR __builtin_amdgcn_s_barrier()
#define PG8_SCHED __builtin_amdgcn_sched_barrier(0)
    Unit cur, nxt; int ui = 0;
    if (!S.next(0, cur)) return;
    f32x4 acc[2][2][4][2];
#pragma unroll
    for (int a = 0; a < 2; ++a)
#pragma unroll
        for (int b = 0; b < 2; ++b)
#pragma unroll
            for (int m = 0; m < 4; ++m)
#pragma unroll
                for (int n = 0; n < 2; ++n) acc[a][b][m][n] = (f32x4){0.f, 0.f, 0.f, 0.f};
    bf16x8 At[4][2], B0[2][2], B1[2][2];
    const char* cA = (const char*)g.A + (size_t)cur.pm * tstep; const char* cB = (const char*)g.Bt + (size_t)cur.pn * tstep;
    S.a_ready(cur);
    if constexpr (SP2) {
        PG8_STAGE(PG8_SB(0, 0), cB, voffB); PG8_STAGE(PG8_SB(0, 1), cB + hstep, voffB); PG8_STAGE(PG8_SA(0, 0), cA, voffA); PG8_STAGE(PG8_SA(0, 1), cA + hstep, voffA);
        if (wr == 1) PG8_BAR;
        PG8_WAIT_V(2); PG8_BAR;
        PG8_STAGE(PG8_SB(1, 0), cB + kstep, voffB); PG8_STAGE(PG8_SA(1, 0), cA + kstep, voffA); PG8_STAGE(PG8_SB(1, 1), cB + hstep + kstep, voffB);
        PG8_WAIT_V(6); PG8_BAR;
    } else {
        PG8_STAGE(PG8_SB(0, 0), cB, voffB); PG8_STAGE(PG8_SA(0, 0), cA, voffA); PG8_STAGE(PG8_SB(0, 1), cB + hstep, voffB); PG8_STAGE(PG8_SA(0, 1), cA + hstep, voffA);
        if (wr == 1) PG8_BAR;
        PG8_WAIT_V(4); PG8_BAR;
        PG8_STAGE(PG8_SB(1, 0), cB + kstep, voffB); PG8_STAGE(PG8_SA(1, 0), cA + kstep, voffA); PG8_STAGE(PG8_SB(1, 1), cB + hstep + kstep, voffB);
        PG8_WAIT_V(6); PG8_BAR;
    }
    for (;;) {
        const bool has_next = S.next(ui + 1, nxt);
        const char* nA = has_next ? (const char*)g.A + (size_t)nxt.pm * tstep : cA; const char* nB = has_next ? (const char*)g.Bt + (size_t)nxt.pn * tstep : cB;
        for (int t = 0; t < nt; t += 2) {
            const bool last = (t == nt - 2);
            const char* a1 = cA + (size_t)(t + 1) * kstep;
            const char* a2 = last ? nA : cA + (size_t)(t + 2) * kstep; const char* b2 = last ? nB : cB + (size_t)(t + 2) * kstep;
            const char* a3 = a2 + kstep; const char* b3 = b2 + kstep;
            if (last && has_next) S.a_ready(nxt);
            if constexpr (SP2) {
            PG8_LDB(B0, 0, 0); PG8_LDB(B1, 0, 1); PG8_SCHED; PG8_LDA(At, 0, 0); PG8_STAGE(PG8_SA(1, 1), a1 + hstep, voffA);
            PG8_WAIT_V(8); PG8_WAIT_L(0); PG8_BAR; PG8_MMA(0, 0, At, B0); PG8_MMA(0, 1, At, B1); PG8_BAR; PG8_SCHED;
            PG8_LDA(At, 0, 1); PG8_STAGE(PG8_SB(0, 0), b2, voffB); PG8_STAGE(PG8_SB(0, 1), b2 + hstep, voffB); PG8_STAGE(PG8_SA(0, 0), a2, voffA);
            PG8_WAIT_V(8); PG8_WAIT_L(0); PG8_BAR; PG8_MMA(1, 0, At, B0); PG8_MMA(1, 1, At, B1); PG8_BAR; PG8_SCHED;
            PG8_LDB(B0, 1, 0); PG8_LDB(B1, 1, 1); PG8_SCHED; PG8_LDA(At, 1, 0); PG8_STAGE(PG8_SA(0, 1), a2 + hstep, voffA);
            PG8_WAIT_V(8); PG8_WAIT_L(0); PG8_BAR; PG8_MMA(0, 0, At, B0); PG8_MMA(0, 1, At, B1); PG8_BAR; PG8_SCHED;
            PG8_LDA(At, 1, 1); PG8_STAGE(PG8_SB(1, 0), b3, voffB); PG8_STAGE(PG8_SB(1, 1), b3 + hstep, voffB); PG8_STAGE(PG8_SA(1, 0), a3, voffA);
            PG8_WAIT_V(8); PG8_WAIT_L(0); PG8_BAR; PG8_MMA(1, 0, At, B0); PG8_MMA(1, 1, At, B1); PG8_BAR; PG8_SCHED;
            } else {
            PG8_LDB(B0, 0, 0); PG8_SCHED; PG8_LDA(At, 0, 0); PG8_STAGE(PG8_SA(1, 1), a1 + hstep, voffA);
            PG8_WAIT_L(8); PG8_BAR; PG8_WAIT_L(0); PG8_MMA(0, 0, At, B0); PG8_BAR; PG8_SCHED;
            PG8_LDB(B1, 0, 1); PG8_STAGE(PG8_SB(0, 0), b2, voffB);
            PG8_BAR; PG8_WAIT_L(0); PG8_MMA(0, 1, At, B1); PG8_BAR;
            PG8_LDA(At, 0, 1); PG8_STAGE(PG8_SA(0, 0), a2, voffA);
            PG8_BAR; PG8_WAIT_L(0); PG8_MMA(1, 0, At, B0); PG8_BAR; PG8_SCHED;
            PG8_STAGE(PG8_SB(0, 1), b2 + hstep, voffB);
            PG8_WAIT_V(6); PG8_BAR; PG8_MMA(1, 1, At, B1); PG8_BAR;
            PG8_LDB(B0, 1, 0); PG8_SCHED; PG8_LDA(At, 1, 0); PG8_STAGE(PG8_SA(0, 1), a2 + hstep, voffA);
            PG8_WAIT_L(8); PG8_BAR; PG8_WAIT_L(0); PG8_MMA(0, 0, At, B0); PG8_BAR; PG8_SCHED;
            PG8_LDB(B1, 1, 1); PG8_STAGE(PG8_SB(1, 0), b3, voffB);
            PG8_BAR; PG8_WAIT_L(0); PG8_MMA(0, 1, At, B1); PG8_BAR;
            PG8_LDA(At, 1, 1); PG8_STAGE(PG8_SA(1, 0), a3, voffA);
            PG8_BAR; PG8_WAIT_L(0); PG8_MMA(1, 0, At, B0); PG8_BAR; PG8_SCHED;
            PG8_STAGE(PG8_SB(1, 1), b3 + hstep, voffB);
            PG8_WAIT_V(6); PG8_BAR; PG8_MMA(1, 1, At, B1); PG8_BAR;
            }
        }
        if constexpr (ALIGN_EPI) { if (wr == 0) PG8_BAR; }
        if constexpr (!Epi::AFTER_DRAIN) { E(acc, cur, wr, wc, fr, fq); S.done(cur); }
        if (!has_next) break;
#pragma unroll
        for (int a = 0; a < 2; ++a)
#pragma unroll
            for (int b = 0; b < 2; ++b)
#pragma unroll
                for (int m = 0; m < 4; ++m)
#pragma unroll
                    for (int n = 0; n < 2; ++n) acc[a][b][m][n] = (f32x4){0.f, 0.f, 0.f, 0.f};
        cur = nxt; cA = nA; cB = nB; ++ui;
        if constexpr (ALIGN_EPI) { if (wr == 1) PG8_BAR; }
    }
    PG8_WAIT_V(0);
    if constexpr (!ALIGN_EPI) { if (wr == 0) PG8_BAR; }
    PG8_BAR;
    if constexpr (Epi::AFTER_DRAIN) { E.fused(acc, cur, wr, wc, fr, fq, lds, wid, lane); S.done(cur); }
#undef PG8_SA
#undef PG8_SB
#undef PG8_STAGE
#undef PG8_LDA
#undef PG8_LDB
#undef PG8_MMA
#undef PG8_WAIT_V
#undef PG8_WAIT_L
#undef PG8_BAR
#undef PG8_SCHED
}
}

namespace pg8 {
__device__ __forceinline__ float fast_silu(float x) { return x * __builtin_amdgcn_rcpf(1.0f + __expf(-x)); }
struct EpiProj {
    static constexpr bool PERM = true, AFTER_DRAIN = false;
    bf16_t *QA, *KA, *VA, *ZA, *ZD, *QKVD; float* KMEAN; const float *qnw, *knw; int pt_off;
    PG8_LAS unsigned char* stg;
    __device__ __forceinline__ void st_rows(PG8_LAS unsigned char* tile, int fr, int fq, const u32x4& w0, const u32x4& w1, bf16_t* rowbase, size_t ld) const {
        const int lane = fr + 16 * fq, rrow = lane >> 3, ch = lane & 7;
        *(PG8_LAS u32x4*)(tile + fr * 144 + 16 * fq) = w0; *(PG8_LAS u32x4*)(tile + fr * 144 + 64 + 16 * fq) = w1;
        const u32x4 r0 = *(const PG8_LAS u32x4*)(tile + rrow * 144 + 16 * ch), r1 = *(const PG8_LAS u32x4*)(tile + (rrow + 8) * 144 + 16 * ch);
        gst16(rowbase + (size_t)rrow * ld + 8 * ch, r0); gst16(rowbase + (size_t)(rrow + 8) * ld + 8 * ch, r1);
    }
    __device__ __forceinline__ void operator()(const f32x4 (&acc)[2][2][4][2], const Unit& u, int wr, int wc, int fr, int fq) const {
        const int pn = wt1_ltile(u.pn + pt_off), b = u.pm >> 5, blk = u.pm & 31;
        const int s0 = blk * 256 + wr * 64 + fr;
        const int row0 = u.pm * BM + wr * 64 + fr;
        if (pn < 4) {
            const bool isq = pn < 2; const int head = (pn & 1) * 4 + wc; const float* nwp = isq ? qnw : knw;
            f32x4 nw[2][2];
#pragma unroll
            for (int bj = 0; bj < 2; ++bj)
#pragma unroll
                for (int n = 0; n < 2; ++n) nw[bj][n] = *(const f32x4*)(nwp + 32 * bj + 8 * fq + 4 * n);
            f32x4 ksum[2][2];
#pragma unroll
            for (int bj = 0; bj < 2; ++bj)
#pragma unroll
                for (int n = 0; n < 2; ++n) ksum[bj][n] = (f32x4){0.f, 0.f, 0.f, 0.f};
            bf16_t* dbase = (isq ? QA : KA) + ((size_t)(b * 8 + head) * 8192) * 64;
            PG8_LAS unsigned char* tile = stg + (wr * 4 + wc) * 2304;
            const float sc = isq ? 0.125f * 1.4426950408889634f : 1.0f;
#pragma unroll
            for (int ai = 0; ai < 2; ++ai)
#pragma unroll
                for (int m = 0; m < 4; ++m) {
                    float ss = 0.f;
#pragma unroll
                    for (int bj = 0; bj < 2; ++bj)
#pragma unroll
                        for (int n = 0; n < 2; ++n) { const f32x4 v = acc[ai][bj][m][n]; ss += (v[0] * v[0] + v[1] * v[1]) + (v[2] * v[2] + v[3] * v[3]); }
                    ss = xor16_sum(ss); ss = xor32_sum(ss);
                    const float rs = __builtin_amdgcn_rsqf(ss * (1.0f / 64.0f) + 1e-6f);
                    u32x4 wq[2];
#pragma unroll
                    for (int bj = 0; bj < 2; ++bj) {
                        const f32x4 v0 = acc[ai][bj][m][0] * rs * nw[bj][0], v1 = acc[ai][bj][m][1] * rs * nw[bj][1];
                        ksum[bj][0] += v0; ksum[bj][1] += v1;
                        u32x4 w; w.x = cvt_pk_bf16(v0[0] * sc, v0[1] * sc); w.y = cvt_pk_bf16(v0[2] * sc, v0[3] * sc); w.z = cvt_pk_bf16(v1[0] * sc, v1[1] * sc); w.w = cvt_pk_bf16(v1[2] * sc, v1[3] * sc);
                        wq[bj] = w;
                    }
                    st_rows(tile, fr, fq, wq[0], wq[1], dbase + (size_t)(blk * 256 + wr * 64 + ai * 128 + m * 16) * 64, 64);
                }
            if (!isq) {
                float* km = KMEAN + ((size_t)(b * 8 + head) * 32 + blk) * 64 + 8 * fq;
#pragma unroll
                for (int bj = 0; bj < 2; ++bj)
#pragma unroll
                    for (int n = 0; n < 2; ++n)
#pragma unroll
                        for (int e = 0; e < 4; ++e) {
                            float t = ksum[bj][n][e];
                            t = row_sum16(t);
                            if (fr == 0) atomicAdd(km + 32 * bj + 4 * n + e, t * (1.0f / 256.0f));
                        }
            }
        } else {
            bf16_t* dbase; size_t ld; int colb; bool act;
            if (pn < 6) { const int head = (pn - 4) * 4 + wc; dbase = VA + ((size_t)(b * 8 + head) * 8192 + blk * 256) * 64; ld = 64; colb = 0; act = false; }
            else if (pn < 8) { dbase = ZA + (size_t)(u.pm * BM) * 512; ld = 512; colb = (pn - 6) * 256 + wc * 64; act = true; }
            else if (pn < 14) { dbase = QKVD + (size_t)(u.pm * BM) * 1536; ld = 1536; colb = (pn - 8) * 256 + wc * 64; act = false; }
            else { dbase = ZD + (size_t)(u.pm * BM) * 512; ld = 512; colb = (pn - 14) * 256 + wc * 64; act = true; }
            PG8_LAS unsigned char* tile = stg + (wr * 4 + wc) * 2304;
#pragma unroll
            for (int ai = 0; ai < 2; ++ai)
#pragma unroll
                for (int m = 0; m < 4; ++m) {
                    u32x4 wq[2];
#pragma unroll
                    for (int bj = 0; bj < 2; ++bj) {
                        f32x4 v0 = acc[ai][bj][m][0], v1 = acc[ai][bj][m][1];
                        if (act) {
#pragma unroll
                            for (int e = 0; e < 4; ++e) { v0[e] = fast_silu(v0[e]); v1[e] = fast_silu(v1[e]); }
                        }
                        u32x4 w; w.x = cvt_pk_bf16(v0[0], v0[1]); w.y = cvt_pk_bf16(v0[2], v0[3]); w.z = cvt_pk_bf16(v1[0], v1[1]); w.w = cvt_pk_bf16(v1[2], v1[3]);
                        wq[bj] = w;
                    }
                    st_rows(tile, fr, fq, wq[0], wq[1], dbase + (size_t)(wr * 64 + ai * 128 + m * 16) * ld + colb, ld);
                }
        }
        (void)row0;
    }
};
struct EpiOut {
    static constexpr bool PERM = false, AFTER_DRAIN = false;
    const float* X; float* O; PG8_LAS unsigned char* stg;
    __device__ __forceinline__ void operator()(const f32x4 (&acc)[2][2][4][2], const Unit& u, int wr, int wc, int fr, int fq) const {
        const int lane = fr + 16 * fq, rrow = lane >> 3, ch = lane & 7;
        PG8_LAS float* tile = (PG8_LAS float*)(stg + (wr * 4 + wc) * 2304);
        PG8_LAS float* tw = tile + fr * 36 + 4 * fq;
        const PG8_LAS float* tr = tile + rrow * 36 + 4 * ch;
        const size_t g0 = (size_t)(u.pm * BM + wr * 64 + rrow) * 1024 + u.pn * BM + wc * 32 + 4 * ch;
#define EPO_OFF(ai, m, bj, h) (g0 + (size_t)((ai) * HALF + (m) * 16 + (h) * 8) * 1024 + (bj) * HALF)
        f32x4 xa[4][2][2], xb[4][2][2];
#pragma unroll
        for (int m = 0; m < 4; ++m)
#pragma unroll
            for (int bj = 0; bj < 2; ++bj)
#pragma unroll
                for (int h = 0; h < 2; ++h) xa[m][bj][h] = *(const f32x4*)(X + EPO_OFF(0, m, bj, h));
#pragma unroll
        for (int m = 0; m < 4; ++m)
#pragma unroll
            for (int bj = 0; bj < 2; ++bj) {
                *(PG8_LAS f32x4*)(tw) = acc[0][bj][m][0]; *(PG8_LAS f32x4*)(tw + 16) = acc[0][bj][m][1];
                xa[m][bj][0] = xa[m][bj][0] + *(const PG8_LAS f32x4*)(tr); xa[m][bj][1] = xa[m][bj][1] + *(const PG8_LAS f32x4*)(tr + 8 * 36);
            }
        __builtin_amdgcn_sched_barrier(0);
#pragma unroll
        for (int m = 0; m < 4; ++m)
#pragma unroll
            for (int bj = 0; bj < 2; ++bj)
#pragma unroll
                for (int h = 0; h < 2; ++h) xb[m][bj][h] = *(const f32x4*)(X + EPO_OFF(1, m, bj, h));
        __builtin_amdgcn_sched_barrier(0);
#pragma unroll
        for (int m = 0; m < 4; ++m)
#pragma unroll
            for (int bj = 0; bj < 2; ++bj)
#pragma unroll
                for (int h = 0; h < 2; ++h) *(f32x4*)(O + EPO_OFF(0, m, bj, h)) = xa[m][bj][h];
#pragma unroll
        for (int m = 0; m < 4; ++m)
#pragma unroll
            for (int bj = 0; bj < 2; ++bj) {
                *(PG8_LAS f32x4*)(tw) = acc[1][bj][m][0]; *(PG8_LAS f32x4*)(tw + 16) = acc[1][bj][m][1];
                xb[m][bj][0] = xb[m][bj][0] + *(const PG8_LAS f32x4*)(tr); xb[m][bj][1] = xb[m][bj][1] + *(const PG8_LAS f32x4*)(tr + 8 * 36);
            }
#pragma unroll
        for (int m = 0; m < 4; ++m)
#pragma unroll
            for (int bj = 0; bj < 2; ++bj)
#pragma unroll
                for (int h = 0; h < 2; ++h) *(f32x4*)(O + EPO_OFF(1, m, bj, h)) = xb[m][bj][h];
#undef EPO_OFF
    }
};
}

#define LAS __attribute__((address_space(3)))
constexpr int NWAVES = 8;
constexpr int RING_OFF = 0;
constexpr int LDS_BYTES = 163840;
constexpr int LDSCTL_OFF = LDS_BYTES - 1024, MISC_OFF = LDSCTL_OFF + 320;
constexpr int CW_BAR = 4096;

#define XB_TMO      128
#define XB_XCNT(j)  (256  + 64 * (j))
#define XB_XSUB(j)  (1280 + 64 * (j))
#define XB_XGEN(j)  (2304 + 64 * (j))
#define XB_TOP      3328
#define XB_TOPGEN   3392
#define XCD_BAR_WORDS 3456
#define XB_SPIN_CAP (1u << 18)
__device__ __forceinline__ unsigned xb_ld(unsigned* p)              { return __hip_atomic_load(p, __ATOMIC_RELAXED, __HIP_MEMORY_SCOPE_AGENT); }
__device__ __forceinline__ unsigned xb_add(unsigned* p, unsigned v) { return __hip_atomic_fetch_add(p, v, __ATOMIC_RELAXED, __HIP_MEMORY_SCOPE_AGENT); }
__device__ __forceinline__ unsigned xb_xcc_id() { return (unsigned)__builtin_amdgcn_s_getreg((3 << 11) | 20) & 0xFu; }
#define XB_SPIN(cond, bar) do { unsigned _sp = 0; while (cond) { __builtin_amdgcn_s_sleep(1); \
    if ((++_sp & 255u) == 0u) { if (xb_ld(&(bar)[XB_TMO])) break; if (_sp > XB_SPIN_CAP) { atomicAdd(&(bar)[XB_TMO], 1u); break; } } } } while (0)
struct XcdBarrier { unsigned* bar; unsigned x; volatile LAS unsigned* st; };
__device__ __forceinline__ XcdBarrier xcd_barrier_post(unsigned* bar, volatile LAS unsigned* st) {
    XcdBarrier b; b.bar = bar; b.x = xb_xcc_id(); b.st = st;
    if (threadIdx.x == 0) (void)xb_add(&bar[XB_XCNT(b.x)], 1u);
    return b;
}
__device__ __forceinline__ void xcd_barrier_complete(unsigned* bar, unsigned x, unsigned& nloc, unsigned& nx) {
    const unsigned G = gridDim.x * gridDim.y * gridDim.z;
    unsigned sum, cnt, mine, sp = 0u;
    for (;;) {
        sum = 0u; cnt = 0u; mine = 0u;
#pragma unroll
        for (unsigned j = 0; j < 16; ++j) { const unsigned c = xb_ld(&bar[XB_XCNT(j)]); sum += c; cnt += (c > 0u) ? 1u : 0u; mine = (j == x) ? c : mine; }
        if (sum == G) break;
        __builtin_amdgcn_s_sleep(1);
        if ((++sp & 255u) == 0u) { if (xb_ld(&bar[XB_TMO])) break; if (sp > XB_SPIN_CAP) { atomicAdd(&bar[XB_TMO], 1u); break; } }
    }
    nloc = mine > 0u ? mine : 1u; nx = cnt > 0u ? cnt : 1u;
}
__device__ __forceinline__ void xcd_barrier(const XcdBarrier& b) {
    asm volatile("s_waitcnt vmcnt(0)" ::: "memory");
    __syncthreads();
    if (threadIdx.x == 0) {
        unsigned* bar = b.bar;
        __builtin_amdgcn_s_waitcnt(0);
        unsigned nloc = b.st[0], nx = b.st[1];
        if (nloc == 0u) { xcd_barrier_complete(bar, b.x, nloc, nx); b.st[0] = nloc; b.st[1] = nx; }
        const unsigned old = xb_add(&bar[XB_XSUB(b.x)], 1u);
        const unsigned gen = old / nloc;
        if (old + 1u == (gen + 1u) * nloc) {
            __builtin_amdgcn_fence(__ATOMIC_RELEASE, "agent");
            asm volatile("s_waitcnt vmcnt(0)" ::: "memory");
            const unsigned og = xb_add(&bar[XB_TOP], 1u);
            const unsigned tg = og / nx;
            __builtin_amdgcn_fence(__ATOMIC_ACQUIRE, "agent");
            if (og + 1u == (tg + 1u) * nx) xb_add(&bar[XB_TOPGEN], 1u);
            else XB_SPIN(xb_ld(&bar[XB_TOPGEN]) == tg, bar);
            asm volatile("s_waitcnt vmcnt(0)" ::: "memory");
            xb_add(&bar[XB_XGEN(b.x)], 1u);
            asm volatile("s_waitcnt vmcnt(0)" ::: "memory");
        } else {
            __builtin_amdgcn_fence(__ATOMIC_ACQUIRE, "agent");
            XB_SPIN(xb_ld(&bar[XB_XGEN(b.x)]) == gen, bar);
            asm volatile("s_waitcnt vmcnt(0)" ::: "memory");
        }
    }
    __syncthreads();
}

struct Ptrs {
    const float *x, *rel_bias, *norm_w, *w_in, *qnw, *knw, *conv_w, *a_log, *dt_bias, *dnw, *w_out;
    float* out; bf16_t* HN; bf16_t *WT1, *WT2; float *BETA, *GDEC, *KMEAN; bf16_t *QA, *KA, *VA, *ZA, *ZD, *QKVD; bf16_t* Y; unsigned* ctl; unsigned char* REC; float* GLB; unsigned* SEL; unsigned short* LIST; float* LP; bf16_t* OPART;
};
__host__ __device__ inline Ptrs make_ptrs(void* const* d_in, void* d_out, unsigned char* ws) {
    Ptrs p;
    p.x = (const float*)d_in[0]; p.rel_bias = (const float*)d_in[1]; p.norm_w = (const float*)d_in[2]; p.w_in = (const float*)d_in[3]; p.qnw = (const float*)d_in[4]; p.knw = (const float*)d_in[5];
    p.conv_w = (const float*)d_in[6]; p.a_log = (const float*)d_in[7]; p.dt_bias = (const float*)d_in[8]; p.dnw = (const float*)d_in[9]; p.w_out = (const float*)d_in[10];
    p.out = (float*)d_out; p.HN = (bf16_t*)d_out;
    p.WT1 = (bf16_t*)(ws + WS_WT1); p.WT2 = (bf16_t*)(ws + WS_WT2); p.BETA = (float*)(ws + WS_BETA); p.GDEC = (float*)(ws + WS_GDEC); p.KMEAN = (float*)(ws + WS_KMEAN);
    p.QA = (bf16_t*)(ws + WS_QA); p.KA = (bf16_t*)(ws + WS_KA); p.VA = (bf16_t*)(ws + WS_VA); p.ZA = (bf16_t*)(ws + WS_ZA); p.ZD = (bf16_t*)(ws + WS_ZD); p.QKVD = (bf16_t*)(ws + WS_QKVD);
    p.Y = (bf16_t*)(ws + WS_Y); p.ctl = (unsigned*)(ws + WS_CTL); p.REC = ws + WS_REC; p.GLB = (float*)(ws + WS_GLB);
    { unsigned char* o8 = (unsigned char*)d_out; p.SEL = (unsigned*)o8; p.LIST = (unsigned short*)(o8 + 1 * MiB); p.LP = (float*)(o8 + 17 * MiB); p.OPART = (bf16_t*)(o8 + 21 * MiB); }
    return p;
}


namespace dn {
using f32x16=__attribute__((ext_vector_type(16)))float;
typedef unsigned u32x2v __attribute__((ext_vector_type(2)));
constexpr int REC_NW=0, REC_QD=16384, REC_KT=32768, REC_AI=49152, REC_U=57344, REC_BYTES=73728;
constexpr int CH=64;
__device__ __forceinline__ int crow(int r,int hi){return (r&3)+8*(r>>2)+4*hi;}
typedef float f32x2_t __attribute__((ext_vector_type(2))); typedef __bf16 bf16x2_t __attribute__((ext_vector_type(2)));
__device__ __forceinline__ unsigned cvtpk(float lo,float hi){f32x2_t v={lo,hi};bf16x2_t b=__builtin_convertvector(v,bf16x2_t);return __builtin_bit_cast(unsigned,b);}
__device__ __forceinline__ float bflo(unsigned w){return __uint_as_float(w<<16);}
__device__ __forceinline__ float bfhi(unsigned w){return __uint_as_float(w&0xffff0000u);}
#define DN_MFMA32(a,b,c) __builtin_amdgcn_mfma_f32_32x32x16_bf16((a),(b),(c),0,0,0)
#define SCANDBG 0
#define DN_MFMA4(a,b,c) __builtin_amdgcn_mfma_f32_16x16x4f32((a),(b),(c),0,0,0)
#define DN_BAR() CBAR_ALL()
__device__ __forceinline__ void st16_wt(void*p,u32x4 v){ asm volatile("global_store_dwordx4 %0, %1, off sc1\n\ts_nop 1"::"v"(p),"v"(v):"memory"); }
__device__ __forceinline__ void st8_wt(void*p,unsigned lo,unsigned hi){ __hip_atomic_store((unsigned long long*)p,((unsigned long long)hi<<32)|lo,__ATOMIC_RELAXED,__HIP_MEMORY_SCOPE_AGENT); }

constexpr int P_QI=0, P_KI=16384, P_XT=32768, XT_LD=68, P_LF=P_XT+256*XT_LD*4, LF_LD=68, P_DF=P_LF+64*LF_LD*4, DF_LD=20, P_GC=P_DF+4*16*DF_LD*4, P_EG=P_GC+256, P_EKD=P_EG+256, P_BETA=P_EKD+256, P_END=P_BETA+256;
static_assert(P_END<=131072,"prep LDS");

__device__ __forceinline__ void prep_load(int c,const bf16_t*QKVD,unsigned(&xr)[3][11]){
  const int tid=threadIdx.x; int lane=tid&63; asm volatile("":"+v"(lane));
  const int wid=__builtin_amdgcn_readfirstlane(tid>>6);
  const int bh=c>>7,n=c&127,b=bh>>2,h=bh&3,s0=n*CH; const size_t tok0=(size_t)b*SEQ+s0;
  #pragma unroll
  for(int rr=0;rr<11;++rr){ const int sp=s0+8*wid-3+rr;
    #pragma unroll
    for(int p=0;p<3;++p) xr[p][rr]=(sp>=0)?*(const unsigned*)(QKVD+(tok0+8*wid-3+rr)*DCONV+p*512+h*128+2*lane):0u; }
}
__device__ __forceinline__ int prep_item_chunk(unsigned k,int second){ const unsigned cq=(k<256u?k:2u*k-256u)+(unsigned)second; return (int)(cq&15u)*128+(int)(cq>>4); }
struct PrepNext { volatile LAS unsigned*qw; unsigned pfk; const bf16_t*QKVD; unsigned klimit; };
template<bool PF> __device__ __forceinline__ void prep_chunk(int c,const unsigned(&xr)[3][11],const float*conv_w,const float*BETA,const float*GDEC,unsigned char*rec,float*GLB,unsigned*flags,LAS unsigned char*lds,const PrepNext&pn,unsigned(&xn)[3][11],unsigned&knext,int pub0,int pub1){
  const int tid=threadIdx.x; int lane=tid&63; asm volatile("":"+v"(lane));
  const int wid=__builtin_amdgcn_readfirstlane(tid>>6);
  const int bh=c>>7,n=c&127,b=bh>>2,h=bh&3,s0=n*CH; const size_t tok0=(size_t)b*SEQ+s0;
  LAS float*GC=(LAS float*)(lds+P_GC); LAS float*EG=(LAS float*)(lds+P_EG); LAS float*EKD=(LAS float*)(lds+P_EKD); LAS float*BT=(LAS float*)(lds+P_BETA);
  LAS float*XT=(LAS float*)(lds+P_XT); LAS float*LF=(LAS float*)(lds+P_LF); LAS float*DF=(LAS float*)(lds+P_DF);
  float g_l=GDEC[(size_t)bh*SEQ+s0+lane]; const float bt_l=BETA[(size_t)bh*SEQ+s0+lane];
  g_l=wave_scan_incl(g_l);
  const float eg_l=__expf(g_l);
  if(wid==0){
    const float gl=__shfl(g_l,63);
    GC[lane]=g_l; EG[lane]=eg_l; EKD[lane]=__expf(gl-g_l); BT[lane]=bt_l;
    if(lane==63)__hip_atomic_store(GLB+c,eg_l,__ATOMIC_RELAXED,__HIP_MEMORY_SCOPE_AGENT);
  }
  {
    float cw[3][4][2];
    #pragma unroll
    for(int p=0;p<3;++p)
      #pragma unroll
      for(int j=0;j<4;++j){ const float2 w2=*(const float2*)(conv_w+j*DCONV+p*512+h*128+2*lane); cw[p][j][0]=w2.x; cw[p][j][1]=w2.y; }
    #pragma unroll
    for(int i=0;i<8;++i){
      const int pos=8*wid+i;
      float v[3][2];
      #pragma unroll
      for(int p=0;p<3;++p){ float a0=0.f,a1=0.f;
        #pragma unroll
        for(int j=0;j<4;++j){ a0+=cw[p][j][0]*bflo(xr[p][i+j]); a1+=cw[p][j][1]*bfhi(xr[p][i+j]); }
        v[p][0]=a0*__builtin_amdgcn_rcpf(1.0f+__expf(-a0)); v[p][1]=a1*__builtin_amdgcn_rcpf(1.0f+__expf(-a1)); }
      const float sq=wave_sum(v[0][0]*v[0][0]+v[0][1]*v[0][1]), sk=wave_sum(v[1][0]*v[1][0]+v[1][1]*v[1][1]);
      const float rq=__builtin_amdgcn_rsqf(sq+EPS)*0.08838834764831845f, rk=__builtin_amdgcn_rsqf(sk+EPS);
      const float q0=v[0][0]*rq,q1=v[0][1]*rq,k0=v[1][0]*rk,k1=v[1][1]*rk;
      const int ch=2*lane; const int off=((ch>>3)*64+pos)*16+(ch&7)*2;
      *(LAS unsigned*)(lds+P_QI+off)=cvtpk(q0,q1);
      *(LAS unsigned*)(lds+P_KI+off)=cvtpk(k0,k1);
      const float bt=__shfl(bt_l,pos), be=bt*__shfl(eg_l,pos);
      XT[(ch)*XT_LD+pos]=v[2][0]*bt; XT[(ch+1)*XT_LD+pos]=v[2][1]*bt;
      XT[(128+ch)*XT_LD+pos]=k0*be; XT[(128+ch+1)*XT_LD+pos]=k1*be;
    }
  }
  if(PF&&threadIdx.x==0)pn.qw[1]=pn.pfk;
  if(pub0>=0)asm volatile("s_waitcnt vmcnt(0)":::"memory");
  CBAR_LDS();
  if(pub0>=0&&threadIdx.x==0){ __hip_atomic_store(flags+pub0,1u,__ATOMIC_RELAXED,__HIP_MEMORY_SCOPE_AGENT); if(pub1>=0)__hip_atomic_store(flags+pub1,1u,__ATOMIC_RELAXED,__HIP_MEMORY_SCOPE_AGENT); }
  if(PF){ knext=(unsigned)__builtin_amdgcn_readfirstlane((int)pn.qw[1]); if(knext<pn.klimit)prep_load(prep_item_chunk(knext,0),pn.QKVD,xn); }
  {
    const int r32=lane&31,hi=lane>>5;
    if(wid<6){
      const int kind=wid/3, w3=wid%3;
      const int ta=(kind==0)?(w3==0?0:1):(w3==2?1:0);
      const int tb=(kind==0)?(w3==2?1:0):(w3==0?0:1);
      const LAS unsigned char*Ab=lds+P_KI+(32*ta+r32)*16+hi*1024;
      const LAS unsigned char*Bb=lds+(kind==0?P_KI:P_QI)+(32*tb+r32)*16+hi*1024;
      f32x16 acc=f32x16{};
      #pragma unroll
      for(int ks=0;ks<8;++ks){ const bf16x8 a=*(const LAS bf16x8*)(Ab+ks*2048), bb=*(const LAS bf16x8*)(Bb+ks*2048); acc=DN_MFMA32(a,bb,acc); }
      if(kind==0){
        const int j=32*tb+r32; const float gj=GC[j];
        #pragma unroll
        for(int r=0;r<16;++r){ const int i=32*ta+crow(r,0)+4*hi; const float val=(j<i)?BT[i]*acc[r]*__expf(GC[i]-gj):0.f; LF[i*LF_LD+j]=val; }
      } else {
        const int i=32*tb+r32; const float gi=GC[i];
        float o_[16];
        #pragma unroll
        for(int r=0;r<16;++r){ const int j=32*ta+crow(r,0)+4*hi; o_[r]=(j<=i)?acc[r]*__expf(gi-GC[j]):0.f; }
        #pragma unroll
        for(int s=0;s<2;++s){ u32x4 w; w.x=cvtpk(o_[8*s],o_[8*s+1]); w.y=cvtpk(o_[8*s+2],o_[8*s+3]); w.z=cvtpk(o_[8*s+4],o_[8*s+5]); w.w=cvtpk(o_[8*s+6],o_[8*s+7]);
          st16_wt(rec+REC_AI+((tb*4+2*ta+s)*64+lane)*16,w); }
      }
    }
  }
  CBAR_LDS();
  if(wid==0){
    const int bb=lane>>4,j=lane&15; float t[16];
    const LAS float*Lb=LF+(16*bb)*LF_LD+16*bb;
    f32x4 rw[16][4];
    #pragma unroll
    for(int i=1;i<16;++i)
      #pragma unroll
      for(int q=0;q<(i+3)/4;++q) rw[i][q]=*(const LAS f32x4*)(Lb+i*LF_LD+4*q);
    #pragma unroll
    for(int i=0;i<16;++i){ float s=(i==j)?1.0f:0.0f;
      #pragma unroll
      for(int m=0;m<i;++m) s-=rw[i][m>>2][m&3]*t[m];
      t[i]=s; DF[(bb*16+i)*DF_LD+j]=s; }
  } else {
    const int r32=lane&31,hi=lane>>5;
    for(int f=wid-1;f<32;f+=7){
      if(f<16){
        const int i2=f>>3,ks=f&7,pos=32*i2+r32; const float e=EG[pos];
        const u32x2v lo=*(const LAS u32x2v*)(lds+P_QI+((2*ks)*64+pos)*16+8*hi), hi2=*(const LAS u32x2v*)(lds+P_QI+((2*ks+1)*64+pos)*16+8*hi);
        u32x4 w; w.x=cvtpk(bflo(lo.x)*e,bfhi(lo.x)*e); w.y=cvtpk(bflo(lo.y)*e,bfhi(lo.y)*e); w.z=cvtpk(bflo(hi2.x)*e,bfhi(hi2.x)*e); w.w=cvtpk(bflo(hi2.y)*e,bfhi(hi2.y)*e);
        st16_wt(rec+REC_QD+(f*64+lane)*16,w);
      } else {
        const int f2=f-16,t=f2>>2,ks=f2&3,dk=32*t+r32; const LAS unsigned short*kp=(const LAS unsigned short*)(lds+P_KI+(dk>>3)*1024+(dk&7)*2);
        const f32x4 e0=*(const LAS f32x4*)(EKD+16*ks+4*hi), e1=*(const LAS f32x4*)(EKD+16*ks+8+4*hi);
        float x[8];
        #pragma unroll
        for(int j=0;j<8;++j){ const int pos=16*ks+8*(j>>2)+4*hi+(j&3); x[j]=__uint_as_float(((unsigned)kp[pos*8])<<16)*((j<4)?e0[j&3]:e1[j&3]); }
        u32x4 w; w.x=cvtpk(x[0],x[1]); w.y=cvtpk(x[2],x[3]); w.z=cvtpk(x[4],x[5]); w.w=cvtpk(x[6],x[7]);
        st16_wt(rec+REC_KT+(f2*64+lane)*16,w);
      }
    }
  }
  CBAR_LDS();
  {
    const int cl=lane&15,g=lane>>4;
    #define PK4(v) cvtpk((v)[0],(v)[1]),cvtpk((v)[2],(v)[3])
    #define FRAG(a_,b_) __builtin_bit_cast(bf16x8,(u32x4){PK4(a_),PK4(b_)})
    #define DN_MFMA16(a,b,c) __builtin_amdgcn_mfma_f32_16x16x32_bf16((a),(b),(c),0,0,0)
    const f32x4 z4=(f32x4){0.f,0.f,0.f,0.f};
    #pragma unroll 1
    for(int cc=0;cc<2;++cc){
      const int ct=2*wid+cc, col=16*ct+cl;
      f32x4 Y[4];
      #pragma unroll
      for(int bb=0;bb<4;++bb){
        f32x4 acc=*(const LAS f32x4*)(XT+col*XT_LD+16*bb+4*g);
        const LAS float*Lr=LF+(16*bb+cl)*LF_LD+4*g;
        if(bb==1){ const f32x4 l0=-*(const LAS f32x4*)(Lr); acc=DN_MFMA16(FRAG(l0,z4),FRAG(Y[0],z4),acc); }
        if(bb==2){ const f32x4 l0=-*(const LAS f32x4*)(Lr), l1=-*(const LAS f32x4*)(Lr+16); acc=DN_MFMA16(FRAG(l0,l1),FRAG(Y[0],Y[1]),acc); }
        if(bb==3){ const f32x4 l0=-*(const LAS f32x4*)(Lr), l1=-*(const LAS f32x4*)(Lr+16), l2=-*(const LAS f32x4*)(Lr+32);
          acc=DN_MFMA16(FRAG(l0,l1),FRAG(Y[0],Y[1]),acc); acc=DN_MFMA16(FRAG(l2,z4),FRAG(Y[2],z4),acc); }
        const f32x4 Da=*(const LAS f32x4*)(DF+(bb*16+cl)*DF_LD+4*g);
        Y[bb]=DN_MFMA16(FRAG(Da,z4),FRAG(acc,z4),z4);
      }
      if(ct<8){
        const int dv=col,c4=dv>>5,r32=dv&31;
        #pragma unroll
        for(int bb=0;bb<4;++bb){ const int i2=bb>>1,rh=bb&1,hi2=g&1;
          st8_wt(rec+REC_U+((((c4*2+i2)*2+rh)*64+hi2*32+r32)*8+4*(g>>1))*2,cvtpk(Y[bb][0],Y[bb][1]),cvtpk(Y[bb][2],Y[bb][3])); }
      } else {
        const int kt=ct-8;
        f32x4 sel; sel[0]=(cl==4*g)?-1.f:0.f; sel[1]=(cl==4*g+1)?-1.f:0.f; sel[2]=(cl==4*g+2)?-1.f:0.f; sel[3]=(cl==4*g+3)?-1.f:0.f;
        const bf16x8 selb=FRAG(sel,z4);
        #pragma unroll
        for(int bb=0;bb<4;++bb){
          const f32x4 zt=DN_MFMA16(FRAG(Y[bb],z4),selb,z4);
          const int pos=16*bb+cl,i2=pos>>5,r32=pos&31,hi2=g&1;
          st8_wt(rec+REC_NW+(((i2*8+kt)*64+hi2*32+r32)*8+4*(g>>1))*2,cvtpk(zt[0],zt[1]),cvtpk(zt[2],zt[3])); }
      }
    }
    #undef PK4
    #undef FRAG
    #undef DN_MFMA16
  }
  CBAR_LDS();
}

__device__ __forceinline__ void glds16(const void*gsrc,unsigned lds_dst){unsigned keep;
  asm volatile("s_mov_b32 %0, m0\n\ts_mov_b32 m0, %2\n\ts_nop 0\n\tglobal_load_lds_dwordx4 %1, off\n\ts_mov_b32 m0, %0":"=&s"(keep):"v"(gsrc),"s"(lds_dst):"memory");}
__device__ __forceinline__ void glds4(const void*gsrc,unsigned lds_dst){unsigned keep;
  asm volatile("s_mov_b32 %0, m0\n\ts_mov_b32 m0, %2\n\ts_nop 0\n\tglobal_load_lds_dword %1, off\n\ts_mov_b32 m0, %0":"=&s"(keep):"v"(gsrc),"s"(lds_dst):"memory");}
__device__ __forceinline__ bf16x8 pack8(const f32x16&x,int s){ u32x4 p; p.x=cvtpk(x[8*s],x[8*s+1]); p.y=cvtpk(x[8*s+2],x[8*s+3]); p.z=cvtpk(x[8*s+4],x[8*s+5]); p.w=cvtpk(x[8*s+6],x[8*s+7]); return __builtin_bit_cast(bf16x8,p); }

__device__ __forceinline__ void scan_wait_batch(const unsigned*rdy,int bh,int m0,int cnt=16){
  if((threadIdx.x>>6)==4){
    const int l_=threadIdx.x&63; unsigned sp=0u;
    __builtin_amdgcn_fence(__ATOMIC_ACQUIRE,"agent");
    for(;;){ unsigned ok=1u; if(l_<cnt)ok=__hip_atomic_load(rdy+bh*128+m0+l_,__ATOMIC_RELAXED,__HIP_MEMORY_SCOPE_AGENT);
      if(__all(ok!=0u))break; __builtin_amdgcn_s_sleep(8); if(++sp>(1u<<17))break; }
    asm volatile("s_waitcnt vmcnt(0)":::"memory");
  }
  CBAR_LDS();
}
__device__ __forceinline__ void scan_wait_poll(const unsigned*rdy,int bh,int m0,int cnt){
  const int l_=threadIdx.x&63; unsigned sp=0u;
  __builtin_amdgcn_fence(__ATOMIC_ACQUIRE,"agent");
  for(;;){ unsigned ok=1u; if(l_<cnt)ok=__hip_atomic_load(rdy+bh*128+m0+l_,__ATOMIC_RELAXED,__HIP_MEMORY_SCOPE_AGENT);
    if(__all(ok!=0u))break; __builtin_amdgcn_s_sleep(8); if(++sp>(1u<<17))break; }
  asm volatile("s_waitcnt vmcnt(0)":::"memory");
}
#define DN_M(a,b,c) ((DBG&1)?(c):DN_MFMA32(a,b,c))
constexpr int SC_RING=2*REC_U, SC_STG=SC_RING, STG_LD=80, STG_BYTES=4*64*STG_LD, SC_SSQ=SC_STG+2*STG_BYTES, SC_TCH=SC_SSQ+2*4*64*4, SC_END=SC_TCH+512;
static_assert(SC_END<=160*1024-1024,"scan LDS");
#define DN_WAITS(n) do{ if((n)+1==8)scan_wait_batch(rdy,bh,8,8); else if((((n)+1)&15)==0&&(n)+1<128)scan_wait_batch(rdy,bh,(n)+1,16); }while(0)
template<int DBG> __device__ __forceinline__ void scan_head(int bh,const unsigned char*REC,const float*GLB,const float*dnw,const bf16_t*ZD,bf16_t*Y,const unsigned*rdy,char*shm,int flags){
  const int tid=threadIdx.x; int lane=tid&63; asm volatile("":"+v"(lane));
  const int wid=__builtin_amdgcn_readfirstlane(tid>>6);
  const int b=bh>>2,h=bh&3;
  const unsigned lds0=(unsigned)(uintptr_t)shm;
  const LAS unsigned char*ldsb=(const LAS unsigned char*)shm;
  const unsigned char*recb=REC+(size_t)bh*128*REC_BYTES;
  const size_t tokb=(size_t)b*SEQ;
  scan_wait_batch(rdy,bh,0,8);
  if(wid>=4&&wid<6){
    const int lw=wid-4;
    #define DN_PAIR "global_load_lds_dwordx4 %[vo], %[sb]\n\tglobal_load_lds_dwordx4 %[vo], %[sb] offset:2048\n\t"
    #define DN_BUMP "s_add_u32 m0, m0, 0x1000\n\tv_add_u32 %[vo], 0x1000, %[vo]\n\ts_nop 0\n\t"
    #define DN_FILL(nn,bufoff) do{ const unsigned char*b_=recb+(size_t)(nn)*REC_BYTES; unsigned keep_, vo_=(unsigned)(lane*16+lw*1024); \
      const unsigned long long sb_=((unsigned long long)(unsigned)__builtin_amdgcn_readfirstlane((int)((unsigned long long)b_>>32))<<32)|(unsigned)__builtin_amdgcn_readfirstlane((int)(unsigned)(unsigned long long)b_); \
      const unsigned dst_=(unsigned)__builtin_amdgcn_readfirstlane((int)(lds0+(bufoff)+lw*1024)); \
      asm volatile("s_mov_b32 %[keep], m0\n\ts_mov_b32 m0, %[dst]\n\ts_nop 0\n\t" \
        DN_PAIR DN_BUMP DN_PAIR DN_BUMP DN_PAIR DN_BUMP DN_PAIR DN_BUMP DN_PAIR DN_BUMP DN_PAIR DN_BUMP DN_PAIR DN_BUMP \
        DN_PAIR DN_BUMP DN_PAIR DN_BUMP DN_PAIR DN_BUMP DN_PAIR DN_BUMP DN_PAIR DN_BUMP DN_PAIR DN_BUMP DN_PAIR \
        "s_mov_b32 m0, %[keep]" : [keep]"=&s"(keep_), [vo]"+v"(vo_) : [dst]"s"(dst_), [sb]"s"(sb_) : "memory"); }while(0)
    if(!(flags&4)){ DN_FILL(0,0); }
    DN_BAR();
    for(int n=0;n<=128;++n){
      if(n<128){
        if(n+1<128&&!(flags&4)){ DN_FILL(n+1,((n+1)&1)*REC_U); }
        if(lw==0){ if(n+3==8)scan_wait_poll(rdy,bh,8,8); else if(((n+3)&15)==0&&n+3<128)scan_wait_poll(rdy,bh,n+3,16); }
      }
      DN_BAR();
    }
    #undef DN_FILL
    #undef DN_PAIR
    #undef DN_BUMP
  } else if(wid>=6){
    const int ow=wid-6;
    const int rrow=lane>>3,ch8=lane&7,cb=ch8>>2,rch=ch8&3;
    const bf16_t*zdp=ZD+(tokb+rrow)*AW+h*128+64*ow+8*ch8; bf16_t*yp=Y+(tokb+rrow)*DM+512+h*128+64*ow+8*ch8;
    const f32x4 w0=*(const f32x4*)(dnw+64*ow+8*ch8),w1=*(const f32x4*)(dnw+64*ow+8*ch8+4);
    u32x4 zs0[8],zs1[8],zs2[8];
    #define DN_ZLOAD(ZS,m) do{ _Pragma("unroll") for(int q=0;q<8;++q) ZS[q]=*(const u32x4*)(zdp+(size_t)((m)*CH+8*q)*AW); }while(0)
    DN_ZLOAD(zs0,0); DN_ZLOAD(zs1,1);
    asm volatile("s_waitcnt lgkmcnt(0)\n\ts_barrier":::"memory");
    #define DN_OUT_ITER(n,ZL,ZU) do{ \
      if((n)+1<128&&!(DBG&2)&&!(DBG&32)){ DN_ZLOAD(ZL,(n)+1); } \
      if((n)>0&&!(DBG&2)){ \
        const LAS float*sq=(const LAS float*)(ldsb+SC_SSQ)+(((n)-1)&1)*256; \
        const LAS unsigned char*stg=ldsb+SC_STG+(((n)-1)&1)*STG_BYTES+(2*ow+cb)*64*STG_LD+rch*16; \
        _Pragma("unroll") for(int it=0;it<8;++it){ \
          const int pos=8*it+rrow; \
          const float tot=(sq[pos]+sq[64+pos])+(sq[128+pos]+sq[192+pos]); \
          const float rs=__builtin_amdgcn_rsqf(tot*(1.0f/128.0f)+EPS); \
          const u32x4 v=*(const LAS u32x4*)(stg+pos*STG_LD); const u32x4 z=ZU[it]; u32x4 w; \
          w[0]=cvtpk(bflo(v[0])*rs*w0[0]*bflo(z[0]),bfhi(v[0])*rs*w0[1]*bfhi(z[0])); w[1]=cvtpk(bflo(v[1])*rs*w0[2]*bflo(z[1]),bfhi(v[1])*rs*w0[3]*bfhi(z[1])); \
          w[2]=cvtpk(bflo(v[2])*rs*w1[0]*bflo(z[2]),bfhi(v[2])*rs*w1[1]*bfhi(z[2])); w[3]=cvtpk(bflo(v[3])*rs*w1[2]*bflo(z[3]),bfhi(v[3])*rs*w1[3]*bfhi(z[3])); \
          if(!(DBG&16)||w[0]==0x12345678u)gst16(yp+(size_t)(((n)-1)*CH+8*it)*DM,w); \
        } } \
      asm volatile("s_waitcnt lgkmcnt(0)\n\ts_barrier":::"memory"); }while(0)
    for(int n=0;n<129;n+=3){ DN_OUT_ITER(n,zs1,zs2); DN_OUT_ITER(n+1,zs2,zs0); DN_OUT_ITER(n+2,zs0,zs1); }
    #undef DN_OUT_ITER
    #undef DN_ZLOAD
  } else if(flags&8){
    asm volatile("s_waitcnt lgkmcnt(0)\n\ts_barrier":::"memory");
    for(int n=0;n<128;++n){ asm volatile("s_waitcnt lgkmcnt(0)\n\ts_barrier":::"memory"); }
    asm volatile("s_waitcnt lgkmcnt(0)\n\ts_barrier":::"memory");
  } else {
    const int c4=wid,r32=lane&31,hi=lane>>5;
    __builtin_amdgcn_s_setprio(3);
    f32x16 S[4];
    #pragma unroll
    for(int t=0;t<4;++t)S[t]=f32x16{};
    const unsigned char*up=recb+REC_U+(size_t)(c4*4)*1024+lane*16;
    u32x4 un[4],un2[4];
    #pragma unroll
    for(int q=0;q<4;++q) un[q]=*(const u32x4*)(up+q*1024);
    #pragma unroll
    for(int q=0;q<4;++q) un2[q]=*(const u32x4*)(up+REC_BYTES+q*1024);
    float gl_next=__hip_atomic_load(GLB+bh*128,__ATOMIC_RELAXED,__HIP_MEMORY_SCOPE_AGENT);
    float gl_next2=__hip_atomic_load(GLB+bh*128+1,__ATOMIC_RELAXED,__HIP_MEMORY_SCOPE_AGENT);
    asm volatile("s_waitcnt lgkmcnt(0)\n\ts_barrier":::"memory");
    for(int n=0;n<128;++n){
      const LAS unsigned char*rb=ldsb+(n&1)*REC_U+lane*16;
      const float gl=gl_next; gl_next=gl_next2; gl_next2=__hip_atomic_load(GLB+bh*128+((n+2)&127),__ATOMIC_RELAXED,__HIP_MEMORY_SCOPE_AGENT);
      f32x16 av[2],ao[2];
      #pragma unroll
      for(int i2=0;i2<2;++i2)
        #pragma unroll
        for(int rh=0;rh<2;++rh){ const u32x4 u=un[i2*2+rh];
          #pragma unroll
          for(int q=0;q<4;++q){ av[i2][8*rh+2*q]=bflo(u[q]); av[i2][8*rh+2*q+1]=bfhi(u[q]); } }
      { const unsigned char*upn=up+(size_t)((n+2)&127)*REC_BYTES;
        #pragma unroll
        for(int q=0;q<4;++q){ un[q]=un2[q]; un2[q]=*(const u32x4*)(upn+q*1024); } }
      ao[0]=f32x16{}; ao[1]=f32x16{};
      #define FR(off) (*(const LAS bf16x8*)(rb+(off)))
      #define SB0() __builtin_amdgcn_sched_barrier(0)
      bf16x8 fa[4],fb[4],fc[4],Sb[8];
      #pragma unroll
      for(int ks=0;ks<8;++ks)Sb[ks]=pack8(S[ks>>1],ks&1);
      #define LDN(B,k0) do{ B[0]=FR(REC_NW+(k0)*1024); B[1]=FR(REC_NW+(8+(k0))*1024); B[2]=FR(REC_NW+((k0)+1)*1024); B[3]=FR(REC_NW+(9+(k0))*1024); }while(0)
      #define MMN(B,k0) do{ av[0]=DN_M(B[0],Sb[k0],av[0]); av[1]=DN_M(B[1],Sb[k0],av[1]); av[0]=DN_M(B[2],Sb[(k0)+1],av[0]); av[1]=DN_M(B[3],Sb[(k0)+1],av[1]); }while(0)
      #define LDQ(B,k0) do{ B[0]=FR(REC_QD+(k0)*1024); B[1]=FR(REC_QD+(8+(k0))*1024); B[2]=FR(REC_QD+((k0)+1)*1024); B[3]=FR(REC_QD+(9+(k0))*1024); }while(0)
      #define MMQ(B,k0) do{ ao[0]=DN_M(Sb[k0],B[0],ao[0]); ao[1]=DN_M(Sb[k0],B[1],ao[1]); ao[0]=DN_M(Sb[(k0)+1],B[2],ao[0]); ao[1]=DN_M(Sb[(k0)+1],B[3],ao[1]); }while(0)
      LDN(fa,0); LDN(fb,2); SB0();
      LDN(fc,4); SB0(); MMN(fa,0); SB0();
      LDN(fa,6); SB0(); MMN(fb,2); SB0();
      LDQ(fb,0); SB0(); MMN(fc,4); SB0();
      LDQ(fc,2); SB0(); MMN(fa,6); SB0();
      LDQ(fa,4); SB0(); MMQ(fb,0); SB0();
      #pragma unroll
      for(int t=0;t<4;++t)S[t]=S[t]*gl;
      LDQ(fb,6); SB0(); MMQ(fc,2); SB0();
      bf16x8 vb[2][2];
      #pragma unroll
      for(int i2=0;i2<2;++i2){ vb[i2][0]=pack8(av[i2],0); vb[i2][1]=pack8(av[i2],1); }
      fc[0]=FR(REC_AI+0*1024); fc[1]=FR(REC_AI+1*1024); fc[2]=FR(REC_AI+4*1024); fc[3]=FR(REC_AI+5*1024); SB0();
      MMQ(fa,4); SB0();
      fa[0]=FR(REC_AI+6*1024); fa[1]=FR(REC_AI+7*1024); fa[2]=FR(REC_KT+0*1024); fa[3]=FR(REC_KT+1*1024); SB0();
      MMQ(fb,6); SB0();
      fb[0]=FR(REC_KT+2*1024); fb[1]=FR(REC_KT+3*1024); fb[2]=FR(REC_KT+4*1024); fb[3]=FR(REC_KT+5*1024); SB0();
      ao[0]=DN_M(vb[0][0],fc[0],ao[0]); ao[0]=DN_M(vb[0][1],fc[1],ao[0]); ao[1]=DN_M(vb[0][0],fc[2],ao[1]); ao[1]=DN_M(vb[0][1],fc[3],ao[1]); SB0();
      fc[0]=FR(REC_KT+6*1024); fc[1]=FR(REC_KT+7*1024); fc[2]=FR(REC_KT+8*1024); fc[3]=FR(REC_KT+9*1024); SB0();
      ao[1]=DN_M(vb[1][0],fa[0],ao[1]); ao[1]=DN_M(vb[1][1],fa[1],ao[1]); S[0]=DN_M(fa[2],vb[0][0],S[0]); S[0]=DN_M(fa[3],vb[0][1],S[0]); SB0();
      fa[0]=FR(REC_KT+10*1024); fa[1]=FR(REC_KT+11*1024); fa[2]=FR(REC_KT+12*1024); fa[3]=FR(REC_KT+13*1024); SB0();
      S[0]=DN_M(fb[0],vb[1][0],S[0]); S[0]=DN_M(fb[1],vb[1][1],S[0]); S[1]=DN_M(fb[2],vb[0][0],S[1]); S[1]=DN_M(fb[3],vb[0][1],S[1]); SB0();
      fb[0]=FR(REC_KT+14*1024); fb[1]=FR(REC_KT+15*1024); SB0();
      S[1]=DN_M(fc[0],vb[1][0],S[1]); S[1]=DN_M(fc[1],vb[1][1],S[1]); S[2]=DN_M(fc[2],vb[0][0],S[2]); S[2]=DN_M(fc[3],vb[0][1],S[2]); SB0();
      S[2]=DN_M(fa[0],vb[1][0],S[2]); S[2]=DN_M(fa[1],vb[1][1],S[2]); S[3]=DN_M(fa[2],vb[0][0],S[3]); S[3]=DN_M(fa[3],vb[0][1],S[3]); SB0();
      S[3]=DN_M(fb[0],vb[1][0],S[3]); S[3]=DN_M(fb[1],vb[1][1],S[3]);
      #undef FR
      #undef LDN
      #undef MMN
      #undef LDQ
      #undef MMQ
      #undef SB0
      { LAS unsigned char*stg=(LAS unsigned char*)(ldsb+SC_STG)+(n&1)*STG_BYTES+c4*64*STG_LD; LAS float*ssq=(LAS float*)(ldsb+SC_SSQ)+(n&1)*256+c4*64;
        #pragma unroll
        for(int i2=0;i2<2;++i2){ float p=0.f; const int pos=32*i2+r32;
          #pragma unroll
          for(int r=0;r<16;++r)p+=ao[i2][r]*ao[i2][r];
          p=xor32_sum(p);
          if(hi==0)ssq[pos]=p;
          #pragma unroll
          for(int rq=0;rq<4;++rq) *(LAS u32x2v*)(stg+pos*STG_LD+(8*rq+4*hi)*2)=(u32x2v){cvtpk(ao[i2][4*rq],ao[i2][4*rq+1]),cvtpk(ao[i2][4*rq+2],ao[i2][4*rq+3])}; } }
      asm volatile("s_waitcnt lgkmcnt(0)\n\ts_barrier":::"memory");
    }
    __builtin_amdgcn_s_setprio(0);
    asm volatile("s_waitcnt lgkmcnt(0)\n\ts_barrier":::"memory");
  }
}
#undef DN_MFMA32
#undef DN_MFMA4
#undef DN_BAR
}

namespace moba {
using bf16=unsigned short;
using s16x4=__attribute__((ext_vector_type(4)))short;
using f32x16=__attribute__((ext_vector_type(16)))float;
constexpr int D=64,NW=8,QBLK=32,QB=QBLK*NW,KVBLK=64,PITCH=64;
__device__ __forceinline__ int crow(int r,int hi){return (r&3)+8*(r>>2)+4*hi;}
#define SBAR() __builtin_amdgcn_sched_barrier(0)
constexpr int NSLOT=3, SLOTB=8192;
constexpr int NKT=4, LDS_K=0, LDS_V=NKT*SLOTB, LDS_WS=2*NKT*SLOTB, WSW=1024, LDS_OST=LDS_WS+NW*WSW, LDS_TB=LDS_OST+NW*4096, LDS_UNIT=LDS_TB+512, LDS_PFX=LDS_UNIT+64, LDS_BYTES=LDS_PFX+8*132*4;
struct AB { int dbg; const bf16*QA; const bf16*KA; const bf16*VA; const float*KMEAN; const float*rel_bias; const bf16*ZA; bf16*Y; unsigned*SEL; unsigned short*LIST; unsigned*CNT; bf16*OP; float*LP; unsigned*qctl; };
constexpr int LISTCAP=8192, PREVCAP=256;
constexpr float NEGBIG=-1.0e30f;
__device__ __forceinline__ void glds16(const void*gsrc,unsigned lds_dst){unsigned keep;
  asm volatile("s_mov_b32 %0, m0\n\ts_mov_b32 m0, %2\n\ts_nop 0\n\tglobal_load_lds_dwordx4 %1, off\n\ts_mov_b32 m0, %0":"=&s"(keep):"v"(gsrc),"s"(lds_dst):"memory");}
typedef float f32x2_t __attribute__((ext_vector_type(2))); typedef __bf16 bf16x2_t __attribute__((ext_vector_type(2)));
__device__ __forceinline__ unsigned cvtpk_s(float lo,float hi){f32x2_t v={lo,hi};bf16x2_t b=__builtin_convertvector(v,bf16x2_t);return __builtin_bit_cast(unsigned,b);}
#define WAIT_BAR(N) asm volatile("s_waitcnt vmcnt(" #N ") lgkmcnt(0)\n\ts_barrier":::"memory")
__device__ __forceinline__ void qkt(f32x16&p0,f32x16&p1,const char*Kslot,const bf16x8*qr,int r32,int hi){
  const f32x16 negm=f32x16{};
  const char*kb=Kslot+hi*1024+r32*16;
  #pragma unroll
  for(int d0=0;d0<4;++d0){
    const bf16x8 b0=*reinterpret_cast<const bf16x8*>(kb+d0*2048);
    const bf16x8 b1=*reinterpret_cast<const bf16x8*>(kb+d0*2048+512);
    if(d0==0){p0=__builtin_amdgcn_mfma_f32_32x32x16_bf16(b0,qr[0],negm,0,0,0);p1=__builtin_amdgcn_mfma_f32_32x32x16_bf16(b1,qr[0],negm,0,0,0);}
    else{p0=__builtin_amdgcn_mfma_f32_32x32x16_bf16(b0,qr[d0],p0,0,0,0);p1=__builtin_amdgcn_mfma_f32_32x32x16_bf16(b1,qr[d0],p1,0,0,0);}}
}
typedef __attribute__((address_space(3))) const char* lds_cptr;
typedef short v4i16_t __attribute__((ext_vector_type(4)));
__device__ __forceinline__ void kload8(bf16x8*kf,lds_cptr kp){
  kf[0]=*(const __attribute__((address_space(3))) bf16x8*)(kp);      kf[1]=*(const __attribute__((address_space(3))) bf16x8*)(kp+512);
  kf[2]=*(const __attribute__((address_space(3))) bf16x8*)(kp+2048); kf[3]=*(const __attribute__((address_space(3))) bf16x8*)(kp+2560);
  kf[4]=*(const __attribute__((address_space(3))) bf16x8*)(kp+4096); kf[5]=*(const __attribute__((address_space(3))) bf16x8*)(kp+4608);
  kf[6]=*(const __attribute__((address_space(3))) bf16x8*)(kp+6144); kf[7]=*(const __attribute__((address_space(3))) bf16x8*)(kp+6656);
}
__device__ __forceinline__ void kload2(bf16x8*kf,lds_cptr kp,int j){ kf[2*j]=*(const __attribute__((address_space(3))) bf16x8*)(kp+j*2048); kf[2*j+1]=*(const __attribute__((address_space(3))) bf16x8*)(kp+j*2048+512); }
__device__ __forceinline__ s16x4 vtr(lds_cptr p){ return __builtin_bit_cast(s16x4,__builtin_amdgcn_ds_read_tr16_b64_v4i16((__attribute__((address_space(3))) v4i16_t*)p)); }
__device__ __forceinline__ void pv(f32x16*o,int vb,bf16x8 pa0,bf16x8 pa1,bf16x8 pa2,bf16x8 pa3){
  #pragma unroll
  for(int d0=0;d0<2;++d0){s16x4 lo[4],hi[4];
    #pragma unroll
    for(int ks=0;ks<4;++ks){
      asm volatile("ds_read_b64_tr_b16 %0,%1 offset:%c2":"=&v"(lo[ks]):"v"(vb),"i"(d0*4096+ks*1024):"memory");
      asm volatile("ds_read_b64_tr_b16 %0,%1 offset:%c2":"=&v"(hi[ks]):"v"(vb),"i"(d0*4096+ks*1024+512):"memory");}
    asm volatile("s_waitcnt lgkmcnt(0)":::"memory");SBAR();
    #define PK(k) (bf16x8){lo[k][0],lo[k][1],lo[k][2],lo[k][3],hi[k][0],hi[k][1],hi[k][2],hi[k][3]}
    o[d0]=__builtin_amdgcn_mfma_f32_32x32x16_bf16(pa0,PK(0),o[d0],0,0,0);
    o[d0]=__builtin_amdgcn_mfma_f32_32x32x16_bf16(pa1,PK(1),o[d0],0,0,0);
    o[d0]=__builtin_amdgcn_mfma_f32_32x32x16_bf16(pa2,PK(2),o[d0],0,0,0);
    o[d0]=__builtin_amdgcn_mfma_f32_32x32x16_bf16(pa3,PK(3),o[d0],0,0,0);
    #undef PK
  }
}
__device__ __forceinline__ void bandfix(f32x16&p0,f32x16&p1,int t,int qpos,int hi,const float*tb){
  const int kb=64*t+4*hi;
  #pragma unroll
  for(int r=0;r<16;++r){ const int kv=kb+(r&3)+8*(r>>2); const int d0=qpos-kv, d1=d0-32;
    const float b0=tb[d0<0?0:(d0>127?127:d0)], b1=tb[d1<0?0:(d1>127?127:d1)];
    p0[r]=d0<0?NEGBIG:p0[r]+b0; p1[r]=d1<0?NEGBIG:p1[r]+b1; if((r&3)==3)SBAR(); }
}


__device__ __forceinline__ unsigned gate_select(const float*KMEAN,int bh,int qb,const bf16x8*qr,int r32,int hi){
  f32x16 gt=f32x16{};
  const float*km=KMEAN+((size_t)bh*32+r32)*64+hi*8;
  #pragma unroll
  for(int d0=0;d0<4;++d0){ const f32x4 ka=*(const f32x4*)(km+d0*16), kb_=*(const f32x4*)(km+d0*16+4);
    u32x4 w; w.x=cvtpk_s(ka[0],ka[1]); w.y=cvtpk_s(ka[2],ka[3]); w.z=cvtpk_s(kb_[0],kb_[1]); w.w=cvtpk_s(kb_[2],kb_[3]);
    gt=__builtin_amdgcn_mfma_f32_32x32x16_bf16(__builtin_bit_cast(bf16x8,w),qr[d0],gt,0,0,0); }
  float a1=-INFINITY,a2=-INFINITY,a3=-INFINITY;
  const int qbh=qb-4*hi;
  #pragma unroll
  for(int r=0;r<16;++r){ float x=gt[r]; if(crow(r,0)>=qbh)x=-INFINITY; gt[r]=x;
    const float t_=fminf(a1,x); a1=fmaxf(a1,x); const float u_=fminf(a2,t_); a2=fmaxf(a2,t_); a3=fmaxf(a3,u_); }
  const float b1=xor32_get(a1,hi==0),b2=xor32_get(a2,hi==0),b3=xor32_get(a3,hi==0);
  const float th=fmaxf(fmaxf(a3,b3),fmaxf(fminf(a2,b1),fminf(a1,b2)));
  unsigned m_=0u;
  #pragma unroll
  for(int r=0;r<16;++r){ if(gt[r]>=th&&gt[r]>-INFINITY)m_|=1u<<crow(r,0); }
  m_<<=4*hi;
  return xor32_or(m_);
}
struct RouteSt { unsigned rb, mymask, base; int s; };
__device__ __forceinline__ unsigned route_gate(int bh,int qb,const AB&A){
  const int tid=threadIdx.x; int lane=tid&63; asm volatile("":"+v"(lane));
  const int r32=lane&31,hi=lane>>5; const int wid=__builtin_amdgcn_readfirstlane(tid>>6);
  const int s=qb*QB+wid*QBLK+r32;
  const bf16*Qw=A.QA+((size_t)bh*SEQ+s)*PITCH;
  bf16x8 qr[4];
  #pragma unroll
  for(int d0=0;d0<4;++d0)qr[d0]=*reinterpret_cast<const bf16x8*>(&Qw[d0*16+hi*8]);
  const unsigned selmask=gate_select(A.KMEAN,bh,qb,qr,r32,hi);
  if(hi==0)__hip_atomic_store(A.SEL+(size_t)bh*SEQ+s,selmask,__ATOMIC_RELAXED,__HIP_MEMORY_SCOPE_AGENT);
  return selmask;
}
__device__ __forceinline__ void route_count(int bh,int qb,unsigned selmask,const AB&A,RouteSt&st){
  const int tid=threadIdx.x; int lane=tid&63; asm volatile("":"+v"(lane));
  const int r32=lane&31,hi=lane>>5; const int wid=__builtin_amdgcn_readfirstlane(tid>>6);
  st.s=qb*QB+wid*QBLK+r32;
  st.rb=(qb>=1&&hi==0)?(selmask&((1u<<qb)-1u)):0u;
  st.mymask=0u; st.base=0u;
  if(qb>=1){
    unsigned mymask=0u;
    for(int j=0;j<qb;++j){ const unsigned bal=(unsigned)__ballot((st.rb>>j)&1u); if(lane==j)mymask=bal; }
    st.mymask=mymask;
    if(mymask)st.base=__hip_atomic_fetch_add(A.CNT+((lane==qb-1)?1024:0)+bh*32+lane,(unsigned)__popc(mymask),__ATOMIC_RELAXED,__HIP_MEMORY_SCOPE_AGENT);
  }
}
__device__ __forceinline__ void route_append(int bh,int qb,const AB&A,const RouteSt&st){
  const int lane=threadIdx.x&63; const int r32=lane&31;
  if(qb>=1){
    unsigned rbt=st.rb;
    #pragma unroll
    for(int k=0;k<3;++k){
      const int jj=rbt?(__ffs((int)rbt)-1):0; const bool act=rbt!=0u; rbt&=rbt-1u;
      const unsigned mj=(unsigned)__shfl((int)st.mymask,jj), bj=(unsigned)__shfl((int)st.base,jj);
      if(act){ const unsigned pos=bj+(unsigned)__popc(mj&((1u<<r32)-1u)); const bool prev=(jj==qb-1);
        if(pos<(unsigned)(prev?PREVCAP:LISTCAP-PREVCAP)){ unsigned short*dst_=A.LIST+((size_t)bh*32+jj)*LISTCAP+(prev?LISTCAP-PREVCAP:0)+pos; const unsigned val_=(unsigned)(st.s|(k<<13));
          asm volatile("global_store_short %0, %1, off sc1"::"v"(dst_),"v"(val_):"memory"); } }
    }
  }
}
template<int KIND> __device__ __forceinline__ void attn_group(int bh,int j,unsigned gi,unsigned cnt,unsigned entry,const bf16x8(&qr)[4],const AB&A,char*shm){
  const int tid=threadIdx.x; int lane=tid&63; asm volatile("":"+v"(lane));
  const int r32=lane&31,hi=lane>>5; const int wid=__builtin_amdgcn_readfirstlane(tid>>6);
  const int b=bh>>3,h=bh&7;
  const unsigned lds0=(unsigned)(uintptr_t)shm;
  const float*tb=(const float*)(shm+LDS_TB);
  const int srow=(KIND<2)?(int)(entry&8191u):(256*j+32*(int)gi+r32);
  const int vb0=(int)(lds0+LDS_V)+((lane>>4)&1)*32+(lane&3)*8+(4*hi+((lane&15)>>2))*64;
  const char*Kbase=shm+LDS_K; bf16x8 kf[8];
  const lds_cptr shm3=(lds_cptr)shm; const lds_cptr kp0=shm3+LDS_K+hi*1024+r32*16; const lds_cptr vp0=shm3+LDS_V+((lane>>4)&1)*32+(lane&3)*8+(4*hi+((lane&15)>>2))*64;
  constexpr int NT=4;
  float l_reg=0.f;f32x16 o[2];o[0]=f32x16{};o[1]=f32x16{};
  const int qpos=srow;
  #define BANDFIX(P0,P1,t) do{ if(KIND==2||(KIND==1&&(t)>=2)){ bandfix(P0,P1,4*j+(t),qpos,hi,tb); } }while(0)
  f32x16 pA0,pA1,pB0,pB1;
  qkt(pA0,pA1,Kbase,qr,r32,hi);asm volatile("s_nop 15\n\ts_nop 7":"+v"(pA0),"+v"(pA1));BANDFIX(pA0,pA1,0);
  _Pragma("unroll") for(int r=0;r<16;++r)pA0[r]=__builtin_amdgcn_exp2f(pA0[r]);
  _Pragma("unroll") for(int r=0;r<16;++r)pA1[r]=__builtin_amdgcn_exp2f(pA1[r]);
  kload8(kf,kp0+SLOTB);
  s16x4 vlo[8],vhi[8]; u32x4 pw0,pw1,pw2,pw3;
  #define PKW(P,B) cvtpk_s(P[B],P[B+1])
  #define PAF(k) __builtin_bit_cast(bf16x8,pw##k)
  #define VFR(i) (bf16x8){vlo[i][0],vlo[i][1],vlo[i][2],vlo[i][3],vhi[i][0],vhi[i][1],vhi[i][2],vhi[i][3]}
  #define PIN(x) asm volatile("":"+v"(x))
  #define GAPA(MF,A0,A1,A2,A3,W0,W1,PW) do{ MF; sacc+=A0; sacc+=A1; sacc+=A2; sacc+=A3; PIN(sacc); W0; W1; PIN(PW); SBAR(); }while(0)
  #define EX(v) __builtin_amdgcn_exp2f(v)
  #define GAPB(MF,X,B) do{ MF; X[B]=EX(X[B]); X[B+1]=EX(X[B+1]); X[B+2]=EX(X[B+2]); X[B+3]=EX(X[B+3]); PIN(X); SBAR(); }while(0)
  #define VRD(i) do{ vlo[i]=vtr(vp_+(((i)>>2)*4096+((i)&3)*1024)); vhi[i]=vtr(vp_+(((i)>>2)*4096+((i)&3)*1024+512)); }while(0)
  #define KRD(G,jj) do{ if(G){ kload2(kf,kp0+((t_)+1)*SLOTB,jj); SBAR(); } }while(0)
  #define STEP(C0,C1,P0,P1,t,GL) do{ SBAR(); constexpr int t_=(t); \
    const lds_cptr vp_=vp0+(t_-1)*SLOTB; const f32x16 zc_=f32x16{}; \
    VRD(0); SBAR(); float sacc=(P0[0]+P0[1]); \
    GAPA(C0=__builtin_amdgcn_mfma_f32_32x32x16_bf16(kf[0],qr[0],zc_,0,0,0), P0[2],P0[3],P0[4],P0[5],     pw0[0]=PKW(P0,0), pw0[1]=PKW(P0,2), pw0); \
    VRD(4); SBAR(); GAPA(C1=__builtin_amdgcn_mfma_f32_32x32x16_bf16(kf[1],qr[0],zc_,0,0,0), P0[6],P0[7],P0[8],P0[9],     pw0[2]=PKW(P0,4), pw0[3]=PKW(P0,6), pw0); \
    VRD(1); SBAR(); GAPA(C0=__builtin_amdgcn_mfma_f32_32x32x16_bf16(kf[2],qr[1],C0,0,0,0),   P0[10],P0[11],P0[12],P0[13], pw1[0]=PKW(P0,8), pw1[1]=PKW(P0,10), pw1); \
    VRD(5); SBAR(); GAPA(C1=__builtin_amdgcn_mfma_f32_32x32x16_bf16(kf[3],qr[1],C1,0,0,0),   P0[14],P0[15],P1[0],P1[1],   pw1[2]=PKW(P0,12),pw1[3]=PKW(P0,14), pw1); \
    VRD(2); SBAR(); GAPA(C0=__builtin_amdgcn_mfma_f32_32x32x16_bf16(kf[4],qr[2],C0,0,0,0),   P1[2],P1[3],P1[4],P1[5],     pw2[0]=PKW(P1,0), pw2[1]=PKW(P1,2), pw2); \
    VRD(6); SBAR(); GAPA(C1=__builtin_amdgcn_mfma_f32_32x32x16_bf16(kf[5],qr[2],C1,0,0,0),   P1[6],P1[7],P1[8],P1[9],     pw2[2]=PKW(P1,4), pw2[3]=PKW(P1,6), pw2); \
    VRD(3); SBAR(); GAPA(C0=__builtin_amdgcn_mfma_f32_32x32x16_bf16(kf[6],qr[3],C0,0,0,0),   P1[10],P1[11],P1[12],P1[13], pw3[0]=PKW(P1,8), pw3[1]=PKW(P1,10), pw3); \
    VRD(7); SBAR(); GAPA(C1=__builtin_amdgcn_mfma_f32_32x32x16_bf16(kf[7],qr[3],C1,0,0,0),   P1[14],P1[15],0.f,0.f,       pw3[2]=PKW(P1,12),pw3[3]=PKW(P1,14), pw3); \
    l_reg+=sacc; \
    BANDFIX(C0,C1,t_); \
    SBAR(); \
    GAPB(o[0]=__builtin_amdgcn_mfma_f32_32x32x16_bf16(PAF(0),VFR(0),o[0],0,0,0), C0,0); \
    GAPB(o[1]=__builtin_amdgcn_mfma_f32_32x32x16_bf16(PAF(0),VFR(4),o[1],0,0,0), C0,4); \
    KRD(GL,0); GAPB(o[0]=__builtin_amdgcn_mfma_f32_32x32x16_bf16(PAF(1),VFR(1),o[0],0,0,0), C0,8); \
    KRD(GL,1); GAPB(o[1]=__builtin_amdgcn_mfma_f32_32x32x16_bf16(PAF(1),VFR(5),o[1],0,0,0), C0,12); \
    KRD(GL,2); GAPB(o[0]=__builtin_amdgcn_mfma_f32_32x32x16_bf16(PAF(2),VFR(2),o[0],0,0,0), C1,0); \
    KRD(GL,3); GAPB(o[1]=__builtin_amdgcn_mfma_f32_32x32x16_bf16(PAF(2),VFR(6),o[1],0,0,0), C1,4); \
    GAPB(o[0]=__builtin_amdgcn_mfma_f32_32x32x16_bf16(PAF(3),VFR(3),o[0],0,0,0), C1,8); \
    GAPB(o[1]=__builtin_amdgcn_mfma_f32_32x32x16_bf16(PAF(3),VFR(7),o[1],0,0,0), C1,12); \
    }while(0)
  STEP(pB0,pB1,pA0,pA1,1,true);
  STEP(pA0,pA1,pB0,pB1,2,true);
  STEP(pB0,pB1,pA0,pA1,3,false);
  { float sacc=pB0[0]+pB0[1]; _Pragma("unroll") for(int r=2;r<16;++r)sacc+=pB0[r]; _Pragma("unroll") for(int r=0;r<16;++r)sacc+=pB1[r]; l_reg+=sacc;
    pw0=(u32x4){PKW(pB0,0),PKW(pB0,2),PKW(pB0,4),PKW(pB0,6)};pw1=(u32x4){PKW(pB0,8),PKW(pB0,10),PKW(pB0,12),PKW(pB0,14)};pw2=(u32x4){PKW(pB1,0),PKW(pB1,2),PKW(pB1,4),PKW(pB1,6)};pw3=(u32x4){PKW(pB1,8),PKW(pB1,10),PKW(pB1,12),PKW(pB1,14)};
    SBAR(); pv(o,vb0+(NT-1)*SLOTB,PAF(0),PAF(1),PAF(2),PAF(3)); }
  #undef PKW
  #undef PAF
  #undef VFR
  #undef PIN
  #undef GAPA
  #undef GAPB
  #undef EX
  #undef VRD
  #undef KRD
  #undef STEP
  #undef BANDFIX
  l_reg=xor32_sum(l_reg);
  int lane2=threadIdx.x&63; asm volatile("":"+v"(lane2));
  const int r32e=lane2&31,hie=lane2>>5;
  u32x4 pkA[4][3], zA[4];
  if(KIND==2){
    #pragma unroll
    for(int i=0;i<4;++i){ const int row=i*8+(lane2>>3),ch=lane2&7; const size_t rowg=(size_t)bh*SEQ+256*j+32*gi+row, tok=(size_t)b*SEQ+256*j+32*gi+row;
      const bf16*op=A.OP+(rowg*3)*64+ch*8;
      #pragma unroll
      for(int k=0;k<3;++k) pkA[i][k]=*(const u32x4*)(op+k*64);
      zA[i]=*(const u32x4*)(A.ZA+tok*512+h*64+ch*8); }
  }
  float*wsr=(float*)(shm+LDS_WS)+wid*(WSW/4);
  if(KIND<2){
    if(hie==0){ wsr[r32e*8]=__builtin_amdgcn_rcpf(l_reg); wsr[r32e*8+1]=l_reg; ((unsigned*)wsr)[r32e*8+2]=entry; }
  } else {
    if(hie==0){
      const unsigned selmask=A.SEL[(size_t)bh*SEQ+srow];
      const unsigned rbits=(j>=1)?(selmask&((1u<<j)-1u)):0u; const int nr=__popc(rbits);
      const float*lp=A.LP+((size_t)bh*SEQ+srow)*3; float lk[3]; float lt=l_reg;
      #pragma unroll
      for(int k=0;k<3;++k){ const float t_=lp[k]; lk[k]=(k<nr)?t_:0.f; lt+=lk[k]; }
      const float inv=1.0f/lt;
      wsr[r32e*8]=inv; wsr[r32e*8+1]=lk[0]*inv; wsr[r32e*8+2]=lk[1]*inv; wsr[r32e*8+3]=lk[2]*inv; ((int*)wsr)[r32e*8+4]=nr;
    }
  }
  asm volatile("s_waitcnt lgkmcnt(0)":::"memory");
  float rli[16];
  #pragma unroll
  for(int r=0;r<16;++r)rli[r]=wsr[(crow(r,0)+4*hie)*8];
  { bf16*stg=(bf16*)(shm+LDS_OST)+wid*2048;
    bf16*stgw=stg+(4*hie)*64+r32e;
    #pragma unroll
    for(int r=0;r<16;++r){
      #pragma unroll
      for(int d0=0;d0<2;++d0)stgw[crow(r,0)*64+d0*32]=f2bf(o[d0][r]*rli[r]);}
    asm volatile("s_waitcnt lgkmcnt(0)":::"memory");
    #pragma unroll
    for(int i=0;i<4;++i){const int row=i*8+(lane2>>3),ch=lane2&7; const u32x4 v=*(const u32x4*)(stg+row*64+ch*8);
      if(KIND<2){
        const unsigned e_=((const unsigned*)wsr)[row*8+2]; const unsigned idx=32u*gi+row;
        if(idx<cnt){ const size_t slot=((size_t)bh*SEQ+(e_&8191u))*3+(e_>>13);
          bf16*dst=A.OP+slot*64+ch*8;
          asm volatile("global_store_dwordx4 %0, %1, off sc1\n\ts_nop 1"::"v"(dst),"v"(v):"memory");
          if(ch==0)__hip_atomic_store(A.LP+slot,wsr[row*8+1],__ATOMIC_RELAXED,__HIP_MEMORY_SCOPE_AGENT); }
      } else {
        const size_t rowg=(size_t)bh*SEQ+256*j+32*gi+row; const size_t tok=(size_t)b*SEQ+256*j+32*gi+row; const int nr=((const int*)wsr)[row*8+4];
        float a8[8];
        #pragma unroll
        for(int e=0;e<4;++e){ a8[2*e]=__uint_as_float(v[e]<<16); a8[2*e+1]=__uint_as_float(v[e]&0xffff0000u); }
        #pragma unroll
        for(int k=0;k<3;++k){ const float f=wsr[row*8+1+k]; const u32x4 p=(k<nr)?pkA[i][k]:(u32x4){0u,0u,0u,0u};
          #pragma unroll
          for(int e=0;e<4;++e){ a8[2*e]+=f*__uint_as_float(p[e]<<16); a8[2*e+1]+=f*__uint_as_float(p[e]&0xffff0000u); } }
        const u32x4 z=zA[i]; u32x4 w;
        #pragma unroll
        for(int e=0;e<4;++e) w[e]=cvtpk_s(a8[2*e]*__uint_as_float(z[e]<<16),a8[2*e+1]*__uint_as_float(z[e]&0xffff0000u));
        gst16(A.Y+tok*1024+h*64+ch*8,w);
      } } }
  asm volatile("s_waitcnt lgkmcnt(0)":::"memory");
}
struct Pre { unsigned valid, cf, cp, e0, e1; };
__device__ __forceinline__ unsigned load_entry(const unsigned short*lst,unsigned gi,unsigned gp,unsigned np,unsigned nf,unsigned r32){
  const unsigned ip=32u*gi+r32, iq=32u*(gi-gp)+r32;
  const unsigned idx=(gi<gp)?((unsigned)(LISTCAP-PREVCAP)+((ip<np)?ip:0u)):((iq<nf)?iq:0u);
  return lst[idx];
}
template<bool OWN> __device__ __forceinline__ void kv_unit(int bh,int j,const AB&A,char*shm,int&pend_x,unsigned pfr,const Pre&cur,Pre&nxt,unsigned&nk_out,unsigned x){
  const int tid=threadIdx.x; int lane=tid&63; asm volatile("":"+v"(lane));
  const int wid=__builtin_amdgcn_readfirstlane(tid>>6); const int h=bh&7;
  const unsigned lds0=(unsigned)(uintptr_t)shm;
  const int r32_=lane&31,hi_=lane>>5;
  #define LOADQ(dst,row) do{ const bf16*q_=A.QA+((size_t)bh*SEQ+(row))*PITCH+hi_*8; _Pragma("unroll") for(int d0=0;d0<4;++d0)(dst)[d0]=*reinterpret_cast<const bf16x8*>(q_+d0*16); }while(0)
  bf16x8 q_cur[4]; unsigned e_cur=0u,e_nxt=0u,nf=0u,np=0u,gp=0u,gt=0u;
  const unsigned short*lst=A.LIST+((size_t)bh*32+j)*LISTCAP;
  if(OWN){ LOADQ(q_cur,256*j+32*wid+r32_); }
  else {
    unsigned cf,cp;
    if(cur.valid){ cf=cur.cf; cp=cur.cp; } else { cf=A.CNT[bh*32+j]; cp=A.CNT[1024+bh*32+j]; }
    nf=cf<(unsigned)(LISTCAP-PREVCAP)?cf:(unsigned)(LISTCAP-PREVCAP); np=cp<(unsigned)PREVCAP?cp:(unsigned)PREVCAP;
    gp=(np+31u)>>5; gt=gp+((nf+31u)>>5);
    if((unsigned)wid<gt){
      if(cur.valid){ e_cur=cur.e0; e_nxt=cur.e1; }
      else { e_cur=load_entry(lst,(unsigned)wid,gp,np,nf,(unsigned)r32_); e_nxt=((unsigned)wid+NW<gt)?load_entry(lst,(unsigned)wid+NW,gp,np,nf,(unsigned)r32_):0u; }
      LOADQ(q_cur,e_cur&8191u); }
  }
  const bf16*Kh=A.KA+((size_t)bh*SEQ+(size_t)j*256)*PITCH,*Vh=A.VA+((size_t)bh*SEQ+(size_t)j*256)*PITCH;
  const bf16*ksrc=Kh+(long)lane*PITCH+wid*8;
  const bf16*vsrc=Vh+(long)(16*(wid&3)+(lane>>2))*PITCH+(wid>>2)*32+(lane&3)*8;
  const unsigned kdst=lds0+LDS_K+wid*1024, vdst=lds0+LDS_V+wid*1024;
  #pragma unroll
  for(int t=0;t<NKT;++t){ glds16(ksrc+(long)t*KVBLK*PITCH,(unsigned)__builtin_amdgcn_readfirstlane(kdst+t*SLOTB)); glds16(vsrc+(long)t*KVBLK*PITCH,(unsigned)__builtin_amdgcn_readfirstlane(vdst+t*SLOTB)); }
  float*tb=(float*)(shm+LDS_TB);
  if(tid<128) tb[tid]=(A.rel_bias[t5_bucket_dev(tid)*8+h]-A.rel_bias[31*8+h])*1.4426950408889634f;
  volatile unsigned*uw=(volatile unsigned*)(shm+LDS_UNIT);
  if(tid==0)uw[1]=pfr;
  CBAR_ALL();
  if(pend_x>=0){ if(tid==0)__hip_atomic_fetch_add(A.qctl+512+64*pend_x,1u,__ATOMIC_RELAXED,__HIP_MEMORY_SCOPE_AGENT); pend_x=-1; CBAR_LDS(); }
  const unsigned nk=(unsigned)__builtin_amdgcn_readfirstlane((int)uw[1]); nk_out=nk;
  const bool nlist=nk<124u; const int nbh=(int)x+8*(int)(nk&3u), nj=(int)(nk>>2);
  unsigned ncf=0u,ncp=0u;
  if(nlist){ ncf=A.CNT[nbh*32+nj]; ncp=A.CNT[1024+nbh*32+nj]; }
  #define PREFETCH_NEXT() do{ nxt.valid=0u; nxt.cf=ncf; nxt.cp=ncp; nxt.e0=0u; nxt.e1=0u; \
    if(nlist){ const unsigned short*nl_=A.LIST+((size_t)nbh*32+nj)*LISTCAP; \
      const unsigned nnf=ncf<(unsigned)(LISTCAP-PREVCAP)?ncf:(unsigned)(LISTCAP-PREVCAP), nnp=ncp<(unsigned)PREVCAP?ncp:(unsigned)PREVCAP; \
      const unsigned ngp=(nnp+31u)>>5, ngt=ngp+((nnf+31u)>>5); nxt.valid=1u; \
      if((unsigned)wid<ngt)nxt.e0=load_entry(nl_,(unsigned)wid,ngp,nnp,nnf,(unsigned)r32_); \
      if((unsigned)wid+NW<ngt)nxt.e1=load_entry(nl_,(unsigned)wid+NW,ngp,nnp,nnf,(unsigned)r32_); } }while(0)
  if((A.dbg&1)||(OWN&&(A.dbg&2))||(!OWN&&(A.dbg&4))){ PREFETCH_NEXT(); }
  else if(OWN){ attn_group<2>(bh,j,(unsigned)wid,256u,0u,q_cur,A,shm); PREFETCH_NEXT(); }
  else {
    unsigned gi=wid; bool pfd=false;
    if(gi<gt){
      bf16x8 q_nxt[4];
      for(;gi<gt;gi+=NW){
        if(gi+NW<gt)LOADQ(q_nxt,e_nxt&8191u);
        const unsigned e_nn=(gi+2*NW<gt)?load_entry(lst,gi+2*NW,gp,np,nf,(unsigned)r32_):0u;
        if(gi<gp) attn_group<1>(bh,j,gi,np,e_cur,q_cur,A,shm);
        else attn_group<0>(bh,j,gi-gp,nf,e_cur,q_cur,A,shm);
        if(!pfd){ PREFETCH_NEXT(); pfd=true; }
        e_cur=e_nxt; e_nxt=e_nn;
        #pragma unroll
        for(int d0=0;d0<4;++d0)q_cur[d0]=q_nxt[d0];
      }
    }
    if(!pfd){ PREFETCH_NEXT(); }
  }
  #undef PREFETCH_NEXT
  #undef LOADQ
  CBAR_LDS();
  if(!OWN)pend_x=bh&7;
}
__device__ __forceinline__ void flush_pending(const AB&A,int&pend_x){
  if(pend_x>=0){ CBAR_ALL(); if(threadIdx.x==0)__hip_atomic_fetch_add(A.qctl+512+64*pend_x,1u,__ATOMIC_RELAXED,__HIP_MEMORY_SCOPE_AGENT); pend_x=-1; CBAR_LDS(); }
}
__device__ __forceinline__ void moba_phase(char*lds,const AB&A){
  const int tid=threadIdx.x; volatile unsigned*uw=(volatile unsigned*)(lds+LDS_UNIT);
  const unsigned x0=xb_xcc_id()&7u; unsigned acquired=0u; int pend_x=-1;
  bool pf_valid=false; unsigned pf_k=0u; Pre cur{0u,0u,0u,0u,0u},nxt{0u,0u,0u,0u,0u};
  constexpr unsigned T=124u,QEND=T+128u;
  unsigned x=x0;
  for(;;){
    unsigned k;
    if(pf_valid&&pf_k<QEND){ k=pf_k; pf_valid=false; }
    else {
      pf_valid=false; cur.valid=0u;
      if(tid<64){
        unsigned hv=QEND; if(tid<8)hv=__hip_atomic_load(A.qctl+64*((x+(unsigned)tid)&7u),__ATOMIC_RELAXED,__HIP_MEMORY_SCOPE_AGENT);
        unsigned cand=(unsigned)__ballot(hv<QEND)&0xffu, res=0xffffffffu, rx=x;
        while(cand){
          const unsigned st=(unsigned)__builtin_ctz(cand); cand&=cand-1u;
          const unsigned xx=(x+st)&7u; unsigned k0=0u;
          if(tid==0)k0=__hip_atomic_fetch_add(A.qctl+64*xx,1u,__ATOMIC_RELAXED,__HIP_MEMORY_SCOPE_AGENT);
          k0=(unsigned)__builtin_amdgcn_readfirstlane((int)k0);
          if(k0<QEND){ res=k0; rx=xx; break; }
        }
        if(tid==0){ uw[0]=res; uw[2]=rx; }
      }
      CBAR_ALL();
      k=(unsigned)__builtin_amdgcn_readfirstlane((int)uw[0]); x=(unsigned)__builtin_amdgcn_readfirstlane((int)uw[2]);
      CBAR_LDS();
      if(k==0xffffffffu)break;
    }
    unsigned pfr=0u;
    if(tid==0)pfr=__hip_atomic_fetch_add(A.qctl+64*x,1u,__ATOMIC_RELAXED,__HIP_MEMORY_SCOPE_AGENT);
    unsigned nk=0u;
    if(k<T){ kv_unit<false>((int)x+8*(int)(k&3u),(int)(k>>2),A,lds,pend_x,pfr,cur,nxt,nk,x); }
    else {
      const unsigned ko=k-T;
      if(!((acquired>>x)&1u)){
        flush_pending(A,pend_x);
        if(tid<64){ unsigned sp=0u; __builtin_amdgcn_fence(__ATOMIC_ACQUIRE,"agent"); while(__builtin_amdgcn_readfirstlane(__hip_atomic_load(A.qctl+512+64*x,__ATOMIC_RELAXED,__HIP_MEMORY_SCOPE_AGENT))<T){ __builtin_amdgcn_s_sleep(2); if(++sp>(1u<<19))break; }
          asm volatile("s_waitcnt vmcnt(0)":::"memory"); }
        CBAR_LDS();
        acquired|=1u<<x; }
      kv_unit<true>((int)x+8*(int)(ko&3u),31-(int)(ko>>2),A,lds,pend_x,pfr,cur,nxt,nk,x);
    }
    pf_k=nk; pf_valid=true; cur=nxt;
  }
  flush_pending(A,pend_x);
}
#undef SBAR
#undef WAIT_BAR
}
constexpr int CW_WCNT = 23552, CW_WARR = 23808;
constexpr int CW_AQ = 16384, CW_CNT = 20480, CW_RT = 22592, CW_GQ = 22656, CW_GQ2 = 22720, CW_G1B = 22784, CW_FLAGS = 24576;
__device__ __forceinline__ void p0_phase(const Ptrs& P, LAS unsigned char* lds, int tid, int G, LAS unsigned* rowctr) {
    const int lane = tid & 63, wave = tid >> 6;
    const int base = (int)blockIdx.x, nrow = (MTOK - base + G - 1) / G;
#define P0_GRAB(dst) do { int r_ = 0; if (lane == 0) r_ = (int)__hip_atomic_fetch_add(rowctr, 1u, __ATOMIC_RELAXED, __HIP_MEMORY_SCOPE_WORKGROUP); dst = __builtin_amdgcn_readfirstlane(r_); } while (0)
#define P0_LOAD(V, rr) do { if ((rr) < nrow) { const f32x4* xr_ = (const f32x4*)(P.x + (size_t)(base + (rr) * G) * DM) + lane; _Pragma("unroll") for (int j = 0; j < 4; ++j) V[j] = xr_[64 * j]; } } while (0)
    int q0, q1, q2; f32x4 va[4], vb[4], vc[4];
    P0_GRAB(q0); P0_LOAD(va, q0); P0_GRAB(q1); P0_LOAD(vb, q1); P0_GRAB(q2); P0_LOAD(vc, q2);
    f32x4 wa[4][4], wb[4][4];
    {   LAS float* w8 = (LAS float*)(lds + 90112);
        for (int i = tid; i < 1024 * 8; i += 512) w8[i] = P.w_in[(size_t)(i >> 3) * NCOL + 4096 + (i & 7)];
        __syncthreads();
#pragma unroll
        for (int j = 0; j < 4; ++j)
#pragma unroll
            for (int e = 0; e < 4; ++e) { const LAS f32x4* wp = (const LAS f32x4*)(w8 + (4 * (lane + 64 * j) + e) * 8); wa[j][e] = wp[0]; wb[j][e] = wp[1]; }
    }
    f32x4 nw[4];
#pragma unroll
    for (int j = 0; j < 4; ++j) nw[j] = ((const f32x4*)P.norm_w)[lane + 64 * j];
    if (wave < 5) {
        LAS float* scr = (LAS float*)(lds + wave * 16640);
        for (int it = wave * G + (int)blockIdx.x; it < 1024 + 256; it += 5 * G) {
            const bool first = it < 1024; const int r = first ? it : it - 1024; const int kb = r & 15, pb = r >> 4;
            const float* W = first ? P.w_in : P.w_out; const int ldw = first ? NCOL : DM; bf16_t* WT = first ? P.WT1 : P.WT2;
            const int p = pb * 64 + lane; const int c = first ? wt1_logical(p) : p;
#pragma unroll 16
            for (int kk = 0; kk < 64; ++kk) scr[kk * 65 + lane] = W[(size_t)(kb * 64 + kk) * ldw + c];
            asm volatile("s_waitcnt lgkmcnt(0)" ::: "memory");
#pragma unroll 8
            for (int pp = 0; pp < 64; ++pp) WT[(size_t)(pb * 64 + pp) * 1024 + kb * 64 + lane] = f2bf(scr[lane * 65 + pp]);
            asm volatile("s_waitcnt lgkmcnt(0)" ::: "memory");
        }
    }
    auto process = [&](const f32x4 (&v)[4], const int row) {
        float ss = 0.f;
#pragma unroll
        for (int j = 0; j < 4; ++j) ss += v[j][0] * v[j][0] + v[j][1] * v[j][1] + v[j][2] * v[j][2] + v[j][3] * v[j][3];
        ss = wave_sum(ss);
        const float rstd = 1.0f / sqrtf(ss * (1.0f / DM) + EPS);
        f32x4 da = {0.f, 0.f, 0.f, 0.f}, db = {0.f, 0.f, 0.f, 0.f};
#pragma unroll
        for (int j = 0; j < 4; ++j) {
            f32x4 h = v[j] * rstd * nw[j];
            unsigned lo = (unsigned)f2bf(h[0]) | ((unsigned)f2bf(h[1]) << 16), hi = (unsigned)f2bf(h[2]) | ((unsigned)f2bf(h[3]) << 16);
            gst8(P.HN + (size_t)row * DM + 4 * (lane + 64 * j), lo, hi);
#pragma unroll
            for (int e = 0; e < 4; ++e) { da += h[e] * wa[j][e]; db += h[e] * wb[j][e]; }
        }
        float d[8];
#pragma unroll
        for (int c = 0; c < 4; ++c) { d[c] = wave_sum(da[c]); d[4 + c] = wave_sum(db[c]); }
        if (lane < 4) {
            const int hh = lane; float bd = d[0], ad = d[4];
            if (hh == 1) { bd = d[1]; ad = d[5]; } else if (hh == 2) { bd = d[2]; ad = d[6]; } else if (hh == 3) { bd = d[3]; ad = d[7]; }
            const float beta = 1.0f / (1.0f + expf(-bd));
            const float z = ad + P.dt_bias[hh];
            const float sp = fmaxf(z, 0.f) + log1pf(expf(-fabsf(z)));
            const float g = -expf(P.a_log[hh]) * sp;
            const int b = row / SEQ, s = row % SEQ;
            P.BETA[(size_t)(b * DH + hh) * SEQ + s] = beta; P.GDEC[(size_t)(b * DH + hh) * SEQ + s] = g;
        }
    };
    for (;;) {
        if (q0 >= nrow) break;
        { f32x4 v[4]; _Pragma("unroll") for (int j = 0; j < 4; ++j) v[j] = va[j]; const int row = base + q0 * G; P0_GRAB(q0); P0_LOAD(va, q0); process(v, row); }
        if (q1 >= nrow) break;
        { f32x4 v[4]; _Pragma("unroll") for (int j = 0; j < 4; ++j) v[j] = vb[j]; const int row = base + q1 * G; P0_GRAB(q1); P0_LOAD(vb, q1); process(v, row); }
        if (q2 >= nrow) break;
        { f32x4 v[4]; _Pragma("unroll") for (int j = 0; j < 4; ++j) v[j] = vc[j]; const int row = base + q2 * G; P0_GRAB(q2); P0_LOAD(vc, q2); process(v, row); }
    }
#undef P0_LOAD
#undef P0_GRAB
    __syncthreads();
}

struct Args { const float* in[11]; float* out; unsigned char* ws; int ph_lo, ph_hi, qoff, li; };
__global__ void __launch_bounds__(NWAVES * 64, 2) mega(Args args) {
    extern __shared__ __attribute__((aligned(16))) unsigned char lds_raw[];
    LAS unsigned char* lds = (LAS unsigned char*)lds_raw;
    const int tid = threadIdx.x, G = gridDim.x;
    void* din[11];
#pragma unroll
    for (int i = 0; i < 11; ++i) din[i] = (void*)args.in[i];
    const Ptrs P = make_ptrs(din, args.out, args.ws);
    volatile LAS unsigned* MISC = (volatile LAS unsigned*)(lds + MISC_OFF);
    for (int u = tid; u < (LDS_BYTES - LDSCTL_OFF) / 4; u += NWAVES * 64) ((LAS unsigned*)(lds + LDSCTL_OFF))[u] = 0u;
    __syncthreads();
    XcdBarrier bar = xcd_barrier_post(P.ctl + CW_BAR + args.li * XCD_BAR_WORDS, MISC + 8);
    if (tid == 0 && blockIdx.x >= 16 && args.ph_lo == 0) (void)xb_add(P.ctl + CW_WCNT + 16 * xb_xcc_id(), 1u);
    const int lo = args.ph_lo, hi = args.ph_hi;
#define IN(k) (lo <= (k) && (k) < hi)
#define BOTH(k) (IN(k) && IN((k) + 1))
    if (IN(0)) { p0_phase(P, lds, tid, G, (LAS unsigned*)(lds + MISC_OFF) + 32); if (BOTH(0)) xcd_barrier(bar); }
    if (IN(1)) {
        pg8::Gemm g{P.HN, P.WT1 + (size_t)2048 * DM, MTOK, 2048, DM}; pg8::StaticOrder S; S.init(MTOK, 2048, G, (int)blockIdx.x);
        pg8::EpiProj E{P.QA, P.KA, P.VA, P.ZA, P.ZD, P.QKVD, P.KMEAN, P.qnw, P.knw, 8, lds + pg8::STAGE_BYTES};
        pg8::gemm_phase<pg8::EpiProj, pg8::StaticOrder, true, true>(lds + RING_OFF, g, S, E);
        if (BOTH(1)) xcd_barrier(bar);
    }
#define GEMM1B_AND_PUBLISH() do{ \
                pg8::Gemm g{P.HN, P.WT1, MTOK, 2048, DM}; pg8::StaticOrder S; S.init(MTOK, 2048, G - 16, (int)blockIdx.x - 16); \
                pg8::EpiProj E{P.QA, P.KA, P.VA, P.ZA, P.ZD, P.QKVD, P.KMEAN, P.qnw, P.knw, 0, lds + pg8::STAGE_BYTES}; \
                pg8::gemm_phase<pg8::EpiProj, pg8::StaticOrder, true, true>(lds + RING_OFF, g, S, E); \
                CBAR_ALL();                                \
                if (tid == 0) {                            \
                    const unsigned xw_ = xb_xcc_id(); const unsigned nw_ = __hip_atomic_load(P.ctl + CW_WCNT + 16 * xw_, __ATOMIC_RELAXED, __HIP_MEMORY_SCOPE_AGENT); \
                    const unsigned ow_ = __hip_atomic_fetch_add(P.ctl + CW_WARR + 16 * xw_, 1u, __ATOMIC_RELAXED, __HIP_MEMORY_SCOPE_AGENT); \
                    if (ow_ + 1u == nw_) { __builtin_amdgcn_fence(__ATOMIC_RELEASE, "agent"); asm volatile("s_waitcnt vmcnt(0)" ::: "memory"); \
                        __hip_atomic_fetch_add(P.ctl + CW_G1B, nw_, __ATOMIC_RELAXED, __HIP_MEMORY_SCOPE_AGENT); } } \
                CBAR_LDS(); }while(0)
    if (IN(2)) {
        const int dq = args.qoff;
        const moba::AB A{(dq >> 4) & 7, P.QA, P.KA, P.VA, P.KMEAN, P.rel_bias, P.ZA, P.Y, P.SEL, P.LIST, P.ctl + CW_CNT, P.OPART, P.LP, P.ctl + CW_AQ + (dq & ~255)};
        if (blockIdx.x < 16) {
            if (!(dq & 1)) {
                dn::scan_head<0>((int)blockIdx.x, P.REC, P.GLB, P.dnw, P.ZD, (dq & 12) ? (bf16_t*)P.QKVD : P.Y, P.ctl + CW_FLAGS, (char*)lds_raw, dq & 12); }
        } else if (!(dq & 128)) {
            volatile LAS unsigned* qw = MISC + 16;
            bool first_item = true; int pend0 = -1, pend1 = -1, carry = (int)blockIdx.x - 16;
#define PREP_LOOP(LIMIT) for (;;) { \
                unsigned k; \
                if (carry >= 0 || kn_valid) { k = carry >= 0 ? (unsigned)carry : knext; carry = -1; kn_valid = false; }        \
                else { \
                    if (tid == 0) { const unsigned k0 = __hip_atomic_fetch_add(P.ctl + CW_GQ, 1u, __ATOMIC_RELAXED, __HIP_MEMORY_SCOPE_AGENT) + (unsigned)(G - 16); qw[0] = k0; } \
                    CBAR_ALL(); \
                    k = (unsigned)__builtin_amdgcn_readfirstlane((int)qw[0]); \
                    CBAR_LDS(); \
                } \
                if (k >= 1152u || k >= (LIMIT)) {                                  \
                    CBAR_ALL(); \
                    if (pend0 >= 0) { if (tid == 0) { __hip_atomic_store(P.ctl + CW_FLAGS + pend0, 1u, __ATOMIC_RELAXED, __HIP_MEMORY_SCOPE_AGENT); if (pend1 >= 0) __hip_atomic_store(P.ctl + CW_FLAGS + pend1, 1u, __ATOMIC_RELAXED, __HIP_MEMORY_SCOPE_AGENT); } pend0 = -1; } \
                    CBAR_LDS(); \
                    if (k < 1152u) carry = (int)k; \
                    break; } \
                unsigned pfk = 0u; \
                if (tid == 0) pfk = __hip_atomic_fetch_add(P.ctl + CW_GQ, 1u, __ATOMIC_RELAXED, __HIP_MEMORY_SCOPE_AGENT) + (unsigned)(G - 16);        \
                const int pub0 = pend0, pub1 = pend1;                              \
                pend0 = dn::prep_item_chunk(k, 0); pend1 = k < 256u ? -1 : dn::prep_item_chunk(k, 1); \
                if (have_rows) { _Pragma("unroll") for (int p_ = 0; p_ < 3; ++p_) _Pragma("unroll") for (int r_ = 0; r_ < 11; ++r_) xa[p_][r_] = xn[p_][r_]; } \
                else dn::prep_load(pend0, P.QKVD, xa); \
                if (pend1 >= 0) dn::prep_load(pend1, P.QKVD, xb);                  \
                const dn::PrepNext pn_{qw, pfk, P.QKVD, (LIMIT)}; \
                if (pend1 >= 0) { \
                    dn::prep_chunk<false>(pend0, xa, P.conv_w, P.BETA, P.GDEC, P.REC + (size_t)pend0 * dn::REC_BYTES, P.GLB, P.ctl + CW_FLAGS, lds, pn_, xn, knext, pub0, pub1); \
                    dn::prep_chunk<true>(pend1, xb, P.conv_w, P.BETA, P.GDEC, P.REC + (size_t)pend1 * dn::REC_BYTES, P.GLB, P.ctl + CW_FLAGS, lds, pn_, xn, knext, -1, -1); \
                } else dn::prep_chunk<true>(pend0, xa, P.conv_w, P.BETA, P.GDEC, P.REC + (size_t)pend0 * dn::REC_BYTES, P.GLB, P.ctl + CW_FLAGS, lds, pn_, xn, knext, pub0, pub1); \
                kn_valid = true; have_rows = knext < (LIMIT); \
                if (first_item) {                                                   \
                    first_item = false; CBAR_ALL(); \
                    if (tid == 0) { __hip_atomic_store(P.ctl + CW_FLAGS + pend0, 1u, __ATOMIC_RELAXED, __HIP_MEMORY_SCOPE_AGENT); if (pend1 >= 0) __hip_atomic_store(P.ctl + CW_FLAGS + pend1, 1u, __ATOMIC_RELAXED, __HIP_MEMORY_SCOPE_AGENT); } \
                    pend0 = -1; CBAR_LDS(); } \
            }
            { unsigned knext = 0u; bool kn_valid = false, have_rows = false; unsigned xa[3][11], xb[3][11], xn[3][11];
            PREP_LOOP(640u)
            }
            GEMM1B_AND_PUBLISH();
            { unsigned knext = 0u; bool kn_valid = false, have_rows = false; unsigned xa[3][11], xb[3][11], xn[3][11];
            PREP_LOOP(1152u)
            }
#undef PREP_LOOP
            if (tid < 64) { unsigned sp = 0u;
                __builtin_amdgcn_fence(__ATOMIC_ACQUIRE, "agent");     while (__builtin_amdgcn_readfirstlane(__hip_atomic_load(P.ctl + CW_G1B, __ATOMIC_RELAXED, __HIP_MEMORY_SCOPE_AGENT)) < (unsigned)(G - 16)) { __builtin_amdgcn_s_sleep(8); if (++sp > (1u << 17)) break; }
                asm volatile("s_waitcnt vmcnt(0)" ::: "memory"); }
            CBAR_LDS();
            for (;;) {
                if (tid == 0) { const unsigned k = __hip_atomic_fetch_add(P.ctl + CW_GQ2, 1u, __ATOMIC_RELAXED, __HIP_MEMORY_SCOPE_AGENT); qw[0] = k; }
                CBAR_ALL();
                const unsigned k = (unsigned)__builtin_amdgcn_readfirstlane((int)qw[0]);
                CBAR_LDS();
                if (k >= 448u) break;
                const unsigned it0 = k < 192u ? 4u * k : 576u + k, itn = k < 192u ? 4u : 1u;
                {   unsigned sel = moba::route_gate((int)(it0 >> 5), (int)(it0 & 31u), A);
#pragma unroll 1
                    for (unsigned i4 = 0; i4 < itn; ++i4) { const unsigned it = it0 + i4; moba::RouteSt st;
                        moba::route_count((int)(it >> 5), (int)(it & 31u), sel, A, st);
                        if (i4 + 1u < itn) sel = moba::route_gate((int)((it + 1u) >> 5), (int)((it + 1u) & 31u), A);
                        moba::route_append((int)(it >> 5), (int)(it & 31u), A, st); } }
                CBAR_ALL();
                if (tid == 0) __hip_atomic_fetch_add(P.ctl + CW_RT, itn, __ATOMIC_RELAXED, __HIP_MEMORY_SCOPE_AGENT);
                CBAR_LDS();
            }
        }
        if (!(dq & 2)) {
            if (tid < 64) { unsigned sp = 0u;
                __builtin_amdgcn_fence(__ATOMIC_ACQUIRE, "agent");     while (__builtin_amdgcn_readfirstlane(__hip_atomic_load(P.ctl + CW_RT, __ATOMIC_RELAXED, __HIP_MEMORY_SCOPE_AGENT)) < 1024u) { __builtin_amdgcn_s_sleep(8); if (++sp > (1u << 17)) break; }
                asm volatile("s_waitcnt vmcnt(0)" ::: "memory"); }
            CBAR_LDS();
            moba::moba_phase((char*)lds_raw, A);
        }
        if (IN(5)) xcd_barrier(bar);
    }
    if (IN(5)) {
        pg8::Gemm g{P.Y, P.WT2, MTOK, DM, DM}; pg8::StaticOrder S; S.init(MTOK, DM, G, (int)blockIdx.x);
        pg8::EpiOut E{P.x, P.out, lds + pg8::STAGE_BYTES};
        pg8::gemm_phase<pg8::EpiOut, pg8::StaticOrder, true, true>(lds + RING_OFF, g, S, E);
    }
#undef IN
#undef BOTH
}

extern "C" void kernel_launch(void* const* d_in, const int* in_sizes, int n_in, void* d_out, int out_size, void* d_ws, size_t ws_size, hipStream_t stream) {
    static int grid = 0;
    if (grid == 0) {
        if (n_in != 11 || ws_size < WS_END) { fprintf(stderr, "kernel_launch: unexpected inputs / workspace (%d, %zu)\n", n_in, ws_size); grid = -1; return; }
        int dev = 0, cus = 0;
        if (hipGetDevice(&dev) != hipSuccess || hipDeviceGetAttribute(&cus, hipDeviceAttributeMultiprocessorCount, dev) != hipSuccess) { grid = -1; return; }
        if (hipFuncSetAttribute((const void*)mega, hipFuncAttributeMaxDynamicSharedMemorySize, LDS_BYTES) != hipSuccess) { fprintf(stderr, "kernel_launch: hipFuncSetAttribute failed\n"); grid = -1; return; }
        grid = cus;
    }
    if (grid < 0) return;
    unsigned char* ws = (unsigned char*)d_ws;
    const Ptrs P = make_ptrs(d_in, d_out, ws);
    (void)hipMemsetAsync(ws + WS_CTL, 0, CTL_BYTES, stream);
    Args a{};
    for (int i = 0; i < 11; ++i) a.in[i] = (const float*)d_in[i];
    a.out = (float*)d_out; a.ws = ws;
    a.ph_lo = 0; a.ph_hi = 6;
    hipLaunchKernelGGL(mega, dim3(grid), dim3(NWAVES * 64), LDS_BYTES, stream, a);
}
```
